# Optimizing an MI355X kernel written in HIP

```python
import math
import jax, jax.numpy as jnp
from jax import lax
import numpy as np

D_MODEL = 1024
BATCH = 32
SEQ = 2048
DEPTH = 4
DEC_BATCH = 32
DEC_SEQ = 64
PAST_LEN = 4096

CHUNK = 64
N_LEFT_CHUNKS = 8
WIN = N_LEFT_CHUNKS * CHUNK
BAND = WIN + CHUNK
N_HEADS = 16
HEAD_DIM = D_MODEL // N_HEADS
REL_CLIP = 256
SSM_EXPAND = 2
D_INNER = SSM_EXPAND * D_MODEL
SSM_HEAD_DIM = 64
SSM_HEADS = D_INNER // SSM_HEAD_DIM
SSM_GROUPS = 8
HEADS_PER_GROUP = SSM_HEADS // SSM_GROUPS
D_STATE = 128
CONV_WIDTH = 4
CONV_CH = D_INNER + 2 * SSM_GROUPS * D_STATE
SSD_CHUNK = 64
D_FF = 4 * D_MODEL
N_ATT_LAYERS = (DEPTH + 1) // 2
N_SSM_LAYERS = DEPTH // 2
ALPHA = (2 * DEPTH) ** 0.25
BETA = (8 * DEPTH) ** -0.25
LN_EPS = 1e-5
RMS_EPS = 1e-5
NEG_INF = -1e30

kernel_name = "hybrid_chunkband_attn_mamba2_deepnorm_stream_step"


def _layer_norm(x, g, b):
    xf = x.astype(jnp.float32)
    mu = jnp.mean(xf, axis=-1, keepdims=True)
    var = jnp.mean(jnp.square(xf - mu), axis=-1, keepdims=True)
    return ((xf - mu) * lax.rsqrt(var + LN_EPS) * g + b).astype(x.dtype)


def _band_attention(q, k, v, k_past, v_past, rel_table):
    bsz, t = q.shape[0], q.shape[1]
    p = k_past.shape[1]
    n_chunks = -(-t // CHUNK)
    pad_new = n_chunks * CHUNK - t
    qp = jnp.pad(q, ((0, 0), (0, pad_new), (0, 0), (0, 0)))
    kv_pad = ((0, 0), (WIN - p, pad_new), (0, 0), (0, 0))
    kbuf = jnp.pad(jnp.concatenate([k_past.astype(k.dtype), k], axis=1), kv_pad)
    vbuf = jnp.pad(jnp.concatenate([v_past.astype(v.dtype), v], axis=1), kv_pad)
    j = jnp.arange(BAND)
    r = jnp.arange(CHUNK)
    rel = jnp.clip(WIN + r[:, None] - j[None, :], -REL_CLIP, REL_CLIP) + REL_CLIP
    bias = rel_table[:, rel].astype(jnp.float32)
    scale = HEAD_DIM ** -0.5

    def one_chunk(c):
        start = c * CHUNK
        qc = lax.dynamic_slice_in_dim(qp, start, CHUNK, axis=1)
        kc = lax.dynamic_slice_in_dim(kbuf, start, BAND, axis=1)
        vc = lax.dynamic_slice_in_dim(vbuf, start, BAND, axis=1)
        s = jnp.einsum('bqhd,bkhd->bhqk', qc, kc).astype(jnp.float32) * scale + bias
        kidx = start + j
        valid = (kidx >= WIN - p) & (kidx < WIN + t)
        s = jnp.where(valid, s, NEG_INF)
        w = jax.nn.softmax(s, axis=-1).astype(vc.dtype)
        return jnp.einsum('bhqk,bkhd->bqhd', w, vc)

    out = lax.map(one_chunk, jnp.arange(n_chunks))
    out = jnp.moveaxis(out, 0, 1).reshape(bsz, n_chunks * CHUNK, N_HEADS, HEAD_DIM)
    return out[:, :t]


def _attention_mixer(x, k_past, v_past, w_qkv, rel_table, w_o):
    bsz, t, _ = x.shape
    qkv = (x @ w_qkv).reshape(bsz, t, 3, N_HEADS, HEAD_DIM)
    q, k, v = qkv[:, :, 0], qkv[:, :, 1], qkv[:, :, 2]
    o = _band_attention(q, k, v, k_past, v_past, rel_table)
    return (o.reshape(bsz, t, D_MODEL) @ w_o).astype(x.dtype), k, v


def _ssd_scan(xs, dt, a, bm, cm, h0):
    bsz, t = xs.shape[0], xs.shape[1]
    n_chunks = -(-t // SSD_CHUNK)
    pad = n_chunks * SSD_CHUNK - t

    def to_chunks(u):
        u = jnp.pad(u, [(0, 0), (0, pad)] + [(0, 0)] * (u.ndim - 2))
        u = u.reshape((bsz, n_chunks, SSD_CHUNK) + u.shape[2:])
        return jnp.moveaxis(u, 1, 0)

    causal = jnp.tril(jnp.ones((SSD_CHUNK, SSD_CHUNK), dtype=bool))

    def step(h, inp):
        xc, dtc, bc, cc = inp
        cum = jnp.cumsum(dtc * a, axis=1)
        seg = cum[:, :, None] - cum[:, None, :]
        decay = jnp.exp(jnp.where(causal[None, :, :, None, None], seg, -jnp.inf))
        cb = jnp.einsum('btgn,bsgn->btsg', cc, bc)
        y = jnp.einsum('btsg,btsgr,bsgr,bsgrp->btgrp', cb, decay, dtc, xc)
        y = y + jnp.einsum('btgn,bgrpn->btgrp', cc, h) * jnp.exp(cum)[..., None]
        last = cum[:, -1]
        w_in = jnp.exp(last[:, None] - cum) * dtc
        h = h * jnp.exp(last)[..., None, None] + jnp.einsum('bsgn,bsgr,bsgrp->bgrpn', bc, w_in, xc)
        return h, y

    h, ys = lax.scan(step, h0, (to_chunks(xs), to_chunks(dt), to_chunks(bm), to_chunks(cm)))
    y = jnp.moveaxis(ys, 0, 1).reshape((bsz, n_chunks * SSD_CHUNK) + xs.shape[2:])[:, :t]
    return y, h


def _ssm_mixer(x, conv_state, ssm_state, w_in, conv_w, conv_b, dt_bias, a_log, d_skip, norm_w, w_out):
    bsz, t, _ = x.shape
    g, r, p, n = SSM_GROUPS, HEADS_PER_GROUP, SSM_HEAD_DIM, D_STATE
    proj = x @ w_in
    z = proj[..., :D_INNER]
    xbc = proj[..., D_INNER:D_INNER + CONV_CH]
    dt_raw = proj[..., D_INNER + CONV_CH:]
    xpad = jnp.concatenate([conv_state.astype(xbc.dtype), xbc], axis=1)
    conv = conv_b
    for kk in range(CONV_WIDTH):
        conv = conv + xpad[:, kk:kk + t] * conv_w[kk]
    new_conv = xpad[:, -(CONV_WIDTH - 1):]
    xbc = jax.nn.silu(conv)
    xs = xbc[..., :D_INNER].reshape(bsz, t, g, r, p)
    bm = xbc[..., D_INNER:D_INNER + g * n].reshape(bsz, t, g, n)
    cm = xbc[..., D_INNER + g * n:].reshape(bsz, t, g, n)
    dt = jax.nn.softplus((dt_raw + dt_bias).astype(jnp.float32)).reshape(bsz, t, g, r)
    a = -jnp.exp(a_log.astype(jnp.float32)).reshape(g, r)
    h0 = ssm_state.reshape(bsz, g, r, p, n).astype(jnp.float32)
    y, h = _ssd_scan(xs, dt, a, bm, cm, h0)
    y = y + d_skip.reshape(g, r)[..., None] * xs
    y = y.reshape(bsz, t, D_INNER) * jax.nn.silu(z.astype(jnp.float32))
    yg = y.reshape(bsz, t, g, D_INNER // g)
    yg = yg * lax.rsqrt(jnp.mean(jnp.square(yg), axis=-1, keepdims=True) + RMS_EPS)
    y = (yg.reshape(bsz, t, D_INNER) * norm_w).astype(x.dtype)
    return (y @ w_out).astype(x.dtype), new_conv, h.reshape(bsz, SSM_HEADS, SSM_HEAD_DIM, D_STATE)


def _mlp(x, w_up, w_down):
    return (jnp.square(jax.nn.relu(x @ w_up)) @ w_down).astype(x.dtype)


def setup_inputs(seed: int = 0) -> dict:
    key = jax.random.key(seed)
    ks = jax.random.split(key, 24)
    att_cache = min(WIN, PAST_LEN)

    def nrm(k, shape, s):
        return jax.random.normal(k, shape, jnp.float32) * s

    dt0 = jnp.exp(jax.random.uniform(ks[12], (N_SSM_LAYERS, SSM_HEADS), jnp.float32,
                                     math.log(1e-3), math.log(1e-1)))
    return {
        'x_prompt': nrm(ks[0], (BATCH, SEQ, D_MODEL), 1.0),
        'x_sample': nrm(ks[1], (DEC_BATCH, DEC_SEQ, D_MODEL), 1.0),
        'cache_k': nrm(ks[2], (N_ATT_LAYERS, DEC_BATCH, att_cache, N_HEADS, HEAD_DIM), 1.0),
        'cache_v': nrm(ks[3], (N_ATT_LAYERS, DEC_BATCH, att_cache, N_HEADS, HEAD_DIM), 1.0),
        'state_ssm': nrm(ks[4], (N_SSM_LAYERS, DEC_BATCH, SSM_HEADS, SSM_HEAD_DIM, D_STATE), 0.1),
        'state_conv': nrm(ks[5], (N_SSM_LAYERS, DEC_BATCH, CONV_WIDTH - 1, CONV_CH), 1.0),
        'w_qkv': nrm(ks[6], (N_ATT_LAYERS, D_MODEL, 3 * D_MODEL), D_MODEL ** -0.5),
        'rel_bias': nrm(ks[7], (N_ATT_LAYERS, N_HEADS, 2 * REL_CLIP + 1), 0.5),
        'w_attn_out': nrm(ks[8], (N_ATT_LAYERS, D_MODEL, D_MODEL), BETA * D_MODEL ** -0.5),
        'w_ssm_in': nrm(ks[9], (N_SSM_LAYERS, D_MODEL, D_INNER + CONV_CH + SSM_HEADS), D_MODEL ** -0.5),
        'conv_w': nrm(ks[10], (N_SSM_LAYERS, CONV_WIDTH, CONV_CH), CONV_WIDTH ** -0.5),
        'conv_b': nrm(ks[11], (N_SSM_LAYERS, CONV_CH), 0.02),
        'dt_bias': dt0 + jnp.log(-jnp.expm1(-dt0)),
        'a_log': jnp.log(jax.random.uniform(ks[13], (N_SSM_LAYERS, SSM_HEADS), jnp.float32, 1.0, 16.0)),
        'd_skip': 1.0 + nrm(ks[14], (N_SSM_LAYERS, SSM_HEADS), 0.1),
        'ssm_norm_w': 1.0 + nrm(ks[15], (N_SSM_LAYERS, D_INNER), 0.05),
        'w_ssm_out': nrm(ks[16], (N_SSM_LAYERS, D_INNER, D_MODEL), BETA * D_INNER ** -0.5),
        'ln_mix_g': 1.0 + nrm(ks[17], (DEPTH, D_MODEL), 0.05),
        'ln_mix_b': nrm(ks[18], (DEPTH, D_MODEL), 0.02),
        'w_ff_up': nrm(ks[19], (DEPTH, D_MODEL, D_FF), D_MODEL ** -0.5),
        'w_ff_down': nrm(ks[20], (DEPTH, D_FF, D_MODEL), BETA * D_FF ** -0.5),
        'ln_ff_g': 1.0 + nrm(ks[21], (DEPTH, D_MODEL), 0.05),
        'ln_ff_b': nrm(ks[22], (DEPTH, D_MODEL), 0.02),
    }


def reference(x_prompt, x_sample, cache_k, cache_v, state_ssm, state_conv,
              w_qkv, rel_bias, w_attn_out, w_ssm_in, conv_w, conv_b, dt_bias, a_log,
              d_skip, ssm_norm_w, w_ssm_out, ln_mix_g, ln_mix_b, w_ff_up, w_ff_down,
              ln_ff_g, ln_ff_b):
    bp = x_prompt.shape[0]
    keep = min(WIN, x_prompt.shape[1])
    xp, xs = x_prompt, x_sample
    kp_l, vp_l, ks_l, vs_l = [], [], [], []
    hp_l, cp_l, hs_l, cs_l = [], [], [], []
    for i in range(DEPTH):
        if i % 2 == 0:
            li = i // 2
            empty = jnp.zeros((bp, 0, N_HEADS, HEAD_DIM), xp.dtype)
            mp, kp, vp = _attention_mixer(xp, empty, empty, w_qkv[li], rel_bias[li], w_attn_out[li])
            ms, ksm, vsm = _attention_mixer(xs, cache_k[li], cache_v[li], w_qkv[li], rel_bias[li], w_attn_out[li])
            kp_l.append(kp[:, -keep:]); vp_l.append(vp[:, -keep:])
            ks_l.append(ksm); vs_l.append(vsm)
        else:
            li = i // 2
            args = (w_ssm_in[li], conv_w[li], conv_b[li], dt_bias[li], a_log[li], d_skip[li],
                    ssm_norm_w[li], w_ssm_out[li])
            conv0 = jnp.zeros((bp, CONV_WIDTH - 1, CONV_CH), xp.dtype)
            h00 = jnp.zeros((bp, SSM_HEADS, SSM_HEAD_DIM, D_STATE), jnp.float32)
            mp, cp, hp = _ssm_mixer(xp, conv0, h00, *args)
            ms, csm, hsm = _ssm_mixer(xs, state_conv[li], state_ssm[li], *args)
            hp_l.append(hp); cp_l.append(cp)
            hs_l.append(hsm); cs_l.append(csm)
        xp = _layer_norm(ALPHA * xp + mp, ln_mix_g[i], ln_mix_b[i])
        xs = _layer_norm(ALPHA * xs + ms, ln_mix_g[i], ln_mix_b[i])
        xp = _layer_norm(ALPHA * xp + _mlp(xp, w_ff_up[i], w_ff_down[i]), ln_ff_g[i], ln_ff_b[i])
        xs = _layer_norm(ALPHA * xs + _mlp(xs, w_ff_up[i], w_ff_down[i]), ln_ff_g[i], ln_ff_b[i])
    k_prompt = jnp.stack(kp_l)
    v_prompt = jnp.stack(vp_l)
    ssm_prompt = jnp.stack(hp_l)
    conv_prompt = jnp.stack(cp_l)
    k_sample = jnp.stack(ks_l)
    v_sample = jnp.stack(vs_l)
    ssm_sample = jnp.stack(hs_l)
    conv_sample = jnp.stack(cs_l)
    return (xp, xs, k_prompt, v_prompt, ssm_prompt, conv_prompt,
            k_sample, v_sample, ssm_sample, conv_sample)
```

```cpp
#include <hip/hip_runtime.h>
#include <hip/hip_cooperative_groups.h>
#include <cstdio>
#include <cstdint>
namespace cg = cooperative_groups;
namespace pg8 {
#define PG8_LAS __attribute__((address_space(3)))
typedef unsigned short bf16_t;
typedef short bf16x8 __attribute__((ext_vector_type(8)));
typedef float f32x4 __attribute__((ext_vector_type(4)));
typedef unsigned u32x4 __attribute__((ext_vector_type(4)));
constexpr int BM = 256, BK = 64, HALF = 128, HTB = HALF * BK * 2  , STAGE_BYTES = 8 * HTB, NXCD = 8, WGM = 8;

__host__ __device__ __forceinline__ int lds_byte(int r, int c) { const int st = (r >> 4) * 2 + (c >> 5), rr = r & 15, cc = c & 31, ob = rr * 64 + cc * 2; return st * 1024 + (ob ^ (((ob >> 9) & 1) << 5)); }
__host__ __device__ __forceinline__ void stage_rc(int b, int& R, int& C) { const int st = b / 1024, sb = b % 1024, swz = sb ^ (((sb >> 9) & 1) << 5); R = (st >> 1) * 16 + swz / 64; C = (st & 1) * 32 + (swz % 64) / 2; }
__host__ __device__ __forceinline__ int perm32(int rho) { const int n = rho >> 4, i = rho & 15; return 8 * (i >> 2) + 4 * n + (i & 3); }

struct Unit { int pm, pn; };
struct Gemm { const bf16_t* A; const bf16_t* Bt; int M, N, K, lda; };

struct StaticOrder {
    int nM, nN, nwg, G, c;
    __host__ __device__ void init(int M, int N, int G_, int c_) { nM = M / BM; nN = N / BM; nwg = nM * nN; G = G_; c = c_; }
    __host__ __device__ bool next(int i, Unit& u) const {
        const long L = (long)i * G + c; if (L >= nwg) return false;
        int wgid = (int)L; { const int q = nwg / NXCD, r = nwg % NXCD, xcd = wgid % NXCD, off = wgid / NXCD; wgid = (xcd < r ? xcd * (q + 1) : r * (q + 1) + (xcd - r) * q) + off; }
        const int nig = WGM * nN, gid = wgid / nig, fm = gid * WGM, gsz = (nM - fm) < WGM ? (nM - fm) : WGM;
        u.pm = fm + ((wgid % nig) % gsz); u.pn = (wgid % nig) / gsz; return true;
    }
    __device__ __forceinline__ void a_ready(const Unit&) const {}
    __device__ __forceinline__ void done(const Unit&) const {}
};

__device__ __forceinline__ unsigned cvt_pk_bf16(float lo, float hi) { unsigned r; asm volatile("v_cvt_pk_bf16_f32 %0, %1, %2" : "=v"(r) : "v"(lo), "v"(hi)); return r; }
typedef float f32x2 __attribute__((ext_vector_type(2)));
template <class Epi, class Sched, bool ALIGN_EPI = false, bool SP2 = false>
__device__ __forceinline__ void gemm_phase(PG8_LAS unsigned char* lds, const Gemm g, const Sched& S, const Epi& E) {
    int tid_ = threadIdx.x; asm volatile("" : "+v"(tid_));
    const int tid = tid_, wid = __builtin_amdgcn_readfirstlane(tid >> 6), lane = tid & 63, wr = wid >> 2, wc = wid & 3, fr = lane & 15, fq = lane >> 4;
    const int K = g.K, nt = K / BK;
    unsigned voffA[2], voffB[2];
#pragma unroll
    for (int i = 0; i < 2; ++i) { int R, C; stage_rc(tid * 16 + i * 8192, R, C); const int Rb = Epi::PERM ? ((R & ~31) + perm32(R & 31)) : R;
        voffA[i] = (unsigned)(R * g.lda + C) * 2u; voffB[i] = (unsigned)(Rb * K + C) * 2u; }
    const size_t kstep = (size_t)(BK * 2);
    const size_t hstepA = (size_t)HALF * g.lda * 2, hstepB = (size_t)HALF * K * 2;
    const size_t tstepA = 2 * hstepA, tstepB = 2 * hstepB;
    const unsigned ldsw = (unsigned)wid * 1024u;
    const int aoff = lds_byte(wr * 64 + fr, fq * 8), boff = lds_byte(wc * 32 + fr, fq * 8);
#define PG8_SA(b, h) (((b) * 2 + (h)) * HTB)
#define PG8_SB(b, h) ((4 + (b) * 2 + (h)) * HTB)
#define PG8_STAGE(bufoff, gbase, voff) do { _Pragma("unroll") for (int _i = 0; _i < 2; ++_i) \
        __builtin_amdgcn_global_load_lds((const unsigned*)((const char*)(gbase) + (voff)[_i]), (PG8_LAS unsigned*)(lds + (bufoff) + ldsw + _i * 8192), 16, 0, 0); } while (0)
#define PG8_LDA(dst, b, h) do { _Pragma("unroll") for (int m = 0; m < 4; ++m) _Pragma("unroll") for (int k = 0; k < 2; ++k) dst[m][k] = *(const PG8_LAS bf16x8*)(lds + PG8_SA(b, h) + aoff + m * 2048 + k * 1024); } while (0)
#define PG8_LDB(dst, b, h) do { _Pragma("unroll") for (int n = 0; n < 2; ++n) _Pragma("unroll") for (int k = 0; k < 2; ++k) dst[n][k] = *(const PG8_LAS bf16x8*)(lds + PG8_SB(b, h) + boff + n * 2048 + k * 1024); } while (0)
#define PG8_MMA(ai, bj, At, Bt) do { __builtin_amdgcn_s_setprio(1); _Pragma("unroll") for (int m = 0; m < 4; ++m) _Pragma("unroll") for (int n = 0; n < 2; ++n) _Pragma("unroll") for (int k = 0; k < 2; ++k) \
        acc[ai][bj][m][n] = __builtin_amdgcn_mfma_f32_16x16x32_bf16(Bt[n][k], At[m][k], acc[ai][bj][m][n], 0, 0, 0); __builtin_amdgcn_s_setprio(0); } while (0)
#define PG8_WAIT_V(n) asm volatile("s_waitcnt vmcnt(" #n ")" ::: "memory")
#define PG8_WAIT_L(n) asm volatile("s_waitcnt lgkmcnt(" #n ")" ::: "memory")
#define PG8_BAR __builtin_amdgcn_s_barrier()
#define PG8_SCHED __builtin_amdgcn_sched_barrier(0)
    Unit cur, nxt; int ui = 0;
    if (!S.next(0, cur)) return;
    f32x4 acc[2][2][4][2];
#pragma unroll
    for (int a = 0; a < 2; ++a)
#pragma unroll
        for (int b = 0; b < 2; ++b)
#pragma unroll
            for (int m = 0; m < 4; ++m)
#pragma unroll
                for (int n = 0; n < 2; ++n) acc[a][b][m][n] = (f32x4){0.f, 0.f, 0.f, 0.f};
    bf16x8 At[4][2], B0[2][2], B1[2][2];
    const char* cA = (const char*)g.A + (size_t)cur.pm * tstepA; const char* cB = (const char*)g.Bt + (size_t)cur.pn * tstepB;
    S.a_ready(cur);
    if constexpr (SP2) {
        PG8_STAGE(PG8_SB(0, 0), cB, voffB); PG8_STAGE(PG8_SB(0, 1), cB + hstepB, voffB); PG8_STAGE(PG8_SA(0, 0), cA, voffA); PG8_STAGE(PG8_SA(0, 1), cA + hstepA, voffA);
        if (wr == 1) PG8_BAR;
        PG8_WAIT_V(2); PG8_BAR;
        PG8_STAGE(PG8_SB(1, 0), cB + kstep, voffB); PG8_STAGE(PG8_SA(1, 0), cA + kstep, voffA); PG8_STAGE(PG8_SB(1, 1), cB + hstepB + kstep, voffB);
        PG8_WAIT_V(6); PG8_BAR;
    } else {
        PG8_STAGE(PG8_SB(0, 0), cB, voffB); PG8_STAGE(PG8_SA(0, 0), cA, voffA); PG8_STAGE(PG8_SB(0, 1), cB + hstepB, voffB); PG8_STAGE(PG8_SA(0, 1), cA + hstepA, voffA);
        if (wr == 1) PG8_BAR;
        PG8_WAIT_V(4); PG8_BAR;
        PG8_STAGE(PG8_SB(1, 0), cB + kstep, voffB); PG8_STAGE(PG8_SA(1, 0), cA + kstep, voffA); PG8_STAGE(PG8_SB(1, 1), cB + hstepB + kstep, voffB);
        PG8_WAIT_V(6); PG8_BAR;
    }
    for (;;) {
        const bool has_next = S.next(ui + 1, nxt);
        const char* nA = has_next ? (const char*)g.A + (size_t)nxt.pm * tstepA : cA; const char* nB = has_next ? (const char*)g.Bt + (size_t)nxt.pn * tstepB : cB;
        for (int t = 0; t < nt; t += 2) {
            const bool last = (t == nt - 2);
            const char* a1 = cA + (size_t)(t + 1) * kstep;
            const char* a2 = last ? nA : cA + (size_t)(t + 2) * kstep; const char* b2 = last ? nB : cB + (size_t)(t + 2) * kstep;
            const char* a3 = a2 + kstep; const char* b3 = b2 + kstep;
            if (last && has_next) S.a_ready(nxt);
            if constexpr (SP2) {
            PG8_LDB(B0, 0, 0); PG8_LDB(B1, 0, 1); PG8_SCHED; PG8_LDA(At, 0, 0); PG8_STAGE(PG8_SA(1, 1), a1 + hstepA, voffA);
            PG8_WAIT_V(8); PG8_WAIT_L(0); PG8_BAR; PG8_MMA(0, 0, At, B0); PG8_MMA(0, 1, At, B1); PG8_BAR; PG8_SCHED;
            PG8_LDA(At, 0, 1); PG8_STAGE(PG8_SB(0, 0), b2, voffB); PG8_STAGE(PG8_SB(0, 1), b2 + hstepB, voffB); PG8_STAGE(PG8_SA(0, 0), a2, voffA);
            PG8_WAIT_V(8); PG8_WAIT_L(0); PG8_BAR; PG8_MMA(1, 0, At, B0); PG8_MMA(1, 1, At, B1); PG8_BAR; PG8_SCHED;
            PG8_LDB(B0, 1, 0); PG8_LDB(B1, 1, 1); PG8_SCHED; PG8_LDA(At, 1, 0); PG8_STAGE(PG8_SA(0, 1), a2 + hstepA, voffA);
            PG8_WAIT_V(8); PG8_WAIT_L(0); PG8_BAR; PG8_MMA(0, 0, At, B0); PG8_MMA(0, 1, At, B1); PG8_BAR; PG8_SCHED;
            PG8_LDA(At, 1, 1); PG8_STAGE(PG8_SB(1, 0), b3, voffB); PG8_STAGE(PG8_SB(1, 1), b3 + hstepB, voffB); PG8_STAGE(PG8_SA(1, 0), a3, voffA);
            PG8_WAIT_V(8); PG8_WAIT_L(0); PG8_BAR; PG8_MMA(1, 0, At, B0); PG8_MMA(1, 1, At, B1); PG8_BAR; PG8_SCHED;
            } else {
            PG8_LDB(B0, 0, 0); PG8_SCHED; PG8_LDA(At, 0, 0); PG8_STAGE(PG8_SA(1, 1), a1 + hstepA, voffA);
            PG8_WAIT_L(8); PG8_BAR; PG8_WAIT_L(0); PG8_MMA(0, 0, At, B0); PG8_BAR; PG8_SCHED;
            PG8_LDB(B1, 0, 1); PG8_STAGE(PG8_SB(0, 0), b2, voffB);
            PG8_BAR; PG8_WAIT_L(0); PG8_MMA(0, 1, At, B1); PG8_BAR;
            PG8_LDA(At, 0, 1); PG8_STAGE(PG8_SA(0, 0), a2, voffA);
            PG8_BAR; PG8_WAIT_L(0); PG8_MMA(1, 0, At, B0); PG8_BAR; PG8_SCHED;
            PG8_STAGE(PG8_SB(0, 1), b2 + hstepB, voffB);
            PG8_WAIT_V(6); PG8_BAR; PG8_MMA(1, 1, At, B1); PG8_BAR;
            PG8_LDB(B0, 1, 0); PG8_SCHED; PG8_LDA(At, 1, 0); PG8_STAGE(PG8_SA(0, 1), a2 + hstepA, voffA);
            PG8_WAIT_L(8); PG8_BAR; PG8_WAIT_L(0); PG8_MMA(0, 0, At, B0); PG8_BAR; PG8_SCHED;
            PG8_LDB(B1, 1, 1); PG8_STAGE(PG8_SB(1, 0), b3, voffB);
            PG8_BAR; PG8_WAIT_L(0); PG8_MMA(0, 1, At, B1); PG8_BAR;
            PG8_LDA(At, 1, 1); PG8_STAGE(PG8_SA(1, 0), a3, voffA);
            PG8_BAR; PG8_WAIT_L(0); PG8_MMA(1, 0, At, B0); PG8_BAR; PG8_SCHED;
            PG8_STAGE(PG8_SB(1, 1), b3 + hstepB, voffB);
            PG8_WAIT_V(6); PG8_BAR; PG8_MMA(1, 1, At, B1); PG8_BAR;
            }
        }
        if constexpr (ALIGN_EPI) { if (wr == 0) PG8_BAR; }
        if constexpr (!Epi::AFTER_DRAIN) { E(acc, cur, wr, wc, fr, fq); S.done(cur); }
        if (!has_next) break;
#pragma unroll
        for (int a = 0; a < 2; ++a)
#pragma unroll
            for (int b = 0; b < 2; ++b)
#pragma unroll
                for (int m = 0; m < 4; ++m)
#pragma unroll
                    for (int n = 0; n < 2; ++n) acc[a][b][m][n] = (f32x4){0.f, 0.f, 0.f, 0.f};
        cur = nxt; cA = nA; cB = nB; ++ui;
        if constexpr (ALIGN_EPI) { if (wr == 1) PG8_BAR; }
    }
    PG8_WAIT_V(0);
    if constexpr (!ALIGN_EPI) { if (wr == 0) PG8_BAR; }
    PG8_BAR;
    if constexpr (Epi::AFTER_DRAIN) { E.fused(acc, cur, wr, wc, fr, fq, lds, wid, lane); S.done(cur); }
#undef PG8_SA
#undef PG8_SB
#undef PG8_STAGE
#undef PG8_LDA
#undef PG8_LDB
#undef PG8_MMA
#undef PG8_WAIT_V
#undef PG8_WAIT_L
#undef PG8_BAR
#undef PG8_SCHED
}
}
#define LAS __attribute__((address_space(3)))
typedef unsigned short bf16;
typedef float f32x4 __attribute__((ext_vector_type(4)));
typedef float f32x16 __attribute__((ext_vector_type(16)));
typedef short bf16x8 __attribute__((ext_vector_type(8)));
typedef short s16x4 __attribute__((ext_vector_type(4)));
typedef unsigned u32x4 __attribute__((ext_vector_type(4)));
typedef unsigned u32x2 __attribute__((ext_vector_type(2)));
typedef float f32x2_t __attribute__((ext_vector_type(2)));
typedef __bf16 bf16x2_t __attribute__((ext_vector_type(2)));

constexpr int D = 1024, MP = 65536, MS = 2048, M = MP + MS, DFF = 4096;
constexpr int LDP = 6144, NPROJ = 6176, NPROJ_PAD = 6400;
constexpr float ALPHA = 1.6817928305074290f, LN_EPS = 1e-5f, RMS_EPS = 1e-5f, LOG2E = 1.4426950408889634f;
constexpr size_t O_KP = 69206016, O_VP = 102760448, O_HP = 136314880, O_CP = 153092096, O_KS = 153878528, O_VS = 158072832, O_HS = 162267136, O_CS = 179044352;
constexpr size_t MiB = 1u << 20;
constexpr size_t WS_WA = 1 * MiB, WS_WB = 14 * MiB, WS_WUP = 18 * MiB, WS_WDN = 26 * MiB, WS_XB = 34 * MiB, WS_DT = 166 * MiB, WS_BIG = 175 * MiB;
constexpr size_t WS_O = WS_BIG + 396 * MiB, WS_CK = WS_BIG + 528 * MiB, WS_CV = WS_BIG + 560 * MiB, WS_END = WS_BIG + 792 * MiB;
constexpr int LDS_BYTES = 147456;

__device__ __forceinline__ unsigned pk2(float lo, float hi) { f32x2_t v = {lo, hi}; bf16x2_t b = __builtin_convertvector(v, bf16x2_t); return __builtin_bit_cast(unsigned, b); }
__device__ __forceinline__ float bf2f(unsigned short u) { return __uint_as_float((unsigned)u << 16); }
__device__ __forceinline__ float bflo(unsigned u) { return __uint_as_float(u << 16); }
__device__ __forceinline__ float bfhi(unsigned u) { return __uint_as_float(u & 0xffff0000u); }
__device__ __forceinline__ float fexp2(float x) { return __builtin_amdgcn_exp2f(x); }
__device__ __forceinline__ float frcp(float x) { return __builtin_amdgcn_rcpf(x); }
__device__ __forceinline__ float silu_f(float v) { return v * frcp(1.0f + fexp2(-v * LOG2E)); }
__device__ __forceinline__ int crow(int r, int hi) { return (r & 3) + 8 * (r >> 2) + 4 * hi; }
__device__ __forceinline__ bf16x8 pack8(const f32x16& x, int s) {
    u32x4 p; p.x = pk2(x[8 * s], x[8 * s + 1]); p.y = pk2(x[8 * s + 2], x[8 * s + 3]); p.z = pk2(x[8 * s + 4], x[8 * s + 5]); p.w = pk2(x[8 * s + 6], x[8 * s + 7]);
    return __builtin_bit_cast(bf16x8, p);
}
#define MFMA32(a, b, c) __builtin_amdgcn_mfma_f32_32x32x16_bf16((a), (b), (c), 0, 0, 0)
__device__ __forceinline__ float wave_sum(float v) {
#pragma unroll
    for (int o = 1; o < 64; o <<= 1) v += __shfl_xor(v, o);
    return v;
}

namespace pg8 {
struct EpiQKV {
    static constexpr bool PERM = true, AFTER_DRAIN = false;
    bf16_t* QKV; float* out; int li;
    __device__ __forceinline__ void operator()(const f32x4 (&acc)[2][2][4][2], const Unit& u, int wr, int wc, int fr, int fq) const {
        asm volatile("" : "+v"(fr));
        float* fdst = nullptr;
        if (u.pn >= 4) {
            const bool isv = u.pn >= 8;
            if (u.pm < 256) { const int b = u.pm >> 3, tt = u.pm & 7; if (tt >= 6) fdst = out + (isv ? O_VP : O_KP) + ((size_t)(li * 32 + b) * 512 + (size_t)(tt - 6) * 256) * 1024; }
            else fdst = out + (isv ? O_VS : O_KS) + ((size_t)li * 2048 + (size_t)(u.pm - 256) * 256) * 1024;
        }
        const int col0 = u.pn * BM + wc * 32 + 8 * fq, colk = (u.pn & 3) * BM + wc * 32 + 8 * fq;
#pragma unroll
        for (int ai = 0; ai < 2; ++ai)
#pragma unroll
            for (int m = 0; m < 4; ++m) { const int rl = ai * HALF + wr * 64 + m * 16 + fr; bf16_t* rowp = QKV + (unsigned)((u.pm * BM + rl) * 3072 + col0);
#pragma unroll
                for (int bj = 0; bj < 2; ++bj) { const f32x4 v0 = acc[ai][bj][m][0], v1 = acc[ai][bj][m][1];
                    u32x4 w; w.x = pk2(v0[0], v0[1]); w.y = pk2(v0[2], v0[3]); w.z = pk2(v1[0], v1[1]); w.w = pk2(v1[2], v1[3]);
                    *(u32x4*)(rowp + bj * HALF) = w;
                    if (fdst) { float* fp = fdst + (unsigned)(rl * 1024 + colk + bj * HALF); *(f32x4*)fp = v0; *(f32x4*)(fp + 4) = v1; } }
                asm volatile("" ::: "memory"); }
    }
};
struct EpiBf16Plain {
    static constexpr bool PERM = true, AFTER_DRAIN = false;
    bf16_t* O; int ldc; int relu2;
    __device__ __forceinline__ void operator()(const f32x4 (&acc)[2][2][4][2], const Unit& u, int wr, int wc, int fr, int fq) const {
        asm volatile("" : "+v"(fr));
        const int col0 = u.pn * BM + wc * 32 + 8 * fq;
#pragma unroll
        for (int ai = 0; ai < 2; ++ai)
#pragma unroll
            for (int m = 0; m < 4; ++m) { const int rl = ai * HALF + wr * 64 + m * 16 + fr; bf16_t* rowp = O + (unsigned)((u.pm * BM + rl) * ldc + col0);
#pragma unroll
                for (int bj = 0; bj < 2; ++bj) { f32x4 v0 = acc[ai][bj][m][0], v1 = acc[ai][bj][m][1];
                    if (relu2) { v0 = __builtin_elementwise_max(v0, (f32x4){0.f, 0.f, 0.f, 0.f}); v1 = __builtin_elementwise_max(v1, (f32x4){0.f, 0.f, 0.f, 0.f}); v0 = v0 * v0; v1 = v1 * v1; }
                    u32x4 w; w.x = pk2(v0[0], v0[1]); w.y = pk2(v0[2], v0[3]); w.z = pk2(v1[0], v1[1]); w.w = pk2(v1[2], v1[3]);
                    *(u32x4*)(rowp + bj * HALF) = w; } }
    }
};
struct EpiSsmIn {
    static constexpr bool PERM = true, AFTER_DRAIN = false;
    bf16_t* P; float* DT;
    __device__ __forceinline__ void operator()(const f32x4 (&acc)[2][2][4][2], const Unit& u, int wr, int wc, int fr, int fq) const {
        asm volatile("" : "+v"(fr));
        if (u.pn < 24) {
            const int col0 = u.pn * BM + wc * 32 + 8 * fq;
#pragma unroll
            for (int ai = 0; ai < 2; ++ai)
#pragma unroll
                for (int m = 0; m < 4; ++m) { const int rl = ai * HALF + wr * 64 + m * 16 + fr; bf16_t* rowp = P + (unsigned)((u.pm * BM + rl) * LDP + col0);
#pragma unroll
                    for (int bj = 0; bj < 2; ++bj) { const f32x4 v0 = acc[ai][bj][m][0], v1 = acc[ai][bj][m][1];
                        u32x4 w; w.x = pk2(v0[0], v0[1]); w.y = pk2(v0[2], v0[3]); w.z = pk2(v1[0], v1[1]); w.w = pk2(v1[2], v1[3]);
                        *(u32x4*)(rowp + bj * HALF) = w; }
                    asm volatile("" ::: "memory"); }
        } else if (wc == 0) {
#pragma unroll
            for (int ai = 0; ai < 2; ++ai)
#pragma unroll
                for (int m = 0; m < 4; ++m) { const int rl = ai * HALF + wr * 64 + m * 16 + fr; float* fp = DT + (unsigned)((u.pm * BM + rl) * 32 + 8 * fq);
                    *(f32x4*)fp = acc[ai][0][m][0]; *(f32x4*)(fp + 4) = acc[ai][0][m][1]; }
        }
    }
};
struct EpiResid {
    static constexpr bool PERM = false, AFTER_DRAIN = false;
    float* X;
    __device__ __forceinline__ void operator()(const f32x4 (&acc)[2][2][4][2], const Unit& u, int wr, int wc, int fr, int fq) const {
        asm volatile("" : "+v"(fr));
        const int col0 = u.pn * BM + wc * 32 + 4 * fq;
#pragma unroll
        for (int ai = 0; ai < 2; ++ai)
#pragma unroll
            for (int m = 0; m < 4; ++m) { float* rowp = X + (unsigned)((u.pm * BM + ai * HALF + wr * 64 + m * 16 + fr) * D + col0);
#pragma unroll
                for (int bj = 0; bj < 2; ++bj)
#pragma unroll
                    for (int n = 0; n < 2; ++n) { float* p = rowp + bj * HALF + n * 16; const f32x4 x = *(const f32x4*)p; *(f32x4*)p = x * ALPHA + acc[ai][bj][m][n]; }
                asm volatile("" ::: "memory"); }
    }
};
}
struct Args { const float* in[25]; int ph_lo, ph_hi; };
#define AIN(k) (a.in[(k) + z])
struct Frame { unsigned char* lds; int tid, lane, wave, G, bid; };

__device__ __forceinline__ void transpose_item(const float* W, int K, int N, bf16* WT, float* scr, int item, int lane) {
    const int nblk = N / 32, kb = item / nblk, nb = item % nblk, k0 = 64 * kb, n0 = 32 * nb;
#pragma unroll 8
    for (int i = 0; i < 32; ++i) { const int kk = 2 * i + (lane >> 5); scr[kk * 33 + (lane & 31)] = W[(size_t)(k0 + kk) * N + n0 + (lane & 31)]; }
    asm volatile("s_waitcnt lgkmcnt(0)" ::: "memory");
    const int c = lane & 7;
#pragma unroll
    for (int j = 0; j < 4; ++j) { const int n = (lane >> 3) + 8 * j; const float* s = scr + (8 * c) * 33 + n;
        u32x4 o; o.x = pk2(s[0 * 33], s[1 * 33]); o.y = pk2(s[2 * 33], s[3 * 33]); o.z = pk2(s[4 * 33], s[5 * 33]); o.w = pk2(s[6 * 33], s[7 * 33]);
        *(u32x4*)(WT + (size_t)(n0 + n) * K + k0 + 8 * c) = o; }
    asm volatile("s_waitcnt lgkmcnt(0)" ::: "memory");
}
__device__ __forceinline__ void cvt_stream(const float* src, bf16* dst, size_t n, size_t gtid, size_t gthreads) {
    for (size_t i = gtid * 8; i < n; i += gthreads * 8) { const f32x4 a = *(const f32x4*)(src + i), b = *(const f32x4*)(src + i + 4);
        u32x4 o; o.x = pk2(a[0], a[1]); o.y = pk2(a[2], a[3]); o.z = pk2(b[0], b[1]); o.w = pk2(b[2], b[3]); *(u32x4*)(dst + i) = o; }
}
__device__ __forceinline__ void convert_phase(const Frame& F, const Args& a, int z, int L) {
    unsigned char* ws = (unsigned char*)AIN(24); float* outp = (float*)AIN(23); const int li = L >> 1; const bool ssm = (L & 1);
    float* scr = (float*)(F.lds + F.wave * 16384);
    const int gw = F.bid * 8 + F.wave, NGW = F.G * 8;
    const float* Wa = ssm ? AIN(9) + (size_t)li * D * NPROJ : AIN(6) + (size_t)li * D * 3072; const int Na = ssm ? NPROJ : 3072;
    const float* Wb = ssm ? AIN(16) + (size_t)li * 2048 * D : AIN(8) + (size_t)li * D * D; const int Kb = ssm ? 2048 : D;
    const float* Wu = AIN(19) + (size_t)L * D * DFF; const float* Wd = AIN(20) + (size_t)L * DFF * D;
    const int Ia = (D / 64) * (Na / 32), Ib = (Kb / 64) * (D / 32), Iu = (D / 64) * (DFF / 32), Id = (DFF / 64) * (D / 32);
    const int NIT = Ia + Ib + Iu + Id;
    for (int it = gw; it < NIT; it += NGW) {
        int r = it;
        if (r < Ia) { transpose_item(Wa, D, Na, (bf16*)(ws + WS_WA), scr, r, F.lane); continue; } r -= Ia;
        if (r < Ib) { transpose_item(Wb, Kb, D, (bf16*)(ws + WS_WB), scr, r, F.lane); continue; } r -= Ib;
        if (r < Iu) { transpose_item(Wu, D, DFF, (bf16*)(ws + WS_WUP), scr, r, F.lane); continue; } r -= Iu;
        transpose_item(Wd, DFF, D, (bf16*)(ws + WS_WDN), scr, r, F.lane);
    }
    const size_t gtid = (size_t)F.bid * 512 + F.tid, gth = (size_t)F.G * 512;
    if (!ssm) {
        cvt_stream(AIN(2) + (size_t)li * 32 * 512 * 1024, (bf16*)(ws + WS_CK), (size_t)32 * 512 * 1024, gtid, gth);
        cvt_stream(AIN(3) + (size_t)li * 32 * 512 * 1024, (bf16*)(ws + WS_CV), (size_t)32 * 512 * 1024, gtid, gth);
    }
    if (L == 0) {
        const size_t n = (size_t)M * D, np = (size_t)MP * D;
        bf16* XB = (bf16*)(ws + WS_XB);
        for (size_t i = gtid * 8; i < n; i += gth * 8) { const float* src = i < np ? AIN(0) + i : AIN(1) + (i - np);
            const f32x4 x0 = *(const f32x4*)src, x1 = *(const f32x4*)(src + 4);
            *(f32x4*)(outp + i) = x0; *(f32x4*)(outp + i + 4) = x1;
            u32x4 o; o.x = pk2(x0[0], x0[1]); o.y = pk2(x0[2], x0[3]); o.z = pk2(x1[0], x1[1]); o.w = pk2(x1[2], x1[3]); *(u32x4*)(XB + i) = o; }
    }
}
__device__ __forceinline__ void ln_phase(const Frame& F, float* X, bf16* XB, const float* g, const float* b) {
    const int gw = F.bid * 8 + F.wave, NGW = F.G * 8;
    f32x4 gv[4], bv[4];
#pragma unroll
    for (int j = 0; j < 4; ++j) { gv[j] = *(const f32x4*)(g + 4 * F.lane + 256 * j); bv[j] = *(const f32x4*)(b + 4 * F.lane + 256 * j); }
    for (int m = gw; m < M; m += NGW) {
        f32x4* xr = (f32x4*)(X + (size_t)m * D) + F.lane;
        f32x4 v[4]; float s = 0.f;
#pragma unroll
        for (int j = 0; j < 4; ++j) { v[j] = xr[64 * j]; s += (v[j][0] + v[j][1]) + (v[j][2] + v[j][3]); }
        const float mean = wave_sum(s) * (1.f / D); float s2 = 0.f;
#pragma unroll
        for (int j = 0; j < 4; ++j) { v[j] = v[j] - mean; s2 += (v[j][0] * v[j][0] + v[j][1] * v[j][1]) + (v[j][2] * v[j][2] + v[j][3] * v[j][3]); }
        const float rstd = 1.f / sqrtf(wave_sum(s2) * (1.f / D) + LN_EPS);
        u32x2* o8 = (u32x2*)(XB + (size_t)m * D) + F.lane;
#pragma unroll
        for (int j = 0; j < 4; ++j) { const f32x4 y = v[j] * rstd * gv[j] + bv[j]; xr[64 * j] = y; u32x2 w; w.x = pk2(y[0], y[1]); w.y = pk2(y[2], y[3]); o8[64 * j] = w; }
    }
}

__device__ __forceinline__ void attn_phase(const Frame& F, const float* relb, const bf16* QKV, const bf16* CK, const bf16* CV, bf16* O) {
    float* tbl = (float*)F.lds;
    for (int i = F.tid; i < 16 * 513; i += 512) tbl[i] = relb[i] * LOG2E;
    __syncthreads();
    unsigned char* vt = F.lds + 36864 + F.wave * 9216;
    const int lane = F.lane, l31 = lane & 31, hh = lane >> 5;
    const int i16 = lane & 15, q4 = i16 >> 2, p4 = i16 & 3, dblk = (lane >> 4) & 1;
    const int gw = F.bid * 8 + F.wave, NGW = F.G * 8;
    constexpr int NITEM = (32 * 32 + 32) * 32;
    constexpr float C2 = 0.125f * LOG2E;
    for (int it = gw; it < NITEM; it += NGW) {
        const bool smp = it >= 32768;
        const int r = smp ? it - 32768 : it;
        const int qh = r & 1, h = (r >> 1) & 15, c = smp ? 0 : (r >> 5) & 31, b = smp ? (r >> 5) : (r >> 10);
        const size_t qrow0 = smp ? (size_t)MP + b * 64 + 32 * qh : (size_t)b * 2048 + 64 * c + 32 * qh;
        bf16x8 qf[4];
#pragma unroll
        for (int ks = 0; ks < 4; ++ks) qf[ks] = *(const bf16x8*)(QKV + (qrow0 + l31) * 3072 + h * 64 + 16 * ks + 8 * hh);
        f32x16 o0, o1;
#pragma unroll
        for (int i = 0; i < 16; ++i) { o0[i] = 0.f; o1[i] = 0.f; }
        float mrun = -1e30f, lsum = 0.f;
        const float* tb = tbl + h * 513;
        const float cbias = tb[512];
        const int jb0 = smp ? 0 : (c >= 8 ? 0 : 8 - c);
        for (int jb = jb0; jb <= 8; ++jb) {
            const bf16 *Kp, *Vp; int pitch;
            if (!smp) { Kp = QKV + ((size_t)b * 2048 + 64 * (c - 8 + jb)) * 3072 + 1024 + h * 64; Vp = Kp + 1024; pitch = 3072; }
            else if (jb < 8) { Kp = CK + ((size_t)b * 512 + 64 * jb) * 1024 + h * 64; Vp = CV + ((size_t)b * 512 + 64 * jb) * 1024 + h * 64; pitch = 1024; }
            else { Kp = QKV + ((size_t)MP + b * 64) * 3072 + 1024 + h * 64; Vp = Kp + 1024; pitch = 3072; }
            bf16x8 kf[2][4], vr[8];
#pragma unroll
            for (int rb = 0; rb < 2; ++rb)
#pragma unroll
                for (int ks = 0; ks < 4; ++ks) kf[rb][ks] = *(const bf16x8*)(Kp + (size_t)(32 * rb + l31) * pitch + 16 * ks + 8 * hh);
#pragma unroll
            for (int i = 0; i < 8; ++i) vr[i] = *(const bf16x8*)(Vp + (size_t)(8 * i + (lane >> 3)) * pitch + 8 * (lane & 7));
            asm volatile("" ::: "memory");
#pragma unroll
            for (int i = 0; i < 8; ++i) *(bf16x8*)(vt + ((8 * i + (lane >> 3)) * 72 + 8 * (lane & 7)) * 2) = vr[i];
            asm volatile("" ::: "memory");
            f32x16 s0, s1;
#pragma unroll
            for (int i = 0; i < 16; ++i) { s0[i] = 0.f; s1[i] = 0.f; }
#pragma unroll
            for (int ks = 0; ks < 4; ++ks) { s0 = MFMA32(kf[0][ks], qf[ks], s0); s1 = MFMA32(kf[1][ks], qf[ks], s1); }
            if (jb <= 3) {
#pragma unroll
                for (int i = 0; i < 16; ++i) { s0[i] = s0[i] * C2 + cbias; s1[i] = s1[i] * C2 + cbias; }
            } else {
                const int dbase = 64 * (8 - jb) + 32 * qh + l31 + 256;
#pragma unroll
                for (int i = 0; i < 16; ++i) { const int k0 = crow(i, hh); int i0 = dbase - k0, i1 = dbase - k0 - 32; i0 = i0 > 512 ? 512 : i0; i1 = i1 > 512 ? 512 : i1;
                    s0[i] = s0[i] * C2 + tb[i0]; s1[i] = s1[i] * C2 + tb[i1]; }
            }
            float mx = s0[0];
#pragma unroll
            for (int i = 1; i < 16; ++i) mx = fmaxf(mx, s0[i]);
#pragma unroll
            for (int i = 0; i < 16; ++i) mx = fmaxf(mx, s1[i]);
            mx = fmaxf(mx, __shfl_xor(mx, 32));
            const float mnew = fmaxf(mrun, mx), alpha = fexp2(mrun - mnew);
            mrun = mnew;
            float ps = 0.f;
#pragma unroll
            for (int i = 0; i < 16; ++i) { s0[i] = fexp2(s0[i] - mnew); s1[i] = fexp2(s1[i] - mnew); ps += s0[i] + s1[i]; }
            lsum = lsum * alpha + ps;
#pragma unroll
            for (int i = 0; i < 16; ++i) { o0[i] *= alpha; o1[i] *= alpha; }
#pragma unroll
            for (int rb = 0; rb < 2; ++rb)
#pragma unroll
                for (int s2 = 0; s2 < 2; ++s2) {
                    const bf16x8 pf = pack8(rb ? s1 : s0, s2);
                    const int k0 = 32 * rb + 16 * s2 + 4 * hh + q4;
#pragma unroll
                    for (int db = 0; db < 2; ++db) {
                        const int cb = 32 * db + 16 * dblk + 4 * p4;
                        const s16x4 lo = __builtin_amdgcn_ds_read_tr16_b64_v4i16((LAS s16x4*)(vt + (k0 * 72 + cb) * 2));
                        const s16x4 hi = __builtin_amdgcn_ds_read_tr16_b64_v4i16((LAS s16x4*)(vt + ((k0 + 8) * 72 + cb) * 2));
                        const bf16x8 va = __builtin_shufflevector(lo, hi, 0, 1, 2, 3, 4, 5, 6, 7);
                        if (db == 0) o0 = MFMA32(va, pf, o0); else o1 = MFMA32(va, pf, o1);
                    }
                }
            asm volatile("" ::: "memory");
        }
        const float inv = 1.0f / (lsum + __shfl_xor(lsum, 32));
        bf16* orow = O + (qrow0 + l31) * D + h * 64 + 4 * hh;
#pragma unroll
        for (int i4 = 0; i4 < 4; ++i4) {
            u32x2 w0; w0.x = pk2(o0[4 * i4] * inv, o0[4 * i4 + 1] * inv); w0.y = pk2(o0[4 * i4 + 2] * inv, o0[4 * i4 + 3] * inv); *(u32x2*)(orow + 8 * i4) = w0;
            u32x2 w1; w1.x = pk2(o1[4 * i4] * inv, o1[4 * i4 + 1] * inv); w1.y = pk2(o1[4 * i4 + 2] * inv, o1[4 * i4 + 3] * inv); *(u32x2*)(orow + 32 + 8 * i4) = w1;
        }
    }
}
constexpr int SX_XT = 0, SX_XWT = 36864, SX_BT = 73728, SX_BS = 92160, SX_CS = 109568, SX_DT = 126976, SX_CUM = SX_DT + 1024, SX_WIN = SX_DT + 2048, SX_PART = SX_DT + 3072;
__device__ __forceinline__ void ssd_phase(const Frame& F, const Args& a, int z, int li, bf16* PROJ, const float* DT) {
    float* outp = (float*)AIN(23);
    unsigned char* lds = F.lds;
    bf16* Xt = (bf16*)(lds + SX_XT); bf16* Xwt = (bf16*)(lds + SX_XWT); bf16* Bt = (bf16*)(lds + SX_BT); bf16* Bs = (bf16*)(lds + SX_BS); bf16* Cs = (bf16*)(lds + SX_CS);
    float* dts = (float*)(lds + SX_DT); float* cums = (float*)(lds + SX_CUM); float* wins = (float*)(lds + SX_WIN); float* part = (float*)(lds + SX_PART);
    const int tid = F.tid, lane = F.lane, wave = F.wave, l31 = lane & 31, hh = lane >> 5;
    const int r = wave >> 1, half = wave & 1;
    const float* conv_w = AIN(10) + (size_t)li * 4 * 4096; const float* conv_b = AIN(11) + (size_t)li * 4096;
    const float* dt_bias = AIN(12) + li * 32; const float* a_log = AIN(13) + li * 32; const float* d_skip = AIN(14) + li * 32; const float* norm_w = AIN(15) + (size_t)li * 2048;
    for (int item = F.bid; item < 512; item += F.G) {
        const bool smp = item >= 256; const int bg = item & 255, b = bg >> 3, g = bg & 7;
        const size_t row0 = smp ? (size_t)MP + b * 64 : (size_t)b * 2048; const int nchunks = smp ? 1 : 32;
        const int ch = tid < 256 ? g * 256 + tid : (tid < 384 ? 2048 + g * 128 + (tid - 256) : 3072 + g * 128 + (tid - 384));
        const float cw0 = conv_w[ch], cw1 = conv_w[4096 + ch], cw2 = conv_w[8192 + ch], cw3 = conv_w[12288 + ch], cbs = conv_b[ch];
        float x3 = 0.f, x2 = 0.f, x1 = 0.f;
        if (smp) { const float* sc = AIN(5) + ((size_t)(li * 32 + b) * 3) * 4096 + ch; x3 = sc[0]; x2 = sc[4096]; x1 = sc[8192]; }
        const int hglob = g * 4 + r;
        const float Dr = d_skip[hglob];
        f32x16 hT[4];
        const size_t hoff = (((size_t)(li * 32 + b) * 32 + hglob) * 64 + 32 * half + l31) * 128 + 4 * hh;
        if (smp) { const float* hs = AIN(4) + hoff;
#pragma unroll
            for (int nb = 0; nb < 4; ++nb)
#pragma unroll
                for (int i4 = 0; i4 < 4; ++i4) { const f32x4 v = *(const f32x4*)(hs + 32 * nb + 8 * i4); hT[nb][4 * i4] = v[0]; hT[nb][4 * i4 + 1] = v[1]; hT[nb][4 * i4 + 2] = v[2]; hT[nb][4 * i4 + 3] = v[3]; }
        } else {
#pragma unroll
            for (int nb = 0; nb < 4; ++nb)
#pragma unroll
                for (int i = 0; i < 16; ++i) hT[nb][i] = 0.f;
        }
        for (int c = 0; c < nchunks; ++c) {
            const size_t rowc = row0 + 64 * c;
            if (tid < 256) {
                const int hr = g * 4 + wave;
                const float raw = DT[(rowc + lane) * 32 + hr] + dt_bias[hr];
                const float dt = raw > 20.f ? raw : log1pf(__expf(raw));
                const float am = -__expf(a_log[hr]) * LOG2E;
                float v = dt * am;
#pragma unroll
                for (int o = 1; o < 64; o <<= 1) { const float n = __shfl_up(v, o); if (lane >= o) v += n; }
                const float last = __shfl(v, 63);
                dts[wave * 64 + lane] = dt; cums[wave * 64 + lane] = v; wins[wave * 64 + lane] = fexp2(last - v) * dt;
            }
            __syncthreads();
            {
                const bf16* src = PROJ + rowc * LDP + 2048 + ch;
#pragma unroll 1
                for (int t8 = 0; t8 < 8; ++t8) {
                    float xin[8];
#pragma unroll
                    for (int j = 0; j < 8; ++j) xin[j] = bf2f(src[(size_t)(8 * t8 + j) * LDP]);
                    float sv[8];
#pragma unroll
                    for (int j = 0; j < 8; ++j) { const float v = cbs + cw0 * x3 + cw1 * x2 + cw2 * x1 + cw3 * xin[j]; x3 = x2; x2 = x1; x1 = xin[j]; sv[j] = silu_f(v); }
                    u32x4 w; w.x = pk2(sv[0], sv[1]); w.y = pk2(sv[2], sv[3]); w.z = pk2(sv[4], sv[5]); w.w = pk2(sv[6], sv[7]);
                    if (tid < 256) {
                        *(u32x4*)(Xt + tid * 72 + 8 * t8) = w;
                        const float* wr8 = wins + wave * 64 + 8 * t8;
                        u32x4 w2; w2.x = pk2(sv[0] * wr8[0], sv[1] * wr8[1]); w2.y = pk2(sv[2] * wr8[2], sv[3] * wr8[3]); w2.z = pk2(sv[4] * wr8[4], sv[5] * wr8[5]); w2.w = pk2(sv[6] * wr8[6], sv[7] * wr8[7]);
                        *(u32x4*)(Xwt + tid * 72 + 8 * t8) = w2;
                    } else if (tid < 384) {
                        const int n = tid - 256;
                        *(u32x4*)(Bt + n * 72 + 8 * t8) = w;
                        const unsigned ww[4] = {w.x, w.y, w.z, w.w};
#pragma unroll
                        for (int j = 0; j < 8; ++j) Bs[(8 * t8 + j) * 136 + n] = (bf16)((j & 1) ? (ww[j >> 1] >> 16) : (ww[j >> 1] & 0xffffu));
                    } else {
                        const int n = tid - 384;
                        const unsigned ww[4] = {w.x, w.y, w.z, w.w};
#pragma unroll
                        for (int j = 0; j < 8; ++j) Cs[(8 * t8 + j) * 136 + n] = (bf16)((j & 1) ? (ww[j >> 1] >> 16) : (ww[j >> 1] & 0xffffu));
                    }
                }
            }
            __syncthreads();
            f32x16 cb00, cb01, cb11;
#pragma unroll
            for (int i = 0; i < 16; ++i) { cb00[i] = 0.f; cb01[i] = 0.f; cb11[i] = 0.f; }
#pragma unroll
            for (int ns = 0; ns < 8; ++ns) {
                const bf16x8 a0 = *(const bf16x8*)(Bs + l31 * 136 + 16 * ns + 8 * hh), a1 = *(const bf16x8*)(Bs + (32 + l31) * 136 + 16 * ns + 8 * hh);
                const bf16x8 c0 = *(const bf16x8*)(Cs + l31 * 136 + 16 * ns + 8 * hh), c1 = *(const bf16x8*)(Cs + (32 + l31) * 136 + 16 * ns + 8 * hh);
                cb00 = MFMA32(a0, c0, cb00); cb01 = MFMA32(a0, c1, cb01); cb11 = MFMA32(a1, c1, cb11);
            }
            const float* cumr = cums + r * 64; const float* dtr = dts + r * 64;
            const float cum_t0 = cumr[l31], cum_t1 = cumr[32 + l31];
#pragma unroll
            for (int i4 = 0; i4 < 4; ++i4) {
                const f32x4 cs0 = *(const f32x4*)(cumr + 8 * i4 + 4 * hh), cs1 = *(const f32x4*)(cumr + 32 + 8 * i4 + 4 * hh);
                const f32x4 ds0 = *(const f32x4*)(dtr + 8 * i4 + 4 * hh), ds1 = *(const f32x4*)(dtr + 32 + 8 * i4 + 4 * hh);
#pragma unroll
                for (int j = 0; j < 4; ++j) { const int i = 4 * i4 + j, s = 8 * i4 + 4 * hh + j;
                    float v00 = cb00[i] * fexp2(fminf(cum_t0 - cs0[j], 0.f)) * ds0[j]; v00 = (s <= l31) ? v00 : 0.f; v00 += (s == l31) ? Dr : 0.f; cb00[i] = v00;
                    cb01[i] = cb01[i] * fexp2(fminf(cum_t1 - cs0[j], 0.f)) * ds0[j];
                    float v11 = cb11[i] * fexp2(fminf(cum_t1 - cs1[j], 0.f)) * ds1[j]; v11 = (s <= l31) ? v11 : 0.f; v11 += (s == l31) ? Dr : 0.f; cb11[i] = v11; }
            }
            f32x16 y0, y1;
#pragma unroll
            for (int i = 0; i < 16; ++i) { y0[i] = 0.f; y1[i] = 0.f; }
#pragma unroll
            for (int nb = 0; nb < 4; ++nb)
#pragma unroll
                for (int s2 = 0; s2 < 2; ++s2) {
                    const bf16x8 ha = pack8(hT[nb], s2);
                    const int n0 = 32 * nb + 16 * s2 + 4 * hh;
                    const s16x4 c0l = *(const s16x4*)(Cs + l31 * 136 + n0), c0h = *(const s16x4*)(Cs + l31 * 136 + n0 + 8);
                    const s16x4 c1l = *(const s16x4*)(Cs + (32 + l31) * 136 + n0), c1h = *(const s16x4*)(Cs + (32 + l31) * 136 + n0 + 8);
                    y0 = MFMA32(ha, __builtin_shufflevector(c0l, c0h, 0, 1, 2, 3, 4, 5, 6, 7), y0);
                    y1 = MFMA32(ha, __builtin_shufflevector(c1l, c1h, 0, 1, 2, 3, 4, 5, 6, 7), y1);
                }
            { const float e0 = fexp2(cum_t0), e1 = fexp2(cum_t1);
#pragma unroll
              for (int i = 0; i < 16; ++i) { y0[i] *= e0; y1[i] *= e1; } }
            { const bf16* xrow = Xt + (64 * r + 32 * half + l31) * 72;
#pragma unroll
              for (int s2 = 0; s2 < 2; ++s2) {
                  const s16x4 x0l = *(const s16x4*)(xrow + 16 * s2 + 4 * hh), x0h = *(const s16x4*)(xrow + 16 * s2 + 4 * hh + 8);
                  const s16x4 x1l = *(const s16x4*)(xrow + 32 + 16 * s2 + 4 * hh), x1h = *(const s16x4*)(xrow + 32 + 16 * s2 + 4 * hh + 8);
                  const bf16x8 xa0 = __builtin_shufflevector(x0l, x0h, 0, 1, 2, 3, 4, 5, 6, 7), xa1 = __builtin_shufflevector(x1l, x1h, 0, 1, 2, 3, 4, 5, 6, 7);
                  y0 = MFMA32(xa0, pack8(cb00, s2), y0);
                  y1 = MFMA32(xa0, pack8(cb01, s2), y1);
                  y1 = MFMA32(xa1, pack8(cb11, s2), y1);
              } }
            {
                float ss0 = 0.f, ss1 = 0.f;
                bf16* zr0 = PROJ + (rowc + l31) * LDP + g * 256 + 64 * r + 32 * half + 4 * hh; bf16* zr1 = zr0 + (size_t)32 * LDP;
#pragma unroll
                for (int i4 = 0; i4 < 4; ++i4) {
                    const u32x2 z0 = *(const u32x2*)(zr0 + 8 * i4), z1 = *(const u32x2*)(zr1 + 8 * i4);
                    const float za[4] = {bflo(z0.x), bfhi(z0.x), bflo(z0.y), bfhi(z0.y)}, zb[4] = {bflo(z1.x), bfhi(z1.x), bflo(z1.y), bfhi(z1.y)};
#pragma unroll
                    for (int j = 0; j < 4; ++j) { const float v0 = y0[4 * i4 + j] * silu_f(za[j]), v1 = y1[4 * i4 + j] * silu_f(zb[j]); y0[4 * i4 + j] = v0; y1[4 * i4 + j] = v1; ss0 += v0 * v0; ss1 += v1 * v1; }
                }
                ss0 += __shfl_xor(ss0, 32); ss1 += __shfl_xor(ss1, 32);
                if (hh == 0) { part[l31 * 8 + wave] = ss0; part[(32 + l31) * 8 + wave] = ss1; }
                __syncthreads();
                const f32x4 pa = *(const f32x4*)(part + l31 * 8), pb = *(const f32x4*)(part + l31 * 8 + 4), pc = *(const f32x4*)(part + (32 + l31) * 8), pd = *(const f32x4*)(part + (32 + l31) * 8 + 4);
                const float t0 = ((pa[0] + pa[1]) + (pa[2] + pa[3])) + ((pb[0] + pb[1]) + (pb[2] + pb[3])), t1 = ((pc[0] + pc[1]) + (pc[2] + pc[3])) + ((pd[0] + pd[1]) + (pd[2] + pd[3]));
                const float r0 = 1.0f / sqrtf(t0 * (1.f / 256.f) + RMS_EPS), r1 = 1.0f / sqrtf(t1 * (1.f / 256.f) + RMS_EPS);
                const float* nwp = norm_w + g * 256 + 64 * r + 32 * half + 4 * hh;
#pragma unroll
                for (int i4 = 0; i4 < 4; ++i4) { const f32x4 nw = *(const f32x4*)(nwp + 8 * i4);
                    u32x2 w0; w0.x = pk2(y0[4 * i4] * r0 * nw[0], y0[4 * i4 + 1] * r0 * nw[1]); w0.y = pk2(y0[4 * i4 + 2] * r0 * nw[2], y0[4 * i4 + 3] * r0 * nw[3]); *(u32x2*)(zr0 + 8 * i4) = w0;
                    u32x2 w1; w1.x = pk2(y1[4 * i4] * r1 * nw[0], y1[4 * i4 + 1] * r1 * nw[1]); w1.y = pk2(y1[4 * i4 + 2] * r1 * nw[2], y1[4 * i4 + 3] * r1 * nw[3]); *(u32x2*)(zr1 + 8 * i4) = w1; }
            }
            { const float dec = fexp2(cumr[63]);
#pragma unroll
              for (int nb = 0; nb < 4; ++nb)
#pragma unroll
                  for (int i = 0; i < 16; ++i) hT[nb][i] *= dec;
              const bf16* xw = Xwt + (64 * r + 32 * half + l31) * 72 + 8 * hh;
#pragma unroll
              for (int ss = 0; ss < 4; ++ss) { const bf16x8 bx = *(const bf16x8*)(xw + 16 * ss);
#pragma unroll
                  for (int nb = 0; nb < 4; ++nb) { const bf16x8 af = *(const bf16x8*)(Bt + (32 * nb + l31) * 72 + 16 * ss + 8 * hh); hT[nb] = MFMA32(af, bx, hT[nb]); } }
            }
            __syncthreads();
        }
        { float* ho = outp + (smp ? O_HS : O_HP) + hoff;
#pragma unroll
          for (int nb = 0; nb < 4; ++nb)
#pragma unroll
              for (int i4 = 0; i4 < 4; ++i4) *(f32x4*)(ho + 32 * nb + 8 * i4) = (f32x4){hT[nb][4 * i4], hT[nb][4 * i4 + 1], hT[nb][4 * i4 + 2], hT[nb][4 * i4 + 3]};
          float* co = outp + (smp ? O_CS : O_CP) + ((size_t)(li * 32 + b) * 3) * 4096 + ch; co[0] = x3; co[4096] = x2; co[8192] = x1; }
    }
}
__global__ void __launch_bounds__(512, 2) fwd_megakernel(Args a) {
    extern __shared__ __attribute__((aligned(16))) unsigned char lds[];
    cg::grid_group grid = cg::this_grid();
    Frame F; F.lds = lds; F.tid = threadIdx.x; F.lane = F.tid & 63; F.wave = __builtin_amdgcn_readfirstlane(F.tid >> 6); F.G = gridDim.x; F.bid = blockIdx.x;
    PG8_LAS unsigned char* glds = (PG8_LAS unsigned char*)lds;
    for (int ph = a.ph_lo; ph < a.ph_hi; ++ph) {
        { int t_ = threadIdx.x; asm volatile("" : "+v"(t_)); F.tid = t_; F.lane = t_ & 63; F.wave = __builtin_amdgcn_readfirstlane(t_ >> 6); }
        int z = 0; asm volatile("" : "+s"(z));
        unsigned char* ws = (unsigned char*)AIN(24);
        bf16* WA = (bf16*)(ws + WS_WA); bf16* WB = (bf16*)(ws + WS_WB); bf16* WUP = (bf16*)(ws + WS_WUP); bf16* WDN = (bf16*)(ws + WS_WDN);
        bf16* XB = (bf16*)(ws + WS_XB); float* DT = (float*)(ws + WS_DT); bf16* BIG = (bf16*)(ws + WS_BIG);
        bf16* OB = (bf16*)(ws + WS_O); bf16* CK = (bf16*)(ws + WS_CK); bf16* CV = (bf16*)(ws + WS_CV);
        float* X = (float*)AIN(23);
        const int L = ph >> 3, sub = ph & 7, li = L >> 1; const bool ssm = (L & 1);
        if (sub == 0) {
#ifndef NO_CONV
 convert_phase(F, a, z, L);
#endif
 }
        else if (sub == 1) {
#if !defined(ONLY_SUB) || ONLY_SUB == 1
            pg8::StaticOrder S;
            if (!ssm) { pg8::Gemm g{XB, WA, M, 3072, D, D}; S.init(M, 3072, F.G, F.bid); pg8::EpiQKV E{BIG, X, li};
                pg8::gemm_phase<pg8::EpiQKV, pg8::StaticOrder, true, true>(glds, g, S, E); }
            else { pg8::Gemm g{XB, WA, M, NPROJ_PAD, D, D}; S.init(M, NPROJ_PAD, F.G, F.bid); pg8::EpiSsmIn E{BIG, DT};
                pg8::gemm_phase<pg8::EpiSsmIn, pg8::StaticOrder, true, true>(glds, g, S, E); }
#endif
        } else if (sub == 2) {
#ifndef NO_ATTN
            if (!ssm) attn_phase(F, AIN(7) + (size_t)li * 16 * 513, BIG, CK, CV, OB);
#endif
#ifndef NO_SSD
            if (ssm) ssd_phase(F, a, z, li, BIG, DT);
#endif
        } else if (sub == 3) {
#if !defined(ONLY_SUB) || ONLY_SUB == 3
            pg8::StaticOrder S; S.init(M, D, F.G, F.bid); pg8::EpiResid E{X};
            if (!ssm) { pg8::Gemm g{OB, WB, M, D, D, D}; pg8::gemm_phase<pg8::EpiResid, pg8::StaticOrder, true, true>(glds, g, S, E); }
            else { pg8::Gemm g{BIG, WB, M, D, 2048, LDP}; pg8::gemm_phase<pg8::EpiResid, pg8::StaticOrder, true, true>(glds, g, S, E); }
#endif
        } else if (sub == 4) ln_phase(F, X, XB, AIN(17) + L * D, AIN(18) + L * D);
        else if (sub == 5) {
#if !defined(ONLY_SUB) || ONLY_SUB == 5
 pg8::Gemm g{XB, WUP, M, DFF, D, D}; pg8::StaticOrder S; S.init(M, DFF, F.G, F.bid); pg8::EpiBf16Plain E{BIG, DFF, 1};
            pg8::gemm_phase<pg8::EpiBf16Plain, pg8::StaticOrder, true, true>(glds, g, S, E);
#endif
 }
        else if (sub == 6) {
#if !defined(ONLY_SUB) || ONLY_SUB == 6
 pg8::Gemm g{BIG, WDN, M, D, DFF, DFF}; pg8::StaticOrder S; S.init(M, D, F.G, F.bid); pg8::EpiResid E{X};
            pg8::gemm_phase<pg8::EpiResid, pg8::StaticOrder, true, true>(glds, g, S, E);
#endif
 }
        else ln_phase(F, X, XB, AIN(21) + L * D, AIN(22) + L * D);
        if (ph + 1 < a.ph_hi) grid.sync();
    }
}

extern "C" void kernel_launch(void* const* d_in, const int* in_sizes, int n_in, void* d_out, int out_size, void* d_ws, size_t ws_size, hipStream_t stream) {
    static int grid = 0;
    if (grid == 0) {
        if (n_in != 23 || ws_size < WS_END) { fprintf(stderr, "kernel_launch: need 23 inputs and %zu bytes of workspace, got %d and %zu\n", (size_t)WS_END, n_in, ws_size); grid = -1; return; }
        int dev = 0, cus = 0, per_cu = 0;
        hipGetDevice(&dev); hipDeviceGetAttribute(&cus, hipDeviceAttributeMultiprocessorCount, dev);
        if (hipFuncSetAttribute((const void*)fwd_megakernel, hipFuncAttributeMaxDynamicSharedMemorySize, LDS_BYTES) != hipSuccess) { fprintf(stderr, "kernel_launch: hipFuncSetAttribute failed\n"); grid = -1; return; }
        if (hipOccupancyMaxActiveBlocksPerMultiprocessor(&per_cu, (const void*)fwd_megakernel, 512, LDS_BYTES) != hipSuccess || per_cu < 1) per_cu = 1;
        (void)hipGetLastError();
        grid = cus * per_cu;
    }
    if (grid < 0) return;
    Args a{};
    for (int i = 0; i < 23; ++i) a.in[i] = (const float*)d_in[i];
    a.in[23] = (const float*)d_out; a.in[24] = (const float*)d_ws; a.ph_lo = 0; a.ph_hi = 32;
    void* args[] = {&a};
    hipError_t e = hipLaunchCooperativeKernel((const void*)fwd_megakernel, dim3(grid), dim3(512), args, LDS_BYTES, stream);
    if (e != hipSuccess) fprintf(stderr, "cooperative launch failed: %s (grid %d)\n", hipGetErrorString(e), grid);
}
```

```cpp
#include <hip/hip_runtime.h>
#include <hip/hip_cooperative_groups.h>
#include <cstdio>
#include <cstdint>
namespace cg = cooperative_groups;
namespace pg8 {
#define PG8_LAS __attribute__((address_space(3)))
typedef unsigned short bf16_t;
typedef short bf16x8 __attribute__((ext_vector_type(8)));
typedef float f32x4 __attribute__((ext_vector_type(4)));
typedef unsigned u32x4 __attribute__((ext_vector_type(4)));
constexpr int BM = 256, BK = 64, HALF = 128, HTB = HALF * BK * 2  , STAGE_BYTES = 8 * HTB, NXCD = 8, WGM = 8;

__host__ __device__ __forceinline__ int lds_byte(int r, int c) { const int st = (r >> 4) * 2 + (c >> 5), rr = r & 15, cc = c & 31, ob = rr * 64 + cc * 2; return st * 1024 + (ob ^ (((ob >> 9) & 1) << 5)); }
__host__ __device__ __forceinline__ void stage_rc(int b, int& R, int& C) { const int st = b / 1024, sb = b % 1024, swz = sb ^ (((sb >> 9) & 1) << 5); R = (st >> 1) * 16 + swz / 64; C = (st & 1) * 32 + (swz % 64) / 2; }
__host__ __device__ __forceinline__ int perm32(int rho) { const int n = rho >> 4, i = rho & 15; return 8 * (i >> 2) + 4 * n + (i & 3); }

struct Unit { int pm, pn; };
struct Gemm { const bf16_t* A; const bf16_t* Bt; int M, N, K, lda; };

struct StaticOrder {
    int nM, nN, nwg, G, c;
    __host__ __device__ void init(int M, int N, int G_, int c_) { nM = M / BM; nN = N / BM; nwg = nM * nN; G = G_; c = c_; }
    __host__ __device__ bool next(int i, Unit& u) const {
        const long L = (long)i * G + c; if (L >= nwg) return false;
        int wgid = (int)L; { const int q = nwg / NXCD, r = nwg % NXCD, xcd = wgid % NXCD, off = wgid / NXCD; wgid = (xcd < r ? xcd * (q + 1) : r * (q + 1) + (xcd - r) * q) + off; }
        const int nig = WGM * nN, gid = wgid / nig, fm = gid * WGM, gsz = (nM - fm) < WGM ? (nM - fm) : WGM;
        u.pm = fm + ((wgid % nig) % gsz); u.pn = (wgid % nig) / gsz; return true;
    }
    __device__ __forceinline__ void a_ready(const Unit&) const {}
    __device__ __forceinline__ void done(const Unit&) const {}
};

__device__ __forceinline__ unsigned cvt_pk_bf16(float lo, float hi) { unsigned r; asm volatile("v_cvt_pk_bf16_f32 %0, %1, %2" : "=v"(r) : "v"(lo), "v"(hi)); return r; }
typedef float f32x2 __attribute__((ext_vector_type(2)));
template <class Epi, class Sched, bool ALIGN_EPI = false, bool SP2 = false>
__device__ __forceinline__ void gemm_phase(PG8_LAS unsigned char* lds, const Gemm g, const Sched& S, const Epi& E) {
    int tid_ = threadIdx.x; asm volatile("" : "+v"(tid_));
    const int tid = tid_, wid = __builtin_amdgcn_readfirstlane(tid >> 6), lane = tid & 63, wr = wid >> 2, wc = wid & 3, fr = lane & 15, fq = lane >> 4;
    const int K = g.K, nt = K / BK;
    unsigned voffA[2], voffB[2];
#pragma unroll
    for (int i = 0; i < 2; ++i) { int R, C; stage_rc(tid * 16 + i * 8192, R, C); const int Rb = Epi::PERM ? ((R & ~31) + perm32(R & 31)) : R;
        voffA[i] = (unsigned)(R * g.lda + C) * 2u; voffB[i] = (unsigned)(Rb * K + C) * 2u; }
    const size_t kstep = (size_t)(BK * 2);
    const size_t hstepA = (size_t)HALF * g.lda * 2, hstepB = (size_t)HALF * K * 2;
    const size_t tstepA = 2 * hstepA, tstepB = 2 * hstepB;
    const unsigned ldsw = (unsigned)wid * 1024u;
    const int aoff = lds_byte(wr * 64 + fr, fq * 8), boff = lds_byte(wc * 32 + fr, fq * 8);
#define PG8_SA(b, h) (((b) * 2 + (h)) * HTB)
#define PG8_SB(b, h) ((4 + (b) * 2 + (h)) * HTB)
#define PG8_STAGE(bufoff, gbase, voff) do { _Pragma("unroll") for (int _i = 0; _i < 2; ++_i) \
        __builtin_amdgcn_global_load_lds((const unsigned*)((const char*)(gbase) + (voff)[_i]), (PG8_LAS unsigned*)(lds + (bufoff) + ldsw + _i * 8192), 16, 0, 0); } while (0)
#define PG8_LDA(dst, b, h) do { _Pragma("unroll") for (int m = 0; m < 4; ++m) _Pragma("unroll") for (int k = 0; k < 2; ++k) dst[m][k] = *(const PG8_LAS bf16x8*)(lds + PG8_SA(b, h) + aoff + m * 2048 + k * 1024); } while (0)
#define PG8_LDB(dst, b, h) do { _Pragma("unroll") for (int n = 0; n < 2; ++n) _Pragma("unroll") for (int k = 0; k < 2; ++k) dst[n][k] = *(const PG8_LAS bf16x8*)(lds + PG8_SB(b, h) + boff + n * 2048 + k * 1024); } while (0)
#define PG8_MMA(ai, bj, At, Bt) do { __builtin_amdgcn_s_setprio(1); _Pragma("unroll") for (int m = 0; m < 4; ++m) _Pragma("unroll") for (int n = 0; n < 2; ++n) _Pragma("unroll") for (int k = 0; k < 2; ++k) \
        acc[ai][bj][m][n] = __builtin_amdgcn_mfma_f32_16x16x32_bf16(Bt[n][k], At[m][k], acc[ai][bj][m][n], 0, 0, 0); __builtin_amdgcn_s_setprio(0); } while (0)
#define PG8_WAIT_V(n) asm volatile("s_waitcnt vmcnt(" #n ")" ::: "memory")
#define PG8_WAIT_L(n) asm volatile("s_waitcnt lgkmcnt(" #n ")" ::: "memory")
#define PG8_BAR __builtin_amdgcn_s_barrier()
#define PG8_SCHED __builtin_amdgcn_sched_barrier(0)
    Unit cur, nxt; int ui = 0;
    if (!S.next(0, cur)) return;
    f32x4 acc[2][2][4][2];
#pragma unroll
    for (int a = 0; a < 2; ++a)
#pragma unroll
        for (int b = 0; b < 2; ++b)
#pragma unroll
            for (int m = 0; m < 4; ++m)
#pragma unroll
                for (int n = 0; n < 2; ++n) acc[a][b][m][n] = (f32x4){0.f, 0.f, 0.f, 0.f};
    bf16x8 At[4][2], B0[2][2], B1[2][2];
    const char* cA = (const char*)g.A + (size_t)cur.pm * tstepA; const char* cB = (const char*)g.Bt + (size_t)cur.pn * tstepB;
    S.a_ready(cur);
    if constexpr (SP2) {
        PG8_STAGE(PG8_SB(0, 0), cB, voffB); PG8_STAGE(PG8_SB(0, 1), cB + hstepB, voffB); PG8_STAGE(PG8_SA(0, 0), cA, voffA); PG8_STAGE(PG8_SA(0, 1), cA + hstepA, voffA);
        if (wr == 1) PG8_BAR;
        PG8_WAIT_V(2); PG8_BAR;
        PG8_STAGE(PG8_SB(1, 0), cB + kstep, voffB); PG8_STAGE(PG8_SA(1, 0), cA + kstep, voffA); PG8_STAGE(PG8_SB(1, 1), cB + hstepB + kstep, voffB);
        PG8_WAIT_V(6); PG8_BAR;
    } else {
        PG8_STAGE(PG8_SB(0, 0), cB, voffB); PG8_STAGE(PG8_SA(0, 0), cA, voffA); PG8_STAGE(PG8_SB(0, 1), cB + hstepB, voffB); PG8_STAGE(PG8_SA(0, 1), cA + hstepA, voffA);
        if (wr == 1) PG8_BAR;
        PG8_WAIT_V(4); PG8_BAR;
        PG8_STAGE(PG8_SB(1, 0), cB + kstep, voffB); PG8_STAGE(PG8_SA(1, 0), cA + kstep, voffA); PG8_STAGE(PG8_SB(1, 1), cB + hstepB + kstep, voffB);
        PG8_WAIT_V(6); PG8_BAR;
    }
    for (;;) {
        const bool has_next = S.next(ui + 1, nxt);
        const char* nA = has_next ? (const char*)g.A + (size_t)nxt.pm * tstepA : cA; const char* nB = has_next ? (const char*)g.Bt + (size_t)nxt.pn * tstepB : cB;
        for (int t = 0; t < nt; t += 2) {
            const bool last = (t == nt - 2);
            const char* a1 = cA + (size_t)(t + 1) * kstep;
            const char* a2 = last ? nA : cA + (size_t)(t + 2) * kstep; const char* b2 = last ? nB : cB + (size_t)(t + 2) * kstep;
            const char* a3 = a2 + kstep; const char* b3 = b2 + kstep;
            if (last && has_next) S.a_ready(nxt);
            if constexpr (SP2) {
            PG8_LDB(B0, 0, 0); PG8_LDB(B1, 0, 1); PG8_SCHED; PG8_LDA(At, 0, 0); PG8_STAGE(PG8_SA(1, 1), a1 + hstepA, voffA);
            PG8_WAIT_V(8); PG8_WAIT_L(0); PG8_BAR; PG8_MMA(0, 0, At, B0); PG8_MMA(0, 1, At, B1); PG8_BAR; PG8_SCHED;
            PG8_LDA(At, 0, 1); PG8_STAGE(PG8_SB(0, 0), b2, voffB); PG8_STAGE(PG8_SB(0, 1), b2 + hstepB, voffB); PG8_STAGE(PG8_SA(0, 0), a2, voffA);
            PG8_WAIT_V(8); PG8_WAIT_L(0); PG8_BAR; PG8_MMA(1, 0, At, B0); PG8_MMA(1, 1, At, B1); PG8_BAR; PG8_SCHED;
            PG8_LDB(B0, 1, 0); PG8_LDB(B1, 1, 1); PG8_SCHED; PG8_LDA(At, 1, 0); PG8_STAGE(PG8_SA(0, 1), a2 + hstepA, voffA);
            PG8_WAIT_V(8); PG8_WAIT_L(0); PG8_BAR; PG8_MMA(0, 0, At, B0); PG8_MMA(0, 1, At, B1); PG8_BAR; PG8_SCHED;
            PG8_LDA(At, 1, 1); PG8_STAGE(PG8_SB(1, 0), b3, voffB); PG8_STAGE(PG8_SB(1, 1), b3 + hstepB, voffB); PG8_STAGE(PG8_SA(1, 0), a3, voffA);
            PG8_WAIT_V(8); PG8_WAIT_L(0); PG8_BAR; PG8_MMA(1, 0, At, B0); PG8_MMA(1, 1, At, B1); PG8_BAR; PG8_SCHED;
            } else {
            PG8_LDB(B0, 0, 0); PG8_SCHED; PG8_LDA(At, 0, 0); PG8_STAGE(PG8_SA(1, 1), a1 + hstepA, voffA);
            PG8_WAIT_L(8); PG8_BAR; PG8_WAIT_L(0); PG8_MMA(0, 0, At, B0); PG8_BAR; PG8_SCHED;
            PG8_LDB(B1, 0, 1); PG8_STAGE(PG8_SB(0, 0), b2, voffB);
            PG8_BAR; PG8_WAIT_L(0); PG8_MMA(0, 1, At, B1); PG8_BAR;
            PG8_LDA(At, 0, 1); PG8_STAGE(PG8_SA(0, 0), a2, voffA);
            PG8_BAR; PG8_WAIT_L(0); PG8_MMA(1, 0, At, B0); PG8_BAR; PG8_SCHED;
            PG8_STAGE(PG8_SB(0, 1), b2 + hstepB, voffB);
            PG8_WAIT_V(6); PG8_BAR; PG8_MMA(1, 1, At, B1); PG8_BAR;
            PG8_LDB(B0, 1, 0); PG8_SCHED; PG8_LDA(At, 1, 0); PG8_STAGE(PG8_SA(0, 1), a2 + hstepA, voffA);
            PG8_WAIT_L(8); PG8_BAR; PG8_WAIT_L(0); PG8_MMA(0, 0, At, B0); PG8_BAR; PG8_SCHED;
            PG8_LDB(B1, 1, 1); PG8_STAGE(PG8_SB(1, 0), b3, voffB);
            PG8_BAR; PG8_WAIT_L(0); PG8_MMA(0, 1, At, B1); PG8_BAR;
            PG8_LDA(At, 1, 1); PG8_STAGE(PG8_SA(1, 0), a3, voffA);
            PG8_BAR; PG8_WAIT_L(0); PG8_MMA(1, 0, At, B0); PG8_BAR; PG8_SCHED;
            PG8_STAGE(PG8_SB(1, 1), b3 + hstepB, voffB);
            PG8_WAIT_V(6); PG8_BAR; PG8_MMA(1, 1, At, B1); PG8_BAR;
            }
        }
        if constexpr (ALIGN_EPI) { if (wr == 0) PG8_BAR; }
        if constexpr (!Epi::AFTER_DRAIN) { E(acc, cur, wr, wc, fr, fq); S.done(cur); }
        if (!has_next) break;
#pragma unroll
        for (int a = 0; a < 2; ++a)
#pragma unroll
            for (int b = 0; b < 2; ++b)
#pragma unroll
                for (int m = 0; m < 4; ++m)
#pragma unroll
                    for (int n = 0; n < 2; ++n) acc[a][b][m][n] = (f32x4){0.f, 0.f, 0.f, 0.f};
        cur = nxt; cA = nA; cB = nB; ++ui;
        if constexpr (ALIGN_EPI) { if (wr == 1) PG8_BAR; }
    }
    PG8_WAIT_V(0);
    if constexpr (!ALIGN_EPI) { if (wr == 0) PG8_BAR; }
    PG8_BAR;
    if constexpr (Epi::AFTER_DRAIN) { E.fused(acc, cur, wr, wc, fr, fq, lds, wid, lane); S.done(cur); }
#undef PG8_SA
#undef PG8_SB
#undef PG8_STAGE
#undef PG8_LDA
#undef PG8_LDB
#undef PG8_MMA
#undef PG8_WAIT_V
#undef PG8_WAIT_L
#undef PG8_BAR
#undef PG8_SCHED
}
}
#define LAS __attribute__((address_space(3)))
typedef unsigned short bf16;
typedef float f32x4 __attribute__((ext_vector_type(4)));
typedef float f32x16 __attribute__((ext_vector_type(16)));
typedef short bf16x8 __attribute__((ext_vector_type(8)));
typedef short s16x4 __attribute__((ext_vector_type(4)));
typedef unsigned u32x4 __attribute__((ext_vector_type(4)));
typedef unsigned u32x2 __attribute__((ext_vector_type(2)));
typedef float f32x2_t __attribute__((ext_vector_type(2)));
typedef __bf16 bf16x2_t __attribute__((ext_vector_type(2)));

constexpr int D = 1024, MP = 65536, MS = 2048, M = MP + MS, DFF = 4096;
constexpr int LDP = 6144, NPROJ = 6176, NPROJ_PAD = 6400;
constexpr float ALPHA = 1.6817928305074290f, LN_EPS = 1e-5f, RMS_EPS = 1e-5f, LOG2E = 1.4426950408889634f;
constexpr size_t O_KP = 69206016, O_VP = 102760448, O_HP = 136314880, O_CP = 153092096, O_KS = 153878528, O_VS = 158072832, O_HS = 162267136, O_CS = 179044352;
constexpr size_t MiB = 1u << 20;
constexpr size_t WS_WA = 1 * MiB, WS_WB = 14 * MiB, WS_WUP = 18 * MiB, WS_WDN = 26 * MiB, WS_XB = 34 * MiB, WS_DT = 166 * MiB, WS_BIG = 175 * MiB;
constexpr size_t WS_O = WS_BIG + 396 * MiB, WS_CK = WS_BIG + 528 * MiB, WS_CV = WS_BIG + 560 * MiB, WS_END = WS_BIG + 792 * MiB;
constexpr int LDS_BYTES = 147456;

__device__ __forceinline__ unsigned pk2(float lo, float hi) { f32x2_t v = {lo, hi}; bf16x2_t b = __builtin_convertvector(v, bf16x2_t); return __builtin_bit_cast(unsigned, b); }
__device__ __forceinline__ float bf2f(unsigned short u) { return __uint_as_float((unsigned)u << 16); }
__device__ __forceinline__ float bflo(unsigned u) { return __uint_as_float(u << 16); }
__device__ __forceinline__ float bfhi(unsigned u) { return __uint_as_float(u & 0xffff0000u); }
__device__ __forceinline__ float fexp2(float x) { return __builtin_amdgcn_exp2f(x); }
__device__ __forceinline__ float frcp(float x) { return __builtin_amdgcn_rcpf(x); }
__device__ __forceinline__ float silu_f(float v) { return v * frcp(1.0f + fexp2(-v * LOG2E)); }
__device__ __forceinline__ int crow(int r, int hi) { return (r & 3) + 8 * (r >> 2) + 4 * hi; }
__device__ __forceinline__ bf16x8 pack8(const f32x16& x, int s) {
    u32x4 p; p.x = pk2(x[8 * s], x[8 * s + 1]); p.y = pk2(x[8 * s + 2], x[8 * s + 3]); p.z = pk2(x[8 * s + 4], x[8 * s + 5]); p.w = pk2(x[8 * s + 6], x[8 * s + 7]);
    return __builtin_bit_cast(bf16x8, p);
}
#define MFMA32(a, b, c) __builtin_amdgcn_mfma_f32_32x32x16_bf16((a), (b), (c), 0, 0, 0)
__device__ __forceinline__ float wave_sum(float v) {
#pragma unroll
    for (int o = 1; o < 64; o <<= 1) v += __shfl_xor(v, o);
    return v;
}

namespace pg8 {
struct EpiQKV {
    static constexpr bool PERM = true, AFTER_DRAIN = false;
    bf16_t* QKV; float* out; int li;
    __device__ __forceinline__ void operator()(const f32x4 (&acc)[2][2][4][2], const Unit& u, int wr, int wc, int fr, int fq) const {
        asm volatile("" : "+v"(fr));
        float* fdst = nullptr;
        if (u.pn >= 4) {
            const bool isv = u.pn >= 8;
            if (u.pm < 256) { const int b = u.pm >> 3, tt = u.pm & 7; if (tt >= 6) fdst = out + (isv ? O_VP : O_KP) + ((size_t)(li * 32 + b) * 512 + (size_t)(tt - 6) * 256) * 1024; }
            else fdst = out + (isv ? O_VS : O_KS) + ((size_t)li * 2048 + (size_t)(u.pm - 256) * 256) * 1024;
        }
        const int col0 = u.pn * BM + wc * 32 + 8 * fq, colk = (u.pn & 3) * BM + wc * 32 + 8 * fq;
#pragma unroll
        for (int ai = 0; ai < 2; ++ai)
#pragma unroll
            for (int m = 0; m < 4; ++m) { const int rl = ai * HALF + wr * 64 + m * 16 + fr; bf16_t* rowp = QKV + (unsigned)((u.pm * BM + rl) * 3072 + col0);
#pragma unroll
                for (int bj = 0; bj < 2; ++bj) { const f32x4 v0 = acc[ai][bj][m][0], v1 = acc[ai][bj][m][1];
                    u32x4 w; w.x = pk2(v0[0], v0[1]); w.y = pk2(v0[2], v0[3]); w.z = pk2(v1[0], v1[1]); w.w = pk2(v1[2], v1[3]);
                    *(u32x4*)(rowp + bj * HALF) = w;
                    if (fdst) { float* fp = fdst + (unsigned)(rl * 1024 + colk + bj * HALF); *(f32x4*)fp = v0; *(f32x4*)(fp + 4) = v1; } }
                asm volatile("" ::: "memory"); }
    }
};
struct EpiBf16Plain {
    static constexpr bool PERM = true, AFTER_DRAIN = false;
    bf16_t* O; int ldc; int relu2;
    __device__ __forceinline__ void operator()(const f32x4 (&acc)[2][2][4][2], const Unit& u, int wr, int wc, int fr, int fq) const {
        asm volatile("" : "+v"(fr));
        const int col0 = u.pn * BM + wc * 32 + 8 * fq;
#pragma unroll
        for (int ai = 0; ai < 2; ++ai)
#pragma unroll
            for (int m = 0; m < 4; ++m) { const int rl = ai * HALF + wr * 64 + m * 16 + fr; bf16_t* rowp = O + (unsigned)((u.pm * BM + rl) * ldc + col0);
#pragma unroll
                for (int bj = 0; bj < 2; ++bj) { f32x4 v0 = acc[ai][bj][m][0], v1 = acc[ai][bj][m][1];
                    if (relu2) { v0 = __builtin_elementwise_max(v0, (f32x4){0.f, 0.f, 0.f, 0.f}); v1 = __builtin_elementwise_max(v1, (f32x4){0.f, 0.f, 0.f, 0.f}); v0 = v0 * v0; v1 = v1 * v1; }
                    u32x4 w; w.x = pk2(v0[0], v0[1]); w.y = pk2(v0[2], v0[3]); w.z = pk2(v1[0], v1[1]); w.w = pk2(v1[2], v1[3]);
                    *(u32x4*)(rowp + bj * HALF) = w; } }
    }
};
struct EpiSsmIn {
    static constexpr bool PERM = true, AFTER_DRAIN = false;
    bf16_t* P; float* DT;
    __device__ __forceinline__ void operator()(const f32x4 (&acc)[2][2][4][2], const Unit& u, int wr, int wc, int fr, int fq) const {
        asm volatile("" : "+v"(fr));
        if (u.pn < 24) {
            const int col0 = u.pn * BM + wc * 32 + 8 * fq;
#pragma unroll
            for (int ai = 0; ai < 2; ++ai)
#pragma unroll
                for (int m = 0; m < 4; ++m) { const int rl = ai * HALF + wr * 64 + m * 16 + fr; bf16_t* rowp = P + (unsigned)((u.pm * BM + rl) * LDP + col0);
#pragma unroll
                    for (int bj = 0; bj < 2; ++bj) { const f32x4 v0 = acc[ai][bj][m][0], v1 = acc[ai][bj][m][1];
                        u32x4 w; w.x = pk2(v0[0], v0[1]); w.y = pk2(v0[2], v0[3]); w.z = pk2(v1[0], v1[1]); w.w = pk2(v1[2], v1[3]);
                        *(u32x4*)(rowp + bj * HALF) = w; }
                    asm volatile("" ::: "memory"); }
        } else if (wc == 0) {
#pragma unroll
            for (int ai = 0; ai < 2; ++ai)
#pragma unroll
                for (int m = 0; m < 4; ++m) { const int rl = ai * HALF + wr * 64 + m * 16 + fr; float* fp = DT + (unsigned)((u.pm * BM + rl) * 32 + 8 * fq);
                    *(f32x4*)fp = acc[ai][0][m][0]; *(f32x4*)(fp + 4) = acc[ai][0][m][1]; }
        }
    }
};
struct EpiResid {
    static constexpr bool PERM = false, AFTER_DRAIN = false;
    float* X;
    __device__ __forceinline__ void operator()(const f32x4 (&acc)[2][2][4][2], const Unit& u, int wr, int wc, int fr, int fq) const {
        asm volatile("" : "+v"(fr));
        const int col0 = u.pn * BM + wc * 32 + 4 * fq;
#pragma unroll
        for (int ai = 0; ai < 2; ++ai)
#pragma unroll
            for (int m = 0; m < 4; ++m) { float* rowp = X + (unsigned)((u.pm * BM + ai * HALF + wr * 64 + m * 16 + fr) * D + col0);
#pragma unroll
                for (int bj = 0; bj < 2; ++bj)
#pragma unroll
                    for (int n = 0; n < 2; ++n) { float* p = rowp + bj * HALF + n * 16; const f32x4 x = *(const f32x4*)p; *(f32x4*)p = x * ALPHA + acc[ai][bj][m][n]; }
                asm volatile("" ::: "memory"); }
    }
};
}
#define XB_TMO      128
#define XB_XCNT(j)  (256  + 64 * (j))
#define XB_XSUB(j)  (1280 + 64 * (j))
#define XB_XGEN(j)  (2304 + 64 * (j))
#define XB_TOP      3328
#define XB_TOPGEN   3392
#define XCD_BAR_WORDS 3456
#define XB_SPIN_CAP (1u << 18)

__device__ __forceinline__ unsigned xb_ld(unsigned* p)              { return __hip_atomic_load(p, __ATOMIC_RELAXED, __HIP_MEMORY_SCOPE_AGENT); }
__device__ __forceinline__ unsigned xb_add(unsigned* p, unsigned v) { return __hip_atomic_fetch_add(p, v, __ATOMIC_RELAXED, __HIP_MEMORY_SCOPE_AGENT); }
__device__ __forceinline__ unsigned xb_xcc_id() { return (unsigned)__builtin_amdgcn_s_getreg((3 << 11) | 20) & 0xFu; }
#define XB_SPIN(cond, bar) do { unsigned _sp = 0; while (cond) { __builtin_amdgcn_s_sleep(1); \
    if ((++_sp & 255u) == 0u) { if (xb_ld(&(bar)[XB_TMO])) break; if (_sp > XB_SPIN_CAP) { atomicAdd(&(bar)[XB_TMO], 1u); break; } } } } while (0)

struct XcdBarrier {
    unsigned* bar; unsigned x;
    volatile LAS unsigned* st;
};

__device__ __forceinline__ XcdBarrier xcd_barrier_post(unsigned* bar, volatile LAS unsigned* st) {
    XcdBarrier b; b.bar = bar; b.x = xb_xcc_id(); b.st = st;
    if (threadIdx.x == 0) (void)xb_add(&bar[XB_XCNT(b.x)], 1u);
    return b;
}
__device__ __forceinline__ void xcd_barrier_complete(unsigned* bar, unsigned x, unsigned& nloc, unsigned& nx) {
    const unsigned G = gridDim.x * gridDim.y * gridDim.z;
    unsigned sum, cnt, mine, sp = 0u;
    for (;;) {
        sum = 0u; cnt = 0u; mine = 0u;
#pragma unroll
        for (unsigned j = 0; j < 16; ++j) { const unsigned c = xb_ld(&bar[XB_XCNT(j)]); sum += c; cnt += (c > 0u) ? 1u : 0u; mine = (j == x) ? c : mine; }
        if (sum == G) break;
        __builtin_amdgcn_s_sleep(1);
        if ((++sp & 255u) == 0u) { if (xb_ld(&bar[XB_TMO])) break; if (sp > XB_SPIN_CAP) { atomicAdd(&bar[XB_TMO], 1u); break; } }
    }
    nloc = mine > 0u ? mine : 1u; nx = cnt > 0u ? cnt : 1u;
}

__device__ __forceinline__ void xcd_barrier(const XcdBarrier& b) {
    asm volatile("s_waitcnt vmcnt(0)" ::: "memory");
    __syncthreads();
    if (threadIdx.x == 0) {
        unsigned* bar = b.bar;
        __builtin_amdgcn_s_waitcnt(0);
        unsigned nloc = b.st[0], nx = b.st[1];
        if (nloc == 0u) { xcd_barrier_complete(bar, b.x, nloc, nx); b.st[0] = nloc; b.st[1] = nx; }
        const unsigned old = xb_add(&bar[XB_XSUB(b.x)], 1u);
        const unsigned gen = old / nloc;
        if (old + 1u == (gen + 1u) * nloc) {
            __builtin_amdgcn_fence(__ATOMIC_RELEASE, "agent");
            asm volatile("s_waitcnt vmcnt(0)" ::: "memory");
            const unsigned og = xb_add(&bar[XB_TOP], 1u);
            const unsigned tg = og / nx;
            if (og + 1u == (tg + 1u) * nx) xb_add(&bar[XB_TOPGEN], 1u);
            else XB_SPIN(xb_ld(&bar[XB_TOPGEN]) == tg, bar);
            __builtin_amdgcn_fence(__ATOMIC_ACQUIRE, "agent");
            xb_add(&bar[XB_XGEN(b.x)], 1u);
            asm volatile("s_waitcnt vmcnt(0)" ::: "memory");
        } else {
            XB_SPIN(xb_ld(&bar[XB_XGEN(b.x)]) == gen, bar);
            __builtin_amdgcn_fence(__ATOMIC_ACQUIRE, "agent");
            asm volatile("s_waitcnt vmcnt(0)" ::: "memory");
        }
    }
    __syncthreads();
}

struct Args { const float* in[25]; int ph_lo, ph_hi; };
#define AIN(k) (a.in[(k) + z])
struct Frame { unsigned char* lds; int tid, lane, wave, G, bid; };

__device__ __forceinline__ void transpose_item(const float* W, int K, int N, bf16* WT, float* scr, int item, int lane) {
    const int nblk = N / 32, kb = item / nblk, nb = item % nblk, k0 = 64 * kb, n0 = 32 * nb;
#pragma unroll 8
    for (int i = 0; i < 32; ++i) { const int kk = 2 * i + (lane >> 5); scr[kk * 33 + (lane & 31)] = W[(size_t)(k0 + kk) * N + n0 + (lane & 31)]; }
    asm volatile("s_waitcnt lgkmcnt(0)" ::: "memory");
    const int c = lane & 7;
#pragma unroll
    for (int j = 0; j < 4; ++j) { const int n = (lane >> 3) + 8 * j; const float* s = scr + (8 * c) * 33 + n;
        u32x4 o; o.x = pk2(s[0 * 33], s[1 * 33]); o.y = pk2(s[2 * 33], s[3 * 33]); o.z = pk2(s[4 * 33], s[5 * 33]); o.w = pk2(s[6 * 33], s[7 * 33]);
        *(u32x4*)(WT + (size_t)(n0 + n) * K + k0 + 8 * c) = o; }
    asm volatile("s_waitcnt lgkmcnt(0)" ::: "memory");
}
__device__ __forceinline__ void cvt_stream(const float* src, bf16* dst, size_t n, size_t gtid, size_t gthreads) {
    for (size_t i = gtid * 8; i < n; i += gthreads * 8) { const f32x4 a = *(const f32x4*)(src + i), b = *(const f32x4*)(src + i + 4);
        u32x4 o; o.x = pk2(a[0], a[1]); o.y = pk2(a[2], a[3]); o.z = pk2(b[0], b[1]); o.w = pk2(b[2], b[3]); *(u32x4*)(dst + i) = o; }
}
__device__ __forceinline__ void convert_phase(const Frame& F, const Args& a, int z, int L) {
    unsigned char* ws = (unsigned char*)AIN(24); float* outp = (float*)AIN(23); const int li = L >> 1; const bool ssm = (L & 1);
    float* scr = (float*)(F.lds + F.wave * 16384);
    const int gw = F.bid * 8 + F.wave, NGW = F.G * 8;
    const float* Wa = ssm ? AIN(9) + (size_t)li * D * NPROJ : AIN(6) + (size_t)li * D * 3072; const int Na = ssm ? NPROJ : 3072;
    const float* Wb = ssm ? AIN(16) + (size_t)li * 2048 * D : AIN(8) + (size_t)li * D * D; const int Kb = ssm ? 2048 : D;
    const float* Wu = AIN(19) + (size_t)L * D * DFF; const float* Wd = AIN(20) + (size_t)L * DFF * D;
    const int Ia = (D / 64) * (Na / 32), Ib = (Kb / 64) * (D / 32), Iu = (D / 64) * (DFF / 32), Id = (DFF / 64) * (D / 32);
    const int NIT = Ia + Ib + Iu + Id;
    for (int it = gw; it < NIT; it += NGW) {
        int r = it;
        if (r < Ia) { transpose_item(Wa, D, Na, (bf16*)(ws + WS_WA), scr, r, F.lane); continue; } r -= Ia;
        if (r < Ib) { transpose_item(Wb, Kb, D, (bf16*)(ws + WS_WB), scr, r, F.lane); continue; } r -= Ib;
        if (r < Iu) { transpose_item(Wu, D, DFF, (bf16*)(ws + WS_WUP), scr, r, F.lane); continue; } r -= Iu;
        transpose_item(Wd, DFF, D, (bf16*)(ws + WS_WDN), scr, r, F.lane);
    }
    const size_t gtid = (size_t)F.bid * 512 + F.tid, gth = (size_t)F.G * 512;
    if (!ssm) {
        cvt_stream(AIN(2) + (size_t)li * 32 * 512 * 1024, (bf16*)(ws + WS_CK), (size_t)32 * 512 * 1024, gtid, gth);
        cvt_stream(AIN(3) + (size_t)li * 32 * 512 * 1024, (bf16*)(ws + WS_CV), (size_t)32 * 512 * 1024, gtid, gth);
    }
    if (L == 0) {
        const size_t n = (size_t)M * D, np = (size_t)MP * D;
        bf16* XB = (bf16*)(ws + WS_XB);
        for (size_t i = gtid * 8; i < n; i += gth * 8) { const float* src = i < np ? AIN(0) + i : AIN(1) + (i - np);
            const f32x4 x0 = *(const f32x4*)src, x1 = *(const f32x4*)(src + 4);
            *(f32x4*)(outp + i) = x0; *(f32x4*)(outp + i + 4) = x1;
            u32x4 o; o.x = pk2(x0[0], x0[1]); o.y = pk2(x0[2], x0[3]); o.z = pk2(x1[0], x1[1]); o.w = pk2(x1[2], x1[3]); *(u32x4*)(XB + i) = o; }
    }
}
__device__ __forceinline__ void ln_phase(const Frame& F, float* X, bf16* XB, const float* g, const float* b) {
    const int gw = F.bid * 8 + F.wave, NGW = F.G * 8;
    f32x4 gv[4], bv[4];
#pragma unroll
    for (int j = 0; j < 4; ++j) { gv[j] = *(const f32x4*)(g + 4 * F.lane + 256 * j); bv[j] = *(const f32x4*)(b + 4 * F.lane + 256 * j); }
    for (int m = gw; m < M; m += NGW) {
        f32x4* xr = (f32x4*)(X + (size_t)m * D) + F.lane;
        f32x4 v[4]; float s = 0.f;
#pragma unroll
        for (int j = 0; j < 4; ++j) { v[j] = xr[64 * j]; s += (v[j][0] + v[j][1]) + (v[j][2] + v[j][3]); }
        const float mean = wave_sum(s) * (1.f / D); float s2 = 0.f;
#pragma unroll
        for (int j = 0; j < 4; ++j) { v[j] = v[j] - mean; s2 += (v[j][0] * v[j][0] + v[j][1] * v[j][1]) + (v[j][2] * v[j][2] + v[j][3] * v[j][3]); }
        const float rstd = 1.f / sqrtf(wave_sum(s2) * (1.f / D) + LN_EPS);
        u32x2* o8 = (u32x2*)(XB + (size_t)m * D) + F.lane;
#pragma unroll
        for (int j = 0; j < 4; ++j) { const f32x4 y = v[j] * rstd * gv[j] + bv[j]; xr[64 * j] = y; u32x2 w; w.x = pk2(y[0], y[1]); w.y = pk2(y[2], y[3]); o8[64 * j] = w; }
    }
}

__device__ __forceinline__ void attn_phase(const Frame& F, const float* relb, const bf16* QKV, const bf16* CK, const bf16* CV, bf16* O) {
    float* tbl = (float*)F.lds;
    for (int i = F.tid; i < 16 * 513; i += 512) tbl[i] = relb[i] * LOG2E;
    __syncthreads();
    unsigned char* vt = F.lds + 36864 + F.wave * 9216;
    const int lane = F.lane, l31 = lane & 31, hh = lane >> 5;
    const int i16 = lane & 15, q4 = i16 >> 2, p4 = i16 & 3, dblk = (lane >> 4) & 1;
    const int gw = F.bid * 8 + F.wave, NGW = F.G * 8;
    constexpr int NITEM = (32 * 32 + 32) * 32;
    constexpr float C2 = 0.125f * LOG2E;
    for (int it = gw; it < NITEM; it += NGW) {
        const bool smp = it >= 32768;
        const int r = smp ? it - 32768 : it;
        const int qh = r & 1, h = (r >> 1) & 15, c = smp ? 0 : (r >> 5) & 31, b = smp ? (r >> 5) : (r >> 10);
        const size_t qrow0 = smp ? (size_t)MP + b * 64 + 32 * qh : (size_t)b * 2048 + 64 * c + 32 * qh;
        bf16x8 qf[4];
#pragma unroll
        for (int ks = 0; ks < 4; ++ks) qf[ks] = *(const bf16x8*)(QKV + (qrow0 + l31) * 3072 + h * 64 + 16 * ks + 8 * hh);
        f32x16 o0, o1;
#pragma unroll
        for (int i = 0; i < 16; ++i) { o0[i] = 0.f; o1[i] = 0.f; }
        float mrun = -1e30f, lsum = 0.f;
        const float* tb = tbl + h * 513;
        const float cbias = tb[512];
        const int jb0 = smp ? 0 : (c >= 8 ? 0 : 8 - c);
        for (int jb = jb0; jb <= 8; ++jb) {
            const bf16 *Kp, *Vp; int pitch;
            if (!smp) { Kp = QKV + ((size_t)b * 2048 + 64 * (c - 8 + jb)) * 3072 + 1024 + h * 64; Vp = Kp + 1024; pitch = 3072; }
            else if (jb < 8) { Kp = CK + ((size_t)b * 512 + 64 * jb) * 1024 + h * 64; Vp = CV + ((size_t)b * 512 + 64 * jb) * 1024 + h * 64; pitch = 1024; }
            else { Kp = QKV + ((size_t)MP + b * 64) * 3072 + 1024 + h * 64; Vp = Kp + 1024; pitch = 3072; }
            bf16x8 kf[2][4], vr[8];
#pragma unroll
            for (int rb = 0; rb < 2; ++rb)
#pragma unroll
                for (int ks = 0; ks < 4; ++ks) kf[rb][ks] = *(const bf16x8*)(Kp + (size_t)(32 * rb + l31) * pitch + 16 * ks + 8 * hh);
#pragma unroll
            for (int i = 0; i < 8; ++i) vr[i] = *(const bf16x8*)(Vp + (size_t)(8 * i + (lane >> 3)) * pitch + 8 * (lane & 7));
            asm volatile("" ::: "memory");
#pragma unroll
            for (int i = 0; i < 8; ++i) *(bf16x8*)(vt + ((8 * i + (lane >> 3)) * 72 + 8 * (lane & 7)) * 2) = vr[i];
            asm volatile("" ::: "memory");
            f32x16 s0, s1;
#pragma unroll
            for (int i = 0; i < 16; ++i) { s0[i] = 0.f; s1[i] = 0.f; }
#pragma unroll
            for (int ks = 0; ks < 4; ++ks) { s0 = MFMA32(kf[0][ks], qf[ks], s0); s1 = MFMA32(kf[1][ks], qf[ks], s1); }
            if (jb <= 3) {
#pragma unroll
                for (int i = 0; i < 16; ++i) { s0[i] = s0[i] * C2 + cbias; s1[i] = s1[i] * C2 + cbias; }
            } else {
                const int dbase = 64 * (8 - jb) + 32 * qh + l31 + 256;
#pragma unroll
                for (int i = 0; i < 16; ++i) { const int k0 = crow(i, hh); int i0 = dbase - k0, i1 = dbase - k0 - 32; i0 = i0 > 512 ? 512 : i0; i1 = i1 > 512 ? 512 : i1;
                    s0[i] = s0[i] * C2 + tb[i0]; s1[i] = s1[i] * C2 + tb[i1]; }
            }
            float mx = s0[0];
#pragma unroll
            for (int i = 1; i < 16; ++i) mx = fmaxf(mx, s0[i]);
#pragma unroll
            for (int i = 0; i < 16; ++i) mx = fmaxf(mx, s1[i]);
            mx = fmaxf(mx, __shfl_xor(mx, 32));
            const float mnew = fmaxf(mrun, mx), alpha = fexp2(mrun - mnew);
            mrun = mnew;
            float ps = 0.f;
#pragma unroll
            for (int i = 0; i < 16; ++i) { s0[i] = fexp2(s0[i] - mnew); s1[i] = fexp2(s1[i] - mnew); ps += s0[i] + s1[i]; }
            lsum = lsum * alpha + ps;
#pragma unroll
            for (int i = 0; i < 16; ++i) { o0[i] *= alpha; o1[i] *= alpha; }
#pragma unroll
            for (int rb = 0; rb < 2; ++rb)
#pragma unroll
                for (int s2 = 0; s2 < 2; ++s2) {
                    const bf16x8 pf = pack8(rb ? s1 : s0, s2);
                    const int k0 = 32 * rb + 16 * s2 + 4 * hh + q4;
#pragma unroll
                    for (int db = 0; db < 2; ++db) {
                        const int cb = 32 * db + 16 * dblk + 4 * p4;
                        const s16x4 lo = __builtin_amdgcn_ds_read_tr16_b64_v4i16((LAS s16x4*)(vt + (k0 * 72 + cb) * 2));
                        const s16x4 hi = __builtin_amdgcn_ds_read_tr16_b64_v4i16((LAS s16x4*)(vt + ((k0 + 8) * 72 + cb) * 2));
                        const bf16x8 va = __builtin_shufflevector(lo, hi, 0, 1, 2, 3, 4, 5, 6, 7);
                        if (db == 0) o0 = MFMA32(va, pf, o0); else o1 = MFMA32(va, pf, o1);
                    }
                }
            asm volatile("" ::: "memory");
        }
        const float inv = 1.0f / (lsum + __shfl_xor(lsum, 32));
        bf16* orow = O + (qrow0 + l31) * D + h * 64 + 4 * hh;
#pragma unroll
        for (int i4 = 0; i4 < 4; ++i4) {
            u32x2 w0; w0.x = pk2(o0[4 * i4] * inv, o0[4 * i4 + 1] * inv); w0.y = pk2(o0[4 * i4 + 2] * inv, o0[4 * i4 + 3] * inv); *(u32x2*)(orow + 8 * i4) = w0;
            u32x2 w1; w1.x = pk2(o1[4 * i4] * inv, o1[4 * i4 + 1] * inv); w1.y = pk2(o1[4 * i4 + 2] * inv, o1[4 * i4 + 3] * inv); *(u32x2*)(orow + 32 + 8 * i4) = w1;
        }
    }
}
constexpr int SX_XT = 0, SX_XWT = 36864, SX_BT = 73728, SX_BS = 92160, SX_CS = 109568, SX_DT = 126976, SX_CUM = SX_DT + 1024, SX_WIN = SX_DT + 2048, SX_PART = SX_DT + 3072;
__device__ __forceinline__ void ssd_phase(const Frame& F, const Args& a, int z, int li, bf16* PROJ, const float* DT) {
    float* outp = (float*)AIN(23);
    unsigned char* lds = F.lds;
    bf16* Xt = (bf16*)(lds + SX_XT); bf16* Xwt = (bf16*)(lds + SX_XWT); bf16* Bt = (bf16*)(lds + SX_BT); bf16* Bs = (bf16*)(lds + SX_BS); bf16* Cs = (bf16*)(lds + SX_CS);
    float* dts = (float*)(lds + SX_DT); float* cums = (float*)(lds + SX_CUM); float* wins = (float*)(lds + SX_WIN); float* part = (float*)(lds + SX_PART);
    const int tid = F.tid, lane = F.lane, wave = F.wave, l31 = lane & 31, hh = lane >> 5;
    const int r = wave >> 1, half = wave & 1;
    const float* conv_w = AIN(10) + (size_t)li * 4 * 4096; const float* conv_b = AIN(11) + (size_t)li * 4096;
    const float* dt_bias = AIN(12) + li * 32; const float* a_log = AIN(13) + li * 32; const float* d_skip = AIN(14) + li * 32; const float* norm_w = AIN(15) + (size_t)li * 2048;
    for (int item = F.bid; item < 512; item += F.G) {
        const bool smp = item >= 256; const int bg = item & 255, b = bg >> 3, g = bg & 7;
        const size_t row0 = smp ? (size_t)MP + b * 64 : (size_t)b * 2048; const int nchunks = smp ? 1 : 32;
        const int ch = tid < 256 ? g * 256 + tid : (tid < 384 ? 2048 + g * 128 + (tid - 256) : 3072 + g * 128 + (tid - 384));
        const float cw0 = conv_w[ch], cw1 = conv_w[4096 + ch], cw2 = conv_w[8192 + ch], cw3 = conv_w[12288 + ch], cbs = conv_b[ch];
        float x3 = 0.f, x2 = 0.f, x1 = 0.f;
        if (smp) { const float* sc = AIN(5) + ((size_t)(li * 32 + b) * 3) * 4096 + ch; x3 = sc[0]; x2 = sc[4096]; x1 = sc[8192]; }
        const int hglob = g * 4 + r;
        const float Dr = d_skip[hglob];
        f32x16 hT[4];
        const size_t hoff = (((size_t)(li * 32 + b) * 32 + hglob) * 64 + 32 * half + l31) * 128 + 4 * hh;
        if (smp) { const float* hs = AIN(4) + hoff;
#pragma unroll
            for (int nb = 0; nb < 4; ++nb)
#pragma unroll
                for (int i4 = 0; i4 < 4; ++i4) { const f32x4 v = *(const f32x4*)(hs + 32 * nb + 8 * i4); hT[nb][4 * i4] = v[0]; hT[nb][4 * i4 + 1] = v[1]; hT[nb][4 * i4 + 2] = v[2]; hT[nb][4 * i4 + 3] = v[3]; }
        } else {
#pragma unroll
            for (int nb = 0; nb < 4; ++nb)
#pragma unroll
                for (int i = 0; i < 16; ++i) hT[nb][i] = 0.f;
        }
        for (int c = 0; c < nchunks; ++c) {
            const size_t rowc = row0 + 64 * c;
            if (tid < 256) {
                const int hr = g * 4 + wave;
                const float raw = DT[(rowc + lane) * 32 + hr] + dt_bias[hr];
                const float dt = raw > 20.f ? raw : log1pf(__expf(raw));
                const float am = -__expf(a_log[hr]) * LOG2E;
                float v = dt * am;
#pragma unroll
                for (int o = 1; o < 64; o <<= 1) { const float n = __shfl_up(v, o); if (lane >= o) v += n; }
                const float last = __shfl(v, 63);
                dts[wave * 64 + lane] = dt; cums[wave * 64 + lane] = v; wins[wave * 64 + lane] = fexp2(last - v) * dt;
            }
            __syncthreads();
            {
                const bf16* src = PROJ + rowc * LDP + 2048 + ch;
#pragma unroll 1
                for (int t8 = 0; t8 < 8; ++t8) {
                    float xin[8];
#pragma unroll
                    for (int j = 0; j < 8; ++j) xin[j] = bf2f(src[(size_t)(8 * t8 + j) * LDP]);
                    float sv[8];
#pragma unroll
                    for (int j = 0; j < 8; ++j) { const float v = cbs + cw0 * x3 + cw1 * x2 + cw2 * x1 + cw3 * xin[j]; x3 = x2; x2 = x1; x1 = xin[j]; sv[j] = silu_f(v); }
                    u32x4 w; w.x = pk2(sv[0], sv[1]); w.y = pk2(sv[2], sv[3]); w.z = pk2(sv[4], sv[5]); w.w = pk2(sv[6], sv[7]);
                    if (tid < 256) {
                        *(u32x4*)(Xt + tid * 72 + 8 * t8) = w;
                        const float* wr8 = wins + wave * 64 + 8 * t8;
                        u32x4 w2; w2.x = pk2(sv[0] * wr8[0], sv[1] * wr8[1]); w2.y = pk2(sv[2] * wr8[2], sv[3] * wr8[3]); w2.z = pk2(sv[4] * wr8[4], sv[5] * wr8[5]); w2.w = pk2(sv[6] * wr8[6], sv[7] * wr8[7]);
                        *(u32x4*)(Xwt + tid * 72 + 8 * t8) = w2;
                    } else if (tid < 384) {
                        const int n = tid - 256;
                        *(u32x4*)(Bt + n * 72 + 8 * t8) = w;
                        const unsigned ww[4] = {w.x, w.y, w.z, w.w};
#pragma unroll
                        for (int j = 0; j < 8; ++j) Bs[(8 * t8 + j) * 136 + n] = (bf16)((j & 1) ? (ww[j >> 1] >> 16) : (ww[j >> 1] & 0xffffu));
                    } else {
                        const int n = tid - 384;
                        const unsigned ww[4] = {w.x, w.y, w.z, w.w};
#pragma unroll
                        for (int j = 0; j < 8; ++j) Cs[(8 * t8 + j) * 136 + n] = (bf16)((j & 1) ? (ww[j >> 1] >> 16) : (ww[j >> 1] & 0xffffu));
                    }
                }
            }
            __syncthreads();
            f32x16 cb00, cb01, cb11;
#pragma unroll
            for (int i = 0; i < 16; ++i) { cb00[i] = 0.f; cb01[i] = 0.f; cb11[i] = 0.f; }
#pragma unroll
            for (int ns = 0; ns < 8; ++ns) {
                const bf16x8 a0 = *(const bf16x8*)(Bs + l31 * 136 + 16 * ns + 8 * hh), a1 = *(const bf16x8*)(Bs + (32 + l31) * 136 + 16 * ns + 8 * hh);
                const bf16x8 c0 = *(const bf16x8*)(Cs + l31 * 136 + 16 * ns + 8 * hh), c1 = *(const bf16x8*)(Cs + (32 + l31) * 136 + 16 * ns + 8 * hh);
                cb00 = MFMA32(a0, c0, cb00); cb01 = MFMA32(a0, c1, cb01); cb11 = MFMA32(a1, c1, cb11);
            }
            const float* cumr = cums + r * 64; const float* dtr = dts + r * 64;
            const float cum_t0 = cumr[l31], cum_t1 = cumr[32 + l31];
#pragma unroll
            for (int i4 = 0; i4 < 4; ++i4) {
                const f32x4 cs0 = *(const f32x4*)(cumr + 8 * i4 + 4 * hh), cs1 = *(const f32x4*)(cumr + 32 + 8 * i4 + 4 * hh);
                const f32x4 ds0 = *(const f32x4*)(dtr + 8 * i4 + 4 * hh), ds1 = *(const f32x4*)(dtr + 32 + 8 * i4 + 4 * hh);
#pragma unroll
                for (int j = 0; j < 4; ++j) { const int i = 4 * i4 + j, s = 8 * i4 + 4 * hh + j;
                    float v00 = cb00[i] * fexp2(fminf(cum_t0 - cs0[j], 0.f)) * ds0[j]; v00 = (s <= l31) ? v00 : 0.f; v00 += (s == l31) ? Dr : 0.f; cb00[i] = v00;
                    cb01[i] = cb01[i] * fexp2(fminf(cum_t1 - cs0[j], 0.f)) * ds0[j];
                    float v11 = cb11[i] * fexp2(fminf(cum_t1 - cs1[j], 0.f)) * ds1[j]; v11 = (s <= l31) ? v11 : 0.f; v11 += (s == l31) ? Dr : 0.f; cb11[i] = v11; }
            }
            f32x16 y0, y1;
#pragma unroll
            for (int i = 0; i < 16; ++i) { y0[i] = 0.f; y1[i] = 0.f; }
#pragma unroll
            for (int nb = 0; nb < 4; ++nb)
#pragma unroll
                for (int s2 = 0; s2 < 2; ++s2) {
                    const bf16x8 ha = pack8(hT[nb], s2);
                    const int n0 = 32 * nb + 16 * s2 + 4 * hh;
                    const s16x4 c0l = *(const s16x4*)(Cs + l31 * 136 + n0), c0h = *(const s16x4*)(Cs + l31 * 136 + n0 + 8);
                    const s16x4 c1l = *(const s16x4*)(Cs + (32 + l31) * 136 + n0), c1h = *(const s16x4*)(Cs + (32 + l31) * 136 + n0 + 8);
                    y0 = MFMA32(ha, __builtin_shufflevector(c0l, c0h, 0, 1, 2, 3, 4, 5, 6, 7), y0);
                    y1 = MFMA32(ha, __builtin_shufflevector(c1l, c1h, 0, 1, 2, 3, 4, 5, 6, 7), y1);
                }
            { const float e0 = fexp2(cum_t0), e1 = fexp2(cum_t1);
#pragma unroll
              for (int i = 0; i < 16; ++i) { y0[i] *= e0; y1[i] *= e1; } }
            { const bf16* xrow = Xt + (64 * r + 32 * half + l31) * 72;
#pragma unroll
              for (int s2 = 0; s2 < 2; ++s2) {
                  const s16x4 x0l = *(const s16x4*)(xrow + 16 * s2 + 4 * hh), x0h = *(const s16x4*)(xrow + 16 * s2 + 4 * hh + 8);
                  const s16x4 x1l = *(const s16x4*)(xrow + 32 + 16 * s2 + 4 * hh), x1h = *(const s16x4*)(xrow + 32 + 16 * s2 + 4 * hh + 8);
                  const bf16x8 xa0 = __builtin_shufflevector(x0l, x0h, 0, 1, 2, 3, 4, 5, 6, 7), xa1 = __builtin_shufflevector(x1l, x1h, 0, 1, 2, 3, 4, 5, 6, 7);
                  y0 = MFMA32(xa0, pack8(cb00, s2), y0);
                  y1 = MFMA32(xa0, pack8(cb01, s2), y1);
                  y1 = MFMA32(xa1, pack8(cb11, s2), y1);
              } }
            {
                float ss0 = 0.f, ss1 = 0.f;
                bf16* zr0 = PROJ + (rowc + l31) * LDP + g * 256 + 64 * r + 32 * half + 4 * hh; bf16* zr1 = zr0 + (size_t)32 * LDP;
#pragma unroll
                for (int i4 = 0; i4 < 4; ++i4) {
                    const u32x2 z0 = *(const u32x2*)(zr0 + 8 * i4), z1 = *(const u32x2*)(zr1 + 8 * i4);
                    const float za[4] = {bflo(z0.x), bfhi(z0.x), bflo(z0.y), bfhi(z0.y)}, zb[4] = {bflo(z1.x), bfhi(z1.x), bflo(z1.y), bfhi(z1.y)};
#pragma unroll
                    for (int j = 0; j < 4; ++j) { const float v0 = y0[4 * i4 + j] * silu_f(za[j]), v1 = y1[4 * i4 + j] * silu_f(zb[j]); y0[4 * i4 + j] = v0; y1[4 * i4 + j] = v1; ss0 += v0 * v0; ss1 += v1 * v1; }
                }
                ss0 += __shfl_xor(ss0, 32); ss1 += __shfl_xor(ss1, 32);
                if (hh == 0) { part[l31 * 8 + wave] = ss0; part[(32 + l31) * 8 + wave] = ss1; }
                __syncthreads();
                const f32x4 pa = *(const f32x4*)(part + l31 * 8), pb = *(const f32x4*)(part + l31 * 8 + 4), pc = *(const f32x4*)(part + (32 + l31) * 8), pd = *(const f32x4*)(part + (32 + l31) * 8 + 4);
                const float t0 = ((pa[0] + pa[1]) + (pa[2] + pa[3])) + ((pb[0] + pb[1]) + (pb[2] + pb[3])), t1 = ((pc[0] + pc[1]) + (pc[2] + pc[3])) + ((pd[0] + pd[1]) + (pd[2] + pd[3]));
                const float r0 = 1.0f / sqrtf(t0 * (1.f / 256.f) + RMS_EPS), r1 = 1.0f / sqrtf(t1 * (1.f / 256.f) + RMS_EPS);
                const float* nwp = norm_w + g * 256 + 64 * r + 32 * half + 4 * hh;
#pragma unroll
                for (int i4 = 0; i4 < 4; ++i4) { const f32x4 nw = *(const f32x4*)(nwp + 8 * i4);
                    u32x2 w0; w0.x = pk2(y0[4 * i4] * r0 * nw[0], y0[4 * i4 + 1] * r0 * nw[1]); w0.y = pk2(y0[4 * i4 + 2] * r0 * nw[2], y0[4 * i4 + 3] * r0 * nw[3]); *(u32x2*)(zr0 + 8 * i4) = w0;
                    u32x2 w1; w1.x = pk2(y1[4 * i4] * r1 * nw[0], y1[4 * i4 + 1] * r1 * nw[1]); w1.y = pk2(y1[4 * i4 + 2] * r1 * nw[2], y1[4 * i4 + 3] * r1 * nw[3]); *(u32x2*)(zr1 + 8 * i4) = w1; }
            }
            { const float dec = fexp2(cumr[63]);
#pragma unroll
              for (int nb = 0; nb < 4; ++nb)
#pragma unroll
                  for (int i = 0; i < 16; ++i) hT[nb][i] *= dec;
              const bf16* xw = Xwt + (64 * r + 32 * half + l31) * 72 + 8 * hh;
#pragma unroll
              for (int ss = 0; ss < 4; ++ss) { const bf16x8 bx = *(const bf16x8*)(xw + 16 * ss);
#pragma unroll
                  for (int nb = 0; nb < 4; ++nb) { const bf16x8 af = *(const bf16x8*)(Bt + (32 * nb + l31) * 72 + 16 * ss + 8 * hh); hT[nb] = MFMA32(af, bx, hT[nb]); } }
            }
            __syncthreads();
        }
        { float* ho = outp + (smp ? O_HS : O_HP) + hoff;
#pragma unroll
          for (int nb = 0; nb < 4; ++nb)
#pragma unroll
              for (int i4 = 0; i4 < 4; ++i4) *(f32x4*)(ho + 32 * nb + 8 * i4) = (f32x4){hT[nb][4 * i4], hT[nb][4 * i4 + 1], hT[nb][4 * i4 + 2], hT[nb][4 * i4 + 3]};
          float* co = outp + (smp ? O_CS : O_CP) + ((size_t)(li * 32 + b) * 3) * 4096 + ch; co[0] = x3; co[4096] = x2; co[8192] = x1; }
    }
}
__global__ void __launch_bounds__(512, 2) fwd_megakernel(Args a) {
    extern __shared__ __attribute__((aligned(16))) unsigned char lds[];
    cg::grid_group grid = cg::this_grid();
    Frame F; F.lds = lds; F.tid = threadIdx.x; F.lane = F.tid & 63; F.wave = __builtin_amdgcn_readfirstlane(F.tid >> 6); F.G = gridDim.x; F.bid = blockIdx.x;
    PG8_LAS unsigned char* glds = (PG8_LAS unsigned char*)lds;
    {
        int z = 0; asm volatile("" : "+s"(z));
        unsigned* bw = (unsigned*)AIN(24);
        if (blockIdx.x == 0) for (int i = threadIdx.x; i < XCD_BAR_WORDS; i += 512) __hip_atomic_store(bw + i, 0u, __ATOMIC_RELAXED, __HIP_MEMORY_SCOPE_AGENT);
        volatile LAS unsigned* st = (volatile LAS unsigned*)(glds + (LDS_BYTES - 16));
        if (threadIdx.x < 2) st[threadIdx.x] = 0u;
        __syncthreads();
        grid.sync();
        (void)xcd_barrier_post(bw, st);
    }
#ifndef REP_IN
#define REP_IN 1
#endif
#ifndef REP_ATT
#define REP_ATT 1
#endif
#ifndef REP_UP
#define REP_UP 1
#endif
#ifndef REP_CONV
#define REP_CONV 1
#endif
#ifndef REP_SYNC
#define REP_SYNC 1
#endif
    for (int ph = a.ph_lo; ph < a.ph_hi; ++ph) {
      const int sub_ = ph & 7; const int nrep = sub_ == 0 ? REP_CONV : sub_ == 1 ? REP_IN : (sub_ == 2 && !((ph >> 3) & 1)) ? REP_ATT : sub_ == 5 ? REP_UP : 1;
      for (int rep = 0; rep < nrep; ++rep) {
        { int t_ = threadIdx.x; asm volatile("" : "+v"(t_)); F.tid = t_; F.lane = t_ & 63; F.wave = __builtin_amdgcn_readfirstlane(t_ >> 6); }
        int z = 0; asm volatile("" : "+s"(z));
        unsigned char* ws = (unsigned char*)AIN(24);
        bf16* WA = (bf16*)(ws + WS_WA); bf16* WB = (bf16*)(ws + WS_WB); bf16* WUP = (bf16*)(ws + WS_WUP); bf16* WDN = (bf16*)(ws + WS_WDN);
        bf16* XB = (bf16*)(ws + WS_XB); float* DT = (float*)(ws + WS_DT); bf16* BIG = (bf16*)(ws + WS_BIG);
        bf16* OB = (bf16*)(ws + WS_O); bf16* CK = (bf16*)(ws + WS_CK); bf16* CV = (bf16*)(ws + WS_CV);
        float* X = (float*)AIN(23);
        const int L = ph >> 3, sub = ph & 7, li = L >> 1; const bool ssm = (L & 1);
        if (sub == 0) {
#ifndef NO_CONV
 convert_phase(F, a, z, L);
#endif
 }
        else if (sub == 1) {
#if !defined(ONLY_SUB) || ONLY_SUB == 1
            pg8::StaticOrder S;
            if (!ssm) { pg8::Gemm g{XB, WA, M, 3072, D, D}; S.init(M, 3072, F.G, F.bid); pg8::EpiQKV E{BIG, X, li};
                pg8::gemm_phase<pg8::EpiQKV, pg8::StaticOrder, true, true>(glds, g, S, E); }
            else { pg8::Gemm g{XB, WA, M, NPROJ_PAD, D, D}; S.init(M, NPROJ_PAD, F.G, F.bid); pg8::EpiSsmIn E{BIG, DT};
                pg8::gemm_phase<pg8::EpiSsmIn, pg8::StaticOrder, true, true>(glds, g, S, E); }
#endif
        } else if (sub == 2) {
#ifndef NO_ATTN
            if (!ssm) attn_phase(F, AIN(7) + (size_t)li * 16 * 513, BIG, CK, CV, OB);
#endif
#ifndef NO_SSD
            if (ssm) ssd_phase(F, a, z, li, BIG, DT);
#endif
        } else if (sub == 3) {
#if !defined(ONLY_SUB) || ONLY_SUB == 3
            pg8::StaticOrder S; S.init(M, D, F.G, F.bid); pg8::EpiResid E{X};
            if (!ssm) { pg8::Gemm g{OB, WB, M, D, D, D}; pg8::gemm_phase<pg8::EpiResid, pg8::StaticOrder, true, true>(glds, g, S, E); }
            else { pg8::Gemm g{BIG, WB, M, D, 2048, LDP}; pg8::gemm_phase<pg8::EpiResid, pg8::StaticOrder, true, true>(glds, g, S, E); }
#endif
        } else if (sub == 4) ln_phase(F, X, XB, AIN(17) + L * D, AIN(18) + L * D);
        else if (sub == 5) {
#if !defined(ONLY_SUB) || ONLY_SUB == 5
 pg8::Gemm g{XB, WUP, M, DFF, D, D}; pg8::StaticOrder S; S.init(M, DFF, F.G, F.bid); pg8::EpiBf16Plain E{BIG, DFF, 1};
            pg8::gemm_phase<pg8::EpiBf16Plain, pg8::StaticOrder, true, true>(glds, g, S, E);
#endif
 }
        else if (sub == 6) {
#if !defined(ONLY_SUB) || ONLY_SUB == 6
 pg8::Gemm g{BIG, WDN, M, D, DFF, DFF}; pg8::StaticOrder S; S.init(M, D, F.G, F.bid); pg8::EpiResid E{X};
            pg8::gemm_phase<pg8::EpiResid, pg8::StaticOrder, true, true>(glds, g, S, E);
#endif
 }
        else ln_phase(F, X, XB, AIN(21) + L * D, AIN(22) + L * D);
        if (ph + 1 < a.ph_hi || rep + 1 < nrep) { for (int s_ = 0; s_ < REP_SYNC; ++s_) { XcdBarrier xb_; xb_.bar = (unsigned*)AIN(24); xb_.x = xb_xcc_id(); xb_.st = (volatile LAS unsigned*)(glds + (LDS_BYTES - 16)); xcd_barrier(xb_); } }
      }
    }
}

extern "C" void kernel_launch(void* const* d_in, const int* in_sizes, int n_in, void* d_out, int out_size, void* d_ws, size_t ws_size, hipStream_t stream) {
    static int grid = 0;
    if (grid == 0) {
        if (n_in != 23 || ws_size < WS_END) { fprintf(stderr, "kernel_launch: need 23 inputs and %zu bytes of workspace, got %d and %zu\n", (size_t)WS_END, n_in, ws_size); grid = -1; return; }
        int dev = 0, cus = 0, per_cu = 0;
        hipGetDevice(&dev); hipDeviceGetAttribute(&cus, hipDeviceAttributeMultiprocessorCount, dev);
        if (hipFuncSetAttribute((const void*)fwd_megakernel, hipFuncAttributeMaxDynamicSharedMemorySize, LDS_BYTES) != hipSuccess) { fprintf(stderr, "kernel_launch: hipFuncSetAttribute failed\n"); grid = -1; return; }
        if (hipOccupancyMaxActiveBlocksPerMultiprocessor(&per_cu, (const void*)fwd_megakernel, 512, LDS_BYTES) != hipSuccess || per_cu < 1) per_cu = 1;
        (void)hipGetLastError();
        grid = cus * per_cu;
    }
    if (grid < 0) return;
    Args a{};
    for (int i = 0; i < 23; ++i) a.in[i] = (const float*)d_in[i];
    a.in[23] = (const float*)d_out; a.in[24] = (const float*)d_ws; a.ph_lo = 0; a.ph_hi = 32;
    void* args[] = {&a};
    hipError_t e = hipLaunchCooperativeKernel((const void*)fwd_megakernel, dim3(grid), dim3(512), args, LDS_BYTES, stream);
    if (e != hipSuccess) fprintf(stderr, "cooperative launch failed: %s (grid %d)\n", hipGetErrorString(e), grid);
}
```

```cpp
#include <hip/hip_runtime.h>
#include <hip/hip_cooperative_groups.h>
#include <cstdio>
#include <cstdint>
namespace cg = cooperative_groups;
namespace pg8 {
#define PG8_LAS __attribute__((address_space(3)))
typedef unsigned short bf16_t;
typedef short bf16x8 __attribute__((ext_vector_type(8)));
typedef float f32x4 __attribute__((ext_vector_type(4)));
typedef unsigned u32x4 __attribute__((ext_vector_type(4)));
constexpr int BM = 256, BK = 64, HALF = 128, HTB = HALF * BK * 2  , STAGE_BYTES = 8 * HTB, NXCD = 8, WGM = 8;

__host__ __device__ __forceinline__ int lds_byte(int r, int c) { const int st = (r >> 4) * 2 + (c >> 5), rr = r & 15, cc = c & 31, ob = rr * 64 + cc * 2; return st * 1024 + (ob ^ (((ob >> 9) & 1) << 5)); }
__host__ __device__ __forceinline__ void stage_rc(int b, int& R, int& C) { const int st = b / 1024, sb = b % 1024, swz = sb ^ (((sb >> 9) & 1) << 5); R = (st >> 1) * 16 + swz / 64; C = (st & 1) * 32 + (swz % 64) / 2; }
__host__ __device__ __forceinline__ int perm32(int rho) { const int n = rho >> 4, i = rho & 15; return 8 * (i >> 2) + 4 * n + (i & 3); }

struct Unit { int pm, pn; };
struct Gemm { const bf16_t* A; const bf16_t* Bt; int M, N, K, lda; };

struct StaticOrder {
    int nM, nN, nwg, G, c;
    __host__ __device__ void init(int M, int N, int G_, int c_) { nM = M / BM; nN = N / BM; nwg = nM * nN; G = G_; c = c_; }
    __host__ __device__ bool next(int i, Unit& u) const {
        const long L = (long)i * G + c; if (L >= nwg) return false;
        int wgid = (int)L; { const int q = nwg / NXCD, r = nwg % NXCD, xcd = wgid % NXCD, off = wgid / NXCD; wgid = (xcd < r ? xcd * (q + 1) : r * (q + 1) + (xcd - r) * q) + off; }
        const int nig = WGM * nN, gid = wgid / nig, fm = gid * WGM, gsz = (nM - fm) < WGM ? (nM - fm) : WGM;
        u.pm = fm + ((wgid % nig) % gsz); u.pn = (wgid % nig) / gsz; return true;
    }
    __device__ __forceinline__ void a_ready(const Unit&) const {}
    __device__ __forceinline__ void done(const Unit&) const {}
};

__device__ __forceinline__ unsigned cvt_pk_bf16(float lo, float hi) { unsigned r; asm volatile("v_cvt_pk_bf16_f32 %0, %1, %2" : "=v"(r) : "v"(lo), "v"(hi)); return r; }
typedef float f32x2 __attribute__((ext_vector_type(2)));
template <class Epi, class Sched, bool ALIGN_EPI = false, bool SP2 = false>
__device__ __forceinline__ void gemm_phase(PG8_LAS unsigned char* lds, const Gemm g, const Sched& S, const Epi& E) {
    int tid_ = threadIdx.x; asm volatile("" : "+v"(tid_));
    const int tid = tid_, wid = __builtin_amdgcn_readfirstlane(tid >> 6), lane = tid & 63, wr = wid >> 2, wc = wid & 3, fr = lane & 15, fq = lane >> 4;
    const int K = g.K, nt = K / BK;
    unsigned voffA[2], voffB[2];
#pragma unroll
    for (int i = 0; i < 2; ++i) { int R, C; stage_rc(tid * 16 + i * 8192, R, C); const int Rb = Epi::PERM ? ((R & ~31) + perm32(R & 31)) : R;
        voffA[i] = (unsigned)(R * g.lda + C) * 2u; voffB[i] = (unsigned)(Rb * K + C) * 2u; }
    const size_t kstep = (size_t)(BK * 2);
    const size_t hstepA = (size_t)HALF * g.lda * 2, hstepB = (size_t)HALF * K * 2;
    const size_t tstepA = 2 * hstepA, tstepB = 2 * hstepB;
    const unsigned ldsw = (unsigned)wid * 1024u;
    const int aoff = lds_byte(wr * 64 + fr, fq * 8), boff = lds_byte(wc * 32 + fr, fq * 8);
#define PG8_SA(b, h) (((b) * 2 + (h)) * HTB)
#define PG8_SB(b, h) ((4 + (b) * 2 + (h)) * HTB)
#define PG8_STAGE(bufoff, gbase, voff) do { _Pragma("unroll") for (int _i = 0; _i < 2; ++_i) \
        __builtin_amdgcn_global_load_lds((const unsigned*)((const char*)(gbase) + (voff)[_i]), (PG8_LAS unsigned*)(lds + (bufoff) + ldsw + _i * 8192), 16, 0, 0); } while (0)
#define PG8_LDA(dst, b, h) do { _Pragma("unroll") for (int m = 0; m < 4; ++m) _Pragma("unroll") for (int k = 0; k < 2; ++k) dst[m][k] = *(const PG8_LAS bf16x8*)(lds + PG8_SA(b, h) + aoff + m * 2048 + k * 1024); } while (0)
#define PG8_LDB(dst, b, h) do { _Pragma("unroll") for (int n = 0; n < 2; ++n) _Pragma("unroll") for (int k = 0; k < 2; ++k) dst[n][k] = *(const PG8_LAS bf16x8*)(lds + PG8_SB(b, h) + boff + n * 2048 + k * 1024); } while (0)
#define PG8_MMA(ai, bj, At, Bt) do { __builtin_amdgcn_s_setprio(1); _Pragma("unroll") for (int m = 0; m < 4; ++m) _Pragma("unroll") for (int n = 0; n < 2; ++n) _Pragma("unroll") for (int k = 0; k < 2; ++k) \
        acc[ai][bj][m][n] = __builtin_amdgcn_mfma_f32_16x16x32_bf16(Bt[n][k], At[m][k], acc[ai][bj][m][n], 0, 0, 0); __builtin_amdgcn_s_setprio(0); } while (0)
#define PG8_WAIT_V(n) asm volatile("s_waitcnt vmcnt(" #n ")" ::: "memory")
#define PG8_WAIT_L(n) asm volatile("s_waitcnt lgkmcnt(" #n ")" ::: "memory")
#define PG8_BAR __builtin_amdgcn_s_barrier()
#define PG8_SCHED __builtin_amdgcn_sched_barrier(0)
    Unit cur, nxt; int ui = 0;
    if (!S.next(0, cur)) return;
    f32x4 acc[2][2][4][2];
#pragma unroll
    for (int a = 0; a < 2; ++a)
#pragma unroll
        for (int b = 0; b < 2; ++b)
#pragma unroll
            for (int m = 0; m < 4; ++m)
#pragma unroll
                for (int n = 0; n < 2; ++n) acc[a][b][m][n] = (f32x4){0.f, 0.f, 0.f, 0.f};
    bf16x8 At[4][2], B0[2][2], B1[2][2];
    const char* cA = (const char*)g.A + (size_t)cur.pm * tstepA; const char* cB = (const char*)g.Bt + (size_t)cur.pn * tstepB;
    S.a_ready(cur);
    if constexpr (SP2) {
        PG8_STAGE(PG8_SB(0, 0), cB, voffB); PG8_STAGE(PG8_SB(0, 1), cB + hstepB, voffB); PG8_STAGE(PG8_SA(0, 0), cA, voffA); PG8_STAGE(PG8_SA(0, 1), cA + hstepA, voffA);
        if (wr == 1) PG8_BAR;
        PG8_WAIT_V(2); PG8_BAR;
        PG8_STAGE(PG8_SB(1, 0), cB + kstep, voffB); PG8_STAGE(PG8_SA(1, 0), cA + kstep, voffA); PG8_STAGE(PG8_SB(1, 1), cB + hstepB + kstep, voffB);
        PG8_WAIT_V(6); PG8_BAR;
    } else {
        PG8_STAGE(PG8_SB(0, 0), cB, voffB); PG8_STAGE(PG8_SA(0, 0), cA, voffA); PG8_STAGE(PG8_SB(0, 1), cB + hstepB, voffB); PG8_STAGE(PG8_SA(0, 1), cA + hstepA, voffA);
        if (wr == 1) PG8_BAR;
        PG8_WAIT_V(4); PG8_BAR;
        PG8_STAGE(PG8_SB(1, 0), cB + kstep, voffB); PG8_STAGE(PG8_SA(1, 0), cA + kstep, voffA); PG8_STAGE(PG8_SB(1, 1), cB + hstepB + kstep, voffB);
        PG8_WAIT_V(6); PG8_BAR;
    }
    for (;;) {
        const bool has_next = S.next(ui + 1, nxt);
        const char* nA = has_next ? (const char*)g.A + (size_t)nxt.pm * tstepA : cA; const char* nB = has_next ? (const char*)g.Bt + (size_t)nxt.pn * tstepB : cB;
        for (int t = 0; t < nt; t += 2) {
            const bool last = (t == nt - 2);
            const char* a1 = cA + (size_t)(t + 1) * kstep;
            const char* a2 = last ? nA : cA + (size_t)(t + 2) * kstep; const char* b2 = last ? nB : cB + (size_t)(t + 2) * kstep;
            const char* a3 = a2 + kstep; const char* b3 = b2 + kstep;
            if (last && has_next) S.a_ready(nxt);
            if constexpr (SP2) {
            PG8_LDB(B0, 0, 0); PG8_LDB(B1, 0, 1); PG8_SCHED; PG8_LDA(At, 0, 0); PG8_STAGE(PG8_SA(1, 1), a1 + hstepA, voffA);
            PG8_WAIT_V(8); PG8_WAIT_L(0); PG8_BAR; PG8_MMA(0, 0, At, B0); PG8_MMA(0, 1, At, B1); PG8_BAR; PG8_SCHED;
            PG8_LDA(At, 0, 1); PG8_STAGE(PG8_SB(0, 0), b2, voffB); PG8_STAGE(PG8_SB(0, 1), b2 + hstepB, voffB); PG8_STAGE(PG8_SA(0, 0), a2, voffA);
            PG8_WAIT_V(8); PG8_WAIT_L(0); PG8_BAR; PG8_MMA(1, 0, At, B0); PG8_MMA(1, 1, At, B1); PG8_BAR; PG8_SCHED;
            PG8_LDB(B0, 1, 0); PG8_LDB(B1, 1, 1); PG8_SCHED; PG8_LDA(At, 1, 0); PG8_STAGE(PG8_SA(0, 1), a2 + hstepA, voffA);
            PG8_WAIT_V(8); PG8_WAIT_L(0); PG8_BAR; PG8_MMA(0, 0, At, B0); PG8_MMA(0, 1, At, B1); PG8_BAR; PG8_SCHED;
            PG8_LDA(At, 1, 1); PG8_STAGE(PG8_SB(1, 0), b3, voffB); PG8_STAGE(PG8_SB(1, 1), b3 + hstepB, voffB); PG8_STAGE(PG8_SA(1, 0), a3, voffA);
            PG8_WAIT_V(8); PG8_WAIT_L(0); PG8_BAR; PG8_MMA(1, 0, At, B0); PG8_MMA(1, 1, At, B1); PG8_BAR; PG8_SCHED;
            } else {
            PG8_LDB(B0, 0, 0); PG8_SCHED; PG8_LDA(At, 0, 0); PG8_STAGE(PG8_SA(1, 1), a1 + hstepA, voffA);
            PG8_WAIT_L(8); PG8_BAR; PG8_WAIT_L(0); PG8_MMA(0, 0, At, B0); PG8_BAR; PG8_SCHED;
            PG8_LDB(B1, 0, 1); PG8_STAGE(PG8_SB(0, 0), b2, voffB);
            PG8_BAR; PG8_WAIT_L(0); PG8_MMA(0, 1, At, B1); PG8_BAR;
            PG8_LDA(At, 0, 1); PG8_STAGE(PG8_SA(0, 0), a2, voffA);
            PG8_BAR; PG8_WAIT_L(0); PG8_MMA(1, 0, At, B0); PG8_BAR; PG8_SCHED;
            PG8_STAGE(PG8_SB(0, 1), b2 + hstepB, voffB);
            PG8_WAIT_V(6); PG8_BAR; PG8_MMA(1, 1, At, B1); PG8_BAR;
            PG8_LDB(B0, 1, 0); PG8_SCHED; PG8_LDA(At, 1, 0); PG8_STAGE(PG8_SA(0, 1), a2 + hstepA, voffA);
            PG8_WAIT_L(8); PG8_BAR; PG8_WAIT_L(0); PG8_MMA(0, 0, At, B0); PG8_BAR; PG8_SCHED;
            PG8_LDB(B1, 1, 1); PG8_STAGE(PG8_SB(1, 0), b3, voffB);
            PG8_BAR; PG8_WAIT_L(0); PG8_MMA(0, 1, At, B1); PG8_BAR;
            PG8_LDA(At, 1, 1); PG8_STAGE(PG8_SA(1, 0), a3, voffA);
            PG8_BAR; PG8_WAIT_L(0); PG8_MMA(1, 0, At, B0); PG8_BAR; PG8_SCHED;
            PG8_STAGE(PG8_SB(1, 1), b3 + hstepB, voffB);
            PG8_WAIT_V(6); PG8_BAR; PG8_MMA(1, 1, At, B1); PG8_BAR;
            }
        }
        if constexpr (ALIGN_EPI) { if (wr == 0) PG8_BAR; }
        if constexpr (!Epi::AFTER_DRAIN) { E(acc, cur, wr, wc, fr, fq); S.done(cur); }
        if (!has_next) break;
#pragma unroll
        for (int a = 0; a < 2; ++a)
#pragma unroll
            for (int b = 0; b < 2; ++b)
#pragma unroll
                for (int m = 0; m < 4; ++m)
#pragma unroll
                    for (int n = 0; n < 2; ++n) acc[a][b][m][n] = (f32x4){0.f, 0.f, 0.f, 0.f};
        cur = nxt; cA = nA; cB = nB; ++ui;
        if constexpr (ALIGN_EPI) { if (wr == 1) PG8_BAR; }
    }
    PG8_WAIT_V(0);
    if constexpr (!ALIGN_EPI) { if (wr == 0) PG8_BAR; }
    PG8_BAR;
    if constexpr (Epi::AFTER_DRAIN) { E.fused(acc, cur, wr, wc, fr, fq, lds, wid, lane); S.done(cur); }
#undef PG8_SA
#undef PG8_SB
#undef PG8_STAGE
#undef PG8_LDA
#undef PG8_LDB
#undef PG8_MMA
#undef PG8_WAIT_V
#undef PG8_WAIT_L
#undef PG8_BAR
#undef PG8_SCHED
}
}
#define LAS __attribute__((address_space(3)))
typedef unsigned short bf16;
typedef float f32x4 __attribute__((ext_vector_type(4)));
typedef float f32x16 __attribute__((ext_vector_type(16)));
typedef short bf16x8 __attribute__((ext_vector_type(8)));
typedef short s16x4 __attribute__((ext_vector_type(4)));
typedef unsigned u32x4 __attribute__((ext_vector_type(4)));
typedef unsigned u32x2 __attribute__((ext_vector_type(2)));
typedef float f32x2_t __attribute__((ext_vector_type(2)));
typedef __bf16 bf16x2_t __attribute__((ext_vector_type(2)));

constexpr int D = 1024, MP = 65536, MS = 2048, M = MP + MS, DFF = 4096;
constexpr int LDP = 6144, NPROJ = 6176, NPROJ_PAD = 6400;
constexpr float ALPHA = 1.6817928305074290f, LN_EPS = 1e-5f, RMS_EPS = 1e-5f, LOG2E = 1.4426950408889634f;
constexpr size_t O_KP = 69206016, O_VP = 102760448, O_HP = 136314880, O_CP = 153092096, O_KS = 153878528, O_VS = 158072832, O_HS = 162267136, O_CS = 179044352;
constexpr size_t MiB = 1u << 20;
constexpr size_t WS_WA = 1 * MiB, WS_WB = 14 * MiB, WS_WUP = 18 * MiB, WS_WDN = 26 * MiB, WS_XB = 34 * MiB, WS_DT = 166 * MiB, WS_BIG = 175 * MiB;
constexpr size_t WS_O = WS_BIG + 396 * MiB, WS_CK = WS_BIG + 528 * MiB, WS_CV = WS_BIG + 560 * MiB, WS_END = WS_BIG + 792 * MiB;
constexpr size_t WS_AUX = WS_END, WS_ST0 = WS_AUX, WS_ST1 = WS_AUX + 2304 * 1024, WS_CSA = WS_AUX + 4608 * 1024, WS_BWA = WS_CSA + 32 * 1024, WS_CSU = WS_CSA + 64 * 1024, WS_BWU = WS_CSA + 80 * 1024, WS_END2 = WS_AUX + 5 * MiB;
constexpr float FXS = 1048576.f, FXI = 1.f / 1048576.f;
typedef long long i64x2_t __attribute__((ext_vector_type(2)));
constexpr int LDS_BYTES = 147456;

__device__ __forceinline__ unsigned pk2(float lo, float hi) { f32x2_t v = {lo, hi}; bf16x2_t b = __builtin_convertvector(v, bf16x2_t); return __builtin_bit_cast(unsigned, b); }
__device__ __forceinline__ float bf2f(unsigned short u) { return __uint_as_float((unsigned)u << 16); }
__device__ __forceinline__ float bflo(unsigned u) { return __uint_as_float(u << 16); }
__device__ __forceinline__ float bfhi(unsigned u) { return __uint_as_float(u & 0xffff0000u); }
__device__ __forceinline__ float fexp2(float x) { return __builtin_amdgcn_exp2f(x); }
__device__ __forceinline__ float frcp(float x) { return __builtin_amdgcn_rcpf(x); }
__device__ __forceinline__ float silu_f(float v) { return v * frcp(1.0f + fexp2(-v * LOG2E)); }
__device__ __forceinline__ int crow(int r, int hi) { return (r & 3) + 8 * (r >> 2) + 4 * hi; }
__device__ __forceinline__ bf16x8 pack8(const f32x16& x, int s) {
    u32x4 p; p.x = pk2(x[8 * s], x[8 * s + 1]); p.y = pk2(x[8 * s + 2], x[8 * s + 3]); p.z = pk2(x[8 * s + 4], x[8 * s + 5]); p.w = pk2(x[8 * s + 6], x[8 * s + 7]);
    return __builtin_bit_cast(bf16x8, p);
}
#define MFMA32(a, b, c) __builtin_amdgcn_mfma_f32_32x32x16_bf16((a), (b), (c), 0, 0, 0)
__device__ __forceinline__ float wave_sum(float v) {
#pragma unroll
    for (int o = 1; o < 64; o <<= 1) v += __shfl_xor(v, o);
    return v;
}

namespace pg8 {
struct RowNorm {
    const float* st; const float* cs; const float* bw;
    float mu[2][4], rs[2][4]; f32x4 c[2][2], b[2][2];
    __device__ __forceinline__ void load(const Unit& u, int wr, int wc, int fr, int fq) {
        if (!st) return;
#pragma unroll
        for (int ai = 0; ai < 2; ++ai)
#pragma unroll
            for (int m = 0; m < 4; ++m) { const float* sp = st + 8 * (unsigned)(u.pm * BM + ai * HALF + wr * 64 + m * 16 + fr); const f32x4 pa = *(const f32x4*)sp, pb = *(const f32x4*)(sp + 4);
                const float mean = ((pa[0] + pa[2]) + (pb[0] + pb[2])) * (1.f / 1024.f), var = ((pa[1] + pa[3]) + (pb[1] + pb[3])) * (1.f / 1024.f) - mean * mean; mu[ai][m] = mean; rs[ai][m] = 1.0f / sqrtf(var + LN_EPS); }
        const int cb = u.pn * BM + wc * 32 + 8 * fq;
#pragma unroll
        for (int bj = 0; bj < 2; ++bj)
#pragma unroll
            for (int n = 0; n < 2; ++n) { c[bj][n] = *(const f32x4*)(cs + cb + bj * HALF + 4 * n); b[bj][n] = *(const f32x4*)(bw + cb + bj * HALF + 4 * n); }
    }
    __device__ __forceinline__ f32x4 apply(const f32x4 a, int ai, int m, int bj, int n) const { return st ? (a - c[bj][n] * mu[ai][m]) * rs[ai][m] + b[bj][n] : a; }
};
struct EpiQKV {
    static constexpr bool PERM = true, AFTER_DRAIN = false;
    bf16_t* QKV; float* out; int li; const float* st; const float* cs; const float* bw;
    __device__ __forceinline__ void operator()(const f32x4 (&acc)[2][2][4][2], const Unit& u, int wr, int wc, int fr, int fq) const {
        asm volatile("" : "+v"(fr));
        RowNorm rn; rn.st = st; rn.cs = cs; rn.bw = bw; rn.load(u, wr, wc, fr, fq);
        float* fdst = nullptr;
        if (u.pn >= 4) {
            const bool isv = u.pn >= 8;
            if (u.pm < 256) { const int b = u.pm >> 3, tt = u.pm & 7; if (tt >= 6) fdst = out + (isv ? O_VP : O_KP) + ((size_t)(li * 32 + b) * 512 + (size_t)(tt - 6) * 256) * 1024; }
            else fdst = out + (isv ? O_VS : O_KS) + ((size_t)li * 2048 + (size_t)(u.pm - 256) * 256) * 1024;
        }
        const int col0 = u.pn * BM + wc * 32 + 8 * fq, colk = (u.pn & 3) * BM + wc * 32 + 8 * fq;
#pragma unroll
        for (int ai = 0; ai < 2; ++ai)
#pragma unroll
            for (int m = 0; m < 4; ++m) { const int rl = ai * HALF + wr * 64 + m * 16 + fr; bf16_t* rowp = QKV + (unsigned)((u.pm * BM + rl) * 3072 + col0);
#pragma unroll
                for (int bj = 0; bj < 2; ++bj) { const f32x4 v0 = rn.apply(acc[ai][bj][m][0], ai, m, bj, 0), v1 = rn.apply(acc[ai][bj][m][1], ai, m, bj, 1);
                    u32x4 w; w.x = pk2(v0[0], v0[1]); w.y = pk2(v0[2], v0[3]); w.z = pk2(v1[0], v1[1]); w.w = pk2(v1[2], v1[3]);
                    *(u32x4*)(rowp + bj * HALF) = w;
                    if (fdst) { float* fp = fdst + (unsigned)(rl * 1024 + colk + bj * HALF); *(f32x4*)fp = v0; *(f32x4*)(fp + 4) = v1; } }
                asm volatile("" ::: "memory"); }
    }
};
struct EpiBf16Plain {
    static constexpr bool PERM = true, AFTER_DRAIN = false;
    bf16_t* O; int ldc; int relu2; const float* st; const float* cs; const float* bw;
    __device__ __forceinline__ void operator()(const f32x4 (&acc)[2][2][4][2], const Unit& u, int wr, int wc, int fr, int fq) const {
        asm volatile("" : "+v"(fr));
        RowNorm rn; rn.st = st; rn.cs = cs; rn.bw = bw; rn.load(u, wr, wc, fr, fq);
        const int col0 = u.pn * BM + wc * 32 + 8 * fq;
#pragma unroll
        for (int ai = 0; ai < 2; ++ai)
#pragma unroll
            for (int m = 0; m < 4; ++m) { const int rl = ai * HALF + wr * 64 + m * 16 + fr; bf16_t* rowp = O + (unsigned)((u.pm * BM + rl) * ldc + col0);
#pragma unroll
                for (int bj = 0; bj < 2; ++bj) { f32x4 v0 = rn.apply(acc[ai][bj][m][0], ai, m, bj, 0), v1 = rn.apply(acc[ai][bj][m][1], ai, m, bj, 1);
                    if (relu2) { v0 = __builtin_elementwise_max(v0, (f32x4){0.f, 0.f, 0.f, 0.f}); v1 = __builtin_elementwise_max(v1, (f32x4){0.f, 0.f, 0.f, 0.f}); v0 = v0 * v0; v1 = v1 * v1; }
                    u32x4 w; w.x = pk2(v0[0], v0[1]); w.y = pk2(v0[2], v0[3]); w.z = pk2(v1[0], v1[1]); w.w = pk2(v1[2], v1[3]);
                    *(u32x4*)(rowp + bj * HALF) = w; } }
    }
};
struct EpiSsmIn {
    static constexpr bool PERM = true, AFTER_DRAIN = false;
    bf16_t* P; float* DT; const float* st; const float* cs; const float* bw;
    __device__ __forceinline__ void operator()(const f32x4 (&acc)[2][2][4][2], const Unit& u, int wr, int wc, int fr, int fq) const {
        asm volatile("" : "+v"(fr));
        RowNorm rn; rn.st = st; rn.cs = cs; rn.bw = bw; rn.load(u, wr, wc, fr, fq);
        if (u.pn < 24) {
            const int col0 = u.pn * BM + wc * 32 + 8 * fq;
#pragma unroll
            for (int ai = 0; ai < 2; ++ai)
#pragma unroll
                for (int m = 0; m < 4; ++m) { const int rl = ai * HALF + wr * 64 + m * 16 + fr; bf16_t* rowp = P + (unsigned)((u.pm * BM + rl) * LDP + col0);
#pragma unroll
                    for (int bj = 0; bj < 2; ++bj) { const f32x4 v0 = rn.apply(acc[ai][bj][m][0], ai, m, bj, 0), v1 = rn.apply(acc[ai][bj][m][1], ai, m, bj, 1);
                        u32x4 w; w.x = pk2(v0[0], v0[1]); w.y = pk2(v0[2], v0[3]); w.z = pk2(v1[0], v1[1]); w.w = pk2(v1[2], v1[3]);
                        *(u32x4*)(rowp + bj * HALF) = w; }
                    asm volatile("" ::: "memory"); }
        } else if (wc == 0) {
#pragma unroll
            for (int ai = 0; ai < 2; ++ai)
#pragma unroll
                for (int m = 0; m < 4; ++m) { const int rl = ai * HALF + wr * 64 + m * 16 + fr; float* fp = DT + (unsigned)((u.pm * BM + rl) * 32 + 8 * fq);
                    *(f32x4*)fp = rn.apply(acc[ai][0][m][0], ai, m, 0, 0); *(f32x4*)(fp + 4) = rn.apply(acc[ai][0][m][1], ai, m, 0, 1); }
        }
    }
};
struct EpiResid {
    static constexpr bool PERM = true, AFTER_DRAIN = false;
    bf16_t* XB; const float* st_in; const float* gin; const float* bin; float* st_out; PG8_LAS float* P;
    static constexpr int DEPTH = 1;
    __device__ __forceinline__ void operator()(const f32x4 (&acc)[2][2][4][2], const Unit& u, int wr, int wc, int fr, int fq) const {
        asm volatile("" : "+v"(fr));
        const int col0 = u.pn * BM + wc * 32 + 8 * fq;
        const unsigned rowb0 = (unsigned)(u.pm * BM + wr * 64 + fr);
        u32x4 xv[DEPTH + 1][2]; f32x4 pa[DEPTH + 1], pb[DEPTH + 1];
#define RES_LOAD(q_) do { const unsigned row_ = rowb0 + (unsigned)((((q_) >> 2) * HALF) + ((q_) & 3) * 16); const bf16_t* rp_ = XB + row_ * D + col0; \
            xv[(q_) % (DEPTH + 1)][0] = *(const u32x4*)rp_; xv[(q_) % (DEPTH + 1)][1] = *(const u32x4*)(rp_ + HALF); \
            if (st_in) { pa[(q_) % (DEPTH + 1)] = *(const f32x4*)(st_in + 8 * row_); pb[(q_) % (DEPTH + 1)] = *(const f32x4*)(st_in + 8 * row_ + 4); } } while (0)
#pragma unroll
        for (int q = 0; q < DEPTH; ++q) RES_LOAD(q);
#pragma unroll
        for (int q = 0; q < 8; ++q) {
            const int ai = q >> 2, m = q & 3, sl = q % (DEPTH + 1);
            if (q + DEPTH < 8) RES_LOAD(q + DEPTH);
            f32x4 gq[2][2], bq[2][2];
            if (st_in) { int c_ = col0; asm volatile("" : "+v"(c_));
#pragma unroll
                for (int bj = 0; bj < 2; ++bj) { gq[bj][0] = *(const f32x4*)(gin + c_ + bj * HALF); gq[bj][1] = *(const f32x4*)(gin + c_ + bj * HALF + 4); bq[bj][0] = *(const f32x4*)(bin + c_ + bj * HALF); bq[bj][1] = *(const f32x4*)(bin + c_ + bj * HALF + 4); } }
            asm volatile("" ::: "memory");
            const unsigned row = rowb0 + (unsigned)(ai * HALF + m * 16);
            bf16_t* rowb = XB + row * D + col0;
            float mean = 0.f, rstd = 1.f;
            if (st_in) { mean = ((pa[sl][0] + pa[sl][2]) + (pb[sl][0] + pb[sl][2])) * (1.f / 1024.f); rstd = 1.0f / sqrtf(((pa[sl][1] + pa[sl][3]) + (pb[sl][1] + pb[sl][3])) * (1.f / 1024.f) - mean * mean + LN_EPS); }
            float s1 = 0.f, s2 = 0.f;
#pragma unroll
            for (int bj = 0; bj < 2; ++bj) {
                const u32x4 xw = xv[sl][bj];
                f32x4 x0 = (f32x4){bflo(xw.x), bfhi(xw.x), bflo(xw.y), bfhi(xw.y)}, x1 = (f32x4){bflo(xw.z), bfhi(xw.z), bflo(xw.w), bfhi(xw.w)};
                if (st_in) { x0 = (x0 - mean) * rstd * gq[bj][0] + bq[bj][0]; x1 = (x1 - mean) * rstd * gq[bj][1] + bq[bj][1]; }
                const f32x4 v0 = x0 * ALPHA + acc[ai][bj][m][0], v1 = x1 * ALPHA + acc[ai][bj][m][1];
                u32x4 w; w.x = pk2(v0[0], v0[1]); w.y = pk2(v0[2], v0[3]); w.z = pk2(v1[0], v1[1]); w.w = pk2(v1[2], v1[3]); *(u32x4*)(rowb + bj * HALF) = w;
                s1 += ((v0[0] + v0[1]) + (v0[2] + v0[3])) + ((v1[0] + v1[1]) + (v1[2] + v1[3]));
                s2 += ((v0[0] * v0[0] + v0[1] * v0[1]) + (v0[2] * v0[2] + v0[3] * v0[3])) + ((v1[0] * v1[0] + v1[1] * v1[1]) + (v1[2] * v1[2] + v1[3] * v1[3])); }
            s1 += __shfl_xor(s1, 16); s2 += __shfl_xor(s2, 16); s1 += __shfl_xor(s1, 32); s2 += __shfl_xor(s2, 32);
            if (fq == 0) *(PG8_LAS f32x2_t*)(P + ((ai * HALF + wr * 64 + m * 16 + fr) * 4 + wc) * 2) = (f32x2_t){s1, s2};
        }
#undef RES_LOAD
        asm volatile("s_waitcnt lgkmcnt(0)" ::: "memory"); __builtin_amdgcn_s_barrier(); asm volatile("" ::: "memory");
        const int tid = (wr * 4 + wc) * 64 + fq * 16 + fr;
        if (tid < 256) { const f32x4 qa = *(const PG8_LAS f32x4*)(P + tid * 8), qb = *(const PG8_LAS f32x4*)(P + tid * 8 + 4);
            *(f32x2_t*)(st_out + 8 * (unsigned)(u.pm * BM + tid) + 2 * u.pn) = (f32x2_t){(qa[0] + qa[2]) + (qb[0] + qb[2]), (qa[1] + qa[3]) + (qb[1] + qb[3])}; }
    }
};
}
#define XB_TMO      128
#define XB_XCNT(j)  (256  + 64 * (j))
#define XB_XSUB(j)  (1280 + 64 * (j))
#define XB_XGEN(j)  (2304 + 64 * (j))
#define XB_TOP      3328
#define XB_TOPGEN   3392
#define XCD_BAR_WORDS 3456
#define XB_SPIN_CAP (1u << 18)

__device__ __forceinline__ unsigned xb_ld(unsigned* p)              { return __hip_atomic_load(p, __ATOMIC_RELAXED, __HIP_MEMORY_SCOPE_AGENT); }
__device__ __forceinline__ unsigned xb_add(unsigned* p, unsigned v) { return __hip_atomic_fetch_add(p, v, __ATOMIC_RELAXED, __HIP_MEMORY_SCOPE_AGENT); }
__device__ __forceinline__ unsigned xb_xcc_id() { return (unsigned)__builtin_amdgcn_s_getreg((3 << 11) | 20) & 0xFu; }
#define XB_SPIN(cond, bar) do { unsigned _sp = 0; while (cond) { __builtin_amdgcn_s_sleep(1); \
    if ((++_sp & 255u) == 0u) { if (xb_ld(&(bar)[XB_TMO])) break; if (_sp > XB_SPIN_CAP) { atomicAdd(&(bar)[XB_TMO], 1u); break; } } } } while (0)

struct XcdBarrier {
    unsigned* bar; unsigned x;
    volatile LAS unsigned* st;
};

__device__ __forceinline__ XcdBarrier xcd_barrier_post(unsigned* bar, volatile LAS unsigned* st) {
    XcdBarrier b; b.bar = bar; b.x = xb_xcc_id(); b.st = st;
    if (threadIdx.x == 0) (void)xb_add(&bar[XB_XCNT(b.x)], 1u);
    return b;
}
__device__ __forceinline__ void xcd_barrier_complete(unsigned* bar, unsigned x, unsigned& nloc, unsigned& nx) {
    const unsigned G = gridDim.x * gridDim.y * gridDim.z;
    unsigned sum, cnt, mine, sp = 0u;
    for (;;) {
        sum = 0u; cnt = 0u; mine = 0u;
#pragma unroll
        for (unsigned j = 0; j < 16; ++j) { const unsigned c = xb_ld(&bar[XB_XCNT(j)]); sum += c; cnt += (c > 0u) ? 1u : 0u; mine = (j == x) ? c : mine; }
        if (sum == G) break;
        __builtin_amdgcn_s_sleep(1);
        if ((++sp & 255u) == 0u) { if (xb_ld(&bar[XB_TMO])) break; if (sp > XB_SPIN_CAP) { atomicAdd(&bar[XB_TMO], 1u); break; } }
    }
    nloc = mine > 0u ? mine : 1u; nx = cnt > 0u ? cnt : 1u;
}

__device__ __forceinline__ void xcd_barrier(const XcdBarrier& b) {
    asm volatile("s_waitcnt vmcnt(0)" ::: "memory");
    __syncthreads();
    if (threadIdx.x == 0) {
        unsigned* bar = b.bar;
        __builtin_amdgcn_s_waitcnt(0);
        unsigned nloc = b.st[0], nx = b.st[1];
        if (nloc == 0u) { xcd_barrier_complete(bar, b.x, nloc, nx); b.st[0] = nloc; b.st[1] = nx; }
        const unsigned old = xb_add(&bar[XB_XSUB(b.x)], 1u);
        const unsigned gen = old / nloc;
        if (old + 1u == (gen + 1u) * nloc) {
            __builtin_amdgcn_fence(__ATOMIC_RELEASE, "agent");
            asm volatile("s_waitcnt vmcnt(0)" ::: "memory");
            const unsigned og = xb_add(&bar[XB_TOP], 1u);
            const unsigned tg = og / nx;
            if (og + 1u == (tg + 1u) * nx) xb_add(&bar[XB_TOPGEN], 1u);
            else XB_SPIN(xb_ld(&bar[XB_TOPGEN]) == tg, bar);
            __builtin_amdgcn_fence(__ATOMIC_ACQUIRE, "agent");
            xb_add(&bar[XB_XGEN(b.x)], 1u);
            asm volatile("s_waitcnt vmcnt(0)" ::: "memory");
        } else {
            XB_SPIN(xb_ld(&bar[XB_XGEN(b.x)]) == gen, bar);
            __builtin_amdgcn_fence(__ATOMIC_ACQUIRE, "agent");
            asm volatile("s_waitcnt vmcnt(0)" ::: "memory");
        }
    }
    __syncthreads();
}

struct Args { const float* in[25]; int ph_lo, ph_hi; };
#define AIN(k) (a.in[(k) + z])
struct Frame { unsigned char* lds; int tid, lane, wave, G, bid; };

__device__ __forceinline__ void transpose_item(const float* W, int K, int N, bf16* WT, float* scr, int item, int lane) {
    const int nblk = N / 32, kb = item / nblk, nb = item % nblk, k0 = 64 * kb, n0 = 32 * nb;
#pragma unroll 8
    for (int i = 0; i < 32; ++i) { const int kk = 2 * i + (lane >> 5); scr[kk * 33 + (lane & 31)] = W[(size_t)(k0 + kk) * N + n0 + (lane & 31)]; }
    asm volatile("s_waitcnt lgkmcnt(0)" ::: "memory");
    const int c = lane & 7;
#pragma unroll
    for (int j = 0; j < 4; ++j) { const int n = (lane >> 3) + 8 * j; const float* s = scr + (8 * c) * 33 + n;
        u32x4 o; o.x = pk2(s[0 * 33], s[1 * 33]); o.y = pk2(s[2 * 33], s[3 * 33]); o.z = pk2(s[4 * 33], s[5 * 33]); o.w = pk2(s[6 * 33], s[7 * 33]);
        *(u32x4*)(WT + (size_t)(n0 + n) * K + k0 + 8 * c) = o; }
    asm volatile("s_waitcnt lgkmcnt(0)" ::: "memory");
}
__device__ __forceinline__ void transpose_fold_item(const float* W, int K, int N, bf16* WT, const float* g, const float* b, float* cs, float* bw, float* scr, int nb, int lane) {
    const int n0 = 32 * nb; float csp = 0.f, bwp = 0.f;
    for (int k0 = 0; k0 < K; k0 += 64) {
#pragma unroll 8
        for (int i = 0; i < 32; ++i) { const int kk = 2 * i + (lane >> 5); const float w = W[(size_t)(k0 + kk) * N + n0 + (lane & 31)];
            const float wg = w * g[k0 + kk]; const float wr = bflo(pk2(wg, 0.f) & 0xffffu); scr[kk * 33 + (lane & 31)] = wr; csp += wr; bwp += w * b[k0 + kk]; }
        asm volatile("s_waitcnt lgkmcnt(0)" ::: "memory");
        const int c = lane & 7;
#pragma unroll
        for (int j = 0; j < 4; ++j) { const int n = (lane >> 3) + 8 * j; const float* s = scr + (8 * c) * 33 + n;
            u32x4 o; o.x = pk2(s[0 * 33], s[1 * 33]); o.y = pk2(s[2 * 33], s[3 * 33]); o.z = pk2(s[4 * 33], s[5 * 33]); o.w = pk2(s[6 * 33], s[7 * 33]);
            *(u32x4*)(WT + (size_t)(n0 + n) * K + k0 + 8 * c) = o; }
        asm volatile("s_waitcnt lgkmcnt(0)" ::: "memory");
    }
    csp += __shfl_xor(csp, 32); bwp += __shfl_xor(bwp, 32);
    if (lane < 32) { cs[n0 + lane] = csp; bw[n0 + lane] = bwp; }
}
__device__ __forceinline__ void cvt_stream(const float* src, bf16* dst, size_t n, size_t gtid, size_t gthreads) {
    for (size_t i = gtid * 8; i < n; i += gthreads * 8) { const f32x4 a = *(const f32x4*)(src + i), b = *(const f32x4*)(src + i + 4);
        u32x4 o; o.x = pk2(a[0], a[1]); o.y = pk2(a[2], a[3]); o.z = pk2(b[0], b[1]); o.w = pk2(b[2], b[3]); *(u32x4*)(dst + i) = o; }
}
__device__ __forceinline__ void convert_phase(const Frame& F, const Args& a, int z, int L) {
    unsigned char* ws = (unsigned char*)AIN(24); float* outp = (float*)AIN(23); const int li = L >> 1; const bool ssm = (L & 1);
    float* scr = (float*)(F.lds + F.wave * 16384);
    const int gw = F.bid * 8 + F.wave, NGW = F.G * 8;
    const float* Wa = ssm ? AIN(9) + (size_t)li * D * NPROJ : AIN(6) + (size_t)li * D * 3072; const int Na = ssm ? NPROJ : 3072;
    const float* Wb = ssm ? AIN(16) + (size_t)li * 2048 * D : AIN(8) + (size_t)li * D * D; const int Kb = ssm ? 2048 : D;
    const float* Wu = AIN(19) + (size_t)L * D * DFF; const float* Wd = AIN(20) + (size_t)L * DFF * D;
    const bool foldA = (L > 0);
    const float* gA = AIN(21) + (L - 1) * D; const float* bA = AIN(22) + (L - 1) * D;
    const float* gU = AIN(17) + L * D; const float* bU = AIN(18) + L * D;
    const int Ia = foldA ? Na / 32 : (D / 64) * (Na / 32), Ib = (Kb / 64) * (D / 32), Iu = DFF / 32, Id = (DFF / 64) * (D / 32);
    const int NIT = Ia + Ib + Iu + Id;
    for (int it = gw; it < NIT; it += NGW) {
        int r = it;
        if (r < Iu) { transpose_fold_item(Wu, D, DFF, (bf16*)(ws + WS_WUP), gU, bU, (float*)(ws + WS_CSU), (float*)(ws + WS_BWU), scr, r, F.lane); continue; } r -= Iu;
        if (r < Ia) { if (foldA) transpose_fold_item(Wa, D, Na, (bf16*)(ws + WS_WA), gA, bA, (float*)(ws + WS_CSA), (float*)(ws + WS_BWA), scr, r, F.lane);
                      else transpose_item(Wa, D, Na, (bf16*)(ws + WS_WA), scr, r, F.lane); continue; } r -= Ia;
        if (r < Ib) { transpose_item(Wb, Kb, D, (bf16*)(ws + WS_WB), scr, r, F.lane); continue; } r -= Ib;
        transpose_item(Wd, DFF, D, (bf16*)(ws + WS_WDN), scr, r, F.lane);
    }
    const size_t gtid = (size_t)F.bid * 512 + F.tid, gth = (size_t)F.G * 512;
    if (!ssm) {
        cvt_stream(AIN(2) + (size_t)li * 32 * 512 * 1024, (bf16*)(ws + WS_CK), (size_t)32 * 512 * 1024, gtid, gth);
        cvt_stream(AIN(3) + (size_t)li * 32 * 512 * 1024, (bf16*)(ws + WS_CV), (size_t)32 * 512 * 1024, gtid, gth);
    }
    if (L == 0) {
        const size_t n = (size_t)M * D, np = (size_t)MP * D;
        bf16* XB = (bf16*)(ws + WS_XB);
        for (size_t i = gtid * 8; i < n; i += gth * 8) { const float* src = i < np ? AIN(0) + i : AIN(1) + (i - np);
            const f32x4 x0 = *(const f32x4*)src, x1 = *(const f32x4*)(src + 4);
            u32x4 o; o.x = pk2(x0[0], x0[1]); o.y = pk2(x0[2], x0[3]); o.z = pk2(x1[0], x1[1]); o.w = pk2(x1[2], x1[3]); *(u32x4*)(XB + i) = o; }
    }
}
__device__ __forceinline__ void ln_phase(const Frame& F, float* X, const bf16* XB, const float* g, const float* b) {
    const int gw = F.bid * 8 + F.wave, NGW = F.G * 8;
    f32x4 gv[4], bv[4];
#pragma unroll
    for (int j = 0; j < 4; ++j) { gv[j] = *(const f32x4*)(g + 4 * F.lane + 256 * j); bv[j] = *(const f32x4*)(b + 4 * F.lane + 256 * j); }
    for (int m = gw; m < M; m += NGW) {
        f32x4* xr = (f32x4*)(X + (size_t)m * D) + F.lane;
        const u32x2* xb = (const u32x2*)(XB + (size_t)m * D) + F.lane;
        f32x4 v[4]; float s = 0.f;
#pragma unroll
        for (int j = 0; j < 4; ++j) { const u32x2 w = xb[64 * j]; v[j] = (f32x4){bflo(w.x), bfhi(w.x), bflo(w.y), bfhi(w.y)}; s += (v[j][0] + v[j][1]) + (v[j][2] + v[j][3]); }
        const float mean = wave_sum(s) * (1.f / D); float s2 = 0.f;
#pragma unroll
        for (int j = 0; j < 4; ++j) { v[j] = v[j] - mean; s2 += (v[j][0] * v[j][0] + v[j][1] * v[j][1]) + (v[j][2] * v[j][2] + v[j][3] * v[j][3]); }
        const float rstd = 1.f / sqrtf(wave_sum(s2) * (1.f / D) + LN_EPS);
#pragma unroll
        for (int j = 0; j < 4; ++j) xr[64 * j] = v[j] * rstd * gv[j] + bv[j];
    }
}

__device__ __forceinline__ void attn_phase(const Frame& F, const float* relb, const bf16* QKV, const bf16* CK, const bf16* CV, bf16* O) {
    float* tbl = (float*)F.lds;
    for (int i = F.tid; i < 16 * 513; i += 512) tbl[i] = relb[i] * LOG2E;
    __syncthreads();
    unsigned char* vt = F.lds + 36864 + F.wave * 9216;
    const int lane = F.lane, l31 = lane & 31, hh = lane >> 5;
    const int i16 = lane & 15, q4 = i16 >> 2, p4 = i16 & 3, dblk = (lane >> 4) & 1;
    const int gw = F.bid * 8 + F.wave, NGW = F.G * 8;
    constexpr int NITEM = (32 * 32 + 32) * 32;
    constexpr float C2 = 0.125f * LOG2E;
    for (int it = gw; it < NITEM; it += NGW) {
        const bool smp = it >= 32768;
        const int r = smp ? it - 32768 : it;
        const int qh = r & 1, h = (r >> 1) & 15, c = smp ? 0 : (r >> 5) & 31, b = smp ? (r >> 5) : (r >> 10);
        const size_t qrow0 = smp ? (size_t)MP + b * 64 + 32 * qh : (size_t)b * 2048 + 64 * c + 32 * qh;
        bf16x8 qf[4];
#pragma unroll
        for (int ks = 0; ks < 4; ++ks) qf[ks] = *(const bf16x8*)(QKV + (qrow0 + l31) * 3072 + h * 64 + 16 * ks + 8 * hh);
        f32x16 o0, o1;
#pragma unroll
        for (int i = 0; i < 16; ++i) { o0[i] = 0.f; o1[i] = 0.f; }
        float mrun = -1e30f, lsum = 0.f;
        const float* tb = tbl + h * 513;
        const float cbias = tb[512];
        const int jb0 = smp ? 0 : (c >= 8 ? 0 : 8 - c);
        for (int jb = jb0; jb <= 8; ++jb) {
            const bf16 *Kp, *Vp; int pitch;
            if (!smp) { Kp = QKV + ((size_t)b * 2048 + 64 * (c - 8 + jb)) * 3072 + 1024 + h * 64; Vp = Kp + 1024; pitch = 3072; }
            else if (jb < 8) { Kp = CK + ((size_t)b * 512 + 64 * jb) * 1024 + h * 64; Vp = CV + ((size_t)b * 512 + 64 * jb) * 1024 + h * 64; pitch = 1024; }
            else { Kp = QKV + ((size_t)MP + b * 64) * 3072 + 1024 + h * 64; Vp = Kp + 1024; pitch = 3072; }
            bf16x8 kf[2][4], vr[8];
#pragma unroll
            for (int rb = 0; rb < 2; ++rb)
#pragma unroll
                for (int ks = 0; ks < 4; ++ks) kf[rb][ks] = *(const bf16x8*)(Kp + (size_t)(32 * rb + l31) * pitch + 16 * ks + 8 * hh);
#pragma unroll
            for (int i = 0; i < 8; ++i) vr[i] = *(const bf16x8*)(Vp + (size_t)(8 * i + (lane >> 3)) * pitch + 8 * (lane & 7));
            asm volatile("" ::: "memory");
#pragma unroll
            for (int i = 0; i < 8; ++i) *(bf16x8*)(vt + ((8 * i + (lane >> 3)) * 72 + 8 * (lane & 7)) * 2) = vr[i];
            asm volatile("" ::: "memory");
            f32x16 s0, s1;
#pragma unroll
            for (int i = 0; i < 16; ++i) { s0[i] = 0.f; s1[i] = 0.f; }
#pragma unroll
            for (int ks = 0; ks < 4; ++ks) { s0 = MFMA32(kf[0][ks], qf[ks], s0); s1 = MFMA32(kf[1][ks], qf[ks], s1); }
            if (jb <= 3) {
#pragma unroll
                for (int i = 0; i < 16; ++i) { s0[i] = s0[i] * C2 + cbias; s1[i] = s1[i] * C2 + cbias; }
            } else {
                const int dbase = 64 * (8 - jb) + 32 * qh + l31 + 256;
#pragma unroll
                for (int i = 0; i < 16; ++i) { const int k0 = crow(i, hh); int i0 = dbase - k0, i1 = dbase - k0 - 32; i0 = i0 > 512 ? 512 : i0; i1 = i1 > 512 ? 512 : i1;
                    s0[i] = s0[i] * C2 + tb[i0]; s1[i] = s1[i] * C2 + tb[i1]; }
            }
            float mx = s0[0];
#pragma unroll
            for (int i = 1; i < 16; ++i) mx = fmaxf(mx, s0[i]);
#pragma unroll
            for (int i = 0; i < 16; ++i) mx = fmaxf(mx, s1[i]);
            mx = fmaxf(mx, __shfl_xor(mx, 32));
            const float mnew = fmaxf(mrun, mx), alpha = fexp2(mrun - mnew);
            mrun = mnew;
            float ps = 0.f;
#pragma unroll
            for (int i = 0; i < 16; ++i) { s0[i] = fexp2(s0[i] - mnew); s1[i] = fexp2(s1[i] - mnew); ps += s0[i] + s1[i]; }
            lsum = lsum * alpha + ps;
#pragma unroll
            for (int i = 0; i < 16; ++i) { o0[i] *= alpha; o1[i] *= alpha; }
#pragma unroll
            for (int rb = 0; rb < 2; ++rb)
#pragma unroll
                for (int s2 = 0; s2 < 2; ++s2) {
                    const bf16x8 pf = pack8(rb ? s1 : s0, s2);
                    const int k0 = 32 * rb + 16 * s2 + 4 * hh + q4;
#pragma unroll
                    for (int db = 0; db < 2; ++db) {
                        const int cb = 32 * db + 16 * dblk + 4 * p4;
                        const s16x4 lo = __builtin_amdgcn_ds_read_tr16_b64_v4i16((LAS s16x4*)(vt + (k0 * 72 + cb) * 2));
                        const s16x4 hi = __builtin_amdgcn_ds_read_tr16_b64_v4i16((LAS s16x4*)(vt + ((k0 + 8) * 72 + cb) * 2));
                        const bf16x8 va = __builtin_shufflevector(lo, hi, 0, 1, 2, 3, 4, 5, 6, 7);
                        if (db == 0) o0 = MFMA32(va, pf, o0); else o1 = MFMA32(va, pf, o1);
                    }
                }
            asm volatile("" ::: "memory");
        }
        const float inv = 1.0f / (lsum + __shfl_xor(lsum, 32));
        bf16* orow = O + (qrow0 + l31) * D + h * 64 + 4 * hh;
#pragma unroll
        for (int i4 = 0; i4 < 4; ++i4) {
            u32x2 w0; w0.x = pk2(o0[4 * i4] * inv, o0[4 * i4 + 1] * inv); w0.y = pk2(o0[4 * i4 + 2] * inv, o0[4 * i4 + 3] * inv); *(u32x2*)(orow + 8 * i4) = w0;
            u32x2 w1; w1.x = pk2(o1[4 * i4] * inv, o1[4 * i4 + 1] * inv); w1.y = pk2(o1[4 * i4 + 2] * inv, o1[4 * i4 + 3] * inv); *(u32x2*)(orow + 32 + 8 * i4) = w1;
        }
    }
}
constexpr int SX_XT = 0, SX_XWT = 36864, SX_BT = 73728, SX_BS = 92160, SX_CS = 109568, SX_DT = 126976, SX_CUM = SX_DT + 1024, SX_WIN = SX_DT + 2048, SX_PART = SX_DT + 3072;
__device__ __forceinline__ void ssd_phase(const Frame& F, const Args& a, int z, int li, bf16* PROJ, const float* DT, bf16* dryXB) {
    float* outp = (float*)AIN(23);
    unsigned char* lds = F.lds;
    bf16* Xt = (bf16*)(lds + SX_XT); bf16* Xwt = (bf16*)(lds + SX_XWT); bf16* Bt = (bf16*)(lds + SX_BT); bf16* Bs = (bf16*)(lds + SX_BS); bf16* Cs = (bf16*)(lds + SX_CS);
    float* dts = (float*)(lds + SX_DT); float* cums = (float*)(lds + SX_CUM); float* wins = (float*)(lds + SX_WIN); float* part = (float*)(lds + SX_PART);
    const int tid = F.tid, lane = F.lane, wave = F.wave, l31 = lane & 31, hh = lane >> 5;
    const int r = wave >> 1, half = wave & 1;
    const float* conv_w = AIN(10) + (size_t)li * 4 * 4096; const float* conv_b = AIN(11) + (size_t)li * 4096;
    const float* dt_bias = AIN(12) + li * 32; const float* a_log = AIN(13) + li * 32; const float* d_skip = AIN(14) + li * 32; const float* norm_w = AIN(15) + (size_t)li * 2048;
    for (int item = F.bid; item < 512; item += F.G) {
        const bool smp = item >= 256; const int bg = item & 255, b = bg >> 3, g = bg & 7;
        const size_t row0 = smp ? (size_t)MP + b * 64 : (size_t)b * 2048; const int nchunks = smp ? 1 : 32;
        const int hglob = g * 4 + r;
        const float Dr = d_skip[hglob];
        f32x16 hT[4];
        const size_t hoff = (((size_t)(li * 32 + b) * 32 + hglob) * 64 + 32 * half + l31) * 128 + 4 * hh;
        if (smp) { const float* hs = AIN(4) + hoff;
#pragma unroll
            for (int nb = 0; nb < 4; ++nb)
#pragma unroll
                for (int i4 = 0; i4 < 4; ++i4) { const f32x4 v = *(const f32x4*)(hs + 32 * nb + 8 * i4); hT[nb][4 * i4] = v[0]; hT[nb][4 * i4 + 1] = v[1]; hT[nb][4 * i4 + 2] = v[2]; hT[nb][4 * i4 + 3] = v[3]; }
        } else {
#pragma unroll
            for (int nb = 0; nb < 4; ++nb)
#pragma unroll
                for (int i = 0; i < 16; ++i) hT[nb][i] = 0.f;
        }
        float dt_pf = (tid < 256) ? DT[(row0 + lane) * 32 + g * 4 + wave] : 0.f;
#pragma unroll 1
        for (int c = 0; c < nchunks; ++c) {
            const size_t rowc = row0 + 64 * c;
            int lane_ = F.lane; asm volatile("" : "+v"(lane_));
            const int lane = lane_, l31 = lane & 31, hh = lane >> 5, tid = wave * 64 + lane;
            const int role = lane < 32 ? 0 : (lane < 48 ? 1 : 2);
            const int chbase = role == 0 ? g * 256 + 8 * lane : (role == 1 ? 2048 + g * 128 + 8 * (lane - 32) : 3072 + g * 128 + 8 * (lane - 48));
            if (tid < 256) {
                const int hr = g * 4 + wave;
                const float raw = dt_pf + dt_bias[hr];
                if (c + 1 < nchunks) dt_pf = DT[(rowc + 64 + lane) * 32 + hr];
                const float dt = raw > 20.f ? raw : log1pf(__expf(raw));
                const float am = -__expf(a_log[hr]) * LOG2E;
                float v = dt * am;
#pragma unroll
                for (int o = 1; o < 64; o <<= 1) { const float n = __shfl_up(v, o); if (lane >= o) v += n; }
                const float last = __shfl(v, 63);
                dts[wave * 64 + lane] = dt; cums[wave * 64 + lane] = v; wins[wave * 64 + lane] = fexp2(last - v) * dt;
            }
            __syncthreads();
            {
                const bf16* src = PROJ + 2048 + chbase;
                u32x4 raw[11];
#pragma unroll
                for (int i = 0; i < 11; ++i) {
                    const int rr = 8 * wave - 3 + i;
                    if (rr >= 0 || c > 0) raw[i] = *(const u32x4*)(src + (size_t)((long)rowc + rr) * LDP);
                    else if (!smp) raw[i] = (u32x4){0u, 0u, 0u, 0u};
                    else { const float* sc = AIN(5) + ((size_t)(li * 32 + b) * 3 + (3 + rr)) * 4096 + chbase; const f32x4 s0 = *(const f32x4*)sc, s1 = *(const f32x4*)(sc + 4);
                        raw[i] = (u32x4){pk2(s0[0], s0[1]), pk2(s0[2], s0[3]), pk2(s1[0], s1[1]), pk2(s1[2], s1[3])}; }
                }
                if (c == nchunks - 1 && wave == 7) {
                    float* co = outp + (smp ? O_CS : O_CP) + ((size_t)(li * 32 + b) * 3) * 4096 + chbase;
#pragma unroll
                    for (int k = 0; k < 3; ++k) { const u32x4 rw = raw[8 + k];
                        *(f32x4*)(co + k * 4096) = (f32x4){bflo(rw.x), bfhi(rw.x), bflo(rw.y), bfhi(rw.y)}; *(f32x4*)(co + k * 4096 + 4) = (f32x4){bflo(rw.z), bfhi(rw.z), bflo(rw.w), bfhi(rw.w)}; }
                }
                float win8[8];
                { const float* wp = wins + (lane < 32 ? (lane >> 3) : 0) * 64 + 8 * wave;
                  const f32x4 wa = *(const f32x4*)wp, wb = *(const f32x4*)(wp + 4);
                  win8[0] = wa[0]; win8[1] = wa[1]; win8[2] = wa[2]; win8[3] = wa[3]; win8[4] = wb[0]; win8[5] = wb[1]; win8[6] = wb[2]; win8[7] = wb[3]; }
#pragma unroll
                for (int hb = 0; hb < 2; ++hb) {
                    f32x4 wv[4], bvv;
#pragma unroll
                    for (int k = 0; k < 4; ++k) wv[k] = *(const f32x4*)(conv_w + k * 4096 + chbase + 4 * hb);
                    bvv = *(const f32x4*)(conv_b + chbase + 4 * hb);
                    unsigned pc[4][4];
#pragma unroll
                    for (int e4 = 0; e4 < 4; ++e4) {
                        const int e = 4 * hb + e4;
                        float xv[11];
#pragma unroll
                        for (int i = 0; i < 11; ++i) { const unsigned wd = raw[i][e >> 1]; xv[i] = (e & 1) ? bfhi(wd) : bflo(wd); }
                        const float w0 = wv[0][e4], w1 = wv[1][e4], w2 = wv[2][e4], w3 = wv[3][e4], bb = bvv[e4];
                        float o[8];
#pragma unroll
                        for (int j = 0; j < 8; ++j) o[j] = silu_f(bb + w0 * xv[j] + w1 * xv[j + 1] + w2 * xv[j + 2] + w3 * xv[j + 3]);
#pragma unroll
                        for (int j2 = 0; j2 < 4; ++j2) pc[e4][j2] = pk2(o[2 * j2], o[2 * j2 + 1]);
                        if (role == 0) {
                            *(u32x4*)(Xt + (8 * lane + e) * 72 + 8 * wave) = (u32x4){pc[e4][0], pc[e4][1], pc[e4][2], pc[e4][3]};
                            *(u32x4*)(Xwt + (8 * lane + e) * 72 + 8 * wave) = (u32x4){pk2(o[0] * win8[0], o[1] * win8[1]), pk2(o[2] * win8[2], o[3] * win8[3]), pk2(o[4] * win8[4], o[5] * win8[5]), pk2(o[6] * win8[6], o[7] * win8[7])};
                        } else if (role == 1) {
                            *(u32x4*)(Bt + (8 * (lane - 32) + e) * 72 + 8 * wave) = (u32x4){pc[e4][0], pc[e4][1], pc[e4][2], pc[e4][3]};
                        }
                    }
                    if (role != 0) {
                        bf16* dst = (role == 1 ? Bs + 8 * (lane - 32) : Cs + 8 * (lane - 48)) + (8 * wave) * 136 + 4 * hb;
#pragma unroll
                        for (int j2 = 0; j2 < 4; ++j2) {
                            u32x2 lo, hi;
                            lo.x = __builtin_amdgcn_perm(pc[1][j2], pc[0][j2], 0x05040100u); hi.x = __builtin_amdgcn_perm(pc[1][j2], pc[0][j2], 0x07060302u);
                            lo.y = __builtin_amdgcn_perm(pc[3][j2], pc[2][j2], 0x05040100u); hi.y = __builtin_amdgcn_perm(pc[3][j2], pc[2][j2], 0x07060302u);
                            *(u32x2*)(dst + (2 * j2) * 136) = lo; *(u32x2*)(dst + (2 * j2 + 1) * 136) = hi;
                        }
                    }
                }
            }
            __syncthreads();
            bf16* zr0 = PROJ + (rowc + l31) * LDP + g * 256 + 64 * r + 32 * half + 4 * hh; bf16* zr1 = zr0 + (size_t)32 * LDP;
            u32x2 zp0[4], zp1[4];
#pragma unroll
            for (int i4 = 0; i4 < 4; ++i4) { zp0[i4] = *(const u32x2*)(zr0 + 8 * i4); zp1[i4] = *(const u32x2*)(zr1 + 8 * i4); }
            f32x16 cb00, cb01, cb11;
#pragma unroll
            for (int i = 0; i < 16; ++i) { cb00[i] = 0.f; cb01[i] = 0.f; cb11[i] = 0.f; }
#pragma unroll
            for (int ns = 0; ns < 8; ++ns) {
                const bf16x8 a0 = *(const bf16x8*)(Bs + l31 * 136 + 16 * ns + 8 * hh), a1 = *(const bf16x8*)(Bs + (32 + l31) * 136 + 16 * ns + 8 * hh);
                const bf16x8 c0 = *(const bf16x8*)(Cs + l31 * 136 + 16 * ns + 8 * hh), c1 = *(const bf16x8*)(Cs + (32 + l31) * 136 + 16 * ns + 8 * hh);
                cb00 = MFMA32(a0, c0, cb00); cb01 = MFMA32(a0, c1, cb01); cb11 = MFMA32(a1, c1, cb11);
            }
            const float* cumr = cums + r * 64; const float* dtr = dts + r * 64;
            const float cum_t0 = cumr[l31], cum_t1 = cumr[32 + l31];
#pragma unroll
            for (int i4 = 0; i4 < 4; ++i4) {
                const f32x4 cs0 = *(const f32x4*)(cumr + 8 * i4 + 4 * hh), cs1 = *(const f32x4*)(cumr + 32 + 8 * i4 + 4 * hh);
                const f32x4 ds0 = *(const f32x4*)(dtr + 8 * i4 + 4 * hh), ds1 = *(const f32x4*)(dtr + 32 + 8 * i4 + 4 * hh);
#pragma unroll
                for (int j = 0; j < 4; ++j) { const int i = 4 * i4 + j, s = 8 * i4 + 4 * hh + j;
                    float v00 = cb00[i] * fexp2(fminf(cum_t0 - cs0[j], 0.f)) * ds0[j]; v00 = (s <= l31) ? v00 : 0.f; v00 += (s == l31) ? Dr : 0.f; cb00[i] = v00;
                    cb01[i] = cb01[i] * fexp2(fminf(cum_t1 - cs0[j], 0.f)) * ds0[j];
                    float v11 = cb11[i] * fexp2(fminf(cum_t1 - cs1[j], 0.f)) * ds1[j]; v11 = (s <= l31) ? v11 : 0.f; v11 += (s == l31) ? Dr : 0.f; cb11[i] = v11; }
            }
            f32x16 y0, y1;
#pragma unroll
            for (int i = 0; i < 16; ++i) { y0[i] = 0.f; y1[i] = 0.f; }
#pragma unroll
            for (int nb = 0; nb < 4; ++nb)
#pragma unroll
                for (int s2 = 0; s2 < 2; ++s2) {
                    const bf16x8 ha = pack8(hT[nb], s2);
                    const int n0 = 32 * nb + 16 * s2 + 4 * hh;
                    const s16x4 c0l = *(const s16x4*)(Cs + l31 * 136 + n0), c0h = *(const s16x4*)(Cs + l31 * 136 + n0 + 8);
                    const s16x4 c1l = *(const s16x4*)(Cs + (32 + l31) * 136 + n0), c1h = *(const s16x4*)(Cs + (32 + l31) * 136 + n0 + 8);
                    y0 = MFMA32(ha, __builtin_shufflevector(c0l, c0h, 0, 1, 2, 3, 4, 5, 6, 7), y0);
                    y1 = MFMA32(ha, __builtin_shufflevector(c1l, c1h, 0, 1, 2, 3, 4, 5, 6, 7), y1);
                }
            { const float e0 = fexp2(cum_t0), e1 = fexp2(cum_t1);
#pragma unroll
              for (int i = 0; i < 16; ++i) { y0[i] *= e0; y1[i] *= e1; } }
            { const bf16* xrow = Xt + (64 * r + 32 * half + l31) * 72;
#pragma unroll
              for (int s2 = 0; s2 < 2; ++s2) {
                  const s16x4 x0l = *(const s16x4*)(xrow + 16 * s2 + 4 * hh), x0h = *(const s16x4*)(xrow + 16 * s2 + 4 * hh + 8);
                  const s16x4 x1l = *(const s16x4*)(xrow + 32 + 16 * s2 + 4 * hh), x1h = *(const s16x4*)(xrow + 32 + 16 * s2 + 4 * hh + 8);
                  const bf16x8 xa0 = __builtin_shufflevector(x0l, x0h, 0, 1, 2, 3, 4, 5, 6, 7), xa1 = __builtin_shufflevector(x1l, x1h, 0, 1, 2, 3, 4, 5, 6, 7);
                  y0 = MFMA32(xa0, pack8(cb00, s2), y0);
                  y1 = MFMA32(xa0, pack8(cb01, s2), y1);
                  y1 = MFMA32(xa1, pack8(cb11, s2), y1);
              } }
            {
                float ss0 = 0.f, ss1 = 0.f;
#pragma unroll
                for (int i4 = 0; i4 < 4; ++i4) {
                    const u32x2 z0 = zp0[i4], z1 = zp1[i4];
                    const float za[4] = {bflo(z0.x), bfhi(z0.x), bflo(z0.y), bfhi(z0.y)}, zb[4] = {bflo(z1.x), bfhi(z1.x), bflo(z1.y), bfhi(z1.y)};
#pragma unroll
                    for (int j = 0; j < 4; ++j) { const float v0 = y0[4 * i4 + j] * silu_f(za[j]), v1 = y1[4 * i4 + j] * silu_f(zb[j]); y0[4 * i4 + j] = v0; y1[4 * i4 + j] = v1; ss0 += v0 * v0; ss1 += v1 * v1; }
                }
                ss0 += __shfl_xor(ss0, 32); ss1 += __shfl_xor(ss1, 32);
                if (hh == 0) { part[l31 * 8 + wave] = ss0; part[(32 + l31) * 8 + wave] = ss1; }
                __syncthreads();
                const f32x4 pa = *(const f32x4*)(part + l31 * 8), pb = *(const f32x4*)(part + l31 * 8 + 4), pc = *(const f32x4*)(part + (32 + l31) * 8), pd = *(const f32x4*)(part + (32 + l31) * 8 + 4);
                const float t0 = ((pa[0] + pa[1]) + (pa[2] + pa[3])) + ((pb[0] + pb[1]) + (pb[2] + pb[3])), t1 = ((pc[0] + pc[1]) + (pc[2] + pc[3])) + ((pd[0] + pd[1]) + (pd[2] + pd[3]));
                const float r0 = 1.0f / sqrtf(t0 * (1.f / 256.f) + RMS_EPS), r1 = 1.0f / sqrtf(t1 * (1.f / 256.f) + RMS_EPS);
                const float* nwp = norm_w + g * 256 + 64 * r + 32 * half + 4 * hh;
#pragma unroll
                for (int i4 = 0; i4 < 4; ++i4) { const f32x4 nw = *(const f32x4*)(nwp + 8 * i4);
                    u32x2 w0; w0.x = pk2(y0[4 * i4] * r0 * nw[0], y0[4 * i4 + 1] * r0 * nw[1]); w0.y = pk2(y0[4 * i4 + 2] * r0 * nw[2], y0[4 * i4 + 3] * r0 * nw[3]); if (!dryXB) *(u32x2*)(zr0 + 8 * i4) = w0; else if (g < 4) *(u32x2*)(dryXB + (rowc + l31) * 1024 + g * 256 + 64 * r + 32 * half + 4 * hh + 8 * i4) = w0;
                    u32x2 w1; w1.x = pk2(y1[4 * i4] * r1 * nw[0], y1[4 * i4 + 1] * r1 * nw[1]); w1.y = pk2(y1[4 * i4 + 2] * r1 * nw[2], y1[4 * i4 + 3] * r1 * nw[3]); if (!dryXB) *(u32x2*)(zr1 + 8 * i4) = w1; else if (g < 4) *(u32x2*)(dryXB + (rowc + 32 + l31) * 1024 + g * 256 + 64 * r + 32 * half + 4 * hh + 8 * i4) = w1; }
            }
            { const float dec = fexp2(cumr[63]);
#pragma unroll
              for (int nb = 0; nb < 4; ++nb)
#pragma unroll
                  for (int i = 0; i < 16; ++i) hT[nb][i] *= dec;
              const bf16* xw = Xwt + (64 * r + 32 * half + l31) * 72 + 8 * hh;
#pragma unroll
              for (int ss = 0; ss < 4; ++ss) { const bf16x8 bx = *(const bf16x8*)(xw + 16 * ss);
#pragma unroll
                  for (int nb = 0; nb < 4; ++nb) { const bf16x8 af = *(const bf16x8*)(Bt + (32 * nb + l31) * 72 + 16 * ss + 8 * hh); hT[nb] = MFMA32(af, bx, hT[nb]); } }
            }
            __syncthreads();
        }
        { float* ho = outp + (smp ? O_HS : O_HP) + hoff;
#pragma unroll
          for (int nb = 0; nb < 4; ++nb)
#pragma unroll
              for (int i4 = 0; i4 < 4; ++i4) *(f32x4*)(ho + 32 * nb + 8 * i4) = (f32x4){hT[nb][4 * i4], hT[nb][4 * i4 + 1], hT[nb][4 * i4 + 2], hT[nb][4 * i4 + 3]};
          }
    }
}
__global__ void __launch_bounds__(512, 2) fwd_megakernel(Args a) {
    extern __shared__ __attribute__((aligned(16))) unsigned char lds[];
    cg::grid_group grid = cg::this_grid();
    Frame F; F.lds = lds; F.tid = threadIdx.x; F.lane = F.tid & 63; F.wave = __builtin_amdgcn_readfirstlane(F.tid >> 6); F.G = gridDim.x; F.bid = blockIdx.x;
    PG8_LAS unsigned char* glds = (PG8_LAS unsigned char*)lds;
    {
        int z = 0; asm volatile("" : "+s"(z));
        unsigned* bw = (unsigned*)AIN(24);
        if (blockIdx.x == 0) for (int i = threadIdx.x; i < XCD_BAR_WORDS; i += 512) __hip_atomic_store(bw + i, 0u, __ATOMIC_RELAXED, __HIP_MEMORY_SCOPE_AGENT);
        volatile LAS unsigned* st = (volatile LAS unsigned*)(glds + (LDS_BYTES - 16));
        if (threadIdx.x < 2) st[threadIdx.x] = 0u;
        __syncthreads();
        grid.sync();
        (void)xcd_barrier_post(bw, st);
    }
#ifndef REP_IN
#define REP_IN 1
#endif
#ifndef REP_ATT
#define REP_ATT 1
#endif
#ifndef REP_UP
#define REP_UP 1
#endif
#ifndef REP_CONV
#define REP_CONV 1
#endif
#ifndef REP_SYNC
#define REP_SYNC 1
#endif
    for (int ph = a.ph_lo; ph < a.ph_hi; ++ph) {
      const int sub_ = ph & 7; if (sub_ == 4 || (sub_ == 7 && ph != 31)) continue; const int nrep = sub_ == 0 ? REP_CONV : sub_ == 1 ? REP_IN : (sub_ == 2 && !((ph >> 3) & 1)) ? REP_ATT : sub_ == 5 ? REP_UP : 1;
      for (int rep = 0; rep < nrep; ++rep) {
        { int t_ = threadIdx.x; asm volatile("" : "+v"(t_)); F.tid = t_; F.lane = t_ & 63; F.wave = __builtin_amdgcn_readfirstlane(t_ >> 6); }
        int z = 0; asm volatile("" : "+s"(z));
        unsigned char* ws = (unsigned char*)AIN(24);
        bf16* WA = (bf16*)(ws + WS_WA); bf16* WB = (bf16*)(ws + WS_WB); bf16* WUP = (bf16*)(ws + WS_WUP); bf16* WDN = (bf16*)(ws + WS_WDN);
        bf16* XB = (bf16*)(ws + WS_XB); float* DT = (float*)(ws + WS_DT); bf16* BIG = (bf16*)(ws + WS_BIG);
        bf16* OB = (bf16*)(ws + WS_O); bf16* CK = (bf16*)(ws + WS_CK); bf16* CV = (bf16*)(ws + WS_CV);
        float* X = (float*)AIN(23);
        float* ST0 = (float*)(ws + WS_ST0); float* ST1 = (float*)(ws + WS_ST1);
        const int L = ph >> 3, sub = ph & 7, li = L >> 1; const bool ssm = (L & 1);
        if (sub == 0) {
#ifndef NO_CONV
 convert_phase(F, a, z, L);
#endif
 }
        else if (sub == 1) {
#if !defined(ONLY_SUB) || ONLY_SUB == 1
            pg8::StaticOrder S;
            if (!ssm) { pg8::Gemm g{XB, WA, M, 3072, D, D}; S.init(M, 3072, F.G, F.bid); pg8::EpiQKV E{BIG, X, li, L > 0 ? ST0 : (const float*)nullptr, (const float*)(ws + WS_CSA), (const float*)(ws + WS_BWA)};
                pg8::gemm_phase<pg8::EpiQKV, pg8::StaticOrder, true, true>(glds, g, S, E); }
            else { pg8::Gemm g{XB, WA, M, NPROJ_PAD, D, D}; S.init(M, NPROJ_PAD, F.G, F.bid); pg8::EpiSsmIn E{BIG, DT, ST0, (const float*)(ws + WS_CSA), (const float*)(ws + WS_BWA)};
                pg8::gemm_phase<pg8::EpiSsmIn, pg8::StaticOrder, true, true>(glds, g, S, E); }
#endif
        } else if (sub == 2) {
#ifndef NO_ATTN
            if (!ssm) attn_phase(F, AIN(7) + (size_t)li * 16 * 513, BIG, CK, CV, OB);
#endif
#ifndef NO_SSD
#ifdef PROBE_SSD
            if (ssm) for (int pass = 0; pass < 2; ++pass) { ssd_phase(F, a, z, li, BIG, DT, pass == 0 ? XB : nullptr);
                if (pass == 0) { XcdBarrier xb_; xb_.bar = (unsigned*)AIN(24); xb_.x = xb_xcc_id(); xb_.st = (volatile LAS unsigned*)(glds + (LDS_BYTES - 16)); xcd_barrier(xb_); } }
#else
            if (ssm) ssd_phase(F, a, z, li, BIG, DT, nullptr);
#endif
#endif
        } else if (sub == 3) {
#if !defined(ONLY_SUB) || ONLY_SUB == 3
            pg8::StaticOrder S; S.init(M, D, F.G, F.bid); pg8::EpiResid E{XB, L > 0 ? ST0 : (const float*)nullptr, AIN(21) + (L > 0 ? L - 1 : 0) * D, AIN(22) + (L > 0 ? L - 1 : 0) * D, ST1, (PG8_LAS float*)(glds + 131072)};
            if (!ssm) { pg8::Gemm g{OB, WB, M, D, D, D}; pg8::gemm_phase<pg8::EpiResid, pg8::StaticOrder, true, true>(glds, g, S, E); }
            else { pg8::Gemm g{BIG, WB, M, D, 2048, LDP}; pg8::gemm_phase<pg8::EpiResid, pg8::StaticOrder, true, true>(glds, g, S, E); }
#endif
        } else if (sub == 4) ln_phase(F, X, XB, AIN(17) + L * D, AIN(18) + L * D);
        else if (sub == 5) {
#if !defined(ONLY_SUB) || ONLY_SUB == 5
 pg8::Gemm g{XB, WUP, M, DFF, D, D}; pg8::StaticOrder S; S.init(M, DFF, F.G, F.bid); pg8::EpiBf16Plain E{BIG, DFF, 1, ST1, (const float*)(ws + WS_CSU), (const float*)(ws + WS_BWU)};
            pg8::gemm_phase<pg8::EpiBf16Plain, pg8::StaticOrder, true, true>(glds, g, S, E);
#endif
 }
        else if (sub == 6) {
#if !defined(ONLY_SUB) || ONLY_SUB == 6
 pg8::Gemm g{BIG, WDN, M, D, DFF, DFF}; pg8::StaticOrder S; S.init(M, D, F.G, F.bid);
#ifdef PROBE_DN
            { pg8::EpiBf16Plain E0{(bf16*)(ws + WS_CK), D, 0, (const float*)nullptr, (const float*)nullptr, (const float*)nullptr};
              pg8::gemm_phase<pg8::EpiBf16Plain, pg8::StaticOrder, true, true>(glds, g, S, E0);
              XcdBarrier xb_; xb_.bar = (unsigned*)AIN(24); xb_.x = xb_xcc_id(); xb_.st = (volatile LAS unsigned*)(glds + (LDS_BYTES - 16)); xcd_barrier(xb_); }
#endif
 pg8::EpiResid E{XB, ST1, AIN(17) + L * D, AIN(18) + L * D, ST0, (PG8_LAS float*)(glds + 131072)};
            pg8::gemm_phase<pg8::EpiResid, pg8::StaticOrder, true, true>(glds, g, S, E);
#endif
 }
        else ln_phase(F, X, XB, AIN(21) + L * D, AIN(22) + L * D);
        if (ph + 1 < a.ph_hi || rep + 1 < nrep) { for (int s_ = 0; s_ < REP_SYNC; ++s_) { XcdBarrier xb_; xb_.bar = (unsigned*)AIN(24); xb_.x = xb_xcc_id(); xb_.st = (volatile LAS unsigned*)(glds + (LDS_BYTES - 16)); xcd_barrier(xb_); } }
      }
    }
}

extern "C" void kernel_launch(void* const* d_in, const int* in_sizes, int n_in, void* d_out, int out_size, void* d_ws, size_t ws_size, hipStream_t stream) {
    static int grid = 0;
    if (grid == 0) {
        if (n_in != 23 || ws_size < WS_END2) { fprintf(stderr, "kernel_launch: need 23 inputs and %zu bytes of workspace, got %d and %zu\n", (size_t)WS_END2, n_in, ws_size); grid = -1; return; }
        int dev = 0, cus = 0, per_cu = 0;
        hipGetDevice(&dev); hipDeviceGetAttribute(&cus, hipDeviceAttributeMultiprocessorCount, dev);
        if (hipFuncSetAttribute((const void*)fwd_megakernel, hipFuncAttributeMaxDynamicSharedMemorySize, LDS_BYTES) != hipSuccess) { fprintf(stderr, "kernel_launch: hipFuncSetAttribute failed\n"); grid = -1; return; }
        if (hipOccupancyMaxActiveBlocksPerMultiprocessor(&per_cu, (const void*)fwd_megakernel, 512, LDS_BYTES) != hipSuccess || per_cu < 1) per_cu = 1;
        (void)hipGetLastError();
        grid = cus * per_cu;
    }
    if (grid < 0) return;
    Args a{};
    for (int i = 0; i < 23; ++i) a.in[i] = (const float*)d_in[i];
    a.in[23] = (const float*)d_out; a.in[24] = (const float*)d_ws; a.ph_lo = 0; a.ph_hi = 32;
    void* args[] = {&a};
    hipError_t e = hipLaunchCooperativeKernel((const void*)fwd_megakernel, dim3(grid), dim3(512), args, LDS_BYTES, stream);
    if (e != hipSuccess) fprintf(stderr, "cooperative launch failed: %s (grid %d)\n", hipGetErrorString(e), grid);
}
```

```cpp
#include <hip/hip_runtime.h>
#include <hip/hip_cooperative_groups.h>
#include <cstdio>
#include <cstdint>
namespace cg = cooperative_groups;
namespace pg8 {
#define PG8_LAS __attribute__((address_space(3)))
typedef unsigned short bf16_t;
typedef short bf16x8 __attribute__((ext_vector_type(8)));
typedef float f32x4 __attribute__((ext_vector_type(4)));
typedef unsigned u32x4 __attribute__((ext_vector_type(4)));
constexpr int BM = 256, BK = 64, HALF = 128, HTB = HALF * BK * 2  , STAGE_BYTES = 8 * HTB, NXCD = 8, WGM = 8;

__host__ __device__ __forceinline__ int lds_byte(int r, int c) { const int st = (r >> 4) * 2 + (c >> 5), rr = r & 15, cc = c & 31, ob = rr * 64 + cc * 2; return st * 1024 + (ob ^ (((ob >> 9) & 1) << 5)); }
__host__ __device__ __forceinline__ void stage_rc(int b, int& R, int& C) { const int st = b / 1024, sb = b % 1024, swz = sb ^ (((sb >> 9) & 1) << 5); R = (st >> 1) * 16 + swz / 64; C = (st & 1) * 32 + (swz % 64) / 2; }
__host__ __device__ __forceinline__ int perm32(int rho) { const int n = rho >> 4, i = rho & 15; return 8 * (i >> 2) + 4 * n + (i & 3); }

struct Unit { int pm, pn; };
struct Gemm { const bf16_t* A; const bf16_t* Bt; int M, N, K, lda; };

struct StaticOrder {
    int nM, nN, nwg, G, c;
    __host__ __device__ void init(int M, int N, int G_, int c_) { nM = M / BM; nN = N / BM; nwg = nM * nN; G = G_; c = c_; }
    __host__ __device__ bool next(int i, Unit& u) const {
        const long L = (long)i * G + c; if (L >= nwg) return false;
        int wgid = (int)L; { const int q = nwg / NXCD, r = nwg % NXCD, xcd = wgid % NXCD, off = wgid / NXCD; wgid = (xcd < r ? xcd * (q + 1) : r * (q + 1) + (xcd - r) * q) + off; }
        const int nig = WGM * nN, gid = wgid / nig, fm = gid * WGM, gsz = (nM - fm) < WGM ? (nM - fm) : WGM;
        u.pm = fm + ((wgid % nig) % gsz); u.pn = (wgid % nig) / gsz; return true;
    }
    __device__ __forceinline__ void a_ready(const Unit&) const {}
    __device__ __forceinline__ void done(const Unit&) const {}
};

__device__ __forceinline__ unsigned cvt_pk_bf16(float lo, float hi) { unsigned r; asm volatile("v_cvt_pk_bf16_f32 %0, %1, %2" : "=v"(r) : "v"(lo), "v"(hi)); return r; }
typedef float f32x2 __attribute__((ext_vector_type(2)));
template <class Epi, class Sched, bool ALIGN_EPI = false, bool SP2 = false>
__device__ __forceinline__ void gemm_phase(PG8_LAS unsigned char* lds, const Gemm g, const Sched& S, const Epi& E) {
    int tid_ = threadIdx.x; asm volatile("" : "+v"(tid_));
    const int tid = tid_, wid = __builtin_amdgcn_readfirstlane(tid >> 6), lane = tid & 63, wr = wid >> 2, wc = wid & 3, fr = lane & 15, fq = lane >> 4;
    const int K = g.K, nt = K / BK;
    unsigned voffA[2], voffB[2];
#pragma unroll
    for (int i = 0; i < 2; ++i) { int R, C; stage_rc(tid * 16 + i * 8192, R, C); const int Rb = Epi::PERM ? ((R & ~31) + perm32(R & 31)) : R;
        voffA[i] = (unsigned)(R * g.lda + C) * 2u; voffB[i] = (unsigned)(Rb * K + C) * 2u; }
    const size_t kstep = (size_t)(BK * 2);
    const size_t hstepA = (size_t)HALF * g.lda * 2, hstepB = (size_t)HALF * K * 2;
    const size_t tstepA = 2 * hstepA, tstepB = 2 * hstepB;
    const unsigned ldsw = (unsigned)wid * 1024u;
    const int aoff = lds_byte(wr * 64 + fr, fq * 8), boff = lds_byte(wc * 32 + fr, fq * 8);
#define PG8_SA(b, h) (((b) * 2 + (h)) * HTB)
#define PG8_SB(b, h) ((4 + (b) * 2 + (h)) * HTB)
#define PG8_STAGE(bufoff, gbase, voff) do { _Pragma("unroll") for (int _i = 0; _i < 2; ++_i) \
        __builtin_amdgcn_global_load_lds((const unsigned*)((const char*)(gbase) + (voff)[_i]), (PG8_LAS unsigned*)(lds + (bufoff) + ldsw + _i * 8192), 16, 0, 0); } while (0)
#define PG8_LDA(dst, b, h) do { _Pragma("unroll") for (int m = 0; m < 4; ++m) _Pragma("unroll") for (int k = 0; k < 2; ++k) dst[m][k] = *(const PG8_LAS bf16x8*)(lds + PG8_SA(b, h) + aoff + m * 2048 + k * 1024); } while (0)
#define PG8_LDB(dst, b, h) do { _Pragma("unroll") for (int n = 0; n < 2; ++n) _Pragma("unroll") for (int k = 0; k < 2; ++k) dst[n][k] = *(const PG8_LAS bf16x8*)(lds + PG8_SB(b, h) + boff + n * 2048 + k * 1024); } while (0)
#define PG8_MMA(ai, bj, At, Bt) do { __builtin_amdgcn_s_setprio(1); _Pragma("unroll") for (int m = 0; m < 4; ++m) _Pragma("unroll") for (int n = 0; n < 2; ++n) _Pragma("unroll") for (int k = 0; k < 2; ++k) \
        acc[ai][bj][m][n] = __builtin_amdgcn_mfma_f32_16x16x32_bf16(Bt[n][k], At[m][k], acc[ai][bj][m][n], 0, 0, 0); __builtin_amdgcn_s_setprio(0); } while (0)
#define PG8_WAIT_V(n) asm volatile("s_waitcnt vmcnt(" #n ")" ::: "memory")
#define PG8_WAIT_L(n) asm volatile("s_waitcnt lgkmcnt(" #n ")" ::: "memory")
#define PG8_BAR __builtin_amdgcn_s_barrier()
#define PG8_SCHED __builtin_amdgcn_sched_barrier(0)
    Unit cur, nxt; int ui = 0;
    if (!S.next(0, cur)) return;
    f32x4 acc[2][2][4][2];
#pragma unroll
    for (int a = 0; a < 2; ++a)
#pragma unroll
        for (int b = 0; b < 2; ++b)
#pragma unroll
            for (int m = 0; m < 4; ++m)
#pragma unroll
                for (int n = 0; n < 2; ++n) acc[a][b][m][n] = (f32x4){0.f, 0.f, 0.f, 0.f};
    bf16x8 At[4][2], B0[2][2], B1[2][2];
    const char* cA = (const char*)g.A + (size_t)cur.pm * tstepA; const char* cB = (const char*)g.Bt + (size_t)cur.pn * tstepB;
    S.a_ready(cur);
    if constexpr (Epi::HAS_PF) E.prefetch(cur, tid);
    if constexpr (SP2) {
        PG8_STAGE(PG8_SB(0, 0), cB, voffB); PG8_STAGE(PG8_SB(0, 1), cB + hstepB, voffB); PG8_STAGE(PG8_SA(0, 0), cA, voffA); PG8_STAGE(PG8_SA(0, 1), cA + hstepA, voffA);
        if (wr == 1) PG8_BAR;
        PG8_WAIT_V(2); PG8_BAR;
        PG8_STAGE(PG8_SB(1, 0), cB + kstep, voffB); PG8_STAGE(PG8_SA(1, 0), cA + kstep, voffA); PG8_STAGE(PG8_SB(1, 1), cB + hstepB + kstep, voffB);
        PG8_WAIT_V(6); PG8_BAR;
    } else {
        PG8_STAGE(PG8_SB(0, 0), cB, voffB); PG8_STAGE(PG8_SA(0, 0), cA, voffA); PG8_STAGE(PG8_SB(0, 1), cB + hstepB, voffB); PG8_STAGE(PG8_SA(0, 1), cA + hstepA, voffA);
        if (wr == 1) PG8_BAR;
        PG8_WAIT_V(4); PG8_BAR;
        PG8_STAGE(PG8_SB(1, 0), cB + kstep, voffB); PG8_STAGE(PG8_SA(1, 0), cA + kstep, voffA); PG8_STAGE(PG8_SB(1, 1), cB + hstepB + kstep, voffB);
        PG8_WAIT_V(6); PG8_BAR;
    }
    for (;;) {
        const bool has_next = S.next(ui + 1, nxt);
        const char* nA = has_next ? (const char*)g.A + (size_t)nxt.pm * tstepA : cA; const char* nB = has_next ? (const char*)g.Bt + (size_t)nxt.pn * tstepB : cB;
        for (int t = 0; t < nt; t += 2) {
            const bool last = (t == nt - 2);
            const char* a1 = cA + (size_t)(t + 1) * kstep;
            const char* a2 = last ? nA : cA + (size_t)(t + 2) * kstep; const char* b2 = last ? nB : cB + (size_t)(t + 2) * kstep;
            const char* a3 = a2 + kstep; const char* b3 = b2 + kstep;
            if (last && has_next) S.a_ready(nxt);
            if constexpr (SP2) {
            PG8_LDB(B0, 0, 0); PG8_LDB(B1, 0, 1); PG8_SCHED; PG8_LDA(At, 0, 0); PG8_STAGE(PG8_SA(1, 1), a1 + hstepA, voffA);
            PG8_WAIT_V(8); PG8_WAIT_L(0); PG8_BAR; PG8_MMA(0, 0, At, B0); PG8_MMA(0, 1, At, B1); PG8_BAR; PG8_SCHED;
            PG8_LDA(At, 0, 1); PG8_STAGE(PG8_SB(0, 0), b2, voffB); PG8_STAGE(PG8_SB(0, 1), b2 + hstepB, voffB); PG8_STAGE(PG8_SA(0, 0), a2, voffA);
            PG8_WAIT_V(8); PG8_WAIT_L(0); PG8_BAR; PG8_MMA(1, 0, At, B0); PG8_MMA(1, 1, At, B1); PG8_BAR; PG8_SCHED;
            PG8_LDB(B0, 1, 0); PG8_LDB(B1, 1, 1); PG8_SCHED; PG8_LDA(At, 1, 0); PG8_STAGE(PG8_SA(0, 1), a2 + hstepA, voffA);
            PG8_WAIT_V(8); PG8_WAIT_L(0); PG8_BAR; PG8_MMA(0, 0, At, B0); PG8_MMA(0, 1, At, B1); PG8_BAR; PG8_SCHED;
            PG8_LDA(At, 1, 1); PG8_STAGE(PG8_SB(1, 0), b3, voffB); PG8_STAGE(PG8_SB(1, 1), b3 + hstepB, voffB); PG8_STAGE(PG8_SA(1, 0), a3, voffA);
            PG8_WAIT_V(8); PG8_WAIT_L(0); PG8_BAR; PG8_MMA(1, 0, At, B0); PG8_MMA(1, 1, At, B1); PG8_BAR; PG8_SCHED;
            } else {
            PG8_LDB(B0, 0, 0); PG8_SCHED; PG8_LDA(At, 0, 0); PG8_STAGE(PG8_SA(1, 1), a1 + hstepA, voffA);
            PG8_WAIT_L(8); PG8_BAR; PG8_WAIT_L(0); PG8_MMA(0, 0, At, B0); PG8_BAR; PG8_SCHED;
            PG8_LDB(B1, 0, 1); PG8_STAGE(PG8_SB(0, 0), b2, voffB);
            PG8_BAR; PG8_WAIT_L(0); PG8_MMA(0, 1, At, B1); PG8_BAR;
            PG8_LDA(At, 0, 1); PG8_STAGE(PG8_SA(0, 0), a2, voffA);
            PG8_BAR; PG8_WAIT_L(0); PG8_MMA(1, 0, At, B0); PG8_BAR; PG8_SCHED;
            PG8_STAGE(PG8_SB(0, 1), b2 + hstepB, voffB);
            PG8_WAIT_V(6); PG8_BAR; PG8_MMA(1, 1, At, B1); PG8_BAR;
            PG8_LDB(B0, 1, 0); PG8_SCHED; PG8_LDA(At, 1, 0); PG8_STAGE(PG8_SA(0, 1), a2 + hstepA, voffA);
            PG8_WAIT_L(8); PG8_BAR; PG8_WAIT_L(0); PG8_MMA(0, 0, At, B0); PG8_BAR; PG8_SCHED;
            PG8_LDB(B1, 1, 1); PG8_STAGE(PG8_SB(1, 0), b3, voffB);
            PG8_BAR; PG8_WAIT_L(0); PG8_MMA(0, 1, At, B1); PG8_BAR;
            PG8_LDA(At, 1, 1); PG8_STAGE(PG8_SA(1, 0), a3, voffA);
            PG8_BAR; PG8_WAIT_L(0); PG8_MMA(1, 0, At, B0); PG8_BAR; PG8_SCHED;
            PG8_STAGE(PG8_SB(1, 1), b3 + hstepB, voffB);
            PG8_WAIT_V(6); PG8_BAR; PG8_MMA(1, 1, At, B1); PG8_BAR;
            }
        }
        if constexpr (ALIGN_EPI) { if (wr == 0) PG8_BAR; }
        if constexpr (!Epi::AFTER_DRAIN) { E(acc, cur, wr, wc, fr, fq); S.done(cur); }
        if (!has_next) break;
#pragma unroll
        for (int a = 0; a < 2; ++a)
#pragma unroll
            for (int b = 0; b < 2; ++b)
#pragma unroll
                for (int m = 0; m < 4; ++m)
#pragma unroll
                    for (int n = 0; n < 2; ++n) acc[a][b][m][n] = (f32x4){0.f, 0.f, 0.f, 0.f};
        cur = nxt; cA = nA; cB = nB; ++ui;
        if constexpr (Epi::HAS_PF) E.prefetch(cur, tid);
        if constexpr (ALIGN_EPI) { if (wr == 1) PG8_BAR; }
    }
    PG8_WAIT_V(0);
    if constexpr (!ALIGN_EPI) { if (wr == 0) PG8_BAR; }
    PG8_BAR;
    if constexpr (Epi::AFTER_DRAIN) { E.fused(acc, cur, wr, wc, fr, fq, lds, wid, lane); S.done(cur); }
#undef PG8_SA
#undef PG8_SB
#undef PG8_STAGE
#undef PG8_LDA
#undef PG8_LDB
#undef PG8_MMA
#undef PG8_WAIT_V
#undef PG8_WAIT_L
#undef PG8_BAR
#undef PG8_SCHED
}
}
#define LAS __attribute__((address_space(3)))
typedef unsigned short bf16;
typedef float f32x4 __attribute__((ext_vector_type(4)));
typedef float f32x16 __attribute__((ext_vector_type(16)));
typedef short bf16x8 __attribute__((ext_vector_type(8)));
typedef short s16x4 __attribute__((ext_vector_type(4)));
typedef unsigned u32x4 __attribute__((ext_vector_type(4)));
typedef unsigned u32x2 __attribute__((ext_vector_type(2)));
typedef float f32x2_t __attribute__((ext_vector_type(2)));
typedef __bf16 bf16x2_t __attribute__((ext_vector_type(2)));

constexpr int D = 1024, MP = 65536, MS = 2048, M = MP + MS, DFF = 4096;
constexpr int LDP = 6144, NPROJ = 6176, NPROJ_PAD = 6400;
constexpr float ALPHA = 1.6817928305074290f, LN_EPS = 1e-5f, RMS_EPS = 1e-5f, LOG2E = 1.4426950408889634f;
constexpr size_t O_KP = 69206016, O_VP = 102760448, O_HP = 136314880, O_CP = 153092096, O_KS = 153878528, O_VS = 158072832, O_HS = 162267136, O_CS = 179044352;
constexpr size_t MiB = 1u << 20;
constexpr size_t WS_WA = 1 * MiB, WS_WB = 14 * MiB, WS_WUP = 18 * MiB, WS_WDN = 26 * MiB, WS_XB = 34 * MiB, WS_DT = 166 * MiB, WS_BIG = 175 * MiB;
constexpr size_t WS_O = WS_BIG + 396 * MiB, WS_CK = WS_BIG + 528 * MiB, WS_CV = WS_BIG + 560 * MiB, WS_END = WS_BIG + 792 * MiB;
constexpr size_t WS_AUX = WS_END, WS_ST0 = WS_AUX, WS_ST1 = WS_AUX + 2304 * 1024, WS_CSA = WS_AUX + 4608 * 1024, WS_BWA = WS_CSA + 32 * 1024, WS_CSU = WS_CSA + 64 * 1024, WS_BWU = WS_CSA + 80 * 1024, WS_MR0 = WS_AUX + 4736 * 1024, WS_MR1 = WS_AUX + 5312 * 1024, WS_WDN1 = WS_AUX + 6 * MiB, WS_END2 = WS_AUX + 14 * MiB;
constexpr float FXS = 1048576.f, FXI = 1.f / 1048576.f;
typedef long long i64x2_t __attribute__((ext_vector_type(2)));
constexpr int LDS_BYTES = 147456;

__device__ __forceinline__ unsigned pk2(float lo, float hi) { f32x2_t v = {lo, hi}; bf16x2_t b = __builtin_convertvector(v, bf16x2_t); return __builtin_bit_cast(unsigned, b); }
__device__ __forceinline__ float bf2f(unsigned short u) { return __uint_as_float((unsigned)u << 16); }
__device__ __forceinline__ float bflo(unsigned u) { return __uint_as_float(u << 16); }
__device__ __forceinline__ float bfhi(unsigned u) { return __uint_as_float(u & 0xffff0000u); }
__device__ __forceinline__ float fexp2(float x) { return __builtin_amdgcn_exp2f(x); }
__device__ __forceinline__ float frcp(float x) { return __builtin_amdgcn_rcpf(x); }
__device__ __forceinline__ float silu_f(float v) { return v * frcp(1.0f + fexp2(-v * LOG2E)); }
__device__ __forceinline__ int crow(int r, int hi) { return (r & 3) + 8 * (r >> 2) + 4 * hi; }
__device__ __forceinline__ bf16x8 pack8(const f32x16& x, int s) {
    u32x4 p; p.x = pk2(x[8 * s], x[8 * s + 1]); p.y = pk2(x[8 * s + 2], x[8 * s + 3]); p.z = pk2(x[8 * s + 4], x[8 * s + 5]); p.w = pk2(x[8 * s + 6], x[8 * s + 7]);
    return __builtin_bit_cast(bf16x8, p);
}
#define MFMA32(a, b, c) __builtin_amdgcn_mfma_f32_32x32x16_bf16((a), (b), (c), 0, 0, 0)
__device__ __forceinline__ float wave_sum(float v) {
#pragma unroll
    for (int o = 1; o < 64; o <<= 1) v += __shfl_xor(v, o);
    return v;
}

namespace pg8 {
struct RowNorm {
    const float* st; const float* cs; const float* bw; float* mr_out;
    PG8_LAS float* T;
    float mu[2][4], rs[2][4]; f32x4 c[2][2], b[2][2];
    __device__ __forceinline__ void load(const Unit& u, int wr, int wc, int fr, int fq, const f32x4 pfa, const f32x4 pfb) {
        if (!st) return;
        const int tid = (wr * 4 + wc) * 64 + fq * 16 + fr;
        if (tid < 256) { const float mean = ((pfa[0] + pfa[2]) + (pfb[0] + pfb[2])) * (1.f / 1024.f), var = ((pfa[1] + pfa[3]) + (pfb[1] + pfb[3])) * (1.f / 1024.f) - mean * mean;
            const f32x2_t mrv = {mean, 1.0f / sqrtf(var + LN_EPS)};
            *(PG8_LAS f32x2_t*)(T + 2 * tid) = mrv;
            if (mr_out && u.pn == 0) *(f32x2_t*)(mr_out + 2 * (unsigned)(u.pm * BM + tid)) = mrv; }
        const int cb = u.pn * BM + wc * 32 + 8 * fq;
#pragma unroll
        for (int bj = 0; bj < 2; ++bj)
#pragma unroll
            for (int n = 0; n < 2; ++n) { c[bj][n] = *(const f32x4*)(cs + cb + bj * HALF + 4 * n); b[bj][n] = *(const f32x4*)(bw + cb + bj * HALF + 4 * n); }
        asm volatile("s_waitcnt lgkmcnt(0)" ::: "memory"); __builtin_amdgcn_s_barrier(); asm volatile("" ::: "memory");
#pragma unroll
        for (int ai = 0; ai < 2; ++ai)
#pragma unroll
            for (int m = 0; m < 4; ++m) { const f32x2_t v = *(const PG8_LAS f32x2_t*)(T + 2 * (ai * HALF + wr * 64 + m * 16 + fr)); mu[ai][m] = v.x; rs[ai][m] = v.y; }
    }
    __device__ __forceinline__ f32x4 apply(const f32x4 a, int ai, int m, int bj, int n) const { return st ? (a - c[bj][n] * mu[ai][m]) * rs[ai][m] + b[bj][n] : a; }
};
#define PG8_PF_MEMBERS mutable f32x4 pfa, pfb; static constexpr bool HAS_PF = true; \
    __device__ __forceinline__ void prefetch(const Unit& u, int tid) const { if (st && tid < 256) { const float* sp = st + 8 * (unsigned)(u.pm * BM + tid); pfa = *(const f32x4*)sp; pfb = *(const f32x4*)(sp + 4); } }
struct EpiQKV {
    static constexpr bool PERM = true, AFTER_DRAIN = false;
    bf16_t* QKV; float* out; int li; const float* st; const float* cs; const float* bw; float* mr_out; PG8_LAS float* T; PG8_PF_MEMBERS
    __device__ __forceinline__ void operator()(const f32x4 (&acc)[2][2][4][2], const Unit& u, int wr, int wc, int fr, int fq) const {
        asm volatile("" : "+v"(fr));
        RowNorm rn; rn.st = st; rn.cs = cs; rn.bw = bw; rn.mr_out = mr_out; rn.T = T; rn.load(u, wr, wc, fr, fq, pfa, pfb);
        float* fdst = nullptr;
        if (u.pn >= 4) {
            const bool isv = u.pn >= 8;
            if (u.pm < 256) { const int b = u.pm >> 3, tt = u.pm & 7; if (tt >= 6) fdst = out + (isv ? O_VP : O_KP) + ((size_t)(li * 32 + b) * 512 + (size_t)(tt - 6) * 256) * 1024; }
            else fdst = out + (isv ? O_VS : O_KS) + ((size_t)li * 2048 + (size_t)(u.pm - 256) * 256) * 1024;
        }
        const int col0 = u.pn * BM + wc * 32 + 8 * fq, colk = (u.pn & 3) * BM + wc * 32 + 8 * fq;
#pragma unroll
        for (int ai = 0; ai < 2; ++ai)
#pragma unroll
            for (int m = 0; m < 4; ++m) { const int rl = ai * HALF + wr * 64 + m * 16 + fr; bf16_t* rowp = QKV + (unsigned)((u.pm * BM + rl) * 3072 + col0);
#pragma unroll
                for (int bj = 0; bj < 2; ++bj) { const f32x4 v0 = rn.apply(acc[ai][bj][m][0], ai, m, bj, 0), v1 = rn.apply(acc[ai][bj][m][1], ai, m, bj, 1);
                    u32x4 w; w.x = pk2(v0[0], v0[1]); w.y = pk2(v0[2], v0[3]); w.z = pk2(v1[0], v1[1]); w.w = pk2(v1[2], v1[3]);
                    *(u32x4*)(rowp + bj * HALF) = w;
                    if (fdst) { float* fp = fdst + (unsigned)(rl * 1024 + colk + bj * HALF); *(f32x4*)fp = v0; *(f32x4*)(fp + 4) = v1; } }
                asm volatile("" ::: "memory"); }
    }
};
struct EpiBf16Plain {
    static constexpr bool PERM = true, AFTER_DRAIN = false;
    bf16_t* O; int ldc; int relu2; const float* st; const float* cs; const float* bw; float* mr_out; PG8_LAS float* T; PG8_PF_MEMBERS
    __device__ __forceinline__ void operator()(const f32x4 (&acc)[2][2][4][2], const Unit& u, int wr, int wc, int fr, int fq) const {
        asm volatile("" : "+v"(fr));
        RowNorm rn; rn.st = st; rn.cs = cs; rn.bw = bw; rn.mr_out = mr_out; rn.T = T; rn.load(u, wr, wc, fr, fq, pfa, pfb);
        const int col0 = u.pn * BM + wc * 32 + 8 * fq;
#pragma unroll
        for (int ai = 0; ai < 2; ++ai)
#pragma unroll
            for (int m = 0; m < 4; ++m) { const int rl = ai * HALF + wr * 64 + m * 16 + fr; bf16_t* rowp = O + (unsigned)((u.pm * BM + rl) * ldc + col0);
#pragma unroll
                for (int bj = 0; bj < 2; ++bj) { f32x4 v0 = rn.apply(acc[ai][bj][m][0], ai, m, bj, 0), v1 = rn.apply(acc[ai][bj][m][1], ai, m, bj, 1);
                    if (relu2) { v0 = __builtin_elementwise_max(v0, (f32x4){0.f, 0.f, 0.f, 0.f}); v1 = __builtin_elementwise_max(v1, (f32x4){0.f, 0.f, 0.f, 0.f}); v0 = v0 * v0; v1 = v1 * v1; }
                    u32x4 w; w.x = pk2(v0[0], v0[1]); w.y = pk2(v0[2], v0[3]); w.z = pk2(v1[0], v1[1]); w.w = pk2(v1[2], v1[3]);
                    *(u32x4*)(rowp + bj * HALF) = w; } }
    }
};
struct EpiSsmIn {
    static constexpr bool PERM = true, AFTER_DRAIN = false;
    bf16_t* P; float* DT; const float* st; const float* cs; const float* bw; float* mr_out; PG8_LAS float* T; PG8_PF_MEMBERS
    __device__ __forceinline__ void operator()(const f32x4 (&acc)[2][2][4][2], const Unit& u, int wr, int wc, int fr, int fq) const {
        asm volatile("" : "+v"(fr));
        RowNorm rn; rn.st = st; rn.cs = cs; rn.bw = bw; rn.mr_out = mr_out; rn.T = T; rn.load(u, wr, wc, fr, fq, pfa, pfb);
        if (u.pn < 24) {
            const int col0 = u.pn * BM + wc * 32 + 8 * fq;
#pragma unroll
            for (int ai = 0; ai < 2; ++ai)
#pragma unroll
                for (int m = 0; m < 4; ++m) { const int rl = ai * HALF + wr * 64 + m * 16 + fr; bf16_t* rowp = P + (unsigned)((u.pm * BM + rl) * LDP + col0);
#pragma unroll
                    for (int bj = 0; bj < 2; ++bj) { const f32x4 v0 = rn.apply(acc[ai][bj][m][0], ai, m, bj, 0), v1 = rn.apply(acc[ai][bj][m][1], ai, m, bj, 1);
                        u32x4 w; w.x = pk2(v0[0], v0[1]); w.y = pk2(v0[2], v0[3]); w.z = pk2(v1[0], v1[1]); w.w = pk2(v1[2], v1[3]);
                        *(u32x4*)(rowp + bj * HALF) = w; }
                    asm volatile("" ::: "memory"); }
        } else if (wc == 0) {
#pragma unroll
            for (int ai = 0; ai < 2; ++ai)
#pragma unroll
                for (int m = 0; m < 4; ++m) { const int rl = ai * HALF + wr * 64 + m * 16 + fr; float* fp = DT + (unsigned)((u.pm * BM + rl) * 32 + 8 * fq);
                    *(f32x4*)fp = rn.apply(acc[ai][0][m][0], ai, m, 0, 0); *(f32x4*)(fp + 4) = rn.apply(acc[ai][0][m][1], ai, m, 0, 1); }
        }
    }
};
struct EpiResid {
    static constexpr bool PERM = true, AFTER_DRAIN = false, HAS_PF = false;
    bf16_t* XB; const float* st_in; const float* gin; const float* bin; float* st_out; PG8_LAS float* P;
    static constexpr int DEPTH = 1;
    __device__ __forceinline__ void operator()(const f32x4 (&acc)[2][2][4][2], const Unit& u, int wr, int wc, int fr, int fq) const {
        asm volatile("" : "+v"(fr));
        const int col0 = u.pn * BM + wc * 32 + 8 * fq;
        const unsigned rowb0 = (unsigned)(u.pm * BM + wr * 64 + fr);
#pragma unroll
        for (int ai = 0; ai < 2; ++ai) {
            u32x4 xv[4][2]; f32x2_t mr[4];
#pragma unroll
            for (int m = 0; m < 4; ++m) { const unsigned row_ = rowb0 + (unsigned)(ai * HALF + m * 16); const bf16_t* rp_ = XB + row_ * D + col0;
                xv[m][0] = *(const u32x4*)rp_; xv[m][1] = *(const u32x4*)(rp_ + HALF);
                if (st_in) mr[m] = *(const f32x2_t*)(st_in + 2 * row_); else mr[m] = (f32x2_t){0.f, 1.f}; }
            asm volatile("" ::: "memory");
#pragma unroll
            for (int m = 0; m < 4; ++m) {
                const unsigned row = rowb0 + (unsigned)(ai * HALF + m * 16);
                bf16_t* rowb = XB + row * D + col0;
                float mean = 0.f, rstd = 1.f;
                if (st_in) { mean = mr[m].x; rstd = mr[m].y; }
                float s1 = 0.f, s2 = 0.f;
#pragma unroll
                for (int bj = 0; bj < 2; ++bj) {
                    const u32x4 xw = xv[m][bj];
                    f32x4 x0 = (f32x4){bflo(xw.x), bfhi(xw.x), bflo(xw.y), bfhi(xw.y)}, x1 = (f32x4){bflo(xw.z), bfhi(xw.z), bflo(xw.w), bfhi(xw.w)};
                    if (st_in) { int c_ = col0 + bj * HALF; asm volatile("" : "+v"(c_));
                        const f32x4 g0 = *(const f32x4*)(gin + c_), g1 = *(const f32x4*)(gin + c_ + 4), b0 = *(const f32x4*)(bin + c_), b1 = *(const f32x4*)(bin + c_ + 4);
                        x0 = (x0 - mean) * rstd * g0 + b0; x1 = (x1 - mean) * rstd * g1 + b1; }
                    const f32x4 v0 = x0 * ALPHA + acc[ai][bj][m][0], v1 = x1 * ALPHA + acc[ai][bj][m][1];
                    u32x4 w; w.x = pk2(v0[0], v0[1]); w.y = pk2(v0[2], v0[3]); w.z = pk2(v1[0], v1[1]); w.w = pk2(v1[2], v1[3]); *(u32x4*)(rowb + bj * HALF) = w;
                    s1 += ((v0[0] + v0[1]) + (v0[2] + v0[3])) + ((v1[0] + v1[1]) + (v1[2] + v1[3]));
                    s2 += ((v0[0] * v0[0] + v0[1] * v0[1]) + (v0[2] * v0[2] + v0[3] * v0[3])) + ((v1[0] * v1[0] + v1[1] * v1[1]) + (v1[2] * v1[2] + v1[3] * v1[3])); }
                s1 += __shfl_xor(s1, 16); s2 += __shfl_xor(s2, 16); s1 += __shfl_xor(s1, 32); s2 += __shfl_xor(s2, 32);
                if (fq == 0) *(PG8_LAS f32x2_t*)(P + ((ai * HALF + wr * 64 + m * 16 + fr) * 4 + wc) * 2) = (f32x2_t){s1, s2};
            }
            asm volatile("" ::: "memory");
        }
        asm volatile("s_waitcnt lgkmcnt(0)" ::: "memory"); __builtin_amdgcn_s_barrier(); asm volatile("" ::: "memory");
        const int tid = (wr * 4 + wc) * 64 + fq * 16 + fr;
        if (tid < 256) { const f32x4 qa = *(const PG8_LAS f32x4*)(P + tid * 8), qb = *(const PG8_LAS f32x4*)(P + tid * 8 + 4);
            *(f32x2_t*)(st_out + 8 * (unsigned)(u.pm * BM + tid) + 2 * u.pn) = (f32x2_t){(qa[0] + qa[2]) + (qb[0] + qb[2]), (qa[1] + qa[3]) + (qb[1] + qb[3])}; }
    }
};
}
#define XB_TMO      128
#define XB_XCNT(j)  (256  + 64 * (j))
#define XB_XSUB(j)  (1280 + 64 * (j))
#define XB_XGEN(j)  (2304 + 64 * (j))
#define XB_TOP      3328
#define XB_TOPGEN   3392
#define XCD_BAR_WORDS 3456
#define XB_SPIN_CAP (1u << 18)

__device__ __forceinline__ unsigned xb_ld(unsigned* p)              { return __hip_atomic_load(p, __ATOMIC_RELAXED, __HIP_MEMORY_SCOPE_AGENT); }
__device__ __forceinline__ unsigned xb_add(unsigned* p, unsigned v) { return __hip_atomic_fetch_add(p, v, __ATOMIC_RELAXED, __HIP_MEMORY_SCOPE_AGENT); }
__device__ __forceinline__ unsigned xb_xcc_id() { return (unsigned)__builtin_amdgcn_s_getreg((3 << 11) | 20) & 0xFu; }
#define XB_SPIN(cond, bar) do { unsigned _sp = 0; while (cond) { __builtin_amdgcn_s_sleep(1); \
    if ((++_sp & 255u) == 0u) { if (xb_ld(&(bar)[XB_TMO])) break; if (_sp > XB_SPIN_CAP) { atomicAdd(&(bar)[XB_TMO], 1u); break; } } } } while (0)

struct XcdBarrier {
    unsigned* bar; unsigned x;
    volatile LAS unsigned* st;
};

__device__ __forceinline__ XcdBarrier xcd_barrier_post(unsigned* bar, volatile LAS unsigned* st) {
    XcdBarrier b; b.bar = bar; b.x = xb_xcc_id(); b.st = st;
    if (threadIdx.x == 0) (void)xb_add(&bar[XB_XCNT(b.x)], 1u);
    return b;
}
__device__ __forceinline__ void xcd_barrier_complete(unsigned* bar, unsigned x, unsigned& nloc, unsigned& nx) {
    const unsigned G = gridDim.x * gridDim.y * gridDim.z;
    unsigned sum, cnt, mine, sp = 0u;
    for (;;) {
        sum = 0u; cnt = 0u; mine = 0u;
#pragma unroll
        for (unsigned j = 0; j < 16; ++j) { const unsigned c = xb_ld(&bar[XB_XCNT(j)]); sum += c; cnt += (c > 0u) ? 1u : 0u; mine = (j == x) ? c : mine; }
        if (sum == G) break;
        __builtin_amdgcn_s_sleep(1);
        if ((++sp & 255u) == 0u) { if (xb_ld(&bar[XB_TMO])) break; if (sp > XB_SPIN_CAP) { atomicAdd(&bar[XB_TMO], 1u); break; } }
    }
    nloc = mine > 0u ? mine : 1u; nx = cnt > 0u ? cnt : 1u;
}

__device__ __forceinline__ void xcd_barrier(const XcdBarrier& b) {
    asm volatile("s_waitcnt vmcnt(0)" ::: "memory");
    __syncthreads();
    if (threadIdx.x == 0) {
        unsigned* bar = b.bar;
        __builtin_amdgcn_s_waitcnt(0);
        unsigned nloc = b.st[0], nx = b.st[1];
        if (nloc == 0u) { xcd_barrier_complete(bar, b.x, nloc, nx); b.st[0] = nloc; b.st[1] = nx; }
        const unsigned old = xb_add(&bar[XB_XSUB(b.x)], 1u);
        const unsigned gen = old / nloc;
        if (old + 1u == (gen + 1u) * nloc) {
            __builtin_amdgcn_fence(__ATOMIC_RELEASE, "agent");
            asm volatile("s_waitcnt vmcnt(0)" ::: "memory");
            const unsigned og = xb_add(&bar[XB_TOP], 1u);
            const unsigned tg = og / nx;
            if (og + 1u == (tg + 1u) * nx) xb_add(&bar[XB_TOPGEN], 1u);
            else XB_SPIN(xb_ld(&bar[XB_TOPGEN]) == tg, bar);
            __builtin_amdgcn_fence(__ATOMIC_ACQUIRE, "agent");
            xb_add(&bar[XB_XGEN(b.x)], 1u);
            asm volatile("s_waitcnt vmcnt(0)" ::: "memory");
        } else {
            XB_SPIN(xb_ld(&bar[XB_XGEN(b.x)]) == gen, bar);
            __builtin_amdgcn_fence(__ATOMIC_ACQUIRE, "agent");
            asm volatile("s_waitcnt vmcnt(0)" ::: "memory");
        }
    }
    __syncthreads();
}

struct Args { const float* in[25]; int ph_lo, ph_hi; };
#define AIN(k) (a.in[(k) + z])
struct Frame { unsigned char* lds; int tid, lane, wave, G, bid; };

__device__ __forceinline__ void transpose_item(const float* W, int K, int N, bf16* WT, float* scr, int item, int lane) {
    const int nblk = N / 32, kb = item / nblk, nb = item % nblk, k0 = 64 * kb, n0 = 32 * nb;
#pragma unroll 8
    for (int i = 0; i < 32; ++i) { const int kk = 2 * i + (lane >> 5); scr[kk * 33 + (lane & 31)] = W[(size_t)(k0 + kk) * N + n0 + (lane & 31)]; }
    asm volatile("s_waitcnt lgkmcnt(0)" ::: "memory");
    const int c = lane & 7;
#pragma unroll
    for (int j = 0; j < 4; ++j) { const int n = (lane >> 3) + 8 * j; const float* s = scr + (8 * c) * 33 + n;
        u32x4 o; o.x = pk2(s[0 * 33], s[1 * 33]); o.y = pk2(s[2 * 33], s[3 * 33]); o.z = pk2(s[4 * 33], s[5 * 33]); o.w = pk2(s[6 * 33], s[7 * 33]);
        *(u32x4*)(WT + (size_t)(n0 + n) * K + k0 + 8 * c) = o; }
    asm volatile("s_waitcnt lgkmcnt(0)" ::: "memory");
}
__device__ __forceinline__ void transpose_fold_item(const float* W, int K, int N, bf16* WT, const float* g, const float* b, float* cs, float* bw, float* scr, int nb, int lane) {
    const int n0 = 32 * nb; float csp = 0.f, bwp = 0.f;
    for (int k0 = 0; k0 < K; k0 += 64) {
#pragma unroll 8
        for (int i = 0; i < 32; ++i) { const int kk = 2 * i + (lane >> 5); const float w = W[(size_t)(k0 + kk) * N + n0 + (lane & 31)];
            const float wg = w * g[k0 + kk]; const float wr = bflo(pk2(wg, 0.f) & 0xffffu); scr[kk * 33 + (lane & 31)] = wr; csp += wr; bwp += w * b[k0 + kk]; }
        asm volatile("s_waitcnt lgkmcnt(0)" ::: "memory");
        const int c = lane & 7;
#pragma unroll
        for (int j = 0; j < 4; ++j) { const int n = (lane >> 3) + 8 * j; const float* s = scr + (8 * c) * 33 + n;
            u32x4 o; o.x = pk2(s[0 * 33], s[1 * 33]); o.y = pk2(s[2 * 33], s[3 * 33]); o.z = pk2(s[4 * 33], s[5 * 33]); o.w = pk2(s[6 * 33], s[7 * 33]);
            *(u32x4*)(WT + (size_t)(n0 + n) * K + k0 + 8 * c) = o; }
        asm volatile("s_waitcnt lgkmcnt(0)" ::: "memory");
    }
    csp += __shfl_xor(csp, 32); bwp += __shfl_xor(bwp, 32);
    if (lane < 32) { cs[n0 + lane] = csp; bw[n0 + lane] = bwp; }
}
__device__ __forceinline__ void cvt_stream(const float* src, bf16* dst, size_t n, size_t gtid, size_t gthreads) {
    for (size_t i = gtid * 8; i < n; i += gthreads * 8) { const f32x4 a = *(const f32x4*)(src + i), b = *(const f32x4*)(src + i + 4);
        u32x4 o; o.x = pk2(a[0], a[1]); o.y = pk2(a[2], a[3]); o.z = pk2(b[0], b[1]); o.w = pk2(b[2], b[3]); *(u32x4*)(dst + i) = o; }
}
__device__ __forceinline__ void convert_phase(const Frame& F, const Args& a, int z, int L) {
    unsigned char* ws = (unsigned char*)AIN(24); float* outp = (float*)AIN(23); const int li = L >> 1; const bool ssm = (L & 1);
    float* scr = (float*)(F.lds + F.wave * 16384);
    const int gw = F.bid * 8 + F.wave, NGW = F.G * 8;
    const float* Wa = ssm ? AIN(9) + (size_t)li * D * NPROJ : AIN(6) + (size_t)li * D * 3072; const int Na = ssm ? NPROJ : 3072;
    const float* Wb = ssm ? AIN(16) + (size_t)li * 2048 * D : AIN(8) + (size_t)li * D * D; const int Kb = ssm ? 2048 : D;
    const float* Wu = AIN(19) + (size_t)L * D * DFF; const float* Wd = AIN(20) + (size_t)L * DFF * D;
    const bool foldA = (L > 0);
    const float* gA = AIN(21) + (L - 1) * D; const float* bA = AIN(22) + (L - 1) * D;
    const float* gU = AIN(17) + L * D; const float* bU = AIN(18) + L * D;
    const int Ia = foldA ? Na / 32 : (D / 64) * (Na / 32), Ib = (Kb / 64) * (D / 32), Iu = DFF / 32, Id = (DFF / 64) * (D / 32);
    const int NIT = Ia + Ib + Iu + Id;
    for (int it = gw; it < NIT; it += NGW) {
        int r = it;
        if (r < Iu) { transpose_fold_item(Wu, D, DFF, (bf16*)(ws + WS_WUP), gU, bU, (float*)(ws + WS_CSU), (float*)(ws + WS_BWU), scr, r, F.lane); continue; } r -= Iu;
        if (r < Ia) { if (foldA) transpose_fold_item(Wa, D, Na, (bf16*)(ws + WS_WA), gA, bA, (float*)(ws + WS_CSA), (float*)(ws + WS_BWA), scr, r, F.lane);
                      else transpose_item(Wa, D, Na, (bf16*)(ws + WS_WA), scr, r, F.lane); continue; } r -= Ia;
        if (r < Ib) { transpose_item(Wb, Kb, D, (bf16*)(ws + WS_WB), scr, r, F.lane); continue; } r -= Ib;
        transpose_item(Wd, DFF, D, (bf16*)(ws + WS_WDN), scr, r, F.lane);
    }
    const size_t gtid = (size_t)F.bid * 512 + F.tid, gth = (size_t)F.G * 512;
    if (!ssm) {
        cvt_stream(AIN(2) + (size_t)li * 32 * 512 * 1024, (bf16*)(ws + WS_CK), (size_t)32 * 512 * 1024, gtid, gth);
        cvt_stream(AIN(3) + (size_t)li * 32 * 512 * 1024, (bf16*)(ws + WS_CV), (size_t)32 * 512 * 1024, gtid, gth);
    }
    if (L == 0) {
        const size_t n = (size_t)M * D, np = (size_t)MP * D;
        bf16* XB = (bf16*)(ws + WS_XB);
        for (size_t i = gtid * 8; i < n; i += gth * 8) { const float* src = i < np ? AIN(0) + i : AIN(1) + (i - np);
            const f32x4 x0 = *(const f32x4*)src, x1 = *(const f32x4*)(src + 4);
            u32x4 o; o.x = pk2(x0[0], x0[1]); o.y = pk2(x0[2], x0[3]); o.z = pk2(x1[0], x1[1]); o.w = pk2(x1[2], x1[3]); *(u32x4*)(XB + i) = o; }
    }
}
__device__ __forceinline__ void ln_phase(const Frame& F, float* X, const bf16* XB, const float* g, const float* b) {
    const int gw = F.bid * 8 + F.wave, NGW = F.G * 8;
    f32x4 gv[4], bv[4];
#pragma unroll
    for (int j = 0; j < 4; ++j) { gv[j] = *(const f32x4*)(g + 4 * F.lane + 256 * j); bv[j] = *(const f32x4*)(b + 4 * F.lane + 256 * j); }
    for (int m = gw; m < M; m += NGW) {
        f32x4* xr = (f32x4*)(X + (size_t)m * D) + F.lane;
        const u32x2* xb = (const u32x2*)(XB + (size_t)m * D) + F.lane;
        f32x4 v[4]; float s = 0.f;
#pragma unroll
        for (int j = 0; j < 4; ++j) { const u32x2 w = xb[64 * j]; v[j] = (f32x4){bflo(w.x), bfhi(w.x), bflo(w.y), bfhi(w.y)}; s += (v[j][0] + v[j][1]) + (v[j][2] + v[j][3]); }
        const float mean = wave_sum(s) * (1.f / D); float s2 = 0.f;
#pragma unroll
        for (int j = 0; j < 4; ++j) { v[j] = v[j] - mean; s2 += (v[j][0] * v[j][0] + v[j][1] * v[j][1]) + (v[j][2] * v[j][2] + v[j][3] * v[j][3]); }
        const float rstd = 1.f / sqrtf(wave_sum(s2) * (1.f / D) + LN_EPS);
#pragma unroll
        for (int j = 0; j < 4; ++j) xr[64 * j] = v[j] * rstd * gv[j] + bv[j];
    }
}

__device__ __forceinline__ void attn_phase(const Frame& F, const float* relb, const bf16* QKV, const bf16* CK, const bf16* CV, bf16* O) {
    float* tbl = (float*)F.lds;
    for (int i = F.tid; i < 16 * 513; i += 512) tbl[i] = relb[i] * LOG2E;
    __syncthreads();
    unsigned char* vt = F.lds + 36864 + F.wave * 9216;
    const int lane = F.lane, l31 = lane & 31, hh = lane >> 5;
    const int i16 = lane & 15, q4 = i16 >> 2, p4 = i16 & 3, dblk = (lane >> 4) & 1;
    const int gw = F.bid * 8 + F.wave, NGW = F.G * 8;
    constexpr int NITEM = (32 * 32 + 32) * 32;
    constexpr float C2 = 0.125f * LOG2E;
    for (int it = gw; it < NITEM; it += NGW) {
        const bool smp = it >= 32768;
        const int r = smp ? it - 32768 : it;
        const int qh = r & 1, h = (r >> 1) & 15, c = smp ? 0 : (r >> 5) & 31, b = smp ? (r >> 5) : (r >> 10);
        const size_t qrow0 = smp ? (size_t)MP + b * 64 + 32 * qh : (size_t)b * 2048 + 64 * c + 32 * qh;
        bf16x8 qf[4];
#pragma unroll
        for (int ks = 0; ks < 4; ++ks) qf[ks] = *(const bf16x8*)(QKV + (qrow0 + l31) * 3072 + h * 64 + 16 * ks + 8 * hh);
        f32x16 o0, o1;
#pragma unroll
        for (int i = 0; i < 16; ++i) { o0[i] = 0.f; o1[i] = 0.f; }
        float mrun = -1e30f, lsum = 0.f;
        const float* tb = tbl + h * 513;
        const float cbias = tb[512];
        const int jb0 = smp ? 0 : (c >= 8 ? 0 : 8 - c);
#define ATT_SRC(jb_, Kp_, Vp_, pitch_) do { \
            if (!smp) { Kp_ = QKV + ((size_t)b * 2048 + 64 * (c - 8 + (jb_))) * 3072 + 1024 + h * 64; Vp_ = Kp_ + 1024; pitch_ = 3072; } \
            else if ((jb_) < 8) { Kp_ = CK + ((size_t)b * 512 + 64 * (jb_)) * 1024 + h * 64; Vp_ = CV + ((size_t)b * 512 + 64 * (jb_)) * 1024 + h * 64; pitch_ = 1024; } \
            else { Kp_ = QKV + ((size_t)MP + b * 64) * 3072 + 1024 + h * 64; Vp_ = Kp_ + 1024; pitch_ = 3072; } } while (0)
#define ATT_LOAD(kf_, vr_, jb_) do { const bf16 *Kp_, *Vp_; int pitch_; ATT_SRC(jb_, Kp_, Vp_, pitch_); \
            _Pragma("unroll") for (int rb = 0; rb < 2; ++rb) _Pragma("unroll") for (int ks = 0; ks < 4; ++ks) kf_[rb][ks] = *(const bf16x8*)(Kp_ + (size_t)(32 * rb + l31) * pitch_ + 16 * ks + 8 * hh); \
            _Pragma("unroll") for (int i = 0; i < 8; ++i) vr_[i] = *(const bf16x8*)(Vp_ + (size_t)(8 * i + (lane >> 3)) * pitch_ + 8 * (lane & 7)); } while (0)
        bf16x8 kf[2][4], vr[8], kn[2][4], vn[8];
        ATT_LOAD(kf, vr, jb0);
        for (int jb = jb0; jb <= 8; ++jb) {
            if (jb < 8) ATT_LOAD(kn, vn, jb + 1);
            asm volatile("" ::: "memory");
#pragma unroll
            for (int i = 0; i < 8; ++i) *(bf16x8*)(vt + ((8 * i + (lane >> 3)) * 72 + 8 * (lane & 7)) * 2) = vr[i];
            asm volatile("" ::: "memory");
            f32x16 s0, s1;
#pragma unroll
            for (int i = 0; i < 16; ++i) { s0[i] = 0.f; s1[i] = 0.f; }
#pragma unroll
            for (int ks = 0; ks < 4; ++ks) { s0 = MFMA32(kf[0][ks], qf[ks], s0); s1 = MFMA32(kf[1][ks], qf[ks], s1); }
            if (jb <= 3) {
#pragma unroll
                for (int i = 0; i < 16; ++i) { s0[i] = s0[i] * C2 + cbias; s1[i] = s1[i] * C2 + cbias; }
            } else {
                const int dbase = 64 * (8 - jb) + 32 * qh + l31 + 256;
#pragma unroll
                for (int i = 0; i < 16; ++i) { const int k0 = crow(i, hh); int i0 = dbase - k0, i1 = dbase - k0 - 32; i0 = i0 > 512 ? 512 : i0; i1 = i1 > 512 ? 512 : i1;
                    s0[i] = s0[i] * C2 + tb[i0]; s1[i] = s1[i] * C2 + tb[i1]; }
            }
            float mx = s0[0];
#pragma unroll
            for (int i = 1; i < 16; ++i) mx = fmaxf(mx, s0[i]);
#pragma unroll
            for (int i = 0; i < 16; ++i) mx = fmaxf(mx, s1[i]);
            mx = fmaxf(mx, __shfl_xor(mx, 32));
            const float mnew = fmaxf(mrun, mx), alpha = fexp2(mrun - mnew);
            mrun = mnew;
            float ps = 0.f;
#pragma unroll
            for (int i = 0; i < 16; ++i) { s0[i] = fexp2(s0[i] - mnew); s1[i] = fexp2(s1[i] - mnew); ps += s0[i] + s1[i]; }
            lsum = lsum * alpha + ps;
#pragma unroll
            for (int i = 0; i < 16; ++i) { o0[i] *= alpha; o1[i] *= alpha; }
#pragma unroll
            for (int rb = 0; rb < 2; ++rb)
#pragma unroll
                for (int s2 = 0; s2 < 2; ++s2) {
                    const bf16x8 pf = pack8(rb ? s1 : s0, s2);
                    const int k0 = 32 * rb + 16 * s2 + 4 * hh + q4;
#pragma unroll
                    for (int db = 0; db < 2; ++db) {
                        const int cb = 32 * db + 16 * dblk + 4 * p4;
                        const s16x4 lo = __builtin_amdgcn_ds_read_tr16_b64_v4i16((LAS s16x4*)(vt + (k0 * 72 + cb) * 2));
                        const s16x4 hi = __builtin_amdgcn_ds_read_tr16_b64_v4i16((LAS s16x4*)(vt + ((k0 + 8) * 72 + cb) * 2));
                        const bf16x8 va = __builtin_shufflevector(lo, hi, 0, 1, 2, 3, 4, 5, 6, 7);
                        if (db == 0) o0 = MFMA32(va, pf, o0); else o1 = MFMA32(va, pf, o1);
                    }
                }
            asm volatile("" ::: "memory");
#pragma unroll
            for (int rb = 0; rb < 2; ++rb)
#pragma unroll
                for (int ks = 0; ks < 4; ++ks) kf[rb][ks] = kn[rb][ks];
#pragma unroll
            for (int i = 0; i < 8; ++i) vr[i] = vn[i];
        }
#undef ATT_LOAD
#undef ATT_SRC
        const float inv = 1.0f / (lsum + __shfl_xor(lsum, 32));
        bf16* orow = O + (qrow0 + l31) * D + h * 64 + 4 * hh;
#pragma unroll
        for (int i4 = 0; i4 < 4; ++i4) {
            u32x2 w0; w0.x = pk2(o0[4 * i4] * inv, o0[4 * i4 + 1] * inv); w0.y = pk2(o0[4 * i4 + 2] * inv, o0[4 * i4 + 3] * inv); *(u32x2*)(orow + 8 * i4) = w0;
            u32x2 w1; w1.x = pk2(o1[4 * i4] * inv, o1[4 * i4 + 1] * inv); w1.y = pk2(o1[4 * i4 + 2] * inv, o1[4 * i4 + 3] * inv); *(u32x2*)(orow + 32 + 8 * i4) = w1;
        }
    }
}
constexpr int SX_XT = 0, SX_XWT = 36864, SX_BT = 73728, SX_BS = 92160, SX_CS = 109568, SX_DT = 126976, SX_CUM = SX_DT + 1024, SX_WIN = SX_DT + 2048, SX_PART = SX_DT + 3072;
__device__ __forceinline__ void ssd_phase(const Frame& F, const Args& a, int z, int li, bf16* PROJ, const float* DT, bf16* dryXB) {
    float* outp = (float*)AIN(23);
    unsigned char* lds = F.lds;
    bf16* Xt = (bf16*)(lds + SX_XT); bf16* Xwt = (bf16*)(lds + SX_XWT); bf16* Bt = (bf16*)(lds + SX_BT); bf16* Bs = (bf16*)(lds + SX_BS); bf16* Cs = (bf16*)(lds + SX_CS);
    float* dts = (float*)(lds + SX_DT); float* cums = (float*)(lds + SX_CUM); float* wins = (float*)(lds + SX_WIN); float* part = (float*)(lds + SX_PART);
    const int tid = F.tid, lane = F.lane, wave = F.wave, l31 = lane & 31, hh = lane >> 5;
    const int r = wave >> 1, half = wave & 1;
    const float* conv_w = AIN(10) + (size_t)li * 4 * 4096; const float* conv_b = AIN(11) + (size_t)li * 4096;
    const float* dt_bias = AIN(12) + li * 32; const float* a_log = AIN(13) + li * 32; const float* d_skip = AIN(14) + li * 32; const float* norm_w = AIN(15) + (size_t)li * 2048;
    for (int item = F.bid; item < 512; item += F.G) {
        const bool smp = item >= 256; const int bg = item & 255, b = bg >> 3, g = bg & 7;
        const size_t row0 = smp ? (size_t)MP + b * 64 : (size_t)b * 2048; const int nchunks = smp ? 1 : 32;
        const int hglob = g * 4 + r;
        const float Dr = d_skip[hglob];
        f32x16 hT[4];
        const size_t hoff = (((size_t)(li * 32 + b) * 32 + hglob) * 64 + 32 * half + l31) * 128 + 4 * hh;
        if (smp) { const float* hs = AIN(4) + hoff;
#pragma unroll
            for (int nb = 0; nb < 4; ++nb)
#pragma unroll
                for (int i4 = 0; i4 < 4; ++i4) { const f32x4 v = *(const f32x4*)(hs + 32 * nb + 8 * i4); hT[nb][4 * i4] = v[0]; hT[nb][4 * i4 + 1] = v[1]; hT[nb][4 * i4 + 2] = v[2]; hT[nb][4 * i4 + 3] = v[3]; }
        } else {
#pragma unroll
            for (int nb = 0; nb < 4; ++nb)
#pragma unroll
                for (int i = 0; i < 16; ++i) hT[nb][i] = 0.f;
        }
        float dt_pf = (tid < 256) ? DT[(row0 + lane) * 32 + g * 4 + wave] : 0.f;
#pragma unroll 1
        for (int c = 0; c < nchunks; ++c) {
            const size_t rowc = row0 + 64 * c;
            int lane_ = F.lane; asm volatile("" : "+v"(lane_));
            const int lane = lane_, l31 = lane & 31, hh = lane >> 5, tid = wave * 64 + lane;
            const int role = lane < 32 ? 0 : (lane < 48 ? 1 : 2);
            const int chbase = role == 0 ? g * 256 + 8 * lane : (role == 1 ? 2048 + g * 128 + 8 * (lane - 32) : 3072 + g * 128 + 8 * (lane - 48));
            if (tid < 256) {
                const int hr = g * 4 + wave;
                const float raw = dt_pf + dt_bias[hr];
                if (c + 1 < nchunks) dt_pf = DT[(rowc + 64 + lane) * 32 + hr];
                const float dt = raw > 20.f ? raw : log1pf(__expf(raw));
                const float am = -__expf(a_log[hr]) * LOG2E;
                float v = dt * am;
#pragma unroll
                for (int o = 1; o < 64; o <<= 1) { const float n = __shfl_up(v, o); if (lane >= o) v += n; }
                const float last = __shfl(v, 63);
                dts[wave * 64 + lane] = dt; cums[wave * 64 + lane] = v; wins[wave * 64 + lane] = fexp2(last - v) * dt;
            }
            __syncthreads();
            {
                const bf16* src = PROJ + 2048 + chbase;
                u32x4 raw[11];
#pragma unroll
                for (int i = 0; i < 11; ++i) {
                    const int rr = 8 * wave - 3 + i;
                    if (rr >= 0 || c > 0) raw[i] = *(const u32x4*)(src + (size_t)((long)rowc + rr) * LDP);
                    else if (!smp) raw[i] = (u32x4){0u, 0u, 0u, 0u};
                    else { const float* sc = AIN(5) + ((size_t)(li * 32 + b) * 3 + (3 + rr)) * 4096 + chbase; const f32x4 s0 = *(const f32x4*)sc, s1 = *(const f32x4*)(sc + 4);
                        raw[i] = (u32x4){pk2(s0[0], s0[1]), pk2(s0[2], s0[3]), pk2(s1[0], s1[1]), pk2(s1[2], s1[3])}; }
                }
                if (c == nchunks - 1 && wave == 7) {
                    float* co = outp + (smp ? O_CS : O_CP) + ((size_t)(li * 32 + b) * 3) * 4096 + chbase;
#pragma unroll
                    for (int k = 0; k < 3; ++k) { const u32x4 rw = raw[8 + k];
                        *(f32x4*)(co + k * 4096) = (f32x4){bflo(rw.x), bfhi(rw.x), bflo(rw.y), bfhi(rw.y)}; *(f32x4*)(co + k * 4096 + 4) = (f32x4){bflo(rw.z), bfhi(rw.z), bflo(rw.w), bfhi(rw.w)}; }
                }
                float win8[8];
                { const float* wp = wins + (lane < 32 ? (lane >> 3) : 0) * 64 + 8 * wave;
                  const f32x4 wa = *(const f32x4*)wp, wb = *(const f32x4*)(wp + 4);
                  win8[0] = wa[0]; win8[1] = wa[1]; win8[2] = wa[2]; win8[3] = wa[3]; win8[4] = wb[0]; win8[5] = wb[1]; win8[6] = wb[2]; win8[7] = wb[3]; }
#pragma unroll
                for (int hb = 0; hb < 2; ++hb) {
                    f32x4 wv[4], bvv;
#pragma unroll
                    for (int k = 0; k < 4; ++k) wv[k] = *(const f32x4*)(conv_w + k * 4096 + chbase + 4 * hb);
                    bvv = *(const f32x4*)(conv_b + chbase + 4 * hb);
                    unsigned pc[4][4];
#pragma unroll
                    for (int e4 = 0; e4 < 4; ++e4) {
                        const int e = 4 * hb + e4;
                        float xv[11];
#pragma unroll
                        for (int i = 0; i < 11; ++i) { const unsigned wd = raw[i][e >> 1]; xv[i] = (e & 1) ? bfhi(wd) : bflo(wd); }
                        const float w0 = wv[0][e4], w1 = wv[1][e4], w2 = wv[2][e4], w3 = wv[3][e4], bb = bvv[e4];
                        float o[8];
#pragma unroll
                        for (int j = 0; j < 8; ++j) o[j] = silu_f(bb + w0 * xv[j] + w1 * xv[j + 1] + w2 * xv[j + 2] + w3 * xv[j + 3]);
#pragma unroll
                        for (int j2 = 0; j2 < 4; ++j2) pc[e4][j2] = pk2(o[2 * j2], o[2 * j2 + 1]);
                        if (role == 0) {
                            *(u32x4*)(Xt + (8 * lane + e) * 72 + 8 * wave) = (u32x4){pc[e4][0], pc[e4][1], pc[e4][2], pc[e4][3]};
                            *(u32x4*)(Xwt + (8 * lane + e) * 72 + 8 * wave) = (u32x4){pk2(o[0] * win8[0], o[1] * win8[1]), pk2(o[2] * win8[2], o[3] * win8[3]), pk2(o[4] * win8[4], o[5] * win8[5]), pk2(o[6] * win8[6], o[7] * win8[7])};
                        } else if (role == 1) {
                            *(u32x4*)(Bt + (8 * (lane - 32) + e) * 72 + 8 * wave) = (u32x4){pc[e4][0], pc[e4][1], pc[e4][2], pc[e4][3]};
                        }
                    }
                    if (role != 0) {
                        bf16* dst = (role == 1 ? Bs + 8 * (lane - 32) : Cs + 8 * (lane - 48)) + (8 * wave) * 136 + 4 * hb;
#pragma unroll
                        for (int j2 = 0; j2 < 4; ++j2) {
                            u32x2 lo, hi;
                            lo.x = __builtin_amdgcn_perm(pc[1][j2], pc[0][j2], 0x05040100u); hi.x = __builtin_amdgcn_perm(pc[1][j2], pc[0][j2], 0x07060302u);
                            lo.y = __builtin_amdgcn_perm(pc[3][j2], pc[2][j2], 0x05040100u); hi.y = __builtin_amdgcn_perm(pc[3][j2], pc[2][j2], 0x07060302u);
                            *(u32x2*)(dst + (2 * j2) * 136) = lo; *(u32x2*)(dst + (2 * j2 + 1) * 136) = hi;
                        }
                    }
                }
            }
            __syncthreads();
            bf16* zr0 = PROJ + (rowc + l31) * LDP + g * 256 + 64 * r + 32 * half + 4 * hh; bf16* zr1 = zr0 + (size_t)32 * LDP;
            u32x2 zp0[4], zp1[4];
#pragma unroll
            for (int i4 = 0; i4 < 4; ++i4) { zp0[i4] = *(const u32x2*)(zr0 + 8 * i4); zp1[i4] = *(const u32x2*)(zr1 + 8 * i4); }
            f32x16 cb00, cb01, cb11;
#pragma unroll
            for (int i = 0; i < 16; ++i) { cb00[i] = 0.f; cb01[i] = 0.f; cb11[i] = 0.f; }
#pragma unroll
            for (int ns = 0; ns < 8; ++ns) {
                const bf16x8 a0 = *(const bf16x8*)(Bs + l31 * 136 + 16 * ns + 8 * hh), a1 = *(const bf16x8*)(Bs + (32 + l31) * 136 + 16 * ns + 8 * hh);
                const bf16x8 c0 = *(const bf16x8*)(Cs + l31 * 136 + 16 * ns + 8 * hh), c1 = *(const bf16x8*)(Cs + (32 + l31) * 136 + 16 * ns + 8 * hh);
                cb00 = MFMA32(a0, c0, cb00); cb01 = MFMA32(a0, c1, cb01); cb11 = MFMA32(a1, c1, cb11);
            }
            const float* cumr = cums + r * 64; const float* dtr = dts + r * 64;
            const float cum_t0 = cumr[l31], cum_t1 = cumr[32 + l31];
#pragma unroll
            for (int i4 = 0; i4 < 4; ++i4) {
                const f32x4 cs0 = *(const f32x4*)(cumr + 8 * i4 + 4 * hh), cs1 = *(const f32x4*)(cumr + 32 + 8 * i4 + 4 * hh);
                const f32x4 ds0 = *(const f32x4*)(dtr + 8 * i4 + 4 * hh), ds1 = *(const f32x4*)(dtr + 32 + 8 * i4 + 4 * hh);
#pragma unroll
                for (int j = 0; j < 4; ++j) { const int i = 4 * i4 + j, s = 8 * i4 + 4 * hh + j;
                    float v00 = cb00[i] * fexp2(fminf(cum_t0 - cs0[j], 0.f)) * ds0[j]; v00 = (s <= l31) ? v00 : 0.f; v00 += (s == l31) ? Dr : 0.f; cb00[i] = v00;
                    cb01[i] = cb01[i] * fexp2(fminf(cum_t1 - cs0[j], 0.f)) * ds0[j];
                    float v11 = cb11[i] * fexp2(fminf(cum_t1 - cs1[j], 0.f)) * ds1[j]; v11 = (s <= l31) ? v11 : 0.f; v11 += (s == l31) ? Dr : 0.f; cb11[i] = v11; }
            }
            f32x16 y0, y1;
#pragma unroll
            for (int i = 0; i < 16; ++i) { y0[i] = 0.f; y1[i] = 0.f; }
#pragma unroll
            for (int nb = 0; nb < 4; ++nb)
#pragma unroll
                for (int s2 = 0; s2 < 2; ++s2) {
                    const bf16x8 ha = pack8(hT[nb], s2);
                    const int n0 = 32 * nb + 16 * s2 + 4 * hh;
                    const s16x4 c0l = *(const s16x4*)(Cs + l31 * 136 + n0), c0h = *(const s16x4*)(Cs + l31 * 136 + n0 + 8);
                    const s16x4 c1l = *(const s16x4*)(Cs + (32 + l31) * 136 + n0), c1h = *(const s16x4*)(Cs + (32 + l31) * 136 + n0 + 8);
                    y0 = MFMA32(ha, __builtin_shufflevector(c0l, c0h, 0, 1, 2, 3, 4, 5, 6, 7), y0);
                    y1 = MFMA32(ha, __builtin_shufflevector(c1l, c1h, 0, 1, 2, 3, 4, 5, 6, 7), y1);
                }
            { const float e0 = fexp2(cum_t0), e1 = fexp2(cum_t1);
#pragma unroll
              for (int i = 0; i < 16; ++i) { y0[i] *= e0; y1[i] *= e1; } }
            { const bf16* xrow = Xt + (64 * r + 32 * half + l31) * 72;
#pragma unroll
              for (int s2 = 0; s2 < 2; ++s2) {
                  const s16x4 x0l = *(const s16x4*)(xrow + 16 * s2 + 4 * hh), x0h = *(const s16x4*)(xrow + 16 * s2 + 4 * hh + 8);
                  const s16x4 x1l = *(const s16x4*)(xrow + 32 + 16 * s2 + 4 * hh), x1h = *(const s16x4*)(xrow + 32 + 16 * s2 + 4 * hh + 8);
                  const bf16x8 xa0 = __builtin_shufflevector(x0l, x0h, 0, 1, 2, 3, 4, 5, 6, 7), xa1 = __builtin_shufflevector(x1l, x1h, 0, 1, 2, 3, 4, 5, 6, 7);
                  y0 = MFMA32(xa0, pack8(cb00, s2), y0);
                  y1 = MFMA32(xa0, pack8(cb01, s2), y1);
                  y1 = MFMA32(xa1, pack8(cb11, s2), y1);
              } }
            {
                float ss0 = 0.f, ss1 = 0.f;
#pragma unroll
                for (int i4 = 0; i4 < 4; ++i4) {
                    const u32x2 z0 = zp0[i4], z1 = zp1[i4];
                    const float za[4] = {bflo(z0.x), bfhi(z0.x), bflo(z0.y), bfhi(z0.y)}, zb[4] = {bflo(z1.x), bfhi(z1.x), bflo(z1.y), bfhi(z1.y)};
#pragma unroll
                    for (int j = 0; j < 4; ++j) { const float v0 = y0[4 * i4 + j] * silu_f(za[j]), v1 = y1[4 * i4 + j] * silu_f(zb[j]); y0[4 * i4 + j] = v0; y1[4 * i4 + j] = v1; ss0 += v0 * v0; ss1 += v1 * v1; }
                }
                ss0 += __shfl_xor(ss0, 32); ss1 += __shfl_xor(ss1, 32);
                if (hh == 0) { part[l31 * 8 + wave] = ss0; part[(32 + l31) * 8 + wave] = ss1; }
                __syncthreads();
                const f32x4 pa = *(const f32x4*)(part + l31 * 8), pb = *(const f32x4*)(part + l31 * 8 + 4), pc = *(const f32x4*)(part + (32 + l31) * 8), pd = *(const f32x4*)(part + (32 + l31) * 8 + 4);
                const float t0 = ((pa[0] + pa[1]) + (pa[2] + pa[3])) + ((pb[0] + pb[1]) + (pb[2] + pb[3])), t1 = ((pc[0] + pc[1]) + (pc[2] + pc[3])) + ((pd[0] + pd[1]) + (pd[2] + pd[3]));
                const float r0 = 1.0f / sqrtf(t0 * (1.f / 256.f) + RMS_EPS), r1 = 1.0f / sqrtf(t1 * (1.f / 256.f) + RMS_EPS);
                const float* nwp = norm_w + g * 256 + 64 * r + 32 * half + 4 * hh;
#pragma unroll
                for (int i4 = 0; i4 < 4; ++i4) { const f32x4 nw = *(const f32x4*)(nwp + 8 * i4);
                    u32x2 w0; w0.x = pk2(y0[4 * i4] * r0 * nw[0], y0[4 * i4 + 1] * r0 * nw[1]); w0.y = pk2(y0[4 * i4 + 2] * r0 * nw[2], y0[4 * i4 + 3] * r0 * nw[3]); if (!dryXB) *(u32x2*)(zr0 + 8 * i4) = w0; else if (g < 4) *(u32x2*)(dryXB + (rowc + l31) * 1024 + g * 256 + 64 * r + 32 * half + 4 * hh + 8 * i4) = w0;
                    u32x2 w1; w1.x = pk2(y1[4 * i4] * r1 * nw[0], y1[4 * i4 + 1] * r1 * nw[1]); w1.y = pk2(y1[4 * i4 + 2] * r1 * nw[2], y1[4 * i4 + 3] * r1 * nw[3]); if (!dryXB) *(u32x2*)(zr1 + 8 * i4) = w1; else if (g < 4) *(u32x2*)(dryXB + (rowc + 32 + l31) * 1024 + g * 256 + 64 * r + 32 * half + 4 * hh + 8 * i4) = w1; }
            }
            { const float dec = fexp2(cumr[63]);
#pragma unroll
              for (int nb = 0; nb < 4; ++nb)
#pragma unroll
                  for (int i = 0; i < 16; ++i) hT[nb][i] *= dec;
              const bf16* xw = Xwt + (64 * r + 32 * half + l31) * 72 + 8 * hh;
#pragma unroll
              for (int ss = 0; ss < 4; ++ss) { const bf16x8 bx = *(const bf16x8*)(xw + 16 * ss);
#pragma unroll
                  for (int nb = 0; nb < 4; ++nb) { const bf16x8 af = *(const bf16x8*)(Bt + (32 * nb + l31) * 72 + 16 * ss + 8 * hh); hT[nb] = MFMA32(af, bx, hT[nb]); } }
            }
            __syncthreads();
        }
        { float* ho = outp + (smp ? O_HS : O_HP) + hoff;
#pragma unroll
          for (int nb = 0; nb < 4; ++nb)
#pragma unroll
              for (int i4 = 0; i4 < 4; ++i4) *(f32x4*)(ho + 32 * nb + 8 * i4) = (f32x4){hT[nb][4 * i4], hT[nb][4 * i4 + 1], hT[nb][4 * i4 + 2], hT[nb][4 * i4 + 3]};
          }
    }
}
__global__ void __launch_bounds__(512, 2) fwd_megakernel(Args a) {
    extern __shared__ __attribute__((aligned(16))) unsigned char lds[];
    cg::grid_group grid = cg::this_grid();
    Frame F; F.lds = lds; F.tid = threadIdx.x; F.lane = F.tid & 63; F.wave = __builtin_amdgcn_readfirstlane(F.tid >> 6); F.G = gridDim.x; F.bid = blockIdx.x;
    PG8_LAS unsigned char* glds = (PG8_LAS unsigned char*)lds;
    {
        int z = 0; asm volatile("" : "+s"(z));
        unsigned* bw = (unsigned*)AIN(24);
        if (blockIdx.x == 0) for (int i = threadIdx.x; i < XCD_BAR_WORDS; i += 512) __hip_atomic_store(bw + i, 0u, __ATOMIC_RELAXED, __HIP_MEMORY_SCOPE_AGENT);
        volatile LAS unsigned* st = (volatile LAS unsigned*)(glds + (LDS_BYTES - 16));
        if (threadIdx.x < 2) st[threadIdx.x] = 0u;
        __syncthreads();
        grid.sync();
        (void)xcd_barrier_post(bw, st);
    }
#ifndef REP_IN
#define REP_IN 1
#endif
#ifndef REP_ATT
#define REP_ATT 1
#endif
#ifndef REP_UP
#define REP_UP 1
#endif
#ifndef REP_CONV
#define REP_CONV 1
#endif
#ifndef REP_SYNC
#define REP_SYNC 1
#endif
    for (int ph = a.ph_lo; ph < a.ph_hi; ++ph) {
      const int sub_ = ph & 7; if (sub_ == 4 || (sub_ == 7 && ph != 31)) continue; const int nrep = sub_ == 0 ? REP_CONV : sub_ == 1 ? REP_IN : (sub_ == 2 && !((ph >> 3) & 1)) ? REP_ATT : sub_ == 5 ? REP_UP : 1;
      for (int rep = 0; rep < nrep; ++rep) {
        { int t_ = threadIdx.x; asm volatile("" : "+v"(t_)); F.tid = t_; F.lane = t_ & 63; F.wave = __builtin_amdgcn_readfirstlane(t_ >> 6); }
        int z = 0; asm volatile("" : "+s"(z));
        unsigned char* ws = (unsigned char*)AIN(24);
        bf16* WA = (bf16*)(ws + WS_WA); bf16* WB = (bf16*)(ws + WS_WB); bf16* WUP = (bf16*)(ws + WS_WUP); bf16* WDN = (bf16*)(ws + WS_WDN);
        bf16* XB = (bf16*)(ws + WS_XB); float* DT = (float*)(ws + WS_DT); bf16* BIG = (bf16*)(ws + WS_BIG);
        bf16* OB = (bf16*)(ws + WS_O); bf16* CK = (bf16*)(ws + WS_CK); bf16* CV = (bf16*)(ws + WS_CV);
        float* X = (float*)AIN(23);
        float* ST0 = (float*)(ws + WS_ST0); float* ST1 = (float*)(ws + WS_ST1);
        const int L = ph >> 3, sub = ph & 7, li = L >> 1; const bool ssm = (L & 1);
        if (sub == 0) {
#ifndef NO_CONV
 convert_phase(F, a, z, L);
#endif
 }
        else if (sub == 1) {
#if !defined(ONLY_SUB) || ONLY_SUB == 1
            pg8::StaticOrder S;
            if (!ssm) { pg8::Gemm g{XB, WA, M, 3072, D, D}; S.init(M, 3072, F.G, F.bid); pg8::EpiQKV E{BIG, X, li, L > 0 ? ST0 : (const float*)nullptr, (const float*)(ws + WS_CSA), (const float*)(ws + WS_BWA), (float*)(ws + WS_MR0), (PG8_LAS float*)(glds + 131072 + 8192)};
                pg8::gemm_phase<pg8::EpiQKV, pg8::StaticOrder, true, true>(glds, g, S, E); }
            else { pg8::Gemm g{XB, WA, M, NPROJ_PAD, D, D}; S.init(M, NPROJ_PAD, F.G, F.bid); pg8::EpiSsmIn E{BIG, DT, ST0, (const float*)(ws + WS_CSA), (const float*)(ws + WS_BWA), (float*)(ws + WS_MR0), (PG8_LAS float*)(glds + 131072 + 8192)};
                pg8::gemm_phase<pg8::EpiSsmIn, pg8::StaticOrder, true, true>(glds, g, S, E); }
#endif
        } else if (sub == 2) {
#ifndef NO_ATTN
            if (!ssm) attn_phase(F, AIN(7) + (size_t)li * 16 * 513, BIG, CK, CV, OB);
#endif
#ifndef NO_SSD
#ifdef PROBE_SSD
            if (ssm) for (int pass = 0; pass < 2; ++pass) { ssd_phase(F, a, z, li, BIG, DT, pass == 0 ? XB : nullptr);
                if (pass == 0) { XcdBarrier xb_; xb_.bar = (unsigned*)AIN(24); xb_.x = xb_xcc_id(); xb_.st = (volatile LAS unsigned*)(glds + (LDS_BYTES - 16)); xcd_barrier(xb_); } }
#else
            if (ssm) ssd_phase(F, a, z, li, BIG, DT, nullptr);
#endif
#endif
        } else if (sub == 3) {
#if !defined(ONLY_SUB) || ONLY_SUB == 3
            pg8::StaticOrder S; S.init(M, D, F.G, F.bid); pg8::EpiResid E{XB, L > 0 ? (const float*)(ws + WS_MR0) : (const float*)nullptr, AIN(21) + (L > 0 ? L - 1 : 0) * D, AIN(22) + (L > 0 ? L - 1 : 0) * D, ST1, (PG8_LAS float*)(glds + 131072)};
            if (!ssm) { pg8::Gemm g{OB, WB, M, D, D, D}; pg8::gemm_phase<pg8::EpiResid, pg8::StaticOrder, true, true>(glds, g, S, E); }
            else { pg8::Gemm g{BIG, WB, M, D, 2048, LDP}; pg8::gemm_phase<pg8::EpiResid, pg8::StaticOrder, true, true>(glds, g, S, E); }
#endif
        } else if (sub == 4) ln_phase(F, X, XB, AIN(17) + L * D, AIN(18) + L * D);
        else if (sub == 5) {
#if !defined(ONLY_SUB) || ONLY_SUB == 5
 pg8::Gemm g{XB, WUP, M, DFF, D, D}; pg8::StaticOrder S; S.init(M, DFF, F.G, F.bid); pg8::EpiBf16Plain E{BIG, DFF, 1, ST1, (const float*)(ws + WS_CSU), (const float*)(ws + WS_BWU), (float*)(ws + WS_MR1), (PG8_LAS float*)(glds + 131072 + 8192)};
            pg8::gemm_phase<pg8::EpiBf16Plain, pg8::StaticOrder, true, true>(glds, g, S, E);
#endif
 }
        else if (sub == 6) {
#if !defined(ONLY_SUB) || ONLY_SUB == 6
 pg8::Gemm g{BIG, WDN, M, D, DFF, DFF}; pg8::StaticOrder S; S.init(M, D, F.G, F.bid);
#ifdef PROBE_DN
            { pg8::EpiBf16Plain E0{(bf16*)(ws + WS_CK), D, 0, (const float*)nullptr, (const float*)nullptr, (const float*)nullptr, (float*)nullptr, (PG8_LAS float*)(glds + 131072 + 8192)};
              pg8::gemm_phase<pg8::EpiBf16Plain, pg8::StaticOrder, true, true>(glds, g, S, E0);
              XcdBarrier xb_; xb_.bar = (unsigned*)AIN(24); xb_.x = xb_xcc_id(); xb_.st = (volatile LAS unsigned*)(glds + (LDS_BYTES - 16)); xcd_barrier(xb_); }
#endif
 pg8::EpiResid E{XB, (const float*)(ws + WS_MR1), AIN(17) + L * D, AIN(18) + L * D, ST0, (PG8_LAS float*)(glds + 131072)};
            pg8::gemm_phase<pg8::EpiResid, pg8::StaticOrder, true, true>(glds, g, S, E);
#endif
 }
        else ln_phase(F, X, XB, AIN(21) + L * D, AIN(22) + L * D);
        if (ph + 1 < a.ph_hi || rep + 1 < nrep) { for (int s_ = 0; s_ < REP_SYNC; ++s_) { XcdBarrier xb_; xb_.bar = (unsigned*)AIN(24); xb_.x = xb_xcc_id(); xb_.st = (volatile LAS unsigned*)(glds + (LDS_BYTES - 16)); xcd_barrier(xb_); } }
      }
    }
}

extern "C" void kernel_launch(void* const* d_in, const int* in_sizes, int n_in, void* d_out, int out_size, void* d_ws, size_t ws_size, hipStream_t stream) {
    static int grid = 0;
    if (grid == 0) {
        if (n_in != 23 || ws_size < WS_END2) { fprintf(stderr, "kernel_launch: need 23 inputs and %zu bytes of workspace, got %d and %zu\n", (size_t)WS_END2, n_in, ws_size); grid = -1; return; }
        int dev = 0, cus = 0, per_cu = 0;
        hipGetDevice(&dev); hipDeviceGetAttribute(&cus, hipDeviceAttributeMultiprocessorCount, dev);
        if (hipFuncSetAttribute((const void*)fwd_megakernel, hipFuncAttributeMaxDynamicSharedMemorySize, LDS_BYTES) != hipSuccess) { fprintf(stderr, "kernel_launch: hipFuncSetAttribute failed\n"); grid = -1; return; }
        if (hipOccupancyMaxActiveBlocksPerMultiprocessor(&per_cu, (const void*)fwd_megakernel, 512, LDS_BYTES) != hipSuccess || per_cu < 1) per_cu = 1;
        (void)hipGetLastError();
        grid = cus * per_cu;
    }
    if (grid < 0) return;
    Args a{};
    for (int i = 0; i < 23; ++i) a.in[i] = (const float*)d_in[i];
    a.in[23] = (const float*)d_out; a.in[24] = (const float*)d_ws; a.ph_lo = 0; a.ph_hi = 32;
    void* args[] = {&a};
    hipError_t e = hipLaunchCooperativeKernel((const void*)fwd_megakernel, dim3(grid), dim3(512), args, LDS_BYTES, stream);
    if (e != hipSuccess) fprintf(stderr, "cooperative launch failed: %s (grid %d)\n", hipGetErrorString(e), grid);
}
```

```cpp
#include <hip/hip_runtime.h>
#include <hip/hip_cooperative_groups.h>
#include <cstdio>
#include <cstdint>
namespace cg = cooperative_groups;
namespace pg8 {
#define PG8_LAS __attribute__((address_space(3)))
typedef unsigned short bf16_t;
typedef short bf16x8 __attribute__((ext_vector_type(8)));
typedef float f32x4 __attribute__((ext_vector_type(4)));
typedef unsigned u32x4 __attribute__((ext_vector_type(4)));
constexpr int BM = 256, BK = 64, HALF = 128, HTB = HALF * BK * 2  , STAGE_BYTES = 8 * HTB, NXCD = 8, WGM = 8;

__host__ __device__ __forceinline__ int lds_byte(int r, int c) { const int st = (r >> 4) * 2 + (c >> 5), rr = r & 15, cc = c & 31, ob = rr * 64 + cc * 2; return st * 1024 + (ob ^ (((ob >> 9) & 1) << 5)); }
__host__ __device__ __forceinline__ void stage_rc(int b, int& R, int& C) { const int st = b / 1024, sb = b % 1024, swz = sb ^ (((sb >> 9) & 1) << 5); R = (st >> 1) * 16 + swz / 64; C = (st & 1) * 32 + (swz % 64) / 2; }
__host__ __device__ __forceinline__ int perm32(int rho) { const int n = rho >> 4, i = rho & 15; return 8 * (i >> 2) + 4 * n + (i & 3); }

struct Unit { int pm, pn; };
struct Gemm { const bf16_t* A; const bf16_t* Bt; int M, N, K, lda; };

struct StaticOrder {
    int nM, nN, nwg, G, c;
    __host__ __device__ void init(int M, int N, int G_, int c_) { nM = M / BM; nN = N / BM; nwg = nM * nN; G = G_; c = c_; }
    __host__ __device__ bool next(int i, Unit& u) const {
        const long L = (long)i * G + c; if (L >= nwg) return false;
        int wgid = (int)L; { const int q = nwg / NXCD, r = nwg % NXCD, xcd = wgid % NXCD, off = wgid / NXCD; wgid = (xcd < r ? xcd * (q + 1) : r * (q + 1) + (xcd - r) * q) + off; }
        const int nig = WGM * nN, gid = wgid / nig, fm = gid * WGM, gsz = (nM - fm) < WGM ? (nM - fm) : WGM;
        u.pm = fm + ((wgid % nig) % gsz); u.pn = (wgid % nig) / gsz; return true;
    }
    __device__ __forceinline__ void a_ready(const Unit&) const {}
    __device__ __forceinline__ void done(const Unit&) const {}
};

__device__ __forceinline__ unsigned cvt_pk_bf16(float lo, float hi) { unsigned r; asm volatile("v_cvt_pk_bf16_f32 %0, %1, %2" : "=v"(r) : "v"(lo), "v"(hi)); return r; }
typedef float f32x2 __attribute__((ext_vector_type(2)));
template <class Epi, class Sched, bool ALIGN_EPI = false, bool SP2 = false>
__device__ __forceinline__ void gemm_phase(PG8_LAS unsigned char* lds, const Gemm g, const Sched& S, const Epi& E) {
    int tid_ = threadIdx.x; asm volatile("" : "+v"(tid_));
    const int tid = tid_, wid = __builtin_amdgcn_readfirstlane(tid >> 6), lane = tid & 63, wr = wid >> 2, wc = wid & 3, fr = lane & 15, fq = lane >> 4;
    const int K = g.K, nt = K / BK;
    unsigned voffA[2], voffB[2];
#pragma unroll
    for (int i = 0; i < 2; ++i) { int R, C; stage_rc(tid * 16 + i * 8192, R, C); const int Rb = Epi::PERM ? ((R & ~31) + perm32(R & 31)) : R;
        voffA[i] = (unsigned)(R * g.lda + C) * 2u; voffB[i] = (unsigned)(Rb * K + C) * 2u; }
    const size_t kstep = (size_t)(BK * 2);
    const size_t hstepA = (size_t)HALF * g.lda * 2, hstepB = (size_t)HALF * K * 2;
    const size_t tstepA = 2 * hstepA, tstepB = 2 * hstepB;
    const unsigned ldsw = (unsigned)wid * 1024u;
    const int aoff = lds_byte(wr * 64 + fr, fq * 8), boff = lds_byte(wc * 32 + fr, fq * 8);
#define PG8_SA(b, h) (((b) * 2 + (h)) * HTB)
#define PG8_SB(b, h) ((4 + (b) * 2 + (h)) * HTB)
#define PG8_STAGE(bufoff, gbase, voff) do { _Pragma("unroll") for (int _i = 0; _i < 2; ++_i) \
        __builtin_amdgcn_global_load_lds((const unsigned*)((const char*)(gbase) + (voff)[_i]), (PG8_LAS unsigned*)(lds + (bufoff) + ldsw + _i * 8192), 16, 0, 0); } while (0)
#define PG8_LDA(dst, b, h) do { _Pragma("unroll") for (int m = 0; m < 4; ++m) _Pragma("unroll") for (int k = 0; k < 2; ++k) dst[m][k] = *(const PG8_LAS bf16x8*)(lds + PG8_SA(b, h) + aoff + m * 2048 + k * 1024); } while (0)
#define PG8_LDB(dst, b, h) do { _Pragma("unroll") for (int n = 0; n < 2; ++n) _Pragma("unroll") for (int k = 0; k < 2; ++k) dst[n][k] = *(const PG8_LAS bf16x8*)(lds + PG8_SB(b, h) + boff + n * 2048 + k * 1024); } while (0)
#define PG8_MMA(ai, bj, At, Bt) do { __builtin_amdgcn_s_setprio(1); _Pragma("unroll") for (int m = 0; m < 4; ++m) _Pragma("unroll") for (int n = 0; n < 2; ++n) _Pragma("unroll") for (int k = 0; k < 2; ++k) \
        acc[ai][bj][m][n] = __builtin_amdgcn_mfma_f32_16x16x32_bf16(Bt[n][k], At[m][k], acc[ai][bj][m][n], 0, 0, 0); __builtin_amdgcn_s_setprio(0); } while (0)
#define PG8_WAIT_V(n) asm volatile("s_waitcnt vmcnt(" #n ")" ::: "memory")
#define PG8_WAIT_L(n) asm volatile("s_waitcnt lgkmcnt(" #n ")" ::: "memory")
#define PG8_BAR __builtin_amdgcn_s_barrier()
#define PG8_SCHED __builtin_amdgcn_sched_barrier(0)
    Unit cur, nxt; int ui = 0;
    if (!S.next(0, cur)) return;
    f32x4 acc[2][2][4][2];
#pragma unroll
    for (int a = 0; a < 2; ++a)
#pragma unroll
        for (int b = 0; b < 2; ++b)
#pragma unroll
            for (int m = 0; m < 4; ++m)
#pragma unroll
                for (int n = 0; n < 2; ++n) acc[a][b][m][n] = (f32x4){0.f, 0.f, 0.f, 0.f};
    bf16x8 At[4][2], B0[2][2], B1[2][2];
    const char* cA = (const char*)g.A + (size_t)cur.pm * tstepA; const char* cB = (const char*)g.Bt + (size_t)cur.pn * tstepB;
    S.a_ready(cur);
    if constexpr (Epi::HAS_PF) E.prefetch(cur, tid);
    if constexpr (SP2) {
        PG8_STAGE(PG8_SB(0, 0), cB, voffB); PG8_STAGE(PG8_SB(0, 1), cB + hstepB, voffB); PG8_STAGE(PG8_SA(0, 0), cA, voffA); PG8_STAGE(PG8_SA(0, 1), cA + hstepA, voffA);
        if (wr == 1) PG8_BAR;
        PG8_WAIT_V(2); PG8_BAR;
        PG8_STAGE(PG8_SB(1, 0), cB + kstep, voffB); PG8_STAGE(PG8_SA(1, 0), cA + kstep, voffA); PG8_STAGE(PG8_SB(1, 1), cB + hstepB + kstep, voffB);
        PG8_WAIT_V(6); PG8_BAR;
    } else {
        PG8_STAGE(PG8_SB(0, 0), cB, voffB); PG8_STAGE(PG8_SA(0, 0), cA, voffA); PG8_STAGE(PG8_SB(0, 1), cB + hstepB, voffB); PG8_STAGE(PG8_SA(0, 1), cA + hstepA, voffA);
        if (wr == 1) PG8_BAR;
        PG8_WAIT_V(4); PG8_BAR;
        PG8_STAGE(PG8_SB(1, 0), cB + kstep, voffB); PG8_STAGE(PG8_SA(1, 0), cA + kstep, voffA); PG8_STAGE(PG8_SB(1, 1), cB + hstepB + kstep, voffB);
        PG8_WAIT_V(6); PG8_BAR;
    }
    for (;;) {
        const bool has_next = S.next(ui + 1, nxt);
        const char* nA = has_next ? (const char*)g.A + (size_t)nxt.pm * tstepA : cA; const char* nB = has_next ? (const char*)g.Bt + (size_t)nxt.pn * tstepB : cB;
        for (int t = 0; t < nt; t += 2) {
            const bool last = (t == nt - 2);
            if constexpr (Epi::HAS_WARM) { if (t == nt - 8) E.warm(cur, wid, lane, lds + 141312); }
            const char* a1 = cA + (size_t)(t + 1) * kstep;
            const char* a2 = last ? nA : cA + (size_t)(t + 2) * kstep; const char* b2 = last ? nB : cB + (size_t)(t + 2) * kstep;
            const char* a3 = a2 + kstep; const char* b3 = b2 + kstep;
            if (last && has_next) S.a_ready(nxt);
            if constexpr (SP2) {
            PG8_LDB(B0, 0, 0); PG8_LDB(B1, 0, 1); PG8_SCHED; PG8_LDA(At, 0, 0); PG8_STAGE(PG8_SA(1, 1), a1 + hstepA, voffA);
            PG8_WAIT_V(8); PG8_WAIT_L(0); PG8_BAR; PG8_MMA(0, 0, At, B0); PG8_MMA(0, 1, At, B1); PG8_BAR; PG8_SCHED;
            PG8_LDA(At, 0, 1); PG8_STAGE(PG8_SB(0, 0), b2, voffB); PG8_STAGE(PG8_SB(0, 1), b2 + hstepB, voffB); PG8_STAGE(PG8_SA(0, 0), a2, voffA);
            PG8_WAIT_V(8); PG8_WAIT_L(0); PG8_BAR; PG8_MMA(1, 0, At, B0); PG8_MMA(1, 1, At, B1); PG8_BAR; PG8_SCHED;
            PG8_LDB(B0, 1, 0); PG8_LDB(B1, 1, 1); PG8_SCHED; PG8_LDA(At, 1, 0); PG8_STAGE(PG8_SA(0, 1), a2 + hstepA, voffA);
            PG8_WAIT_V(8); PG8_WAIT_L(0); PG8_BAR; PG8_MMA(0, 0, At, B0); PG8_MMA(0, 1, At, B1); PG8_BAR; PG8_SCHED;
            PG8_LDA(At, 1, 1); PG8_STAGE(PG8_SB(1, 0), b3, voffB); PG8_STAGE(PG8_SB(1, 1), b3 + hstepB, voffB); PG8_STAGE(PG8_SA(1, 0), a3, voffA);
            PG8_WAIT_V(8); PG8_WAIT_L(0); PG8_BAR; PG8_MMA(1, 0, At, B0); PG8_MMA(1, 1, At, B1); PG8_BAR; PG8_SCHED;
            } else {
            PG8_LDB(B0, 0, 0); PG8_SCHED; PG8_LDA(At, 0, 0); PG8_STAGE(PG8_SA(1, 1), a1 + hstepA, voffA);
            PG8_WAIT_L(8); PG8_BAR; PG8_WAIT_L(0); PG8_MMA(0, 0, At, B0); PG8_BAR; PG8_SCHED;
            PG8_LDB(B1, 0, 1); PG8_STAGE(PG8_SB(0, 0), b2, voffB);
            PG8_BAR; PG8_WAIT_L(0); PG8_MMA(0, 1, At, B1); PG8_BAR;
            PG8_LDA(At, 0, 1); PG8_STAGE(PG8_SA(0, 0), a2, voffA);
            PG8_BAR; PG8_WAIT_L(0); PG8_MMA(1, 0, At, B0); PG8_BAR; PG8_SCHED;
            PG8_STAGE(PG8_SB(0, 1), b2 + hstepB, voffB);
            PG8_WAIT_V(6); PG8_BAR; PG8_MMA(1, 1, At, B1); PG8_BAR;
            PG8_LDB(B0, 1, 0); PG8_SCHED; PG8_LDA(At, 1, 0); PG8_STAGE(PG8_SA(0, 1), a2 + hstepA, voffA);
            PG8_WAIT_L(8); PG8_BAR; PG8_WAIT_L(0); PG8_MMA(0, 0, At, B0); PG8_BAR; PG8_SCHED;
            PG8_LDB(B1, 1, 1); PG8_STAGE(PG8_SB(1, 0), b3, voffB);
            PG8_BAR; PG8_WAIT_L(0); PG8_MMA(0, 1, At, B1); PG8_BAR;
            PG8_LDA(At, 1, 1); PG8_STAGE(PG8_SA(1, 0), a3, voffA);
            PG8_BAR; PG8_WAIT_L(0); PG8_MMA(1, 0, At, B0); PG8_BAR; PG8_SCHED;
            PG8_STAGE(PG8_SB(1, 1), b3 + hstepB, voffB);
            PG8_WAIT_V(6); PG8_BAR; PG8_MMA(1, 1, At, B1); PG8_BAR;
            }
        }
        if constexpr (ALIGN_EPI) { if (wr == 0) PG8_BAR; }
        if constexpr (!Epi::AFTER_DRAIN) { E(acc, cur, wr, wc, fr, fq); S.done(cur); }
        if (!has_next) break;
#pragma unroll
        for (int a = 0; a < 2; ++a)
#pragma unroll
            for (int b = 0; b < 2; ++b)
#pragma unroll
                for (int m = 0; m < 4; ++m)
#pragma unroll
                    for (int n = 0; n < 2; ++n) acc[a][b][m][n] = (f32x4){0.f, 0.f, 0.f, 0.f};
        cur = nxt; cA = nA; cB = nB; ++ui;
        if constexpr (Epi::HAS_PF) E.prefetch(cur, tid);
        if constexpr (ALIGN_EPI) { if (wr == 1) PG8_BAR; }
    }
    PG8_WAIT_V(0);
    if constexpr (!ALIGN_EPI) { if (wr == 0) PG8_BAR; }
    PG8_BAR;
    if constexpr (Epi::AFTER_DRAIN) { E.fused(acc, cur, wr, wc, fr, fq, lds, wid, lane); S.done(cur); }
#undef PG8_SA
#undef PG8_SB
#undef PG8_STAGE
#undef PG8_LDA
#undef PG8_LDB
#undef PG8_MMA
#undef PG8_WAIT_V
#undef PG8_WAIT_L
#undef PG8_BAR
#undef PG8_SCHED
}
}
#define LAS __attribute__((address_space(3)))
typedef unsigned short bf16;
typedef float f32x4 __attribute__((ext_vector_type(4)));
typedef float f32x16 __attribute__((ext_vector_type(16)));
typedef short bf16x8 __attribute__((ext_vector_type(8)));
typedef short s16x4 __attribute__((ext_vector_type(4)));
typedef unsigned u32x4 __attribute__((ext_vector_type(4)));
typedef unsigned u32x2 __attribute__((ext_vector_type(2)));
typedef float f32x2_t __attribute__((ext_vector_type(2)));
typedef __bf16 bf16x2_t __attribute__((ext_vector_type(2)));

constexpr int D = 1024, MP = 65536, MS = 2048, M = MP + MS, DFF = 4096;
constexpr int LDP = 6144, NPROJ = 6176, NPROJ_PAD = 6400;
constexpr float ALPHA = 1.6817928305074290f, LN_EPS = 1e-5f, RMS_EPS = 1e-5f, LOG2E = 1.4426950408889634f;
constexpr size_t O_KP = 69206016, O_VP = 102760448, O_HP = 136314880, O_CP = 153092096, O_KS = 153878528, O_VS = 158072832, O_HS = 162267136, O_CS = 179044352;
constexpr size_t MiB = 1u << 20;
constexpr size_t WS_WA = 1 * MiB, WS_WB = 14 * MiB, WS_WUP = 18 * MiB, WS_WDN = 26 * MiB, WS_XB = 34 * MiB, WS_DT = 166 * MiB, WS_BIG = 175 * MiB;
constexpr size_t WS_O = WS_BIG + 396 * MiB, WS_CK = WS_BIG + 528 * MiB, WS_CV = WS_BIG + 560 * MiB, WS_END = WS_BIG + 792 * MiB;
constexpr size_t WS_AUX = WS_END, WS_ST0 = WS_AUX, WS_ST1 = WS_AUX + 2304 * 1024, WS_CSA = WS_AUX + 4608 * 1024, WS_BWA = WS_CSA + 32 * 1024, WS_CSU = WS_CSA + 64 * 1024, WS_BWU = WS_CSA + 80 * 1024, WS_MR0 = WS_AUX + 4736 * 1024, WS_MR1 = WS_AUX + 5312 * 1024, WS_WDN1 = WS_AUX + 6 * MiB, WS_END2 = WS_AUX + 14 * MiB;
constexpr float FXS = 1048576.f, FXI = 1.f / 1048576.f;
typedef long long i64x2_t __attribute__((ext_vector_type(2)));
constexpr int LDS_BYTES = 147456;

__device__ __forceinline__ unsigned pk2(float lo, float hi) { f32x2_t v = {lo, hi}; bf16x2_t b = __builtin_convertvector(v, bf16x2_t); return __builtin_bit_cast(unsigned, b); }
__device__ __forceinline__ float bf2f(unsigned short u) { return __uint_as_float((unsigned)u << 16); }
__device__ __forceinline__ float bflo(unsigned u) { return __uint_as_float(u << 16); }
__device__ __forceinline__ float bfhi(unsigned u) { return __uint_as_float(u & 0xffff0000u); }
__device__ __forceinline__ float fexp2(float x) { return __builtin_amdgcn_exp2f(x); }
__device__ __forceinline__ float frcp(float x) { return __builtin_amdgcn_rcpf(x); }
__device__ __forceinline__ float silu_f(float v) { return v * frcp(1.0f + fexp2(-v * LOG2E)); }
__device__ __forceinline__ int crow(int r, int hi) { return (r & 3) + 8 * (r >> 2) + 4 * hi; }
__device__ __forceinline__ bf16x8 pack8(const f32x16& x, int s) {
    u32x4 p; p.x = pk2(x[8 * s], x[8 * s + 1]); p.y = pk2(x[8 * s + 2], x[8 * s + 3]); p.z = pk2(x[8 * s + 4], x[8 * s + 5]); p.w = pk2(x[8 * s + 6], x[8 * s + 7]);
    return __builtin_bit_cast(bf16x8, p);
}
#define MFMA32(a, b, c) __builtin_amdgcn_mfma_f32_32x32x16_bf16((a), (b), (c), 0, 0, 0)
__device__ __forceinline__ float wave_sum(float v) {
#pragma unroll
    for (int o = 1; o < 64; o <<= 1) v += __shfl_xor(v, o);
    return v;
}

namespace pg8 {
struct RowNorm {
    const float* st; const float* cs; const float* bw; float* mr_out;
    PG8_LAS float* T;
    float mu[2][4], rs[2][4]; f32x4 c[2][2], b[2][2];
    __device__ __forceinline__ void load(const Unit& u, int wr, int wc, int fr, int fq, const f32x4 pfa, const f32x4 pfb) {
        if (!st) return;
        const int tid = (wr * 4 + wc) * 64 + fq * 16 + fr;
        if (tid < 256) { const float mean = ((pfa[0] + pfa[2]) + (pfb[0] + pfb[2])) * (1.f / 1024.f), var = ((pfa[1] + pfa[3]) + (pfb[1] + pfb[3])) * (1.f / 1024.f) - mean * mean;
            const f32x2_t mrv = {mean, 1.0f / sqrtf(var + LN_EPS)};
            *(PG8_LAS f32x2_t*)(T + 2 * tid) = mrv;
            if (mr_out && u.pn == 0) *(f32x2_t*)(mr_out + 2 * (unsigned)(u.pm * BM + tid)) = mrv; }
        const int cb = u.pn * BM + wc * 32 + 8 * fq;
#pragma unroll
        for (int bj = 0; bj < 2; ++bj)
#pragma unroll
            for (int n = 0; n < 2; ++n) { c[bj][n] = *(const f32x4*)(cs + cb + bj * HALF + 4 * n); b[bj][n] = *(const f32x4*)(bw + cb + bj * HALF + 4 * n); }
        asm volatile("s_waitcnt lgkmcnt(0)" ::: "memory"); __builtin_amdgcn_s_barrier(); asm volatile("" ::: "memory");
#pragma unroll
        for (int ai = 0; ai < 2; ++ai)
#pragma unroll
            for (int m = 0; m < 4; ++m) { const f32x2_t v = *(const PG8_LAS f32x2_t*)(T + 2 * (ai * HALF + wr * 64 + m * 16 + fr)); mu[ai][m] = v.x; rs[ai][m] = v.y; }
    }
    __device__ __forceinline__ f32x4 apply(const f32x4 a, int ai, int m, int bj, int n) const { return st ? (a - c[bj][n] * mu[ai][m]) * rs[ai][m] + b[bj][n] : a; }
};
#define PG8_PF_MEMBERS mutable f32x4 pfa, pfb; static constexpr bool HAS_PF = true, HAS_WARM = false; \
    __device__ __forceinline__ void prefetch(const Unit& u, int tid) const { if (st && tid < 256) { const float* sp = st + 8 * (unsigned)(u.pm * BM + tid); pfa = *(const f32x4*)sp; pfb = *(const f32x4*)(sp + 4); } }
struct EpiQKV {
    static constexpr bool PERM = true, AFTER_DRAIN = false;
    bf16_t* QKV; float* out; int li; const float* st; const float* cs; const float* bw; float* mr_out; PG8_LAS float* T; PG8_PF_MEMBERS
    __device__ __forceinline__ void operator()(const f32x4 (&acc)[2][2][4][2], const Unit& u, int wr, int wc, int fr, int fq) const {
        asm volatile("" : "+v"(fr));
        RowNorm rn; rn.st = st; rn.cs = cs; rn.bw = bw; rn.mr_out = mr_out; rn.T = T; rn.load(u, wr, wc, fr, fq, pfa, pfb);
        float* fdst = nullptr;
        if (u.pn >= 4) {
            const bool isv = u.pn >= 8;
            if (u.pm < 256) { const int b = u.pm >> 3, tt = u.pm & 7; if (tt >= 6) fdst = out + (isv ? O_VP : O_KP) + ((size_t)(li * 32 + b) * 512 + (size_t)(tt - 6) * 256) * 1024; }
            else fdst = out + (isv ? O_VS : O_KS) + ((size_t)li * 2048 + (size_t)(u.pm - 256) * 256) * 1024;
        }
        const int col0 = u.pn * BM + wc * 32 + 8 * fq, colk = (u.pn & 3) * BM + wc * 32 + 8 * fq;
#pragma unroll
        for (int ai = 0; ai < 2; ++ai)
#pragma unroll
            for (int m = 0; m < 4; ++m) { const int rl = ai * HALF + wr * 64 + m * 16 + fr; bf16_t* rowp = QKV + (unsigned)((u.pm * BM + rl) * 3072 + col0);
#pragma unroll
                for (int bj = 0; bj < 2; ++bj) { const f32x4 v0 = rn.apply(acc[ai][bj][m][0], ai, m, bj, 0), v1 = rn.apply(acc[ai][bj][m][1], ai, m, bj, 1);
                    u32x4 w; w.x = pk2(v0[0], v0[1]); w.y = pk2(v0[2], v0[3]); w.z = pk2(v1[0], v1[1]); w.w = pk2(v1[2], v1[3]);
                    *(u32x4*)(rowp + bj * HALF) = w;
                    if (fdst) { float* fp = fdst + (unsigned)(rl * 1024 + colk + bj * HALF); *(f32x4*)fp = v0; *(f32x4*)(fp + 4) = v1; } }
                asm volatile("" ::: "memory"); }
    }
};
struct EpiBf16Plain {
    static constexpr bool PERM = true, AFTER_DRAIN = false;
    bf16_t* O; int ldc; int relu2; const float* st; const float* cs; const float* bw; float* mr_out; PG8_LAS float* T; PG8_PF_MEMBERS
    __device__ __forceinline__ void operator()(const f32x4 (&acc)[2][2][4][2], const Unit& u, int wr, int wc, int fr, int fq) const {
        asm volatile("" : "+v"(fr));
        RowNorm rn; rn.st = st; rn.cs = cs; rn.bw = bw; rn.mr_out = mr_out; rn.T = T; rn.load(u, wr, wc, fr, fq, pfa, pfb);
        const int col0 = u.pn * BM + wc * 32 + 8 * fq;
#pragma unroll
        for (int ai = 0; ai < 2; ++ai)
#pragma unroll
            for (int m = 0; m < 4; ++m) { const int rl = ai * HALF + wr * 64 + m * 16 + fr; bf16_t* rowp = O + (unsigned)((u.pm * BM + rl) * ldc + col0);
#pragma unroll
                for (int bj = 0; bj < 2; ++bj) { f32x4 v0 = rn.apply(acc[ai][bj][m][0], ai, m, bj, 0), v1 = rn.apply(acc[ai][bj][m][1], ai, m, bj, 1);
                    if (relu2) { v0 = __builtin_elementwise_max(v0, (f32x4){0.f, 0.f, 0.f, 0.f}); v1 = __builtin_elementwise_max(v1, (f32x4){0.f, 0.f, 0.f, 0.f}); v0 = v0 * v0; v1 = v1 * v1; }
                    u32x4 w; w.x = pk2(v0[0], v0[1]); w.y = pk2(v0[2], v0[3]); w.z = pk2(v1[0], v1[1]); w.w = pk2(v1[2], v1[3]);
                    *(u32x4*)(rowp + bj * HALF) = w; } }
    }
};
struct EpiSsmIn {
    static constexpr bool PERM = true, AFTER_DRAIN = false;
    bf16_t* P; float* DT; const float* st; const float* cs; const float* bw; float* mr_out; PG8_LAS float* T; PG8_PF_MEMBERS
    __device__ __forceinline__ void operator()(const f32x4 (&acc)[2][2][4][2], const Unit& u, int wr, int wc, int fr, int fq) const {
        asm volatile("" : "+v"(fr));
        RowNorm rn; rn.st = st; rn.cs = cs; rn.bw = bw; rn.mr_out = mr_out; rn.T = T; rn.load(u, wr, wc, fr, fq, pfa, pfb);
        if (u.pn < 24) {
            const int col0 = u.pn * BM + wc * 32 + 8 * fq;
#pragma unroll
            for (int ai = 0; ai < 2; ++ai)
#pragma unroll
                for (int m = 0; m < 4; ++m) { const int rl = ai * HALF + wr * 64 + m * 16 + fr; bf16_t* rowp = P + (unsigned)((u.pm * BM + rl) * LDP + col0);
#pragma unroll
                    for (int bj = 0; bj < 2; ++bj) { const f32x4 v0 = rn.apply(acc[ai][bj][m][0], ai, m, bj, 0), v1 = rn.apply(acc[ai][bj][m][1], ai, m, bj, 1);
                        u32x4 w; w.x = pk2(v0[0], v0[1]); w.y = pk2(v0[2], v0[3]); w.z = pk2(v1[0], v1[1]); w.w = pk2(v1[2], v1[3]);
                        *(u32x4*)(rowp + bj * HALF) = w; }
                    asm volatile("" ::: "memory"); }
        } else if (wc == 0) {
#pragma unroll
            for (int ai = 0; ai < 2; ++ai)
#pragma unroll
                for (int m = 0; m < 4; ++m) { const int rl = ai * HALF + wr * 64 + m * 16 + fr; float* fp = DT + (unsigned)((u.pm * BM + rl) * 32 + 8 * fq);
                    *(f32x4*)fp = rn.apply(acc[ai][0][m][0], ai, m, 0, 0); *(f32x4*)(fp + 4) = rn.apply(acc[ai][0][m][1], ai, m, 0, 1); }
        }
    }
};
struct EpiResid {
    static constexpr bool PERM = true, AFTER_DRAIN = false, HAS_PF = false, HAS_WARM = true;
    __device__ __forceinline__ void warm(const Unit& u, int wid, int lane, PG8_LAS unsigned char* dummy) const {
#pragma unroll
        for (int i = 0; i < 2; ++i) { const int line = wid * 128 + i * 64 + lane, row = line >> 2, seg = line & 3;
            const char* gp = (const char*)XB + ((size_t)(unsigned)((u.pm * BM + row) * D + u.pn * BM)) * 2 + seg * 128;
            __builtin_amdgcn_global_load_lds((const unsigned*)gp, (PG8_LAS unsigned*)(dummy + wid * 256), 4, 0, 0); }
    }
    bf16_t* XB; const float* st_in; const float* gin; const float* bin; float* st_out; PG8_LAS float* P;
    static constexpr int DEPTH = 1;
    __device__ __forceinline__ void operator()(const f32x4 (&acc)[2][2][4][2], const Unit& u, int wr, int wc, int fr, int fq) const {
        asm volatile("" : "+v"(fr));
        const int col0 = u.pn * BM + wc * 32 + 8 * fq;
        const unsigned rowb0 = (unsigned)(u.pm * BM + wr * 64 + fr);
        PG8_LAS float* GB = P + 3072;
        { const int tid_ = (wr * 4 + wc) * 64 + fq * 16 + fr;
          if (st_in && tid_ < 64) { const f32x4 gg = *(const f32x4*)(gin + u.pn * BM + 4 * tid_), bb = *(const f32x4*)(bin + u.pn * BM + 4 * tid_);
              *(PG8_LAS f32x4*)(GB + 4 * tid_) = gg; *(PG8_LAS f32x4*)(GB + 256 + 4 * tid_) = bb; } }
        if (st_in) { asm volatile("s_waitcnt lgkmcnt(0)" ::: "memory"); __builtin_amdgcn_s_barrier(); asm volatile("" ::: "memory"); }
        const int cl = wc * 32 + 8 * fq;
#pragma unroll
        for (int ai = 0; ai < 2; ++ai) {
            u32x4 xv[4][2]; f32x2_t mr[4];
#pragma unroll
            for (int m = 0; m < 4; ++m) { const unsigned row_ = rowb0 + (unsigned)(ai * HALF + m * 16); const bf16_t* rp_ = XB + row_ * D + col0;
                xv[m][0] = *(const u32x4*)rp_; xv[m][1] = *(const u32x4*)(rp_ + HALF);
                if (st_in) mr[m] = *(const f32x2_t*)(st_in + 2 * row_); else mr[m] = (f32x2_t){0.f, 1.f}; }
            asm volatile("" ::: "memory");
#pragma unroll
            for (int m = 0; m < 4; ++m) {
                const unsigned row = rowb0 + (unsigned)(ai * HALF + m * 16);
                bf16_t* rowb = XB + row * D + col0;
                float mean = 0.f, rstd = 1.f;
                if (st_in) { mean = mr[m].x; rstd = mr[m].y; }
                float s1 = 0.f, s2 = 0.f;
#pragma unroll
                for (int bj = 0; bj < 2; ++bj) {
                    const u32x4 xw = xv[m][bj];
                    f32x4 x0 = (f32x4){bflo(xw.x), bfhi(xw.x), bflo(xw.y), bfhi(xw.y)}, x1 = (f32x4){bflo(xw.z), bfhi(xw.z), bflo(xw.w), bfhi(xw.w)};
                    if (st_in) { int c_ = cl + bj * HALF; asm volatile("" : "+v"(c_));
                        const f32x4 g0 = *(const PG8_LAS f32x4*)(GB + c_), g1 = *(const PG8_LAS f32x4*)(GB + c_ + 4), b0 = *(const PG8_LAS f32x4*)(GB + 256 + c_), b1 = *(const PG8_LAS f32x4*)(GB + 256 + c_ + 4);
                        x0 = (x0 - mean) * rstd * g0 + b0; x1 = (x1 - mean) * rstd * g1 + b1; }
                    const f32x4 v0 = x0 * ALPHA + acc[ai][bj][m][0], v1 = x1 * ALPHA + acc[ai][bj][m][1];
                    u32x4 w; w.x = pk2(v0[0], v0[1]); w.y = pk2(v0[2], v0[3]); w.z = pk2(v1[0], v1[1]); w.w = pk2(v1[2], v1[3]); *(u32x4*)(rowb + bj * HALF) = w;
                    s1 += ((v0[0] + v0[1]) + (v0[2] + v0[3])) + ((v1[0] + v1[1]) + (v1[2] + v1[3]));
                    s2 += ((v0[0] * v0[0] + v0[1] * v0[1]) + (v0[2] * v0[2] + v0[3] * v0[3])) + ((v1[0] * v1[0] + v1[1] * v1[1]) + (v1[2] * v1[2] + v1[3] * v1[3])); }
                s1 += __shfl_xor(s1, 16); s2 += __shfl_xor(s2, 16); s1 += __shfl_xor(s1, 32); s2 += __shfl_xor(s2, 32);
                if (fq == 0) *(PG8_LAS f32x2_t*)(P + ((ai * HALF + wr * 64 + m * 16 + fr) * 4 + wc) * 2) = (f32x2_t){s1, s2};
            }
            asm volatile("" ::: "memory");
        }
        asm volatile("s_waitcnt lgkmcnt(0)" ::: "memory"); __builtin_amdgcn_s_barrier(); asm volatile("" ::: "memory");
        const int tid = (wr * 4 + wc) * 64 + fq * 16 + fr;
        if (tid < 256) { const f32x4 qa = *(const PG8_LAS f32x4*)(P + tid * 8), qb = *(const PG8_LAS f32x4*)(P + tid * 8 + 4);
            *(f32x2_t*)(st_out + 8 * (unsigned)(u.pm * BM + tid) + 2 * u.pn) = (f32x2_t){(qa[0] + qa[2]) + (qb[0] + qb[2]), (qa[1] + qa[3]) + (qb[1] + qb[3])}; }
    }
};
}
#define XB_TMO      128
#define XB_XCNT(j)  (256  + 64 * (j))
#define XB_XSUB(j)  (1280 + 64 * (j))
#define XB_XGEN(j)  (2304 + 64 * (j))
#define XB_TOP      3328
#define XB_TOPGEN   3392
#define XCD_BAR_WORDS 3456
#define XB_SPIN_CAP (1u << 18)

__device__ __forceinline__ unsigned xb_ld(unsigned* p)              { return __hip_atomic_load(p, __ATOMIC_RELAXED, __HIP_MEMORY_SCOPE_AGENT); }
__device__ __forceinline__ unsigned xb_add(unsigned* p, unsigned v) { return __hip_atomic_fetch_add(p, v, __ATOMIC_RELAXED, __HIP_MEMORY_SCOPE_AGENT); }
__device__ __forceinline__ unsigned xb_xcc_id() { return (unsigned)__builtin_amdgcn_s_getreg((3 << 11) | 20) & 0xFu; }
#define XB_SPIN(cond, bar) do { unsigned _sp = 0; while (cond) { __builtin_amdgcn_s_sleep(1); \
    if ((++_sp & 255u) == 0u) { if (xb_ld(&(bar)[XB_TMO])) break; if (_sp > XB_SPIN_CAP) { atomicAdd(&(bar)[XB_TMO], 1u); break; } } } } while (0)

struct XcdBarrier {
    unsigned* bar; unsigned x;
    volatile LAS unsigned* st;
};

__device__ __forceinline__ XcdBarrier xcd_barrier_post(unsigned* bar, volatile LAS unsigned* st) {
    XcdBarrier b; b.bar = bar; b.x = xb_xcc_id(); b.st = st;
    if (threadIdx.x == 0) (void)xb_add(&bar[XB_XCNT(b.x)], 1u);
    return b;
}
__device__ __forceinline__ void xcd_barrier_complete(unsigned* bar, unsigned x, unsigned& nloc, unsigned& nx) {
    const unsigned G = gridDim.x * gridDim.y * gridDim.z;
    unsigned sum, cnt, mine, sp = 0u;
    for (;;) {
        sum = 0u; cnt = 0u; mine = 0u;
#pragma unroll
        for (unsigned j = 0; j < 16; ++j) { const unsigned c = xb_ld(&bar[XB_XCNT(j)]); sum += c; cnt += (c > 0u) ? 1u : 0u; mine = (j == x) ? c : mine; }
        if (sum == G) break;
        __builtin_amdgcn_s_sleep(1);
        if ((++sp & 255u) == 0u) { if (xb_ld(&bar[XB_TMO])) break; if (sp > XB_SPIN_CAP) { atomicAdd(&bar[XB_TMO], 1u); break; } }
    }
    nloc = mine > 0u ? mine : 1u; nx = cnt > 0u ? cnt : 1u;
}

__device__ __forceinline__ void xcd_barrier(const XcdBarrier& b) {
    asm volatile("s_waitcnt vmcnt(0)" ::: "memory");
    __syncthreads();
    if (threadIdx.x == 0) {
        unsigned* bar = b.bar;
        __builtin_amdgcn_s_waitcnt(0);
        unsigned nloc = b.st[0], nx = b.st[1];
        if (nloc == 0u) { xcd_barrier_complete(bar, b.x, nloc, nx); b.st[0] = nloc; b.st[1] = nx; }
        const unsigned old = xb_add(&bar[XB_XSUB(b.x)], 1u);
        const unsigned gen = old / nloc;
        if (old + 1u == (gen + 1u) * nloc) {
            __builtin_amdgcn_fence(__ATOMIC_RELEASE, "agent");
            asm volatile("s_waitcnt vmcnt(0)" ::: "memory");
            const unsigned og = xb_add(&bar[XB_TOP], 1u);
            const unsigned tg = og / nx;
            if (og + 1u == (tg + 1u) * nx) xb_add(&bar[XB_TOPGEN], 1u);
            else XB_SPIN(xb_ld(&bar[XB_TOPGEN]) == tg, bar);
            __builtin_amdgcn_fence(__ATOMIC_ACQUIRE, "agent");
            xb_add(&bar[XB_XGEN(b.x)], 1u);
            asm volatile("s_waitcnt vmcnt(0)" ::: "memory");
        } else {
            XB_SPIN(xb_ld(&bar[XB_XGEN(b.x)]) == gen, bar);
            __builtin_amdgcn_fence(__ATOMIC_ACQUIRE, "agent");
            asm volatile("s_waitcnt vmcnt(0)" ::: "memory");
        }
    }
    __syncthreads();
}

struct Args { const float* in[25]; int ph_lo, ph_hi; };
#define AIN(k) (a.in[(k) + z])
struct Frame { unsigned char* lds; int tid, lane, wave, G, bid; };

__device__ __forceinline__ void transpose_item(const float* W, int K, int N, bf16* WT, float* scr, int item, int lane) {
    const int nblk = N / 32, kb = item / nblk, nb = item % nblk, k0 = 64 * kb, n0 = 32 * nb;
#pragma unroll 8
    for (int i = 0; i < 32; ++i) { const int kk = 2 * i + (lane >> 5); scr[kk * 33 + (lane & 31)] = W[(size_t)(k0 + kk) * N + n0 + (lane & 31)]; }
    asm volatile("s_waitcnt lgkmcnt(0)" ::: "memory");
    const int c = lane & 7;
#pragma unroll
    for (int j = 0; j < 4; ++j) { const int n = (lane >> 3) + 8 * j; const float* s = scr + (8 * c) * 33 + n;
        u32x4 o; o.x = pk2(s[0 * 33], s[1 * 33]); o.y = pk2(s[2 * 33], s[3 * 33]); o.z = pk2(s[4 * 33], s[5 * 33]); o.w = pk2(s[6 * 33], s[7 * 33]);
        *(u32x4*)(WT + (size_t)(n0 + n) * K + k0 + 8 * c) = o; }
    asm volatile("s_waitcnt lgkmcnt(0)" ::: "memory");
}
__device__ __forceinline__ void transpose_fold_item(const float* W, int K, int N, bf16* WT, const float* g, const float* b, float* cs, float* bw, float* scr, int nb, int lane) {
    const int n0 = 32 * nb; float csp = 0.f, bwp = 0.f;
    for (int k0 = 0; k0 < K; k0 += 64) {
#pragma unroll 8
        for (int i = 0; i < 32; ++i) { const int kk = 2 * i + (lane >> 5); const float w = W[(size_t)(k0 + kk) * N + n0 + (lane & 31)];
            const float wg = w * g[k0 + kk]; const float wr = bflo(pk2(wg, 0.f) & 0xffffu); scr[kk * 33 + (lane & 31)] = wr; csp += wr; bwp += w * b[k0 + kk]; }
        asm volatile("s_waitcnt lgkmcnt(0)" ::: "memory");
        const int c = lane & 7;
#pragma unroll
        for (int j = 0; j < 4; ++j) { const int n = (lane >> 3) + 8 * j; const float* s = scr + (8 * c) * 33 + n;
            u32x4 o; o.x = pk2(s[0 * 33], s[1 * 33]); o.y = pk2(s[2 * 33], s[3 * 33]); o.z = pk2(s[4 * 33], s[5 * 33]); o.w = pk2(s[6 * 33], s[7 * 33]);
            *(u32x4*)(WT + (size_t)(n0 + n) * K + k0 + 8 * c) = o; }
        asm volatile("s_waitcnt lgkmcnt(0)" ::: "memory");
    }
    csp += __shfl_xor(csp, 32); bwp += __shfl_xor(bwp, 32);
    if (lane < 32) { cs[n0 + lane] = csp; bw[n0 + lane] = bwp; }
}
__device__ __forceinline__ void cvt_stream(const float* src, bf16* dst, size_t n, size_t gtid, size_t gthreads) {
    for (size_t i = gtid * 8; i < n; i += gthreads * 8) { const f32x4 a = *(const f32x4*)(src + i), b = *(const f32x4*)(src + i + 4);
        u32x4 o; o.x = pk2(a[0], a[1]); o.y = pk2(a[2], a[3]); o.z = pk2(b[0], b[1]); o.w = pk2(b[2], b[3]); *(u32x4*)(dst + i) = o; }
}
__device__ __forceinline__ void convert_phase(const Frame& F, const Args& a, int z, int L) {
    unsigned char* ws = (unsigned char*)AIN(24); float* outp = (float*)AIN(23); const int li = L >> 1; const bool ssm = (L & 1);
    float* scr = (float*)(F.lds + F.wave * 16384);
    const int gw = F.bid * 8 + F.wave, NGW = F.G * 8;
    const float* Wa = ssm ? AIN(9) + (size_t)li * D * NPROJ : AIN(6) + (size_t)li * D * 3072; const int Na = ssm ? NPROJ : 3072;
    const float* Wb = ssm ? AIN(16) + (size_t)li * 2048 * D : AIN(8) + (size_t)li * D * D; const int Kb = ssm ? 2048 : D;
    const float* Wu = AIN(19) + (size_t)L * D * DFF; const float* Wd = AIN(20) + (size_t)L * DFF * D;
    const bool foldA = (L > 0);
    const float* gA = AIN(21) + (L - 1) * D; const float* bA = AIN(22) + (L - 1) * D;
    const float* gU = AIN(17) + L * D; const float* bU = AIN(18) + L * D;
    const int Ia = foldA ? Na / 32 : (D / 64) * (Na / 32), Ib = (Kb / 64) * (D / 32), Iu = DFF / 32, Id = (DFF / 64) * (D / 32);
    const int NIT = Ia + Ib + Iu + Id;
    for (int it = gw; it < NIT; it += NGW) {
        int r = it;
        if (r < Iu) { transpose_fold_item(Wu, D, DFF, (bf16*)(ws + WS_WUP), gU, bU, (float*)(ws + WS_CSU), (float*)(ws + WS_BWU), scr, r, F.lane); continue; } r -= Iu;
        if (r < Ia) { if (foldA) transpose_fold_item(Wa, D, Na, (bf16*)(ws + WS_WA), gA, bA, (float*)(ws + WS_CSA), (float*)(ws + WS_BWA), scr, r, F.lane);
                      else transpose_item(Wa, D, Na, (bf16*)(ws + WS_WA), scr, r, F.lane); continue; } r -= Ia;
        if (r < Ib) { transpose_item(Wb, Kb, D, (bf16*)(ws + WS_WB), scr, r, F.lane); continue; } r -= Ib;
        transpose_item(Wd, DFF, D, (bf16*)(ws + WS_WDN), scr, r, F.lane);
    }
    const size_t gtid = (size_t)F.bid * 512 + F.tid, gth = (size_t)F.G * 512;
    if (!ssm) {
        cvt_stream(AIN(2) + (size_t)li * 32 * 512 * 1024, (bf16*)(ws + WS_CK), (size_t)32 * 512 * 1024, gtid, gth);
        cvt_stream(AIN(3) + (size_t)li * 32 * 512 * 1024, (bf16*)(ws + WS_CV), (size_t)32 * 512 * 1024, gtid, gth);
    }
    if (L == 0) {
        const size_t n = (size_t)M * D, np = (size_t)MP * D;
        bf16* XB = (bf16*)(ws + WS_XB);
        for (size_t i = gtid * 8; i < n; i += gth * 8) { const float* src = i < np ? AIN(0) + i : AIN(1) + (i - np);
            const f32x4 x0 = *(const f32x4*)src, x1 = *(const f32x4*)(src + 4);
            u32x4 o; o.x = pk2(x0[0], x0[1]); o.y = pk2(x0[2], x0[3]); o.z = pk2(x1[0], x1[1]); o.w = pk2(x1[2], x1[3]); *(u32x4*)(XB + i) = o; }
    }
}
__device__ __forceinline__ void ln_phase(const Frame& F, float* X, const bf16* XB, const float* g, const float* b) {
    const int gw = F.bid * 8 + F.wave, NGW = F.G * 8;
    f32x4 gv[4], bv[4];
#pragma unroll
    for (int j = 0; j < 4; ++j) { gv[j] = *(const f32x4*)(g + 4 * F.lane + 256 * j); bv[j] = *(const f32x4*)(b + 4 * F.lane + 256 * j); }
    for (int m = gw; m < M; m += NGW) {
        f32x4* xr = (f32x4*)(X + (size_t)m * D) + F.lane;
        const u32x2* xb = (const u32x2*)(XB + (size_t)m * D) + F.lane;
        f32x4 v[4]; float s = 0.f;
#pragma unroll
        for (int j = 0; j < 4; ++j) { const u32x2 w = xb[64 * j]; v[j] = (f32x4){bflo(w.x), bfhi(w.x), bflo(w.y), bfhi(w.y)}; s += (v[j][0] + v[j][1]) + (v[j][2] + v[j][3]); }
        const float mean = wave_sum(s) * (1.f / D); float s2 = 0.f;
#pragma unroll
        for (int j = 0; j < 4; ++j) { v[j] = v[j] - mean; s2 += (v[j][0] * v[j][0] + v[j][1] * v[j][1]) + (v[j][2] * v[j][2] + v[j][3] * v[j][3]); }
        const float rstd = 1.f / sqrtf(wave_sum(s2) * (1.f / D) + LN_EPS);
#pragma unroll
        for (int j = 0; j < 4; ++j) xr[64 * j] = v[j] * rstd * gv[j] + bv[j];
    }
}

__device__ __forceinline__ void attn_phase(const Frame& F, const float* relb, const bf16* QKV, const bf16* CK, const bf16* CV, bf16* O) {
    float* tbl = (float*)F.lds;
    for (int i = F.tid; i < 16 * 513; i += 512) tbl[i] = relb[i] * LOG2E;
    __syncthreads();
    unsigned char* vt = F.lds + 36864 + F.wave * 9216;
    const int lane = F.lane, l31 = lane & 31, hh = lane >> 5;
    const int i16 = lane & 15, q4 = i16 >> 2, p4 = i16 & 3, dblk = (lane >> 4) & 1;
    const int gw = F.bid * 8 + F.wave, NGW = F.G * 8;
    constexpr int NITEM = (32 * 32 + 32) * 32;
    constexpr float C2 = 0.125f * LOG2E;
    for (int it = gw; it < NITEM; it += NGW) {
        const bool smp = it >= 32768;
        const int r = smp ? it - 32768 : it;
        const int qh = r & 1, h = (r >> 1) & 15, c = smp ? 0 : (r >> 5) & 31, b = smp ? (r >> 5) : (r >> 10);
        const size_t qrow0 = smp ? (size_t)MP + b * 64 + 32 * qh : (size_t)b * 2048 + 64 * c + 32 * qh;
        bf16x8 qf[4];
#pragma unroll
        for (int ks = 0; ks < 4; ++ks) qf[ks] = *(const bf16x8*)(QKV + (qrow0 + l31) * 3072 + h * 64 + 16 * ks + 8 * hh);
        f32x16 o0, o1;
#pragma unroll
        for (int i = 0; i < 16; ++i) { o0[i] = 0.f; o1[i] = 0.f; }
        float mrun = -1e30f, lsum = 0.f;
        const float* tb = tbl + h * 513;
        const float cbias = tb[512];
        const int jb0 = smp ? 0 : (c >= 8 ? 0 : 8 - c);
#define ATT_SRC(jb_, Kp_, Vp_, pitch_) do { \
            if (!smp) { Kp_ = QKV + ((size_t)b * 2048 + 64 * (c - 8 + (jb_))) * 3072 + 1024 + h * 64; Vp_ = Kp_ + 1024; pitch_ = 3072; } \
            else if ((jb_) < 8) { Kp_ = CK + ((size_t)b * 512 + 64 * (jb_)) * 1024 + h * 64; Vp_ = CV + ((size_t)b * 512 + 64 * (jb_)) * 1024 + h * 64; pitch_ = 1024; } \
            else { Kp_ = QKV + ((size_t)MP + b * 64) * 3072 + 1024 + h * 64; Vp_ = Kp_ + 1024; pitch_ = 3072; } } while (0)
#define ATT_LOAD(kf_, vr_, jb_) do { const bf16 *Kp_, *Vp_; int pitch_; ATT_SRC(jb_, Kp_, Vp_, pitch_); \
            _Pragma("unroll") for (int rb = 0; rb < 2; ++rb) _Pragma("unroll") for (int ks = 0; ks < 4; ++ks) kf_[rb][ks] = *(const bf16x8*)(Kp_ + (size_t)(32 * rb + l31) * pitch_ + 16 * ks + 8 * hh); \
            _Pragma("unroll") for (int i = 0; i < 8; ++i) vr_[i] = *(const bf16x8*)(Vp_ + (size_t)(8 * i + (lane >> 3)) * pitch_ + 8 * (lane & 7)); } while (0)
        bf16x8 kf[2][4], vr[8], kn[2][4], vn[8];
        ATT_LOAD(kf, vr, jb0);
        for (int jb = jb0; jb <= 8; ++jb) {
            if (jb < 8) ATT_LOAD(kn, vn, jb + 1);
            asm volatile("" ::: "memory");
#pragma unroll
            for (int i = 0; i < 8; ++i) *(bf16x8*)(vt + ((8 * i + (lane >> 3)) * 72 + 8 * (lane & 7)) * 2) = vr[i];
            asm volatile("" ::: "memory");
            f32x16 s0, s1;
#pragma unroll
            for (int i = 0; i < 16; ++i) { s0[i] = 0.f; s1[i] = 0.f; }
#pragma unroll
            for (int ks = 0; ks < 4; ++ks) { s0 = MFMA32(kf[0][ks], qf[ks], s0); s1 = MFMA32(kf[1][ks], qf[ks], s1); }
            if (jb <= 3) {
#pragma unroll
                for (int i = 0; i < 16; ++i) { s0[i] = s0[i] * C2 + cbias; s1[i] = s1[i] * C2 + cbias; }
            } else {
                const int dbase = 64 * (8 - jb) + 32 * qh + l31 + 256;
#pragma unroll
                for (int i = 0; i < 16; ++i) { const int k0 = crow(i, hh); int i0 = dbase - k0, i1 = dbase - k0 - 32; i0 = i0 > 512 ? 512 : i0; i1 = i1 > 512 ? 512 : i1;
                    s0[i] = s0[i] * C2 + tb[i0]; s1[i] = s1[i] * C2 + tb[i1]; }
            }
            float mx = s0[0];
#pragma unroll
            for (int i = 1; i < 16; ++i) mx = fmaxf(mx, s0[i]);
#pragma unroll
            for (int i = 0; i < 16; ++i) mx = fmaxf(mx, s1[i]);
            mx = fmaxf(mx, __shfl_xor(mx, 32));
            const float mnew = fmaxf(mrun, mx), alpha = fexp2(mrun - mnew);
            mrun = mnew;
            float ps = 0.f;
#pragma unroll
            for (int i = 0; i < 16; ++i) { s0[i] = fexp2(s0[i] - mnew); s1[i] = fexp2(s1[i] - mnew); ps += s0[i] + s1[i]; }
            lsum = lsum * alpha + ps;
#pragma unroll
            for (int i = 0; i < 16; ++i) { o0[i] *= alpha; o1[i] *= alpha; }
#pragma unroll
            for (int rb = 0; rb < 2; ++rb)
#pragma unroll
                for (int s2 = 0; s2 < 2; ++s2) {
                    const bf16x8 pf = pack8(rb ? s1 : s0, s2);
                    const int k0 = 32 * rb + 16 * s2 + 4 * hh + q4;
#pragma unroll
                    for (int db = 0; db < 2; ++db) {
                        const int cb = 32 * db + 16 * dblk + 4 * p4;
                        const s16x4 lo = __builtin_amdgcn_ds_read_tr16_b64_v4i16((LAS s16x4*)(vt + (k0 * 72 + cb) * 2));
                        const s16x4 hi = __builtin_amdgcn_ds_read_tr16_b64_v4i16((LAS s16x4*)(vt + ((k0 + 8) * 72 + cb) * 2));
                        const bf16x8 va = __builtin_shufflevector(lo, hi, 0, 1, 2, 3, 4, 5, 6, 7);
                        if (db == 0) o0 = MFMA32(va, pf, o0); else o1 = MFMA32(va, pf, o1);
                    }
                }
            asm volatile("" ::: "memory");
#pragma unroll
            for (int rb = 0; rb < 2; ++rb)
#pragma unroll
                for (int ks = 0; ks < 4; ++ks) kf[rb][ks] = kn[rb][ks];
#pragma unroll
            for (int i = 0; i < 8; ++i) vr[i] = vn[i];
        }
#undef ATT_LOAD
#undef ATT_SRC
        const float inv = 1.0f / (lsum + __shfl_xor(lsum, 32));
        bf16* orow = O + (qrow0 + l31) * D + h * 64 + 4 * hh;
#pragma unroll
        for (int i4 = 0; i4 < 4; ++i4) {
            u32x2 w0; w0.x = pk2(o0[4 * i4] * inv, o0[4 * i4 + 1] * inv); w0.y = pk2(o0[4 * i4 + 2] * inv, o0[4 * i4 + 3] * inv); *(u32x2*)(orow + 8 * i4) = w0;
            u32x2 w1; w1.x = pk2(o1[4 * i4] * inv, o1[4 * i4 + 1] * inv); w1.y = pk2(o1[4 * i4 + 2] * inv, o1[4 * i4 + 3] * inv); *(u32x2*)(orow + 32 + 8 * i4) = w1;
        }
    }
}
constexpr int SX_XT = 0, SX_XWT = 36864, SX_BT = 73728, SX_BS = 92160, SX_CS = 109568, SX_DT = 126976, SX_CUM = SX_DT + 1024, SX_WIN = SX_DT + 2048, SX_PART = SX_DT + 3072;
__device__ __forceinline__ void ssd_phase(const Frame& F, const Args& a, int z, int li, bf16* PROJ, const float* DT, bf16* dryXB) {
    float* outp = (float*)AIN(23);
    unsigned char* lds = F.lds;
    bf16* Xt = (bf16*)(lds + SX_XT); bf16* Xwt = (bf16*)(lds + SX_XWT); bf16* Bt = (bf16*)(lds + SX_BT); bf16* Bs = (bf16*)(lds + SX_BS); bf16* Cs = (bf16*)(lds + SX_CS);
    float* dts = (float*)(lds + SX_DT); float* cums = (float*)(lds + SX_CUM); float* wins = (float*)(lds + SX_WIN); float* part = (float*)(lds + SX_PART);
    const int tid = F.tid, lane = F.lane, wave = F.wave, l31 = lane & 31, hh = lane >> 5;
    const int r = wave >> 1, half = wave & 1;
    const float* conv_w = AIN(10) + (size_t)li * 4 * 4096; const float* conv_b = AIN(11) + (size_t)li * 4096;
    const float* dt_bias = AIN(12) + li * 32; const float* a_log = AIN(13) + li * 32; const float* d_skip = AIN(14) + li * 32; const float* norm_w = AIN(15) + (size_t)li * 2048;
    for (int item = F.bid; item < 512; item += F.G) {
        const bool smp = item >= 256; const int bg = item & 255, b = bg >> 3, g = bg & 7;
        const size_t row0 = smp ? (size_t)MP + b * 64 : (size_t)b * 2048; const int nchunks = smp ? 1 : 32;
        const int hglob = g * 4 + r;
        const float Dr = d_skip[hglob];
        f32x16 hT[4];
        const size_t hoff = (((size_t)(li * 32 + b) * 32 + hglob) * 64 + 32 * half + l31) * 128 + 4 * hh;
        if (smp) { const float* hs = AIN(4) + hoff;
#pragma unroll
            for (int nb = 0; nb < 4; ++nb)
#pragma unroll
                for (int i4 = 0; i4 < 4; ++i4) { const f32x4 v = *(const f32x4*)(hs + 32 * nb + 8 * i4); hT[nb][4 * i4] = v[0]; hT[nb][4 * i4 + 1] = v[1]; hT[nb][4 * i4 + 2] = v[2]; hT[nb][4 * i4 + 3] = v[3]; }
        } else {
#pragma unroll
            for (int nb = 0; nb < 4; ++nb)
#pragma unroll
                for (int i = 0; i < 16; ++i) hT[nb][i] = 0.f;
        }
        float dt_pf = (tid < 256) ? DT[(row0 + lane) * 32 + g * 4 + wave] : 0.f;
#pragma unroll 1
        for (int c = 0; c < nchunks; ++c) {
            const size_t rowc = row0 + 64 * c;
            int lane_ = F.lane; asm volatile("" : "+v"(lane_));
            const int lane = lane_, l31 = lane & 31, hh = lane >> 5, tid = wave * 64 + lane;
            const int role = lane < 32 ? 0 : (lane < 48 ? 1 : 2);
            const int chbase = role == 0 ? g * 256 + 8 * lane : (role == 1 ? 2048 + g * 128 + 8 * (lane - 32) : 3072 + g * 128 + 8 * (lane - 48));
            if (tid < 256) {
                const int hr = g * 4 + wave;
                const float raw = dt_pf + dt_bias[hr];
                if (c + 1 < nchunks) dt_pf = DT[(rowc + 64 + lane) * 32 + hr];
                const float dt = raw > 20.f ? raw : log1pf(__expf(raw));
                const float am = -__expf(a_log[hr]) * LOG2E;
                float v = dt * am;
#pragma unroll
                for (int o = 1; o < 64; o <<= 1) { const float n = __shfl_up(v, o); if (lane >= o) v += n; }
                const float last = __shfl(v, 63);
                dts[wave * 64 + lane] = dt; cums[wave * 64 + lane] = v; wins[wave * 64 + lane] = fexp2(last - v) * dt;
            }
            __syncthreads();
            {
                const bf16* src = PROJ + 2048 + chbase;
                u32x4 raw[11];
#pragma unroll
                for (int i = 0; i < 11; ++i) {
                    const int rr = 8 * wave - 3 + i;
                    if (rr >= 0 || c > 0) raw[i] = *(const u32x4*)(src + (size_t)((long)rowc + rr) * LDP);
                    else if (!smp) raw[i] = (u32x4){0u, 0u, 0u, 0u};
                    else { const float* sc = AIN(5) + ((size_t)(li * 32 + b) * 3 + (3 + rr)) * 4096 + chbase; const f32x4 s0 = *(const f32x4*)sc, s1 = *(const f32x4*)(sc + 4);
                        raw[i] = (u32x4){pk2(s0[0], s0[1]), pk2(s0[2], s0[3]), pk2(s1[0], s1[1]), pk2(s1[2], s1[3])}; }
                }
                if (c == nchunks - 1 && wave == 7) {
                    float* co = outp + (smp ? O_CS : O_CP) + ((size_t)(li * 32 + b) * 3) * 4096 + chbase;
#pragma unroll
                    for (int k = 0; k < 3; ++k) { const u32x4 rw = raw[8 + k];
                        *(f32x4*)(co + k * 4096) = (f32x4){bflo(rw.x), bfhi(rw.x), bflo(rw.y), bfhi(rw.y)}; *(f32x4*)(co + k * 4096 + 4) = (f32x4){bflo(rw.z), bfhi(rw.z), bflo(rw.w), bfhi(rw.w)}; }
                }
                float win8[8];
                { const float* wp = wins + (lane < 32 ? (lane >> 3) : 0) * 64 + 8 * wave;
                  const f32x4 wa = *(const f32x4*)wp, wb = *(const f32x4*)(wp + 4);
                  win8[0] = wa[0]; win8[1] = wa[1]; win8[2] = wa[2]; win8[3] = wa[3]; win8[4] = wb[0]; win8[5] = wb[1]; win8[6] = wb[2]; win8[7] = wb[3]; }
#pragma unroll
                for (int hb = 0; hb < 2; ++hb) {
                    f32x4 wv[4], bvv;
#pragma unroll
                    for (int k = 0; k < 4; ++k) wv[k] = *(const f32x4*)(conv_w + k * 4096 + chbase + 4 * hb);
                    bvv = *(const f32x4*)(conv_b + chbase + 4 * hb);
                    unsigned pc[4][4];
#pragma unroll
                    for (int e4 = 0; e4 < 4; ++e4) {
                        const int e = 4 * hb + e4;
                        float xv[11];
#pragma unroll
                        for (int i = 0; i < 11; ++i) { const unsigned wd = raw[i][e >> 1]; xv[i] = (e & 1) ? bfhi(wd) : bflo(wd); }
                        const float w0 = wv[0][e4], w1 = wv[1][e4], w2 = wv[2][e4], w3 = wv[3][e4], bb = bvv[e4];
                        float o[8];
#pragma unroll
                        for (int j = 0; j < 8; ++j) o[j] = silu_f(bb + w0 * xv[j] + w1 * xv[j + 1] + w2 * xv[j + 2] + w3 * xv[j + 3]);
#pragma unroll
                        for (int j2 = 0; j2 < 4; ++j2) pc[e4][j2] = pk2(o[2 * j2], o[2 * j2 + 1]);
                        if (role == 0) {
                            *(u32x4*)(Xt + (8 * lane + e) * 72 + 8 * wave) = (u32x4){pc[e4][0], pc[e4][1], pc[e4][2], pc[e4][3]};
                            *(u32x4*)(Xwt + (8 * lane + e) * 72 + 8 * wave) = (u32x4){pk2(o[0] * win8[0], o[1] * win8[1]), pk2(o[2] * win8[2], o[3] * win8[3]), pk2(o[4] * win8[4], o[5] * win8[5]), pk2(o[6] * win8[6], o[7] * win8[7])};
                        } else if (role == 1) {
                            *(u32x4*)(Bt + (8 * (lane - 32) + e) * 72 + 8 * wave) = (u32x4){pc[e4][0], pc[e4][1], pc[e4][2], pc[e4][3]};
                        }
                    }
                    if (role != 0) {
                        bf16* dst = (role == 1 ? Bs + 8 * (lane - 32) : Cs + 8 * (lane - 48)) + (8 * wave) * 136 + 4 * hb;
#pragma unroll
                        for (int j2 = 0; j2 < 4; ++j2) {
                            u32x2 lo, hi;
                            lo.x = __builtin_amdgcn_perm(pc[1][j2], pc[0][j2], 0x05040100u); hi.x = __builtin_amdgcn_perm(pc[1][j2], pc[0][j2], 0x07060302u);
                            lo.y = __builtin_amdgcn_perm(pc[3][j2], pc[2][j2], 0x05040100u); hi.y = __builtin_amdgcn_perm(pc[3][j2], pc[2][j2], 0x07060302u);
                            *(u32x2*)(dst + (2 * j2) * 136) = lo; *(u32x2*)(dst + (2 * j2 + 1) * 136) = hi;
                        }
                    }
                }
            }
            __syncthreads();
            bf16* zr0 = PROJ + (rowc + l31) * LDP + g * 256 + 64 * r + 32 * half + 4 * hh; bf16* zr1 = zr0 + (size_t)32 * LDP;
            u32x2 zp0[4], zp1[4];
#pragma unroll
            for (int i4 = 0; i4 < 4; ++i4) { zp0[i4] = *(const u32x2*)(zr0 + 8 * i4); zp1[i4] = *(const u32x2*)(zr1 + 8 * i4); }
            f32x16 cb00, cb01, cb11;
#pragma unroll
            for (int i = 0; i < 16; ++i) { cb00[i] = 0.f; cb01[i] = 0.f; cb11[i] = 0.f; }
#pragma unroll
            for (int ns = 0; ns < 8; ++ns) {
                const bf16x8 a0 = *(const bf16x8*)(Bs + l31 * 136 + 16 * ns + 8 * hh), a1 = *(const bf16x8*)(Bs + (32 + l31) * 136 + 16 * ns + 8 * hh);
                const bf16x8 c0 = *(const bf16x8*)(Cs + l31 * 136 + 16 * ns + 8 * hh), c1 = *(const bf16x8*)(Cs + (32 + l31) * 136 + 16 * ns + 8 * hh);
                cb00 = MFMA32(a0, c0, cb00); cb01 = MFMA32(a0, c1, cb01); cb11 = MFMA32(a1, c1, cb11);
            }
            const float* cumr = cums + r * 64; const float* dtr = dts + r * 64;
            const float cum_t0 = cumr[l31], cum_t1 = cumr[32 + l31];
#pragma unroll
            for (int i4 = 0; i4 < 4; ++i4) {
                const f32x4 cs0 = *(const f32x4*)(cumr + 8 * i4 + 4 * hh), cs1 = *(const f32x4*)(cumr + 32 + 8 * i4 + 4 * hh);
                const f32x4 ds0 = *(const f32x4*)(dtr + 8 * i4 + 4 * hh), ds1 = *(const f32x4*)(dtr + 32 + 8 * i4 + 4 * hh);
#pragma unroll
                for (int j = 0; j < 4; ++j) { const int i = 4 * i4 + j, s = 8 * i4 + 4 * hh + j;
                    float v00 = cb00[i] * fexp2(fminf(cum_t0 - cs0[j], 0.f)) * ds0[j]; v00 = (s <= l31) ? v00 : 0.f; v00 += (s == l31) ? Dr : 0.f; cb00[i] = v00;
                    cb01[i] = cb01[i] * fexp2(fminf(cum_t1 - cs0[j], 0.f)) * ds0[j];
                    float v11 = cb11[i] * fexp2(fminf(cum_t1 - cs1[j], 0.f)) * ds1[j]; v11 = (s <= l31) ? v11 : 0.f; v11 += (s == l31) ? Dr : 0.f; cb11[i] = v11; }
            }
            f32x16 y0, y1;
#pragma unroll
            for (int i = 0; i < 16; ++i) { y0[i] = 0.f; y1[i] = 0.f; }
#pragma unroll
            for (int nb = 0; nb < 4; ++nb)
#pragma unroll
                for (int s2 = 0; s2 < 2; ++s2) {
                    const bf16x8 ha = pack8(hT[nb], s2);
                    const int n0 = 32 * nb + 16 * s2 + 4 * hh;
                    const s16x4 c0l = *(const s16x4*)(Cs + l31 * 136 + n0), c0h = *(const s16x4*)(Cs + l31 * 136 + n0 + 8);
                    const s16x4 c1l = *(const s16x4*)(Cs + (32 + l31) * 136 + n0), c1h = *(const s16x4*)(Cs + (32 + l31) * 136 + n0 + 8);
                    y0 = MFMA32(ha, __builtin_shufflevector(c0l, c0h, 0, 1, 2, 3, 4, 5, 6, 7), y0);
                    y1 = MFMA32(ha, __builtin_shufflevector(c1l, c1h, 0, 1, 2, 3, 4, 5, 6, 7), y1);
                }
            { const float e0 = fexp2(cum_t0), e1 = fexp2(cum_t1);
#pragma unroll
              for (int i = 0; i < 16; ++i) { y0[i] *= e0; y1[i] *= e1; } }
            { const bf16* xrow = Xt + (64 * r + 32 * half + l31) * 72;
#pragma unroll
              for (int s2 = 0; s2 < 2; ++s2) {
                  const s16x4 x0l = *(const s16x4*)(xrow + 16 * s2 + 4 * hh), x0h = *(const s16x4*)(xrow + 16 * s2 + 4 * hh + 8);
                  const s16x4 x1l = *(const s16x4*)(xrow + 32 + 16 * s2 + 4 * hh), x1h = *(const s16x4*)(xrow + 32 + 16 * s2 + 4 * hh + 8);
                  const bf16x8 xa0 = __builtin_shufflevector(x0l, x0h, 0, 1, 2, 3, 4, 5, 6, 7), xa1 = __builtin_shufflevector(x1l, x1h, 0, 1, 2, 3, 4, 5, 6, 7);
                  y0 = MFMA32(xa0, pack8(cb00, s2), y0);
                  y1 = MFMA32(xa0, pack8(cb01, s2), y1);
                  y1 = MFMA32(xa1, pack8(cb11, s2), y1);
              } }
            {
                float ss0 = 0.f, ss1 = 0.f;
#pragma unroll
                for (int i4 = 0; i4 < 4; ++i4) {
                    const u32x2 z0 = zp0[i4], z1 = zp1[i4];
                    const float za[4] = {bflo(z0.x), bfhi(z0.x), bflo(z0.y), bfhi(z0.y)}, zb[4] = {bflo(z1.x), bfhi(z1.x), bflo(z1.y), bfhi(z1.y)};
#pragma unroll
                    for (int j = 0; j < 4; ++j) { const float v0 = y0[4 * i4 + j] * silu_f(za[j]), v1 = y1[4 * i4 + j] * silu_f(zb[j]); y0[4 * i4 + j] = v0; y1[4 * i4 + j] = v1; ss0 += v0 * v0; ss1 += v1 * v1; }
                }
                ss0 += __shfl_xor(ss0, 32); ss1 += __shfl_xor(ss1, 32);
                if (hh == 0) { part[l31 * 8 + wave] = ss0; part[(32 + l31) * 8 + wave] = ss1; }
                __syncthreads();
                const f32x4 pa = *(const f32x4*)(part + l31 * 8), pb = *(const f32x4*)(part + l31 * 8 + 4), pc = *(const f32x4*)(part + (32 + l31) * 8), pd = *(const f32x4*)(part + (32 + l31) * 8 + 4);
                const float t0 = ((pa[0] + pa[1]) + (pa[2] + pa[3])) + ((pb[0] + pb[1]) + (pb[2] + pb[3])), t1 = ((pc[0] + pc[1]) + (pc[2] + pc[3])) + ((pd[0] + pd[1]) + (pd[2] + pd[3]));
                const float r0 = 1.0f / sqrtf(t0 * (1.f / 256.f) + RMS_EPS), r1 = 1.0f / sqrtf(t1 * (1.f / 256.f) + RMS_EPS);
                const float* nwp = norm_w + g * 256 + 64 * r + 32 * half + 4 * hh;
#pragma unroll
                for (int i4 = 0; i4 < 4; ++i4) { const f32x4 nw = *(const f32x4*)(nwp + 8 * i4);
                    u32x2 w0; w0.x = pk2(y0[4 * i4] * r0 * nw[0], y0[4 * i4 + 1] * r0 * nw[1]); w0.y = pk2(y0[4 * i4 + 2] * r0 * nw[2], y0[4 * i4 + 3] * r0 * nw[3]); if (!dryXB) *(u32x2*)(zr0 + 8 * i4) = w0; else if (g < 4) *(u32x2*)(dryXB + (rowc + l31) * 1024 + g * 256 + 64 * r + 32 * half + 4 * hh + 8 * i4) = w0;
                    u32x2 w1; w1.x = pk2(y1[4 * i4] * r1 * nw[0], y1[4 * i4 + 1] * r1 * nw[1]); w1.y = pk2(y1[4 * i4 + 2] * r1 * nw[2], y1[4 * i4 + 3] * r1 * nw[3]); if (!dryXB) *(u32x2*)(zr1 + 8 * i4) = w1; else if (g < 4) *(u32x2*)(dryXB + (rowc + 32 + l31) * 1024 + g * 256 + 64 * r + 32 * half + 4 * hh + 8 * i4) = w1; }
            }
            { const float dec = fexp2(cumr[63]);
#pragma unroll
              for (int nb = 0; nb < 4; ++nb)
#pragma unroll
                  for (int i = 0; i < 16; ++i) hT[nb][i] *= dec;
              const bf16* xw = Xwt + (64 * r + 32 * half + l31) * 72 + 8 * hh;
#pragma unroll
              for (int ss = 0; ss < 4; ++ss) { const bf16x8 bx = *(const bf16x8*)(xw + 16 * ss);
#pragma unroll
                  for (int nb = 0; nb < 4; ++nb) { const bf16x8 af = *(const bf16x8*)(Bt + (32 * nb + l31) * 72 + 16 * ss + 8 * hh); hT[nb] = MFMA32(af, bx, hT[nb]); } }
            }
            __syncthreads();
        }
        { float* ho = outp + (smp ? O_HS : O_HP) + hoff;
#pragma unroll
          for (int nb = 0; nb < 4; ++nb)
#pragma unroll
              for (int i4 = 0; i4 < 4; ++i4) *(f32x4*)(ho + 32 * nb + 8 * i4) = (f32x4){hT[nb][4 * i4], hT[nb][4 * i4 + 1], hT[nb][4 * i4 + 2], hT[nb][4 * i4 + 3]};
          }
    }
}
__global__ void __launch_bounds__(512, 2) fwd_megakernel(Args a) {
    extern __shared__ __attribute__((aligned(16))) unsigned char lds[];
    cg::grid_group grid = cg::this_grid();
    Frame F; F.lds = lds; F.tid = threadIdx.x; F.lane = F.tid & 63; F.wave = __builtin_amdgcn_readfirstlane(F.tid >> 6); F.G = gridDim.x; F.bid = blockIdx.x;
    PG8_LAS unsigned char* glds = (PG8_LAS unsigned char*)lds;
    {
        int z = 0; asm volatile("" : "+s"(z));
        unsigned* bw = (unsigned*)AIN(24);
        if (blockIdx.x == 0) for (int i = threadIdx.x; i < XCD_BAR_WORDS; i += 512) __hip_atomic_store(bw + i, 0u, __ATOMIC_RELAXED, __HIP_MEMORY_SCOPE_AGENT);
        volatile LAS unsigned* st = (volatile LAS unsigned*)(glds + (LDS_BYTES - 16));
        if (threadIdx.x < 2) st[threadIdx.x] = 0u;
        __syncthreads();
        grid.sync();
        (void)xcd_barrier_post(bw, st);
    }
#ifndef REP_IN
#define REP_IN 1
#endif
#ifndef REP_ATT
#define REP_ATT 1
#endif
#ifndef REP_UP
#define REP_UP 1
#endif
#ifndef REP_CONV
#define REP_CONV 1
#endif
#ifndef REP_SYNC
#define REP_SYNC 1
#endif
    for (int ph = a.ph_lo; ph < a.ph_hi; ++ph) {
      const int sub_ = ph & 7; if (sub_ == 4 || (sub_ == 7 && ph != 31)) continue; const int nrep = sub_ == 0 ? REP_CONV : sub_ == 1 ? REP_IN : (sub_ == 2 && !((ph >> 3) & 1)) ? REP_ATT : sub_ == 5 ? REP_UP : 1;
      for (int rep = 0; rep < nrep; ++rep) {
        { int t_ = threadIdx.x; asm volatile("" : "+v"(t_)); F.tid = t_; F.lane = t_ & 63; F.wave = __builtin_amdgcn_readfirstlane(t_ >> 6); }
        int z = 0; asm volatile("" : "+s"(z));
        unsigned char* ws = (unsigned char*)AIN(24);
        bf16* WA = (bf16*)(ws + WS_WA); bf16* WB = (bf16*)(ws + WS_WB); bf16* WUP = (bf16*)(ws + WS_WUP); bf16* WDN = (bf16*)(ws + WS_WDN);
        bf16* XB = (bf16*)(ws + WS_XB); float* DT = (float*)(ws + WS_DT); bf16* BIG = (bf16*)(ws + WS_BIG);
        bf16* OB = (bf16*)(ws + WS_O); bf16* CK = (bf16*)(ws + WS_CK); bf16* CV = (bf16*)(ws + WS_CV);
        float* X = (float*)AIN(23);
        float* ST0 = (float*)(ws + WS_ST0); float* ST1 = (float*)(ws + WS_ST1);
        const int L = ph >> 3, sub = ph & 7, li = L >> 1; const bool ssm = (L & 1);
        if (sub == 0) {
#ifndef NO_CONV
 convert_phase(F, a, z, L);
#endif
 }
        else if (sub == 1) {
#if !defined(ONLY_SUB) || ONLY_SUB == 1
            pg8::StaticOrder S;
            if (!ssm) { pg8::Gemm g{XB, WA, M, 3072, D, D}; S.init(M, 3072, F.G, F.bid); pg8::EpiQKV E{BIG, X, li, L > 0 ? ST0 : (const float*)nullptr, (const float*)(ws + WS_CSA), (const float*)(ws + WS_BWA), (float*)(ws + WS_MR0), (PG8_LAS float*)(glds + 131072 + 8192)};
                pg8::gemm_phase<pg8::EpiQKV, pg8::StaticOrder, true, true>(glds, g, S, E); }
            else { pg8::Gemm g{XB, WA, M, NPROJ_PAD, D, D}; S.init(M, NPROJ_PAD, F.G, F.bid); pg8::EpiSsmIn E{BIG, DT, ST0, (const float*)(ws + WS_CSA), (const float*)(ws + WS_BWA), (float*)(ws + WS_MR0), (PG8_LAS float*)(glds + 131072 + 8192)};
                pg8::gemm_phase<pg8::EpiSsmIn, pg8::StaticOrder, true, true>(glds, g, S, E); }
#endif
        } else if (sub == 2) {
#ifndef NO_ATTN
            if (!ssm) attn_phase(F, AIN(7) + (size_t)li * 16 * 513, BIG, CK, CV, OB);
#endif
#ifndef NO_SSD
#ifdef PROBE_SSD
            if (ssm) for (int pass = 0; pass < 2; ++pass) { ssd_phase(F, a, z, li, BIG, DT, pass == 0 ? XB : nullptr);
                if (pass == 0) { XcdBarrier xb_; xb_.bar = (unsigned*)AIN(24); xb_.x = xb_xcc_id(); xb_.st = (volatile LAS unsigned*)(glds + (LDS_BYTES - 16)); xcd_barrier(xb_); } }
#else
            if (ssm) ssd_phase(F, a, z, li, BIG, DT, nullptr);
#endif
#endif
        } else if (sub == 3) {
#if !defined(ONLY_SUB) || ONLY_SUB == 3
            pg8::StaticOrder S; S.init(M, D, F.G, F.bid); pg8::EpiResid E{XB, L > 0 ? (const float*)(ws + WS_MR0) : (const float*)nullptr, AIN(21) + (L > 0 ? L - 1 : 0) * D, AIN(22) + (L > 0 ? L - 1 : 0) * D, ST1, (PG8_LAS float*)(glds + 131072)};
#ifdef PROBE_S3
            { pg8::Gemm g0 = ssm ? pg8::Gemm{BIG, WB, M, D, 2048, LDP} : pg8::Gemm{OB, WB, M, D, D, D};
              pg8::EpiBf16Plain E0{ssm ? BIG + 2048 : BIG, ssm ? LDP : D, 0, (const float*)nullptr, (const float*)nullptr, (const float*)nullptr, (float*)nullptr, (PG8_LAS float*)(glds + 131072 + 8192)};
              pg8::gemm_phase<pg8::EpiBf16Plain, pg8::StaticOrder, true, true>(glds, g0, S, E0);
              XcdBarrier xb_; xb_.bar = (unsigned*)AIN(24); xb_.x = xb_xcc_id(); xb_.st = (volatile LAS unsigned*)(glds + (LDS_BYTES - 16)); xcd_barrier(xb_); }
#endif
            if (!ssm) { pg8::Gemm g{OB, WB, M, D, D, D}; pg8::gemm_phase<pg8::EpiResid, pg8::StaticOrder, true, true>(glds, g, S, E); }
            else { pg8::Gemm g{BIG, WB, M, D, 2048, LDP}; pg8::gemm_phase<pg8::EpiResid, pg8::StaticOrder, true, true>(glds, g, S, E); }
#endif
        } else if (sub == 4) ln_phase(F, X, XB, AIN(17) + L * D, AIN(18) + L * D);
        else if (sub == 5) {
#if !defined(ONLY_SUB) || ONLY_SUB == 5
 pg8::Gemm g{XB, WUP, M, DFF, D, D}; pg8::StaticOrder S; S.init(M, DFF, F.G, F.bid); pg8::EpiBf16Plain E{BIG, DFF, 1, ST1, (const float*)(ws + WS_CSU), (const float*)(ws + WS_BWU), (float*)(ws + WS_MR1), (PG8_LAS float*)(glds + 131072 + 8192)};
            pg8::gemm_phase<pg8::EpiBf16Plain, pg8::StaticOrder, true, true>(glds, g, S, E);
#endif
 }
        else if (sub == 6) {
#if !defined(ONLY_SUB) || ONLY_SUB == 6
 pg8::Gemm g{BIG, WDN, M, D, DFF, DFF}; pg8::StaticOrder S; S.init(M, D, F.G, F.bid);
#ifdef PROBE_DN
            { pg8::EpiBf16Plain E0{(bf16*)(ws + WS_CK), D, 0, (const float*)nullptr, (const float*)nullptr, (const float*)nullptr, (float*)nullptr, (PG8_LAS float*)(glds + 131072 + 8192)};
              pg8::gemm_phase<pg8::EpiBf16Plain, pg8::StaticOrder, true, true>(glds, g, S, E0);
              XcdBarrier xb_; xb_.bar = (unsigned*)AIN(24); xb_.x = xb_xcc_id(); xb_.st = (volatile LAS unsigned*)(glds + (LDS_BYTES - 16)); xcd_barrier(xb_); }
#endif
 pg8::EpiResid E{XB, (const float*)(ws + WS_MR1), AIN(17) + L * D, AIN(18) + L * D, ST0, (PG8_LAS float*)(glds + 131072)};
            pg8::gemm_phase<pg8::EpiResid, pg8::StaticOrder, true, true>(glds, g, S, E);
#endif
 }
        else ln_phase(F, X, XB, AIN(21) + L * D, AIN(22) + L * D);
        if (ph + 1 < a.ph_hi || rep + 1 < nrep) { for (int s_ = 0; s_ < REP_SYNC; ++s_) { XcdBarrier xb_; xb_.bar = (unsigned*)AIN(24); xb_.x = xb_xcc_id(); xb_.st = (volatile LAS unsigned*)(glds + (LDS_BYTES - 16)); xcd_barrier(xb_); } }
      }
    }
}

extern "C" void kernel_launch(void* const* d_in, const int* in_sizes, int n_in, void* d_out, int out_size, void* d_ws, size_t ws_size, hipStream_t stream) {
    static int grid = 0;
    if (grid == 0) {
        if (n_in != 23 || ws_size < WS_END2) { fprintf(stderr, "kernel_launch: need 23 inputs and %zu bytes of workspace, got %d and %zu\n", (size_t)WS_END2, n_in, ws_size); grid = -1; return; }
        int dev = 0, cus = 0, per_cu = 0;
        hipGetDevice(&dev); hipDeviceGetAttribute(&cus, hipDeviceAttributeMultiprocessorCount, dev);
        if (hipFuncSetAttribute((const void*)fwd_megakernel, hipFuncAttributeMaxDynamicSharedMemorySize, LDS_BYTES) != hipSuccess) { fprintf(stderr, "kernel_launch: hipFuncSetAttribute failed\n"); grid = -1; return; }
        if (hipOccupancyMaxActiveBlocksPerMultiprocessor(&per_cu, (const void*)fwd_megakernel, 512, LDS_BYTES) != hipSuccess || per_cu < 1) per_cu = 1;
        (void)hipGetLastError();
        grid = cus * per_cu;
    }
    if (grid < 0) return;
    Args a{};
    for (int i = 0; i < 23; ++i) a.in[i] = (const float*)d_in[i];
    a.in[23] = (const float*)d_out; a.in[24] = (const float*)d_ws; a.ph_lo = 0; a.ph_hi = 32;
    void* args[] = {&a};
    hipError_t e = hipLaunchCooperativeKernel((const void*)fwd_megakernel, dim3(grid), dim3(512), args, LDS_BYTES, stream);
    if (e != hipSuccess) fprintf(stderr, "cooperative launch failed: %s (grid %d)\n", hipGetErrorString(e), grid);
}
```

```cpp
#include <hip/hip_runtime.h>
#include <hip/hip_cooperative_groups.h>
#include <cstdio>
#include <cstdint>
namespace cg = cooperative_groups;
__device__ __forceinline__ int lane_id_() { return (int)__builtin_amdgcn_mbcnt_hi(~0u, __builtin_amdgcn_mbcnt_lo(~0u, 0u)); }
namespace pg8 {
#define PG8_LAS __attribute__((address_space(3)))
typedef unsigned short bf16_t;
typedef short bf16x8 __attribute__((ext_vector_type(8)));
typedef float f32x4 __attribute__((ext_vector_type(4)));
typedef unsigned u32x4 __attribute__((ext_vector_type(4)));
constexpr int BM = 256, BK = 64, HALF = 128, HTB = HALF * BK * 2  , STAGE_BYTES = 8 * HTB, NXCD = 8, WGM = 8;

__host__ __device__ __forceinline__ int lds_byte(int r, int c) { const int st = (r >> 4) * 2 + (c >> 5), rr = r & 15, cc = c & 31, ob = rr * 64 + cc * 2; return st * 1024 + (ob ^ (((ob >> 9) & 1) << 5)); }
__host__ __device__ __forceinline__ void stage_rc(int b, int& R, int& C) { const int st = b / 1024, sb = b % 1024, swz = sb ^ (((sb >> 9) & 1) << 5); R = (st >> 1) * 16 + swz / 64; C = (st & 1) * 32 + (swz % 64) / 2; }
__host__ __device__ __forceinline__ int perm32(int rho) { const int n = rho >> 4, i = rho & 15; return 8 * (i >> 2) + 4 * n + (i & 3); }

struct Unit { int pm, pn; };
struct Gemm { const bf16_t* A; const bf16_t* Bt; int M, N, K, lda; };

struct StaticOrder {
    int nM, nN, nwg, G, c;
    __host__ __device__ void init(int M, int N, int G_, int c_) { nM = M / BM; nN = N / BM; nwg = nM * nN; G = G_; c = c_; }
    __host__ __device__ bool next(int i, Unit& u) const {
        const long L = (long)i * G + c; if (L >= nwg) return false;
        int wgid = (int)L; { const int q = nwg / NXCD, r = nwg % NXCD, xcd = wgid % NXCD, off = wgid / NXCD; wgid = (xcd < r ? xcd * (q + 1) : r * (q + 1) + (xcd - r) * q) + off; }
        const int nig = WGM * nN, gid = wgid / nig, fm = gid * WGM, gsz = (nM - fm) < WGM ? (nM - fm) : WGM;
        u.pm = fm + ((wgid % nig) % gsz); u.pn = (wgid % nig) / gsz; return true;
    }
    __device__ __forceinline__ void a_ready(const Unit&) const {}
    __device__ __forceinline__ void done(const Unit&) const {}
};

__device__ __forceinline__ unsigned cvt_pk_bf16(float lo, float hi) { unsigned r; asm volatile("v_cvt_pk_bf16_f32 %0, %1, %2" : "=v"(r) : "v"(lo), "v"(hi)); return r; }
typedef float f32x2 __attribute__((ext_vector_type(2)));
template <class Epi, class Sched, bool ALIGN_EPI = false, bool SP2 = false>
__device__ __forceinline__ void gemm_phase(PG8_LAS unsigned char* lds, const Gemm g, const Sched& S, const Epi& E, const int wave_id) {
    int tid_ = wave_id * 64 + lane_id_(); asm volatile("" : "+v"(tid_));
    const int tid = tid_, wid = __builtin_amdgcn_readfirstlane(tid >> 6), lane = tid & 63, wr = wid >> 2, wc = wid & 3, fr = lane & 15, fq = lane >> 4;
    const int K = g.K, nt = K / BK;
    unsigned voffA[2], voffB[2];
#pragma unroll
    for (int i = 0; i < 2; ++i) { int R, C; stage_rc(tid * 16 + i * 8192, R, C); const int Rb = Epi::PERM ? ((R & ~31) + perm32(R & 31)) : R;
        voffA[i] = (unsigned)(R * g.lda + C) * 2u; voffB[i] = (unsigned)(Rb * K + C) * 2u; }
    const size_t kstep = (size_t)(BK * 2);
    const size_t hstepA = (size_t)HALF * g.lda * 2, hstepB = (size_t)HALF * K * 2;
    const size_t tstepA = 2 * hstepA, tstepB = 2 * hstepB;
    const unsigned ldsw = (unsigned)wid * 1024u;
    const int aoff = lds_byte(wr * 64 + fr, fq * 8), boff = lds_byte(wc * 32 + fr, fq * 8);
#define PG8_SA(b, h) (((b) * 2 + (h)) * HTB)
#define PG8_SB(b, h) ((4 + (b) * 2 + (h)) * HTB)
#define PG8_STAGE(bufoff, gbase, voff) do { _Pragma("unroll") for (int _i = 0; _i < 2; ++_i) \
        __builtin_amdgcn_global_load_lds((const unsigned*)((const char*)(gbase) + (voff)[_i]), (PG8_LAS unsigned*)(lds + (bufoff) + ldsw + _i * 8192), 16, 0, 0); } while (0)
#define PG8_LDA(dst, b, h) do { _Pragma("unroll") for (int m = 0; m < 4; ++m) _Pragma("unroll") for (int k = 0; k < 2; ++k) dst[m][k] = *(const PG8_LAS bf16x8*)(lds + PG8_SA(b, h) + aoff + m * 2048 + k * 1024); } while (0)
#define PG8_LDB(dst, b, h) do { _Pragma("unroll") for (int n = 0; n < 2; ++n) _Pragma("unroll") for (int k = 0; k < 2; ++k) dst[n][k] = *(const PG8_LAS bf16x8*)(lds + PG8_SB(b, h) + boff + n * 2048 + k * 1024); } while (0)
#define PG8_MMA(ai, bj, At, Bt) do { __builtin_amdgcn_s_setprio(1); _Pragma("unroll") for (int m = 0; m < 4; ++m) _Pragma("unroll") for (int n = 0; n < 2; ++n) _Pragma("unroll") for (int k = 0; k < 2; ++k) \
        acc[ai][bj][m][n] = __builtin_amdgcn_mfma_f32_16x16x32_bf16(Bt[n][k], At[m][k], acc[ai][bj][m][n], 0, 0, 0); __builtin_amdgcn_s_setprio(0); } while (0)
#define PG8_WAIT_V(n) asm volatile("s_waitcnt vmcnt(" #n ")" ::: "memory")
#define PG8_WAIT_L(n) asm volatile("s_waitcnt lgkmcnt(" #n ")" ::: "memory")
#define PG8_BAR __builtin_amdgcn_s_barrier()
#define PG8_SCHED __builtin_amdgcn_sched_barrier(0)
    Unit cur, nxt; int ui = 0;
    if (!S.next(0, cur)) return;
    f32x4 acc[2][2][4][2];
#pragma unroll
    for (int a = 0; a < 2; ++a)
#pragma unroll
        for (int b = 0; b < 2; ++b)
#pragma unroll
            for (int m = 0; m < 4; ++m)
#pragma unroll
                for (int n = 0; n < 2; ++n) acc[a][b][m][n] = (f32x4){0.f, 0.f, 0.f, 0.f};
    bf16x8 At[4][2], B0[2][2], B1[2][2];
    const char* cA = (const char*)g.A + (size_t)cur.pm * tstepA; const char* cB = (const char*)g.Bt + (size_t)cur.pn * tstepB;
    S.a_ready(cur);
    if constexpr (Epi::HAS_PF) E.prefetch(cur, tid);
    if constexpr (SP2) {
        PG8_STAGE(PG8_SB(0, 0), cB, voffB); PG8_STAGE(PG8_SB(0, 1), cB + hstepB, voffB); PG8_STAGE(PG8_SA(0, 0), cA, voffA); PG8_STAGE(PG8_SA(0, 1), cA + hstepA, voffA);
        if (wr == 1) PG8_BAR;
        PG8_WAIT_V(2); PG8_BAR;
        PG8_STAGE(PG8_SB(1, 0), cB + kstep, voffB); PG8_STAGE(PG8_SA(1, 0), cA + kstep, voffA); PG8_STAGE(PG8_SB(1, 1), cB + hstepB + kstep, voffB);
        PG8_WAIT_V(6); PG8_BAR;
    } else {
        PG8_STAGE(PG8_SB(0, 0), cB, voffB); PG8_STAGE(PG8_SA(0, 0), cA, voffA); PG8_STAGE(PG8_SB(0, 1), cB + hstepB, voffB); PG8_STAGE(PG8_SA(0, 1), cA + hstepA, voffA);
        if (wr == 1) PG8_BAR;
        PG8_WAIT_V(4); PG8_BAR;
        PG8_STAGE(PG8_SB(1, 0), cB + kstep, voffB); PG8_STAGE(PG8_SA(1, 0), cA + kstep, voffA); PG8_STAGE(PG8_SB(1, 1), cB + hstepB + kstep, voffB);
        PG8_WAIT_V(6); PG8_BAR;
    }
    for (;;) {
        const bool has_next = S.next(ui + 1, nxt);
        const char* nA = has_next ? (const char*)g.A + (size_t)nxt.pm * tstepA : cA; const char* nB = has_next ? (const char*)g.Bt + (size_t)nxt.pn * tstepB : cB;
        for (int t = 0; t < nt; t += 2) {
            const bool last = (t == nt - 2);
            if constexpr (Epi::HAS_WARM) { if (t == nt - 8) E.warm(cur, wid, lane, lds + 141312); }
            const char* a1 = cA + (size_t)(t + 1) * kstep;
            const char* a2 = last ? nA : cA + (size_t)(t + 2) * kstep; const char* b2 = last ? nB : cB + (size_t)(t + 2) * kstep;
            const char* a3 = a2 + kstep; const char* b3 = b2 + kstep;
            if (last && has_next) S.a_ready(nxt);
            if constexpr (SP2) {
            PG8_LDB(B0, 0, 0); PG8_LDB(B1, 0, 1); PG8_SCHED; PG8_LDA(At, 0, 0); PG8_STAGE(PG8_SA(1, 1), a1 + hstepA, voffA);
            PG8_WAIT_V(8); PG8_WAIT_L(0); PG8_BAR; PG8_MMA(0, 0, At, B0); PG8_MMA(0, 1, At, B1); PG8_BAR; PG8_SCHED;
            PG8_LDA(At, 0, 1); PG8_STAGE(PG8_SB(0, 0), b2, voffB); PG8_STAGE(PG8_SB(0, 1), b2 + hstepB, voffB); PG8_STAGE(PG8_SA(0, 0), a2, voffA);
            PG8_WAIT_V(8); PG8_WAIT_L(0); PG8_BAR; PG8_MMA(1, 0, At, B0); PG8_MMA(1, 1, At, B1); PG8_BAR; PG8_SCHED;
            PG8_LDB(B0, 1, 0); PG8_LDB(B1, 1, 1); PG8_SCHED; PG8_LDA(At, 1, 0); PG8_STAGE(PG8_SA(0, 1), a2 + hstepA, voffA);
            PG8_WAIT_V(8); PG8_WAIT_L(0); PG8_BAR; PG8_MMA(0, 0, At, B0); PG8_MMA(0, 1, At, B1); PG8_BAR; PG8_SCHED;
            PG8_LDA(At, 1, 1); PG8_STAGE(PG8_SB(1, 0), b3, voffB); PG8_STAGE(PG8_SB(1, 1), b3 + hstepB, voffB); PG8_STAGE(PG8_SA(1, 0), a3, voffA);
            PG8_WAIT_V(8); PG8_WAIT_L(0); PG8_BAR; PG8_MMA(1, 0, At, B0); PG8_MMA(1, 1, At, B1); PG8_BAR; PG8_SCHED;
            } else {
            PG8_LDB(B0, 0, 0); PG8_SCHED; PG8_LDA(At, 0, 0); PG8_STAGE(PG8_SA(1, 1), a1 + hstepA, voffA);
            PG8_WAIT_L(8); PG8_BAR; PG8_WAIT_L(0); PG8_MMA(0, 0, At, B0); PG8_BAR; PG8_SCHED;
            PG8_LDB(B1, 0, 1); PG8_STAGE(PG8_SB(0, 0), b2, voffB);
            PG8_BAR; PG8_WAIT_L(0); PG8_MMA(0, 1, At, B1); PG8_BAR;
            PG8_LDA(At, 0, 1); PG8_STAGE(PG8_SA(0, 0), a2, voffA);
            PG8_BAR; PG8_WAIT_L(0); PG8_MMA(1, 0, At, B0); PG8_BAR; PG8_SCHED;
            PG8_STAGE(PG8_SB(0, 1), b2 + hstepB, voffB);
            PG8_WAIT_V(6); PG8_BAR; PG8_MMA(1, 1, At, B1); PG8_BAR;
            PG8_LDB(B0, 1, 0); PG8_SCHED; PG8_LDA(At, 1, 0); PG8_STAGE(PG8_SA(0, 1), a2 + hstepA, voffA);
            PG8_WAIT_L(8); PG8_BAR; PG8_WAIT_L(0); PG8_MMA(0, 0, At, B0); PG8_BAR; PG8_SCHED;
            PG8_LDB(B1, 1, 1); PG8_STAGE(PG8_SB(1, 0), b3, voffB);
            PG8_BAR; PG8_WAIT_L(0); PG8_MMA(0, 1, At, B1); PG8_BAR;
            PG8_LDA(At, 1, 1); PG8_STAGE(PG8_SA(1, 0), a3, voffA);
            PG8_BAR; PG8_WAIT_L(0); PG8_MMA(1, 0, At, B0); PG8_BAR; PG8_SCHED;
            PG8_STAGE(PG8_SB(1, 1), b3 + hstepB, voffB);
            PG8_WAIT_V(6); PG8_BAR; PG8_MMA(1, 1, At, B1); PG8_BAR;
            }
        }
        if constexpr (ALIGN_EPI) { if (wr == 0) PG8_BAR; }
        if constexpr (!Epi::AFTER_DRAIN) { E(acc, cur, wr, wc, fr, fq); S.done(cur); }
        if (!has_next) break;
#pragma unroll
        for (int a = 0; a < 2; ++a)
#pragma unroll
            for (int b = 0; b < 2; ++b)
#pragma unroll
                for (int m = 0; m < 4; ++m)
#pragma unroll
                    for (int n = 0; n < 2; ++n) acc[a][b][m][n] = (f32x4){0.f, 0.f, 0.f, 0.f};
        cur = nxt; cA = nA; cB = nB; ++ui;
        if constexpr (Epi::HAS_PF) E.prefetch(cur, tid);
        if constexpr (ALIGN_EPI) { if (wr == 1) PG8_BAR; }
    }
    PG8_WAIT_V(0);
    if constexpr (!ALIGN_EPI) { if (wr == 0) PG8_BAR; }
    PG8_BAR;
    if constexpr (Epi::AFTER_DRAIN) { E.fused(acc, cur, wr, wc, fr, fq, lds, wid, lane); S.done(cur); }
#undef PG8_SA
#undef PG8_SB
#undef PG8_STAGE
#undef PG8_LDA
#undef PG8_LDB
#undef PG8_MMA
#undef PG8_WAIT_V
#undef PG8_WAIT_L
#undef PG8_BAR
#undef PG8_SCHED
}
}
#define LAS __attribute__((address_space(3)))
typedef unsigned short bf16;
typedef float f32x4 __attribute__((ext_vector_type(4)));
typedef float f32x16 __attribute__((ext_vector_type(16)));
typedef short bf16x8 __attribute__((ext_vector_type(8)));
typedef short s16x4 __attribute__((ext_vector_type(4)));
typedef unsigned u32x4 __attribute__((ext_vector_type(4)));
typedef unsigned u32x2 __attribute__((ext_vector_type(2)));
typedef float f32x2_t __attribute__((ext_vector_type(2)));
typedef __bf16 bf16x2_t __attribute__((ext_vector_type(2)));

constexpr int D = 1024, MP = 65536, MS = 2048, M = MP + MS, DFF = 4096;
constexpr int LDP = 6144, NPROJ = 6176, NPROJ_PAD = 6400;
constexpr float ALPHA = 1.6817928305074290f, LN_EPS = 1e-5f, RMS_EPS = 1e-5f, LOG2E = 1.4426950408889634f;
constexpr size_t O_KP = 69206016, O_VP = 102760448, O_HP = 136314880, O_CP = 153092096, O_KS = 153878528, O_VS = 158072832, O_HS = 162267136, O_CS = 179044352;
constexpr size_t MiB = 1u << 20;
constexpr size_t WS_WA = 1 * MiB, WS_WB = 14 * MiB, WS_WUP = 18 * MiB, WS_WDN = 26 * MiB, WS_XB = 34 * MiB, WS_DT = 166 * MiB, WS_BIG = 175 * MiB;
constexpr size_t WS_O = WS_BIG + 396 * MiB, WS_CK = WS_BIG + 528 * MiB, WS_CV = WS_BIG + 560 * MiB, WS_END = WS_BIG + 792 * MiB;
constexpr size_t WS_AUX = WS_END, WS_ST0 = WS_AUX, WS_ST1 = WS_AUX + 2304 * 1024, WS_CSA = WS_AUX + 4608 * 1024, WS_BWA = WS_CSA + 32 * 1024, WS_CSU = WS_CSA + 64 * 1024, WS_BWU = WS_CSA + 80 * 1024, WS_MR0 = WS_AUX + 4736 * 1024, WS_MR1 = WS_AUX + 5312 * 1024, WS_WDN1 = WS_AUX + 6 * MiB, WS_END2 = WS_AUX + 14 * MiB;
constexpr float FXS = 1048576.f, FXI = 1.f / 1048576.f;
typedef long long i64x2_t __attribute__((ext_vector_type(2)));
constexpr int LDS_BYTES = 147456;

__device__ __forceinline__ unsigned pk2(float lo, float hi) { f32x2_t v = {lo, hi}; bf16x2_t b = __builtin_convertvector(v, bf16x2_t); return __builtin_bit_cast(unsigned, b); }
__device__ __forceinline__ float bf2f(unsigned short u) { return __uint_as_float((unsigned)u << 16); }
__device__ __forceinline__ float bflo(unsigned u) { return __uint_as_float(u << 16); }
__device__ __forceinline__ float bfhi(unsigned u) { return __uint_as_float(u & 0xffff0000u); }
__device__ __forceinline__ float fexp2(float x) { return __builtin_amdgcn_exp2f(x); }
__device__ __forceinline__ float frcp(float x) { return __builtin_amdgcn_rcpf(x); }
__device__ __forceinline__ float silu_f(float v) { return v * frcp(1.0f + fexp2(-v * LOG2E)); }
__device__ __forceinline__ int crow(int r, int hi) { return (r & 3) + 8 * (r >> 2) + 4 * hi; }
__device__ __forceinline__ bf16x8 pack8(const f32x16& x, int s) {
    u32x4 p; p.x = pk2(x[8 * s], x[8 * s + 1]); p.y = pk2(x[8 * s + 2], x[8 * s + 3]); p.z = pk2(x[8 * s + 4], x[8 * s + 5]); p.w = pk2(x[8 * s + 6], x[8 * s + 7]);
    return __builtin_bit_cast(bf16x8, p);
}
#define MFMA32(a, b, c) __builtin_amdgcn_mfma_f32_32x32x16_bf16((a), (b), (c), 0, 0, 0)
__device__ __forceinline__ float wave_sum(float v) {
#pragma unroll
    for (int o = 1; o < 64; o <<= 1) v += __shfl_xor(v, o);
    return v;
}

namespace pg8 {
struct RowNorm {
    const float* st; const float* cs; const float* bw; float* mr_out;
    PG8_LAS float* T;
    float mu[2][4], rs[2][4]; f32x4 c[2][2], b[2][2];
    __device__ __forceinline__ void load(const Unit& u, int wr, int wc, int fr, int fq, const f32x4 pfa, const f32x4 pfb) {
        if (!st) return;
        const int tid = (wr * 4 + wc) * 64 + fq * 16 + fr;
        if (tid < 256) { const float mean = ((pfa[0] + pfa[2]) + (pfb[0] + pfb[2])) * (1.f / 1024.f), var = ((pfa[1] + pfa[3]) + (pfb[1] + pfb[3])) * (1.f / 1024.f) - mean * mean;
            const f32x2_t mrv = {mean, 1.0f / sqrtf(var + LN_EPS)};
            *(PG8_LAS f32x2_t*)(T + 2 * tid) = mrv;
            if (mr_out && u.pn == 0) *(f32x2_t*)(mr_out + 2 * (unsigned)(u.pm * BM + tid)) = mrv; }
        PG8_LAS float* CB = T + 1024;
        if (tid >= 256 && tid < 320) { const int t4 = 4 * (tid - 256); const f32x4 cc = *(const f32x4*)(cs + u.pn * BM + t4), bb = *(const f32x4*)(bw + u.pn * BM + t4);
            *(PG8_LAS f32x4*)(CB + t4) = cc; *(PG8_LAS f32x4*)(CB + 256 + t4) = bb; }
        asm volatile("s_waitcnt lgkmcnt(0)" ::: "memory"); __builtin_amdgcn_s_barrier(); asm volatile("" ::: "memory");
        const int cl = wc * 32 + 8 * fq;
#pragma unroll
        for (int bj = 0; bj < 2; ++bj)
#pragma unroll
            for (int n = 0; n < 2; ++n) { c[bj][n] = *(const PG8_LAS f32x4*)(CB + cl + bj * HALF + 4 * n); b[bj][n] = *(const PG8_LAS f32x4*)(CB + 256 + cl + bj * HALF + 4 * n); }
#pragma unroll
        for (int ai = 0; ai < 2; ++ai)
#pragma unroll
            for (int m = 0; m < 4; ++m) { const f32x2_t v = *(const PG8_LAS f32x2_t*)(T + 2 * (ai * HALF + wr * 64 + m * 16 + fr)); mu[ai][m] = v.x; rs[ai][m] = v.y; }
    }
    __device__ __forceinline__ f32x4 apply(const f32x4 a, int ai, int m, int bj, int n) const { return st ? (a - c[bj][n] * mu[ai][m]) * rs[ai][m] + b[bj][n] : a; }
};
#define PG8_PF_MEMBERS mutable f32x4 pfa, pfb; static constexpr bool HAS_PF = true, HAS_WARM = false; \
    __device__ __forceinline__ void prefetch(const Unit& u, int tid) const { if (st && tid < 256) { const float* sp = st + 8 * (unsigned)(u.pm * BM + tid); pfa = *(const f32x4*)sp; pfb = *(const f32x4*)(sp + 4); } }
struct EpiQKV {
    static constexpr bool PERM = true, AFTER_DRAIN = false;
    bf16_t* QKV; float* out; int li; const float* st; const float* cs; const float* bw; float* mr_out; PG8_LAS float* T; PG8_PF_MEMBERS
    __device__ __forceinline__ void operator()(const f32x4 (&acc)[2][2][4][2], const Unit& u, int wr, int wc, int fr, int fq) const {
        asm volatile("" : "+v"(fr));
        RowNorm rn; rn.st = st; rn.cs = cs; rn.bw = bw; rn.mr_out = mr_out; rn.T = T; rn.load(u, wr, wc, fr, fq, pfa, pfb);
        float* fdst = nullptr;
        if (u.pn >= 4) {
            const bool isv = u.pn >= 8;
            if (u.pm < 256) { const int b = u.pm >> 3, tt = u.pm & 7; if (tt >= 6) fdst = out + (isv ? O_VP : O_KP) + ((size_t)(li * 32 + b) * 512 + (size_t)(tt - 6) * 256) * 1024; }
            else fdst = out + (isv ? O_VS : O_KS) + ((size_t)li * 2048 + (size_t)(u.pm - 256) * 256) * 1024;
        }
        const int col0 = u.pn * BM + wc * 32 + 8 * fq, colk = (u.pn & 3) * BM + wc * 32 + 8 * fq;
#pragma unroll
        for (int ai = 0; ai < 2; ++ai)
#pragma unroll
            for (int m = 0; m < 4; ++m) { const int rl = ai * HALF + wr * 64 + m * 16 + fr; bf16_t* rowp = QKV + (unsigned)((u.pm * BM + rl) * 3072 + col0);
#pragma unroll
                for (int bj = 0; bj < 2; ++bj) { const f32x4 v0 = rn.apply(acc[ai][bj][m][0], ai, m, bj, 0), v1 = rn.apply(acc[ai][bj][m][1], ai, m, bj, 1);
                    u32x4 w; w.x = pk2(v0[0], v0[1]); w.y = pk2(v0[2], v0[3]); w.z = pk2(v1[0], v1[1]); w.w = pk2(v1[2], v1[3]);
                    *(u32x4*)(rowp + bj * HALF) = w;
                    if (fdst) { float* fp = fdst + (unsigned)(rl * 1024 + colk + bj * HALF); *(f32x4*)fp = v0; *(f32x4*)(fp + 4) = v1; } }
                asm volatile("" ::: "memory"); }
    }
};
struct EpiBf16Plain {
    static constexpr bool PERM = true, AFTER_DRAIN = false;
    bf16_t* O; int ldc; int relu2; const float* st; const float* cs; const float* bw; float* mr_out; PG8_LAS float* T; PG8_PF_MEMBERS
    __device__ __forceinline__ void operator()(const f32x4 (&acc)[2][2][4][2], const Unit& u, int wr, int wc, int fr, int fq) const {
        asm volatile("" : "+v"(fr));
        RowNorm rn; rn.st = st; rn.cs = cs; rn.bw = bw; rn.mr_out = mr_out; rn.T = T; rn.load(u, wr, wc, fr, fq, pfa, pfb);
        const int col0 = u.pn * BM + wc * 32 + 8 * fq;
#pragma unroll
        for (int ai = 0; ai < 2; ++ai)
#pragma unroll
            for (int m = 0; m < 4; ++m) { const int rl = ai * HALF + wr * 64 + m * 16 + fr; bf16_t* rowp = O + (unsigned)((u.pm * BM + rl) * ldc + col0);
#pragma unroll
                for (int bj = 0; bj < 2; ++bj) { f32x4 v0 = rn.apply(acc[ai][bj][m][0], ai, m, bj, 0), v1 = rn.apply(acc[ai][bj][m][1], ai, m, bj, 1);
                    if (relu2) { v0 = __builtin_elementwise_max(v0, (f32x4){0.f, 0.f, 0.f, 0.f}); v1 = __builtin_elementwise_max(v1, (f32x4){0.f, 0.f, 0.f, 0.f}); v0 = v0 * v0; v1 = v1 * v1; }
                    u32x4 w; w.x = pk2(v0[0], v0[1]); w.y = pk2(v0[2], v0[3]); w.z = pk2(v1[0], v1[1]); w.w = pk2(v1[2], v1[3]);
                    *(u32x4*)(rowp + bj * HALF) = w; } }
    }
};
struct EpiSsmIn {
    static constexpr bool PERM = true, AFTER_DRAIN = false;
    bf16_t* P; float* DT; const float* st; const float* cs; const float* bw; float* mr_out; PG8_LAS float* T; PG8_PF_MEMBERS
    __device__ __forceinline__ void operator()(const f32x4 (&acc)[2][2][4][2], const Unit& u, int wr, int wc, int fr, int fq) const {
        asm volatile("" : "+v"(fr));
        RowNorm rn; rn.st = st; rn.cs = cs; rn.bw = bw; rn.mr_out = mr_out; rn.T = T; rn.load(u, wr, wc, fr, fq, pfa, pfb);
        if (u.pn < 24) {
            const int col0 = u.pn * BM + wc * 32 + 8 * fq;
#pragma unroll
            for (int ai = 0; ai < 2; ++ai)
#pragma unroll
                for (int m = 0; m < 4; ++m) { const int rl = ai * HALF + wr * 64 + m * 16 + fr; bf16_t* rowp = P + (unsigned)((u.pm * BM + rl) * LDP + col0);
#pragma unroll
                    for (int bj = 0; bj < 2; ++bj) { const f32x4 v0 = rn.apply(acc[ai][bj][m][0], ai, m, bj, 0), v1 = rn.apply(acc[ai][bj][m][1], ai, m, bj, 1);
                        u32x4 w; w.x = pk2(v0[0], v0[1]); w.y = pk2(v0[2], v0[3]); w.z = pk2(v1[0], v1[1]); w.w = pk2(v1[2], v1[3]);
                        *(u32x4*)(rowp + bj * HALF) = w; }
                    asm volatile("" ::: "memory"); }
        } else if (wc == 0) {
#pragma unroll
            for (int ai = 0; ai < 2; ++ai)
#pragma unroll
                for (int m = 0; m < 4; ++m) { const int rl = ai * HALF + wr * 64 + m * 16 + fr; float* fp = DT + (unsigned)((u.pm * BM + rl) * 32 + 8 * fq);
                    *(f32x4*)fp = rn.apply(acc[ai][0][m][0], ai, m, 0, 0); *(f32x4*)(fp + 4) = rn.apply(acc[ai][0][m][1], ai, m, 0, 1); }
        }
    }
};
struct EpiResid {
    static constexpr bool PERM = true, AFTER_DRAIN = false, HAS_PF = false, HAS_WARM = false;
    __device__ __forceinline__ void warm(const Unit& u, int wid, int lane, PG8_LAS unsigned char* dummy) const {
#pragma unroll
        for (int i = 0; i < 2; ++i) { const int line = wid * 128 + i * 64 + lane, row = line >> 2, seg = line & 3;
            const char* gp = (const char*)XB + ((size_t)(unsigned)((u.pm * BM + row) * D + u.pn * BM)) * 2 + seg * 128;
            __builtin_amdgcn_global_load_lds((const unsigned*)gp, (PG8_LAS unsigned*)(dummy + wid * 256), 4, 0, 0); }
    }
    bf16_t* XB; const float* st_in; const float* gin; const float* bin; float* st_out; PG8_LAS float* P;
    static constexpr int DEPTH = 1;
    __device__ __forceinline__ void operator()(const f32x4 (&acc)[2][2][4][2], const Unit& u, int wr, int wc, int fr, int fq) const {
        asm volatile("" : "+v"(fr));
        const int col0 = u.pn * BM + wc * 32 + 8 * fq;
        const unsigned rowb0 = (unsigned)(u.pm * BM + wr * 64 + fr);
        PG8_LAS float* GB = P + 3072;
        { const int tid_ = (wr * 4 + wc) * 64 + fq * 16 + fr;
          if (st_in && tid_ < 64) { const f32x4 gg = *(const f32x4*)(gin + u.pn * BM + 4 * tid_), bb = *(const f32x4*)(bin + u.pn * BM + 4 * tid_);
              *(PG8_LAS f32x4*)(GB + 4 * tid_) = gg; *(PG8_LAS f32x4*)(GB + 256 + 4 * tid_) = bb; } }
        if (st_in) { asm volatile("s_waitcnt lgkmcnt(0)" ::: "memory"); __builtin_amdgcn_s_barrier(); asm volatile("" ::: "memory"); }
        const int cl = wc * 32 + 8 * fq;
#pragma unroll
        for (int ai = 0; ai < 2; ++ai) {
            u32x4 xv[4][2]; f32x2_t mr[4];
#pragma unroll
            for (int m = 0; m < 4; ++m) { const unsigned row_ = rowb0 + (unsigned)(ai * HALF + m * 16); const bf16_t* rp_ = XB + row_ * D + col0;
                xv[m][0] = *(const u32x4*)rp_; xv[m][1] = *(const u32x4*)(rp_ + HALF);
                if (st_in) mr[m] = *(const f32x2_t*)(st_in + 2 * row_); else mr[m] = (f32x2_t){0.f, 1.f}; }
            asm volatile("" ::: "memory");
#pragma unroll
            for (int m = 0; m < 4; ++m) {
                const unsigned row = rowb0 + (unsigned)(ai * HALF + m * 16);
                bf16_t* rowb = XB + row * D + col0;
                float mean = 0.f, rstd = 1.f;
                if (st_in) { mean = mr[m].x; rstd = mr[m].y; }
                float s1 = 0.f, s2 = 0.f;
#pragma unroll
                for (int bj = 0; bj < 2; ++bj) {
                    const u32x4 xw = xv[m][bj];
                    f32x4 x0 = (f32x4){bflo(xw.x), bfhi(xw.x), bflo(xw.y), bfhi(xw.y)}, x1 = (f32x4){bflo(xw.z), bfhi(xw.z), bflo(xw.w), bfhi(xw.w)};
                    if (st_in) { int c_ = cl + bj * HALF; asm volatile("" : "+v"(c_));
                        const f32x4 g0 = *(const PG8_LAS f32x4*)(GB + c_), g1 = *(const PG8_LAS f32x4*)(GB + c_ + 4), b0 = *(const PG8_LAS f32x4*)(GB + 256 + c_), b1 = *(const PG8_LAS f32x4*)(GB + 256 + c_ + 4);
                        x0 = (x0 - mean) * rstd * g0 + b0; x1 = (x1 - mean) * rstd * g1 + b1; }
                    const f32x4 v0 = x0 * ALPHA + acc[ai][bj][m][0], v1 = x1 * ALPHA + acc[ai][bj][m][1];
                    u32x4 w; w.x = pk2(v0[0], v0[1]); w.y = pk2(v0[2], v0[3]); w.z = pk2(v1[0], v1[1]); w.w = pk2(v1[2], v1[3]); *(u32x4*)(rowb + bj * HALF) = w;
                    s1 += ((v0[0] + v0[1]) + (v0[2] + v0[3])) + ((v1[0] + v1[1]) + (v1[2] + v1[3]));
                    s2 += ((v0[0] * v0[0] + v0[1] * v0[1]) + (v0[2] * v0[2] + v0[3] * v0[3])) + ((v1[0] * v1[0] + v1[1] * v1[1]) + (v1[2] * v1[2] + v1[3] * v1[3])); }
                s1 += __shfl_xor(s1, 16); s2 += __shfl_xor(s2, 16); s1 += __shfl_xor(s1, 32); s2 += __shfl_xor(s2, 32);
                if (fq == 0) *(PG8_LAS f32x2_t*)(P + ((ai * HALF + wr * 64 + m * 16 + fr) * 4 + wc) * 2) = (f32x2_t){s1, s2};
            }
            asm volatile("" ::: "memory");
        }
        asm volatile("s_waitcnt lgkmcnt(0)" ::: "memory"); __builtin_amdgcn_s_barrier(); asm volatile("" ::: "memory");
        const int tid = (wr * 4 + wc) * 64 + fq * 16 + fr;
        if (tid < 256) { const f32x4 qa = *(const PG8_LAS f32x4*)(P + tid * 8), qb = *(const PG8_LAS f32x4*)(P + tid * 8 + 4);
            *(f32x2_t*)(st_out + 8 * (unsigned)(u.pm * BM + tid) + 2 * u.pn) = (f32x2_t){(qa[0] + qa[2]) + (qb[0] + qb[2]), (qa[1] + qa[3]) + (qb[1] + qb[3])}; }
    }
};
}
#define XB_TMO      128
#define XB_XCNT(j)  (256  + 64 * (j))
#define XB_XSUB(j)  (1280 + 64 * (j))
#define XB_XGEN(j)  (2304 + 64 * (j))
#define XB_TOP      3328
#define XB_TOPGEN   3392
#define XCD_BAR_WORDS 3456
#define XB_SPIN_CAP (1u << 18)

__device__ __forceinline__ unsigned xb_ld(unsigned* p)              { return __hip_atomic_load(p, __ATOMIC_RELAXED, __HIP_MEMORY_SCOPE_AGENT); }
__device__ __forceinline__ unsigned xb_add(unsigned* p, unsigned v) { return __hip_atomic_fetch_add(p, v, __ATOMIC_RELAXED, __HIP_MEMORY_SCOPE_AGENT); }
__device__ __forceinline__ unsigned xb_xcc_id() { return (unsigned)__builtin_amdgcn_s_getreg((3 << 11) | 20) & 0xFu; }
#define XB_SPIN(cond, bar) do { unsigned _sp = 0; while (cond) { __builtin_amdgcn_s_sleep(1); \
    if ((++_sp & 255u) == 0u) { if (xb_ld(&(bar)[XB_TMO])) break; if (_sp > XB_SPIN_CAP) { atomicAdd(&(bar)[XB_TMO], 1u); break; } } } } while (0)

struct XcdBarrier {
    int w0;
    unsigned* bar; unsigned x;
    volatile LAS unsigned* st;
};

__device__ __forceinline__ XcdBarrier xcd_barrier_post(unsigned* bar, volatile LAS unsigned* st) {
    XcdBarrier b; b.bar = bar; b.x = xb_xcc_id(); b.st = st;
    if (threadIdx.x == 0) (void)xb_add(&bar[XB_XCNT(b.x)], 1u);
    return b;
}
__device__ __forceinline__ void xcd_barrier_complete(unsigned* bar, unsigned x, unsigned& nloc, unsigned& nx) {
    const unsigned G = gridDim.x * gridDim.y * gridDim.z;
    unsigned sum, cnt, mine, sp = 0u;
    for (;;) {
        sum = 0u; cnt = 0u; mine = 0u;
#pragma unroll
        for (unsigned j = 0; j < 16; ++j) { const unsigned c = xb_ld(&bar[XB_XCNT(j)]); sum += c; cnt += (c > 0u) ? 1u : 0u; mine = (j == x) ? c : mine; }
        if (sum == G) break;
        __builtin_amdgcn_s_sleep(1);
        if ((++sp & 255u) == 0u) { if (xb_ld(&bar[XB_TMO])) break; if (sp > XB_SPIN_CAP) { atomicAdd(&bar[XB_TMO], 1u); break; } }
    }
    nloc = mine > 0u ? mine : 1u; nx = cnt > 0u ? cnt : 1u;
}

__device__ __forceinline__ void xcd_barrier(const XcdBarrier& b) {
    asm volatile("s_waitcnt vmcnt(0)" ::: "memory");
    __syncthreads();
    if (b.w0 == 0 && lane_id_() == 0) {
        unsigned* bar = b.bar;
        __builtin_amdgcn_s_waitcnt(0);
        unsigned nloc = b.st[0], nx = b.st[1];
        if (nloc == 0u) { xcd_barrier_complete(bar, b.x, nloc, nx); b.st[0] = nloc; b.st[1] = nx; }
        const unsigned old = xb_add(&bar[XB_XSUB(b.x)], 1u);
        const unsigned gen = old / nloc;
        if (old + 1u == (gen + 1u) * nloc) {
            __builtin_amdgcn_fence(__ATOMIC_RELEASE, "agent");
            asm volatile("s_waitcnt vmcnt(0)" ::: "memory");
            const unsigned og = xb_add(&bar[XB_TOP], 1u);
            const unsigned tg = og / nx;
            if (og + 1u == (tg + 1u) * nx) xb_add(&bar[XB_TOPGEN], 1u);
            else XB_SPIN(xb_ld(&bar[XB_TOPGEN]) == tg, bar);
            __builtin_amdgcn_fence(__ATOMIC_ACQUIRE, "agent");
            xb_add(&bar[XB_XGEN(b.x)], 1u);
            asm volatile("s_waitcnt vmcnt(0)" ::: "memory");
        } else {
            XB_SPIN(xb_ld(&bar[XB_XGEN(b.x)]) == gen, bar);
            __builtin_amdgcn_fence(__ATOMIC_ACQUIRE, "agent");
            asm volatile("s_waitcnt vmcnt(0)" ::: "memory");
        }
    }
    __syncthreads();
}

struct Args { const float* in[25]; int ph_lo, ph_hi; };
#define AIN(k) (a.in[(k) + z])
struct Frame { unsigned char* lds; int tid, lane, wave, G, bid; };

__device__ __forceinline__ void transpose_item(const float* W, int K, int N, bf16* WT, float* scr, int item, int lane) {
    const int nblk = N / 32, kb = item / nblk, nb = item % nblk, k0 = 64 * kb, n0 = 32 * nb;
#pragma unroll 8
    for (int i = 0; i < 32; ++i) { const int kk = 2 * i + (lane >> 5); scr[kk * 33 + (lane & 31)] = W[(size_t)(k0 + kk) * N + n0 + (lane & 31)]; }
    asm volatile("s_waitcnt lgkmcnt(0)" ::: "memory");
    const int c = lane & 7;
#pragma unroll
    for (int j = 0; j < 4; ++j) { const int n = (lane >> 3) + 8 * j; const float* s = scr + (8 * c) * 33 + n;
        u32x4 o; o.x = pk2(s[0 * 33], s[1 * 33]); o.y = pk2(s[2 * 33], s[3 * 33]); o.z = pk2(s[4 * 33], s[5 * 33]); o.w = pk2(s[6 * 33], s[7 * 33]);
        *(u32x4*)(WT + (size_t)(n0 + n) * K + k0 + 8 * c) = o; }
    asm volatile("s_waitcnt lgkmcnt(0)" ::: "memory");
}
__device__ __forceinline__ void transpose_fold_item(const float* W, int K, int N, bf16* WT, const float* g, const float* b, float* cs, float* bw, float* scr, int nb, int lane) {
    const int n0 = 32 * nb; float csp = 0.f, bwp = 0.f;
    for (int k0 = 0; k0 < K; k0 += 64) {
#pragma unroll 8
        for (int i = 0; i < 32; ++i) { const int kk = 2 * i + (lane >> 5); const float w = W[(size_t)(k0 + kk) * N + n0 + (lane & 31)];
            const float wg = w * g[k0 + kk]; const float wr = bflo(pk2(wg, 0.f) & 0xffffu); scr[kk * 33 + (lane & 31)] = wr; csp += wr; bwp += w * b[k0 + kk]; }
        asm volatile("s_waitcnt lgkmcnt(0)" ::: "memory");
        const int c = lane & 7;
#pragma unroll
        for (int j = 0; j < 4; ++j) { const int n = (lane >> 3) + 8 * j; const float* s = scr + (8 * c) * 33 + n;
            u32x4 o; o.x = pk2(s[0 * 33], s[1 * 33]); o.y = pk2(s[2 * 33], s[3 * 33]); o.z = pk2(s[4 * 33], s[5 * 33]); o.w = pk2(s[6 * 33], s[7 * 33]);
            *(u32x4*)(WT + (size_t)(n0 + n) * K + k0 + 8 * c) = o; }
        asm volatile("s_waitcnt lgkmcnt(0)" ::: "memory");
    }
    csp += __shfl_xor(csp, 32); bwp += __shfl_xor(bwp, 32);
    if (lane < 32) { cs[n0 + lane] = csp; bw[n0 + lane] = bwp; }
}
__device__ __forceinline__ void cvt_stream(const float* src, bf16* dst, size_t n, size_t gtid, size_t gthreads) {
    for (size_t i = gtid * 8; i < n; i += gthreads * 8) { const f32x4 a = *(const f32x4*)(src + i), b = *(const f32x4*)(src + i + 4);
        u32x4 o; o.x = pk2(a[0], a[1]); o.y = pk2(a[2], a[3]); o.z = pk2(b[0], b[1]); o.w = pk2(b[2], b[3]); *(u32x4*)(dst + i) = o; }
}
__device__ __forceinline__ void convert_phase(const Frame& F, const Args& a, int z, int L) {
    unsigned char* ws = (unsigned char*)AIN(24); float* outp = (float*)AIN(23); const int li = L >> 1; const bool ssm = (L & 1);
    float* scr = (float*)(F.lds + F.wave * 16384);
    const int gw = F.bid * 8 + F.wave, NGW = F.G * 8;
    const float* Wa = ssm ? AIN(9) + (size_t)li * D * NPROJ : AIN(6) + (size_t)li * D * 3072; const int Na = ssm ? NPROJ : 3072;
    const float* Wb = ssm ? AIN(16) + (size_t)li * 2048 * D : AIN(8) + (size_t)li * D * D; const int Kb = ssm ? 2048 : D;
    const float* Wu = AIN(19) + (size_t)L * D * DFF; const float* Wd = AIN(20) + (size_t)L * DFF * D;
    const bool foldA = (L > 0);
    const float* gA = AIN(21) + (L - 1) * D; const float* bA = AIN(22) + (L - 1) * D;
    const float* gU = AIN(17) + L * D; const float* bU = AIN(18) + L * D;
    const int Ia = foldA ? Na / 32 : (D / 64) * (Na / 32), Ib = (Kb / 64) * (D / 32), Iu = DFF / 32, Id = (DFF / 64) * (D / 32);
    const int NIT = Ia + Ib + Iu + Id;
    for (int it = gw; it < NIT; it += NGW) {
        int r = it;
        if (r < Iu) { transpose_fold_item(Wu, D, DFF, (bf16*)(ws + WS_WUP), gU, bU, (float*)(ws + WS_CSU), (float*)(ws + WS_BWU), scr, r, F.lane); continue; } r -= Iu;
        if (r < Ia) { if (foldA) transpose_fold_item(Wa, D, Na, (bf16*)(ws + WS_WA), gA, bA, (float*)(ws + WS_CSA), (float*)(ws + WS_BWA), scr, r, F.lane);
                      else transpose_item(Wa, D, Na, (bf16*)(ws + WS_WA), scr, r, F.lane); continue; } r -= Ia;
        if (r < Ib) { transpose_item(Wb, Kb, D, (bf16*)(ws + WS_WB), scr, r, F.lane); continue; } r -= Ib;
        transpose_item(Wd, DFF, D, (bf16*)(ws + WS_WDN), scr, r, F.lane);
    }
    const size_t gtid = (size_t)F.bid * 512 + F.tid, gth = (size_t)F.G * 512;
    if (!ssm) {
        cvt_stream(AIN(2) + (size_t)li * 32 * 512 * 1024, (bf16*)(ws + WS_CK), (size_t)32 * 512 * 1024, gtid, gth);
        cvt_stream(AIN(3) + (size_t)li * 32 * 512 * 1024, (bf16*)(ws + WS_CV), (size_t)32 * 512 * 1024, gtid, gth);
    }
    if (L == 0) {
        const size_t n = (size_t)M * D, np = (size_t)MP * D;
        bf16* XB = (bf16*)(ws + WS_XB);
        for (size_t i = gtid * 8; i < n; i += gth * 8) { const float* src = i < np ? AIN(0) + i : AIN(1) + (i - np);
            const f32x4 x0 = *(const f32x4*)src, x1 = *(const f32x4*)(src + 4);
            u32x4 o; o.x = pk2(x0[0], x0[1]); o.y = pk2(x0[2], x0[3]); o.z = pk2(x1[0], x1[1]); o.w = pk2(x1[2], x1[3]); *(u32x4*)(XB + i) = o; }
    }
}
__device__ __forceinline__ void ln_phase(const Frame& F, float* X, const bf16* XB, const float* g, const float* b) {
    const int gw = F.bid * 8 + F.wave, NGW = F.G * 8;
    f32x4 gv[4], bv[4];
#pragma unroll
    for (int j = 0; j < 4; ++j) { gv[j] = *(const f32x4*)(g + 4 * F.lane + 256 * j); bv[j] = *(const f32x4*)(b + 4 * F.lane + 256 * j); }
    for (int m = gw; m < M; m += NGW) {
        f32x4* xr = (f32x4*)(X + (size_t)m * D) + F.lane;
        const u32x2* xb = (const u32x2*)(XB + (size_t)m * D) + F.lane;
        f32x4 v[4]; float s = 0.f;
#pragma unroll
        for (int j = 0; j < 4; ++j) { const u32x2 w = xb[64 * j]; v[j] = (f32x4){bflo(w.x), bfhi(w.x), bflo(w.y), bfhi(w.y)}; s += (v[j][0] + v[j][1]) + (v[j][2] + v[j][3]); }
        const float mean = wave_sum(s) * (1.f / D); float s2 = 0.f;
#pragma unroll
        for (int j = 0; j < 4; ++j) { v[j] = v[j] - mean; s2 += (v[j][0] * v[j][0] + v[j][1] * v[j][1]) + (v[j][2] * v[j][2] + v[j][3] * v[j][3]); }
        const float rstd = 1.f / sqrtf(wave_sum(s2) * (1.f / D) + LN_EPS);
#pragma unroll
        for (int j = 0; j < 4; ++j) xr[64 * j] = v[j] * rstd * gv[j] + bv[j];
    }
}

__device__ __forceinline__ void attn_phase(const Frame& F, const float* relb, const bf16* QKV, const bf16* CK, const bf16* CV, bf16* O) {
    float* tbl = (float*)F.lds;
    for (int i = F.tid; i < 16 * 513; i += 512) tbl[i] = relb[i] * LOG2E;
    __syncthreads();
    LAS unsigned char* const vtl = (LAS unsigned char*)F.lds + 32896 + F.wave * 9216;
    LAS unsigned char* const qtl = (LAS unsigned char*)F.lds + 106624 + F.wave * 4608;
    const int lane = F.lane, l31 = lane & 31, hh = lane >> 5;
    const int i16 = lane & 15, q4 = i16 >> 2, p4 = i16 & 3, dblk = (lane >> 4) & 1;
    const int gw = F.bid * 8 + F.wave, NGW = F.G * 8;
    constexpr int NITEM = (32 * 32 + 32) * 32;
    constexpr float C2 = 0.125f * LOG2E;
    const int xw = (F.bid >> 3) * 8 + F.wave, xn = (F.G >> 3) * 8, xcd = F.bid & 7;
    for (int jt = xw; jt < NITEM / 8; jt += xn) {
        int lq_ = lane; asm volatile("" : "+v"(lq_));
        LAS unsigned char* const wbase = vtl + (((lq_ >> 3) * 72 + 8 * (lq_ & 7)) * 2);
        LAS unsigned char* const fbase = vtl + (((lq_ & 31) * 72 + 8 * (lq_ >> 5)) * 2);
        LAS unsigned char* const qbase = qtl + (((lq_ & 31) * 72 + 8 * (lq_ >> 5)) * 2);
        LAS unsigned char* const tbase = vtl + (((4 * (lq_ >> 5) + ((lq_ & 15) >> 2)) * 72 + 16 * ((lq_ >> 4) & 1) + 4 * (lq_ & 3)) * 2);
        const bool smp = jt >= 4096; const int r = smp ? jt - 4096 : jt;
        const int qh = r & 1, c = smp ? 0 : (r >> 1) & 31, h = smp ? (r >> 1) & 15 : (r >> 6) & 15, b = xcd + 8 * (smp ? (r >> 5) : (r >> 10));
        const size_t qrow0 = smp ? (size_t)MP + b * 64 + 32 * qh : (size_t)b * 2048 + 64 * c + 32 * qh;
        { bf16x8 qr[4];
#pragma unroll
          for (int i = 0; i < 4; ++i) qr[i] = *(const bf16x8*)(QKV + (qrow0 + 8 * i + (lane >> 3)) * 3072 + h * 64 + 8 * (lane & 7));
#pragma unroll
          for (int i = 0; i < 4; ++i) *(LAS bf16x8*)(qtl + ((8 * i + (lane >> 3)) * 72 + 8 * (lane & 7)) * 2) = qr[i]; }
        asm volatile("" ::: "memory");
        f32x16 o0, o1;
#pragma unroll
        for (int i = 0; i < 16; ++i) { o0[i] = 0.f; o1[i] = 0.f; }
        float mrun = -1e30f, lsum = 0.f;
        const float* tb = tbl + h * 513;
        const int jb0 = smp ? 0 : (c >= 8 ? 0 : 8 - c);
        bf16x8 kr[8], vr[8];
        { const bf16 *K0, *V0; int p0;
          if (!smp) { K0 = QKV + ((size_t)b * 2048 + 64 * (c - 8 + jb0)) * 3072 + 1024 + h * 64; V0 = K0 + 1024; p0 = 3072; }
          else { K0 = CK + ((size_t)b * 512) * 1024 + h * 64; V0 = CV + ((size_t)b * 512) * 1024 + h * 64; p0 = 1024; }
          const unsigned vo_ = ((unsigned)(lane >> 3) * (unsigned)p0 + 8u * (unsigned)(lane & 7)) * 2u;
#pragma unroll
          for (int i = 0; i < 8; ++i) { const unsigned o_ = vo_ + (unsigned)i * 16u * (unsigned)p0; kr[i] = *(const bf16x8*)((const char*)K0 + o_); vr[i] = *(const bf16x8*)((const char*)V0 + o_); } }
        for (int jb = jb0; jb <= 8; ++jb) {
            const bf16 *Kp, *Vp; int pitch;
            if (!smp) { Kp = QKV + ((size_t)b * 2048 + 64 * (c - 8 + jb)) * 3072 + 1024 + h * 64; Vp = Kp + 1024; pitch = 3072; }
            else if (jb < 8) { Kp = CK + ((size_t)b * 512 + 64 * jb) * 1024 + h * 64; Vp = CV + ((size_t)b * 512 + 64 * jb) * 1024 + h * 64; pitch = 1024; }
            else { Kp = QKV + ((size_t)MP + b * 64) * 3072 + 1024 + h * 64; Vp = Kp + 1024; pitch = 3072; }
            bf16x8 kf[2][4];
            asm volatile("" ::: "memory");
#pragma unroll
            for (int i = 0; i < 8; ++i) *(LAS bf16x8*)(wbase + i * 1152) = kr[i];
            asm volatile("" ::: "memory");
#pragma unroll
            for (int rb = 0; rb < 2; ++rb)
#pragma unroll
                for (int ks = 0; ks < 4; ++ks) kf[rb][ks] = *(const LAS bf16x8*)(fbase + rb * 4608 + ks * 32);
            asm volatile("" ::: "memory");
#pragma unroll
            for (int i = 0; i < 8; ++i) *(LAS bf16x8*)(wbase + i * 1152) = vr[i];
            asm volatile("" ::: "memory");
            if (jb < 8) { const bf16 *Kn, *Vn; int pn_;
                if (!smp) { Kn = Kp + (size_t)64 * 3072; Vn = Vp + (size_t)64 * 3072; pn_ = 3072; }
                else if (jb < 7) { Kn = Kp + (size_t)64 * 1024; Vn = Vp + (size_t)64 * 1024; pn_ = 1024; }
                else { Kn = QKV + ((size_t)MP + b * 64) * 3072 + 1024 + h * 64; Vn = Kn + 1024; pn_ = 3072; }
                const unsigned vo_ = ((unsigned)(lane >> 3) * (unsigned)pn_ + 8u * (unsigned)(lane & 7)) * 2u;
#pragma unroll
                for (int i = 0; i < 8; ++i) { const unsigned o_ = vo_ + (unsigned)i * 16u * (unsigned)pn_; kr[i] = *(const bf16x8*)((const char*)Kn + o_); vr[i] = *(const bf16x8*)((const char*)Vn + o_); } }
            f32x16 s0, s1;
#pragma unroll
            for (int i = 0; i < 16; ++i) { s0[i] = 0.f; s1[i] = 0.f; }
#pragma unroll
            for (int ks = 0; ks < 4; ++ks) { const bf16x8 qf = *(const LAS bf16x8*)(qbase + ks * 32); s0 = MFMA32(kf[0][ks], qf, s0); s1 = MFMA32(kf[1][ks], qf, s1); }
            if (jb <= 3) {
                const float cbias = tb[512];
#pragma unroll
                for (int i = 0; i < 16; ++i) { s0[i] = s0[i] * C2 + cbias; s1[i] = s1[i] * C2 + cbias; }
            } else if (jb == 4) {
                const int dbase = 64 * (8 - jb) + 32 * qh + l31 + 256;
#pragma unroll
                for (int i = 0; i < 16; ++i) { const int k0 = crow(i, hh); int i0 = dbase - k0; i0 = i0 > 512 ? 512 : i0; s0[i] = s0[i] * C2 + tb[i0]; }
                asm volatile("" ::: "memory");
#pragma unroll
                for (int i = 0; i < 16; ++i) { const int k0 = crow(i, hh); int i1 = dbase - k0 - 32; i1 = i1 > 512 ? 512 : i1; s1[i] = s1[i] * C2 + tb[i1]; }
            } else {
                const float* pb = tb + (64 * (8 - jb) + 32 * qh + l31 + 256 - 4 * hh - 59);
#pragma unroll
                for (int i = 0; i < 16; ++i) { const int ci = (i & 3) + 8 * (i >> 2); s0[i] = s0[i] * C2 + pb[59 - ci]; }
                asm volatile("" ::: "memory");
#pragma unroll
                for (int i = 0; i < 16; ++i) { const int ci = (i & 3) + 8 * (i >> 2); s1[i] = s1[i] * C2 + pb[27 - ci]; }
            }
            float mx = s0[0];
#pragma unroll
            for (int i = 1; i < 16; ++i) mx = fmaxf(mx, s0[i]);
#pragma unroll
            for (int i = 0; i < 16; ++i) mx = fmaxf(mx, s1[i]);
            mx = fmaxf(mx, __shfl_xor(mx, 32));
            const float mnew = fmaxf(mrun, mx), alpha = fexp2(mrun - mnew);
            mrun = mnew;
            float ps = 0.f;
#pragma unroll
            for (int i = 0; i < 16; ++i) { s0[i] = fexp2(s0[i] - mnew); s1[i] = fexp2(s1[i] - mnew); ps += s0[i] + s1[i]; }
            lsum = lsum * alpha + ps;
#pragma unroll
            for (int i = 0; i < 16; ++i) { o0[i] *= alpha; o1[i] *= alpha; }
#pragma unroll
            for (int rb = 0; rb < 2; ++rb)
#pragma unroll
                for (int s2 = 0; s2 < 2; ++s2) {
                    const bf16x8 pf = pack8(rb ? s1 : s0, s2);
#pragma unroll
                    for (int db = 0; db < 2; ++db) {
                        const s16x4 lo = __builtin_amdgcn_ds_read_tr16_b64_v4i16((LAS s16x4*)(tbase + (32 * rb + 16 * s2) * 144 + db * 64));
                        const s16x4 hi = __builtin_amdgcn_ds_read_tr16_b64_v4i16((LAS s16x4*)(tbase + (32 * rb + 16 * s2 + 8) * 144 + db * 64));
                        const bf16x8 va = __builtin_shufflevector(lo, hi, 0, 1, 2, 3, 4, 5, 6, 7);
                        if (db == 0) o0 = MFMA32(va, pf, o0); else o1 = MFMA32(va, pf, o1);
                    }
                }
            asm volatile("" ::: "memory");
        }
        const float inv = 1.0f / (lsum + __shfl_xor(lsum, 32));
        bf16* orow = O + (qrow0 + l31) * D + h * 64 + 4 * hh;
#pragma unroll
        for (int i4 = 0; i4 < 4; ++i4) {
            u32x2 w0; w0.x = pk2(o0[4 * i4] * inv, o0[4 * i4 + 1] * inv); w0.y = pk2(o0[4 * i4 + 2] * inv, o0[4 * i4 + 3] * inv); *(u32x2*)(orow + 8 * i4) = w0;
            u32x2 w1; w1.x = pk2(o1[4 * i4] * inv, o1[4 * i4 + 1] * inv); w1.y = pk2(o1[4 * i4 + 2] * inv, o1[4 * i4 + 3] * inv); *(u32x2*)(orow + 32 + 8 * i4) = w1;
        }
    }
}
constexpr int SX_XT = 0, SX_XWT = 36864, SX_BT = 73728, SX_BS = 92160, SX_CS = 109568, SX_DT = 126976, SX_CUM = SX_DT + 1024, SX_WIN = SX_DT + 2048, SX_PART = SX_DT + 3072;
__device__ __forceinline__ void ssd_phase(const Frame& F, const Args& a, int z, int li, bf16* PROJ, const float* DT, bf16* dryXB) {
    float* outp = (float*)AIN(23);
    unsigned char* lds = F.lds;
    bf16* Xt = (bf16*)(lds + SX_XT); bf16* Xwt = (bf16*)(lds + SX_XWT); bf16* Bt = (bf16*)(lds + SX_BT); bf16* Bs = (bf16*)(lds + SX_BS); bf16* Cs = (bf16*)(lds + SX_CS);
    float* dts = (float*)(lds + SX_DT); float* cums = (float*)(lds + SX_CUM); float* wins = (float*)(lds + SX_WIN); float* part = (float*)(lds + SX_PART);
    const int tid = F.tid, lane = F.lane, wave = F.wave, l31 = lane & 31, hh = lane >> 5;
    const int r = wave >> 1, half = wave & 1;
    const float* conv_w = AIN(10) + (size_t)li * 4 * 4096; const float* conv_b = AIN(11) + (size_t)li * 4096;
    const float* dt_bias = AIN(12) + li * 32; const float* a_log = AIN(13) + li * 32; const float* d_skip = AIN(14) + li * 32; const float* norm_w = AIN(15) + (size_t)li * 2048;
    for (int item = F.bid; item < 512; item += F.G) {
        const bool smp = item >= 256; const int bg = item & 255, b = bg >> 3, g = bg & 7;
        const size_t row0 = smp ? (size_t)MP + b * 64 : (size_t)b * 2048; const int nchunks = smp ? 1 : 32;
        const int hglob = g * 4 + r;
        const float Dr = d_skip[hglob];
        f32x16 hT[4];
        const size_t hoff = (((size_t)(li * 32 + b) * 32 + hglob) * 64 + 32 * half + l31) * 128 + 4 * hh;
        if (smp) { const float* hs = AIN(4) + hoff;
#pragma unroll
            for (int nb = 0; nb < 4; ++nb)
#pragma unroll
                for (int i4 = 0; i4 < 4; ++i4) { const f32x4 v = *(const f32x4*)(hs + 32 * nb + 8 * i4); hT[nb][4 * i4] = v[0]; hT[nb][4 * i4 + 1] = v[1]; hT[nb][4 * i4 + 2] = v[2]; hT[nb][4 * i4 + 3] = v[3]; }
        } else {
#pragma unroll
            for (int nb = 0; nb < 4; ++nb)
#pragma unroll
                for (int i = 0; i < 16; ++i) hT[nb][i] = 0.f;
        }
        float dt_pf = (tid < 256) ? DT[(row0 + lane) * 32 + g * 4 + wave] : 0.f;
#pragma unroll 1
        for (int c = 0; c < nchunks; ++c) {
            const size_t rowc = row0 + 64 * c;
            int lane_ = F.lane; asm volatile("" : "+v"(lane_));
            const int lane = lane_, l31 = lane & 31, hh = lane >> 5, tid = wave * 64 + lane;
            const int role = lane < 32 ? 0 : (lane < 48 ? 1 : 2);
            const int chbase = role == 0 ? g * 256 + 8 * lane : (role == 1 ? 2048 + g * 128 + 8 * (lane - 32) : 3072 + g * 128 + 8 * (lane - 48));
            if (tid < 256) {
                const int hr = g * 4 + wave;
                const float raw = dt_pf + dt_bias[hr];
                if (c + 1 < nchunks) dt_pf = DT[(rowc + 64 + lane) * 32 + hr];
                const float dt = raw > 20.f ? raw : log1pf(__expf(raw));
                const float am = -__expf(a_log[hr]) * LOG2E;
                float v = dt * am;
#pragma unroll
                for (int o = 1; o < 64; o <<= 1) { const float n = __shfl_up(v, o); if (lane >= o) v += n; }
                const float last = __shfl(v, 63);
                dts[wave * 64 + lane] = dt; cums[wave * 64 + lane] = v; wins[wave * 64 + lane] = fexp2(last - v) * dt;
            }
            __syncthreads();
            {
                const bf16* src = PROJ + 2048 + chbase;
                u32x4 raw[11];
#pragma unroll
                for (int i = 0; i < 11; ++i) {
                    const int rr = 8 * wave - 3 + i;
                    if (rr >= 0 || c > 0) raw[i] = *(const u32x4*)(src + (size_t)((long)rowc + rr) * LDP);
                    else if (!smp) raw[i] = (u32x4){0u, 0u, 0u, 0u};
                    else { const float* sc = AIN(5) + ((size_t)(li * 32 + b) * 3 + (3 + rr)) * 4096 + chbase; const f32x4 s0 = *(const f32x4*)sc, s1 = *(const f32x4*)(sc + 4);
                        raw[i] = (u32x4){pk2(s0[0], s0[1]), pk2(s0[2], s0[3]), pk2(s1[0], s1[1]), pk2(s1[2], s1[3])}; }
                }
                if (c == nchunks - 1 && wave == 7) {
                    float* co = outp + (smp ? O_CS : O_CP) + ((size_t)(li * 32 + b) * 3) * 4096 + chbase;
#pragma unroll
                    for (int k = 0; k < 3; ++k) { const u32x4 rw = raw[8 + k];
                        *(f32x4*)(co + k * 4096) = (f32x4){bflo(rw.x), bfhi(rw.x), bflo(rw.y), bfhi(rw.y)}; *(f32x4*)(co + k * 4096 + 4) = (f32x4){bflo(rw.z), bfhi(rw.z), bflo(rw.w), bfhi(rw.w)}; }
                }
                float win8[8];
                { const float* wp = wins + (lane < 32 ? (lane >> 3) : 0) * 64 + 8 * wave;
                  const f32x4 wa = *(const f32x4*)wp, wb = *(const f32x4*)(wp + 4);
                  win8[0] = wa[0]; win8[1] = wa[1]; win8[2] = wa[2]; win8[3] = wa[3]; win8[4] = wb[0]; win8[5] = wb[1]; win8[6] = wb[2]; win8[7] = wb[3]; }
#pragma unroll
                for (int hb = 0; hb < 2; ++hb) {
                    f32x4 wv[4], bvv;
#pragma unroll
                    for (int k = 0; k < 4; ++k) wv[k] = *(const f32x4*)(conv_w + k * 4096 + chbase + 4 * hb);
                    bvv = *(const f32x4*)(conv_b + chbase + 4 * hb);
                    unsigned pc[4][4];
#pragma unroll
                    for (int e4 = 0; e4 < 4; ++e4) {
                        const int e = 4 * hb + e4;
                        float xv[11];
#pragma unroll
                        for (int i = 0; i < 11; ++i) { const unsigned wd = raw[i][e >> 1]; xv[i] = (e & 1) ? bfhi(wd) : bflo(wd); }
                        const float w0 = wv[0][e4], w1 = wv[1][e4], w2 = wv[2][e4], w3 = wv[3][e4], bb = bvv[e4];
                        float o[8];
#pragma unroll
                        for (int j = 0; j < 8; ++j) o[j] = silu_f(bb + w0 * xv[j] + w1 * xv[j + 1] + w2 * xv[j + 2] + w3 * xv[j + 3]);
#pragma unroll
                        for (int j2 = 0; j2 < 4; ++j2) pc[e4][j2] = pk2(o[2 * j2], o[2 * j2 + 1]);
                        if (role == 0) {
                            *(u32x4*)(Xt + (8 * lane + e) * 72 + 8 * wave) = (u32x4){pc[e4][0], pc[e4][1], pc[e4][2], pc[e4][3]};
                            *(u32x4*)(Xwt + (8 * lane + e) * 72 + 8 * wave) = (u32x4){pk2(o[0] * win8[0], o[1] * win8[1]), pk2(o[2] * win8[2], o[3] * win8[3]), pk2(o[4] * win8[4], o[5] * win8[5]), pk2(o[6] * win8[6], o[7] * win8[7])};
                        } else if (role == 1) {
                            *(u32x4*)(Bt + (8 * (lane - 32) + e) * 72 + 8 * wave) = (u32x4){pc[e4][0], pc[e4][1], pc[e4][2], pc[e4][3]};
                        }
                    }
                    if (role != 0) {
                        bf16* dst = (role == 1 ? Bs + 8 * (lane - 32) : Cs + 8 * (lane - 48)) + (8 * wave) * 136 + 4 * hb;
#pragma unroll
                        for (int j2 = 0; j2 < 4; ++j2) {
                            u32x2 lo, hi;
                            lo.x = __builtin_amdgcn_perm(pc[1][j2], pc[0][j2], 0x05040100u); hi.x = __builtin_amdgcn_perm(pc[1][j2], pc[0][j2], 0x07060302u);
                            lo.y = __builtin_amdgcn_perm(pc[3][j2], pc[2][j2], 0x05040100u); hi.y = __builtin_amdgcn_perm(pc[3][j2], pc[2][j2], 0x07060302u);
                            *(u32x2*)(dst + (2 * j2) * 136) = lo; *(u32x2*)(dst + (2 * j2 + 1) * 136) = hi;
                        }
                    }
                }
            }
            __syncthreads();
            bf16* zr0 = PROJ + (rowc + l31) * LDP + g * 256 + 64 * r + 32 * half + 4 * hh; bf16* zr1 = zr0 + (size_t)32 * LDP;
            u32x2 zp0[4], zp1[4];
#pragma unroll
            for (int i4 = 0; i4 < 4; ++i4) { zp0[i4] = *(const u32x2*)(zr0 + 8 * i4); zp1[i4] = *(const u32x2*)(zr1 + 8 * i4); }
            f32x16 cb00, cb01, cb11;
#pragma unroll
            for (int i = 0; i < 16; ++i) { cb00[i] = 0.f; cb01[i] = 0.f; cb11[i] = 0.f; }
#pragma unroll
            for (int ns = 0; ns < 8; ++ns) {
                const bf16x8 a0 = *(const bf16x8*)(Bs + l31 * 136 + 16 * ns + 8 * hh), a1 = *(const bf16x8*)(Bs + (32 + l31) * 136 + 16 * ns + 8 * hh);
                const bf16x8 c0 = *(const bf16x8*)(Cs + l31 * 136 + 16 * ns + 8 * hh), c1 = *(const bf16x8*)(Cs + (32 + l31) * 136 + 16 * ns + 8 * hh);
                cb00 = MFMA32(a0, c0, cb00); cb01 = MFMA32(a0, c1, cb01); cb11 = MFMA32(a1, c1, cb11);
            }
            const float* cumr = cums + r * 64; const float* dtr = dts + r * 64;
            const float cum_t0 = cumr[l31], cum_t1 = cumr[32 + l31];
#pragma unroll
            for (int i4 = 0; i4 < 4; ++i4) {
                const f32x4 cs0 = *(const f32x4*)(cumr + 8 * i4 + 4 * hh), cs1 = *(const f32x4*)(cumr + 32 + 8 * i4 + 4 * hh);
                const f32x4 ds0 = *(const f32x4*)(dtr + 8 * i4 + 4 * hh), ds1 = *(const f32x4*)(dtr + 32 + 8 * i4 + 4 * hh);
#pragma unroll
                for (int j = 0; j < 4; ++j) { const int i = 4 * i4 + j, s = 8 * i4 + 4 * hh + j;
                    float v00 = cb00[i] * fexp2(fminf(cum_t0 - cs0[j], 0.f)) * ds0[j]; v00 = (s <= l31) ? v00 : 0.f; v00 += (s == l31) ? Dr : 0.f; cb00[i] = v00;
                    cb01[i] = cb01[i] * fexp2(fminf(cum_t1 - cs0[j], 0.f)) * ds0[j];
                    float v11 = cb11[i] * fexp2(fminf(cum_t1 - cs1[j], 0.f)) * ds1[j]; v11 = (s <= l31) ? v11 : 0.f; v11 += (s == l31) ? Dr : 0.f; cb11[i] = v11; }
            }
            f32x16 y0, y1;
#pragma unroll
            for (int i = 0; i < 16; ++i) { y0[i] = 0.f; y1[i] = 0.f; }
#pragma unroll
            for (int nb = 0; nb < 4; ++nb)
#pragma unroll
                for (int s2 = 0; s2 < 2; ++s2) {
                    const bf16x8 ha = pack8(hT[nb], s2);
                    const int n0 = 32 * nb + 16 * s2 + 4 * hh;
                    const s16x4 c0l = *(const s16x4*)(Cs + l31 * 136 + n0), c0h = *(const s16x4*)(Cs + l31 * 136 + n0 + 8);
                    const s16x4 c1l = *(const s16x4*)(Cs + (32 + l31) * 136 + n0), c1h = *(const s16x4*)(Cs + (32 + l31) * 136 + n0 + 8);
                    y0 = MFMA32(ha, __builtin_shufflevector(c0l, c0h, 0, 1, 2, 3, 4, 5, 6, 7), y0);
                    y1 = MFMA32(ha, __builtin_shufflevector(c1l, c1h, 0, 1, 2, 3, 4, 5, 6, 7), y1);
                }
            { const float e0 = fexp2(cum_t0), e1 = fexp2(cum_t1);
#pragma unroll
              for (int i = 0; i < 16; ++i) { y0[i] *= e0; y1[i] *= e1; } }
            { const bf16* xrow = Xt + (64 * r + 32 * half + l31) * 72;
#pragma unroll
              for (int s2 = 0; s2 < 2; ++s2) {
                  const s16x4 x0l = *(const s16x4*)(xrow + 16 * s2 + 4 * hh), x0h = *(const s16x4*)(xrow + 16 * s2 + 4 * hh + 8);
                  const s16x4 x1l = *(const s16x4*)(xrow + 32 + 16 * s2 + 4 * hh), x1h = *(const s16x4*)(xrow + 32 + 16 * s2 + 4 * hh + 8);
                  const bf16x8 xa0 = __builtin_shufflevector(x0l, x0h, 0, 1, 2, 3, 4, 5, 6, 7), xa1 = __builtin_shufflevector(x1l, x1h, 0, 1, 2, 3, 4, 5, 6, 7);
                  y0 = MFMA32(xa0, pack8(cb00, s2), y0);
                  y1 = MFMA32(xa0, pack8(cb01, s2), y1);
                  y1 = MFMA32(xa1, pack8(cb11, s2), y1);
              } }
            {
                float ss0 = 0.f, ss1 = 0.f;
#pragma unroll
                for (int i4 = 0; i4 < 4; ++i4) {
                    const u32x2 z0 = zp0[i4], z1 = zp1[i4];
                    const float za[4] = {bflo(z0.x), bfhi(z0.x), bflo(z0.y), bfhi(z0.y)}, zb[4] = {bflo(z1.x), bfhi(z1.x), bflo(z1.y), bfhi(z1.y)};
#pragma unroll
                    for (int j = 0; j < 4; ++j) { const float v0 = y0[4 * i4 + j] * silu_f(za[j]), v1 = y1[4 * i4 + j] * silu_f(zb[j]); y0[4 * i4 + j] = v0; y1[4 * i4 + j] = v1; ss0 += v0 * v0; ss1 += v1 * v1; }
                }
                ss0 += __shfl_xor(ss0, 32); ss1 += __shfl_xor(ss1, 32);
                if (hh == 0) { part[l31 * 8 + wave] = ss0; part[(32 + l31) * 8 + wave] = ss1; }
                __syncthreads();
                const f32x4 pa = *(const f32x4*)(part + l31 * 8), pb = *(const f32x4*)(part + l31 * 8 + 4), pc = *(const f32x4*)(part + (32 + l31) * 8), pd = *(const f32x4*)(part + (32 + l31) * 8 + 4);
                const float t0 = ((pa[0] + pa[1]) + (pa[2] + pa[3])) + ((pb[0] + pb[1]) + (pb[2] + pb[3])), t1 = ((pc[0] + pc[1]) + (pc[2] + pc[3])) + ((pd[0] + pd[1]) + (pd[2] + pd[3]));
                const float r0 = 1.0f / sqrtf(t0 * (1.f / 256.f) + RMS_EPS), r1 = 1.0f / sqrtf(t1 * (1.f / 256.f) + RMS_EPS);
                const float* nwp = norm_w + g * 256 + 64 * r + 32 * half + 4 * hh;
#pragma unroll
                for (int i4 = 0; i4 < 4; ++i4) { const f32x4 nw = *(const f32x4*)(nwp + 8 * i4);
                    u32x2 w0; w0.x = pk2(y0[4 * i4] * r0 * nw[0], y0[4 * i4 + 1] * r0 * nw[1]); w0.y = pk2(y0[4 * i4 + 2] * r0 * nw[2], y0[4 * i4 + 3] * r0 * nw[3]); if (!dryXB) *(u32x2*)(zr0 + 8 * i4) = w0; else if (g < 4) *(u32x2*)(dryXB + (rowc + l31) * 1024 + g * 256 + 64 * r + 32 * half + 4 * hh + 8 * i4) = w0;
                    u32x2 w1; w1.x = pk2(y1[4 * i4] * r1 * nw[0], y1[4 * i4 + 1] * r1 * nw[1]); w1.y = pk2(y1[4 * i4 + 2] * r1 * nw[2], y1[4 * i4 + 3] * r1 * nw[3]); if (!dryXB) *(u32x2*)(zr1 + 8 * i4) = w1; else if (g < 4) *(u32x2*)(dryXB + (rowc + 32 + l31) * 1024 + g * 256 + 64 * r + 32 * half + 4 * hh + 8 * i4) = w1; }
            }
            { const float dec = fexp2(cumr[63]);
#pragma unroll
              for (int nb = 0; nb < 4; ++nb)
#pragma unroll
                  for (int i = 0; i < 16; ++i) hT[nb][i] *= dec;
              const bf16* xw = Xwt + (64 * r + 32 * half + l31) * 72 + 8 * hh;
#pragma unroll
              for (int ss = 0; ss < 4; ++ss) { const bf16x8 bx = *(const bf16x8*)(xw + 16 * ss);
#pragma unroll
                  for (int nb = 0; nb < 4; ++nb) { const bf16x8 af = *(const bf16x8*)(Bt + (32 * nb + l31) * 72 + 16 * ss + 8 * hh); hT[nb] = MFMA32(af, bx, hT[nb]); } }
            }
            __syncthreads();
        }
        { float* ho = outp + (smp ? O_HS : O_HP) + hoff;
#pragma unroll
          for (int nb = 0; nb < 4; ++nb)
#pragma unroll
              for (int i4 = 0; i4 < 4; ++i4) *(f32x4*)(ho + 32 * nb + 8 * i4) = (f32x4){hT[nb][4 * i4], hT[nb][4 * i4 + 1], hT[nb][4 * i4 + 2], hT[nb][4 * i4 + 3]};
          }
    }
}
__global__ void __launch_bounds__(512, 2) fwd_megakernel(Args a) {
    extern __shared__ __attribute__((aligned(16))) unsigned char lds[];
    cg::grid_group grid = cg::this_grid();
    const int wv0 = __builtin_amdgcn_readfirstlane((int)threadIdx.x >> 6);
    Frame F; F.lds = lds; F.tid = threadIdx.x; F.lane = F.tid & 63; F.wave = __builtin_amdgcn_readfirstlane(F.tid >> 6); F.G = gridDim.x; F.bid = blockIdx.x;
    PG8_LAS unsigned char* glds = (PG8_LAS unsigned char*)lds;
    {
        int z = 0; asm volatile("" : "+s"(z));
        unsigned* bw = (unsigned*)AIN(24);
        if (blockIdx.x == 0) for (int i = threadIdx.x; i < XCD_BAR_WORDS; i += 512) __hip_atomic_store(bw + i, 0u, __ATOMIC_RELAXED, __HIP_MEMORY_SCOPE_AGENT);
        volatile LAS unsigned* st = (volatile LAS unsigned*)(glds + (LDS_BYTES - 16));
        if (threadIdx.x < 2) st[threadIdx.x] = 0u;
        __syncthreads();
        grid.sync();
        (void)xcd_barrier_post(bw, st);
    }
#ifndef REP_IN
#define REP_IN 1
#endif
#ifndef REP_ATT
#define REP_ATT 1
#endif
#ifndef REP_UP
#define REP_UP 1
#endif
#ifndef REP_CONV
#define REP_CONV 1
#endif
#ifndef REP_SYNC
#define REP_SYNC 1
#endif
    for (int ph = a.ph_lo; ph < a.ph_hi; ++ph) {
      const int sub_ = ph & 7; if (sub_ == 4 || (sub_ == 7 && ph != 31)) continue;
      {
        { int t_ = wv0 * 64 + lane_id_(); asm volatile("" : "+v"(t_)); F.tid = t_; F.lane = t_ & 63; F.wave = wv0; }
        { int g_ = (int)gridDim.x, b_ = (int)blockIdx.x; asm volatile("" : "+s"(g_), "+s"(b_)); F.G = g_; F.bid = b_; }
        int z = 0; asm volatile("" : "+s"(z));
        unsigned char* ws = (unsigned char*)AIN(24);
        bf16* WA = (bf16*)(ws + WS_WA); bf16* WB = (bf16*)(ws + WS_WB); bf16* WUP = (bf16*)(ws + WS_WUP); bf16* WDN = (bf16*)(ws + WS_WDN);
        bf16* XB = (bf16*)(ws + WS_XB); float* DT = (float*)(ws + WS_DT); bf16* BIG = (bf16*)(ws + WS_BIG);
        bf16* OB = (bf16*)(ws + WS_O); bf16* CK = (bf16*)(ws + WS_CK); bf16* CV = (bf16*)(ws + WS_CV);
        float* X = (float*)AIN(23);
        float* ST0 = (float*)(ws + WS_ST0); float* ST1 = (float*)(ws + WS_ST1);
        const int L = ph >> 3, sub = ph & 7, li = L >> 1; const bool ssm = (L & 1);
        if (sub == 0) {
#ifndef NO_CONV
 convert_phase(F, a, z, L);
#endif
 }
        else if (sub == 1) {
#if !defined(ONLY_SUB) || ONLY_SUB == 1
            pg8::StaticOrder S;
            if (!ssm) { pg8::Gemm g{XB, WA, M, 3072, D, D}; S.init(M, 3072, F.G, F.bid); pg8::EpiQKV E{BIG, X, li, L > 0 ? ST0 : (const float*)nullptr, (const float*)(ws + WS_CSA), (const float*)(ws + WS_BWA), (float*)(ws + WS_MR0), (PG8_LAS float*)(glds + 131072 + 8192)};
                pg8::gemm_phase<pg8::EpiQKV, pg8::StaticOrder, true, true>(glds, g, S, E, F.wave); }
            else { pg8::Gemm g{XB, WA, M, NPROJ_PAD, D, D}; S.init(M, NPROJ_PAD, F.G, F.bid); pg8::EpiSsmIn E{BIG, DT, ST0, (const float*)(ws + WS_CSA), (const float*)(ws + WS_BWA), (float*)(ws + WS_MR0), (PG8_LAS float*)(glds + 131072 + 8192)};
                pg8::gemm_phase<pg8::EpiSsmIn, pg8::StaticOrder, true, true>(glds, g, S, E, F.wave); }
#endif
        } else if (sub == 2) {
#ifndef NO_ATTN
            if (!ssm) attn_phase(F, AIN(7) + (size_t)li * 16 * 513, BIG, CK, CV, OB);
#endif
#ifndef NO_SSD
#ifdef PROBE_SSD
            if (ssm) for (int pass = 0; pass < 2; ++pass) { ssd_phase(F, a, z, li, BIG, DT, pass == 0 ? XB : nullptr);
                if (pass == 0) { XcdBarrier xb_; xb_.w0 = F.wave; xb_.bar = (unsigned*)AIN(24); xb_.x = xb_xcc_id(); xb_.st = (volatile LAS unsigned*)(glds + (LDS_BYTES - 16)); xcd_barrier(xb_); } }
#else
            if (ssm) ssd_phase(F, a, z, li, BIG, DT, nullptr);
#endif
#endif
        } else if (sub == 3) {
#if !defined(ONLY_SUB) || ONLY_SUB == 3
            pg8::StaticOrder S; S.init(M, D, F.G, F.bid); pg8::EpiResid E{XB, L > 0 ? (const float*)(ws + WS_MR0) : (const float*)nullptr, AIN(21) + (L > 0 ? L - 1 : 0) * D, AIN(22) + (L > 0 ? L - 1 : 0) * D, ST1, (PG8_LAS float*)(glds + 131072)};
#ifdef PROBE_S3
            { pg8::Gemm g0 = ssm ? pg8::Gemm{BIG, WB, M, D, 2048, LDP} : pg8::Gemm{OB, WB, M, D, D, D};
              pg8::EpiBf16Plain E0{ssm ? BIG + 2048 : BIG, ssm ? LDP : D, 0, (const float*)nullptr, (const float*)nullptr, (const float*)nullptr, (float*)nullptr, (PG8_LAS float*)(glds + 131072 + 8192)};
              pg8::gemm_phase<pg8::EpiBf16Plain, pg8::StaticOrder, true, true>(glds, g0, S, E0, F.wave);
              XcdBarrier xb_; xb_.w0 = F.wave; xb_.bar = (unsigned*)AIN(24); xb_.x = xb_xcc_id(); xb_.st = (volatile LAS unsigned*)(glds + (LDS_BYTES - 16)); xcd_barrier(xb_); }
#endif
            if (!ssm) { pg8::Gemm g{OB, WB, M, D, D, D}; pg8::gemm_phase<pg8::EpiResid, pg8::StaticOrder, true, true>(glds, g, S, E, F.wave); }
            else { pg8::Gemm g{BIG, WB, M, D, 2048, LDP}; pg8::gemm_phase<pg8::EpiResid, pg8::StaticOrder, true, true>(glds, g, S, E, F.wave); }
#endif
        } else if (sub == 4) ln_phase(F, X, XB, AIN(17) + L * D, AIN(18) + L * D);
        else if (sub == 5) {
#if !defined(ONLY_SUB) || ONLY_SUB == 5
 pg8::Gemm g{XB, WUP, M, DFF, D, D}; pg8::StaticOrder S; S.init(M, DFF, F.G, F.bid); pg8::EpiBf16Plain E{BIG, DFF, 1, ST1, (const float*)(ws + WS_CSU), (const float*)(ws + WS_BWU), (float*)(ws + WS_MR1), (PG8_LAS float*)(glds + 131072 + 8192)};
            pg8::gemm_phase<pg8::EpiBf16Plain, pg8::StaticOrder, true, true>(glds, g, S, E, F.wave);
#endif
 }
        else if (sub == 6) {
#if !defined(ONLY_SUB) || ONLY_SUB == 6
 pg8::Gemm g{BIG, WDN, M, D, DFF, DFF}; pg8::StaticOrder S; S.init(M, D, F.G, F.bid);
#ifdef PROBE_DN
            { pg8::EpiBf16Plain E0{(bf16*)(ws + WS_CK), D, 0, (const float*)nullptr, (const float*)nullptr, (const float*)nullptr, (float*)nullptr, (PG8_LAS float*)(glds + 131072 + 8192)};
              pg8::gemm_phase<pg8::EpiBf16Plain, pg8::StaticOrder, true, true>(glds, g, S, E0, F.wave);
              XcdBarrier xb_; xb_.w0 = F.wave; xb_.bar = (unsigned*)AIN(24); xb_.x = xb_xcc_id(); xb_.st = (volatile LAS unsigned*)(glds + (LDS_BYTES - 16)); xcd_barrier(xb_); }
#endif
 pg8::EpiResid E{XB, (const float*)(ws + WS_MR1), AIN(17) + L * D, AIN(18) + L * D, ST0, (PG8_LAS float*)(glds + 131072)};
            pg8::gemm_phase<pg8::EpiResid, pg8::StaticOrder, true, true>(glds, g, S, E, F.wave);
#endif
 }
        else ln_phase(F, X, XB, AIN(21) + L * D, AIN(22) + L * D);
        if (ph + 1 < a.ph_hi) { XcdBarrier xb_; xb_.w0 = F.wave; xb_.bar = (unsigned*)AIN(24); xb_.x = xb_xcc_id(); xb_.st = (volatile LAS unsigned*)(glds + (LDS_BYTES - 16)); xcd_barrier(xb_); }
      }
    }
}

extern "C" void kernel_launch(void* const* d_in, const int* in_sizes, int n_in, void* d_out, int out_size, void* d_ws, size_t ws_size, hipStream_t stream) {
    static int grid = 0;
    if (grid == 0) {
        if (n_in != 23 || ws_size < WS_END2) { fprintf(stderr, "kernel_launch: need 23 inputs and %zu bytes of workspace, got %d and %zu\n", (size_t)WS_END2, n_in, ws_size); grid = -1; return; }
        int dev = 0, cus = 0, per_cu = 0;
        hipGetDevice(&dev); hipDeviceGetAttribute(&cus, hipDeviceAttributeMultiprocessorCount, dev);
        if (hipFuncSetAttribute((const void*)fwd_megakernel, hipFuncAttributeMaxDynamicSharedMemorySize, LDS_BYTES) != hipSuccess) { fprintf(stderr, "kernel_launch: hipFuncSetAttribute failed\n"); grid = -1; return; }
        if (hipOccupancyMaxActiveBlocksPerMultiprocessor(&per_cu, (const void*)fwd_megakernel, 512, LDS_BYTES) != hipSuccess || per_cu < 1) per_cu = 1;
        (void)hipGetLastError();
        grid = cus * per_cu;
        if (grid % 8 != 0) { fprintf(stderr, "kernel_launch: grid %d is not a multiple of 8\n", grid); grid = -1; return; }
    }
    if (grid < 0) return;
    Args a{};
    for (int i = 0; i < 23; ++i) a.in[i] = (const float*)d_in[i];
    a.in[23] = (const float*)d_out; a.in[24] = (const float*)d_ws; a.ph_lo = 0; a.ph_hi = 32;
    void* args[] = {&a};
    hipError_t e = hipLaunchCooperativeKernel((const void*)fwd_megakernel, dim3(grid), dim3(512), args, LDS_BYTES, stream);
    if (e != hipSuccess) fprintf(stderr, "cooperative launch failed: %s (grid %d)\n", hipGetErrorString(e), grid);
}
```

```cpp
#include <hip/hip_runtime.h>
#include <hip/hip_cooperative_groups.h>
#include <cstdio>
#include <cstdint>
namespace cg = cooperative_groups;
__device__ __forceinline__ int lane_id_() { return (int)__builtin_amdgcn_mbcnt_hi(~0u, __builtin_amdgcn_mbcnt_lo(~0u, 0u)); }
namespace pg8 {
#define PG8_LAS __attribute__((address_space(3)))
typedef unsigned short bf16_t;
typedef short bf16x8 __attribute__((ext_vector_type(8)));
typedef float f32x4 __attribute__((ext_vector_type(4)));
typedef unsigned u32x4 __attribute__((ext_vector_type(4)));
constexpr int BM = 256, BK = 64, HALF = 128, HTB = HALF * BK * 2  , STAGE_BYTES = 8 * HTB, NXCD = 8, WGM = 8;

__host__ __device__ __forceinline__ int lds_byte(int r, int c) { const int st = (r >> 4) * 2 + (c >> 5), rr = r & 15, cc = c & 31, ob = rr * 64 + cc * 2; return st * 1024 + (ob ^ (((ob >> 9) & 1) << 5)); }
__host__ __device__ __forceinline__ void stage_rc(int b, int& R, int& C) { const int st = b / 1024, sb = b % 1024, swz = sb ^ (((sb >> 9) & 1) << 5); R = (st >> 1) * 16 + swz / 64; C = (st & 1) * 32 + (swz % 64) / 2; }
__host__ __device__ __forceinline__ int perm32(int rho) { const int n = rho >> 4, i = rho & 15; return 8 * (i >> 2) + 4 * n + (i & 3); }

struct Unit { int pm, pn; };
struct Gemm { const bf16_t* A; const bf16_t* Bt; int M, N, K, lda; };

struct StaticOrder {
    int nM, nN, nwg, G, c;
    __host__ __device__ void init(int M, int N, int G_, int c_) { nM = M / BM; nN = N / BM; nwg = nM * nN; G = G_; c = c_; }
    __host__ __device__ bool next(int i, Unit& u) const {
        const long L = (long)i * G + c; if (L >= nwg) return false;
        int wgid = (int)L; { const int q = nwg / NXCD, r = nwg % NXCD, xcd = wgid % NXCD, off = wgid / NXCD; wgid = (xcd < r ? xcd * (q + 1) : r * (q + 1) + (xcd - r) * q) + off; }
        const int nig = WGM * nN, gid = wgid / nig, fm = gid * WGM, gsz = (nM - fm) < WGM ? (nM - fm) : WGM;
        u.pm = fm + ((wgid % nig) % gsz); u.pn = (wgid % nig) / gsz; return true;
    }
    __device__ __forceinline__ void a_ready(const Unit&) const {}
    __device__ __forceinline__ void done(const Unit&) const {}
};

__device__ __forceinline__ unsigned cvt_pk_bf16(float lo, float hi) { unsigned r; asm volatile("v_cvt_pk_bf16_f32 %0, %1, %2" : "=v"(r) : "v"(lo), "v"(hi)); return r; }
typedef float f32x2 __attribute__((ext_vector_type(2)));
template <class Epi, class Sched, bool ALIGN_EPI = false, bool SP2 = false>
__device__ __forceinline__ void gemm_phase(PG8_LAS unsigned char* lds, const Gemm g, const Sched& S, const Epi& E, const int wave_id) {
    int tid_ = wave_id * 64 + lane_id_(); asm volatile("" : "+v"(tid_));
    const int tid = tid_, wid = __builtin_amdgcn_readfirstlane(tid >> 6), lane = tid & 63, wr = wid >> 2, wc = wid & 3, fr = lane & 15, fq = lane >> 4;
    const int K = g.K, nt = K / BK;
    unsigned voffA[2], voffB[2];
#pragma unroll
    for (int i = 0; i < 2; ++i) { int R, C; stage_rc(tid * 16 + i * 8192, R, C); const int Rb = Epi::PERM ? ((R & ~31) + perm32(R & 31)) : R;
        voffA[i] = (unsigned)(R * g.lda + C) * 2u; voffB[i] = (unsigned)(Rb * K + C) * 2u; }
    const size_t kstep = (size_t)(BK * 2);
    const size_t hstepA = (size_t)HALF * g.lda * 2, hstepB = (size_t)HALF * K * 2;
    const size_t tstepA = 2 * hstepA, tstepB = 2 * hstepB;
    const unsigned ldsw = (unsigned)wid * 1024u;
    const int aoff = lds_byte(wr * 64 + fr, fq * 8), boff = lds_byte(wc * 32 + fr, fq * 8);
#define PG8_SA(b, h) (((b) * 2 + (h)) * HTB)
#define PG8_SB(b, h) ((4 + (b) * 2 + (h)) * HTB)
#define PG8_STAGE(bufoff, gbase, voff) do { _Pragma("unroll") for (int _i = 0; _i < 2; ++_i) \
        __builtin_amdgcn_global_load_lds((const unsigned*)((const char*)(gbase) + (voff)[_i]), (PG8_LAS unsigned*)(lds + (bufoff) + ldsw + _i * 8192), 16, 0, 0); } while (0)
#define PG8_LDA(dst, b, h) do { _Pragma("unroll") for (int m = 0; m < 4; ++m) _Pragma("unroll") for (int k = 0; k < 2; ++k) dst[m][k] = *(const PG8_LAS bf16x8*)(lds + PG8_SA(b, h) + aoff + m * 2048 + k * 1024); } while (0)
#define PG8_LDB(dst, b, h) do { _Pragma("unroll") for (int n = 0; n < 2; ++n) _Pragma("unroll") for (int k = 0; k < 2; ++k) dst[n][k] = *(const PG8_LAS bf16x8*)(lds + PG8_SB(b, h) + boff + n * 2048 + k * 1024); } while (0)
#define PG8_MMA(ai, bj, At, Bt) do { __builtin_amdgcn_s_setprio(1); _Pragma("unroll") for (int m = 0; m < 4; ++m) _Pragma("unroll") for (int n = 0; n < 2; ++n) _Pragma("unroll") for (int k = 0; k < 2; ++k) \
        acc[ai][bj][m][n] = __builtin_amdgcn_mfma_f32_16x16x32_bf16(Bt[n][k], At[m][k], acc[ai][bj][m][n], 0, 0, 0); __builtin_amdgcn_s_setprio(0); } while (0)
#define PG8_WAIT_V(n) asm volatile("s_waitcnt vmcnt(" #n ")" ::: "memory")
#define PG8_WAIT_L(n) asm volatile("s_waitcnt lgkmcnt(" #n ")" ::: "memory")
#define PG8_BAR __builtin_amdgcn_s_barrier()
#define PG8_SCHED __builtin_amdgcn_sched_barrier(0)
    Unit cur, nxt; int ui = 0;
    if (!S.next(0, cur)) return;
    f32x4 acc[2][2][4][2];
#pragma unroll
    for (int a = 0; a < 2; ++a)
#pragma unroll
        for (int b = 0; b < 2; ++b)
#pragma unroll
            for (int m = 0; m < 4; ++m)
#pragma unroll
                for (int n = 0; n < 2; ++n) acc[a][b][m][n] = (f32x4){0.f, 0.f, 0.f, 0.f};
    bf16x8 At[4][2], B0[2][2], B1[2][2];
    const char* cA = (const char*)g.A + (size_t)cur.pm * tstepA; const char* cB = (const char*)g.Bt + (size_t)cur.pn * tstepB;
    S.a_ready(cur);
    if constexpr (Epi::HAS_PF) E.prefetch(cur, tid);
    if constexpr (SP2) {
        PG8_STAGE(PG8_SB(0, 0), cB, voffB); PG8_STAGE(PG8_SB(0, 1), cB + hstepB, voffB); PG8_STAGE(PG8_SA(0, 0), cA, voffA); PG8_STAGE(PG8_SA(0, 1), cA + hstepA, voffA);
        if (wr == 1) PG8_BAR;
        PG8_WAIT_V(2); PG8_BAR;
        PG8_STAGE(PG8_SB(1, 0), cB + kstep, voffB); PG8_STAGE(PG8_SA(1, 0), cA + kstep, voffA); PG8_STAGE(PG8_SB(1, 1), cB + hstepB + kstep, voffB);
        PG8_WAIT_V(6); PG8_BAR;
    } else {
        PG8_STAGE(PG8_SB(0, 0), cB, voffB); PG8_STAGE(PG8_SA(0, 0), cA, voffA); PG8_STAGE(PG8_SB(0, 1), cB + hstepB, voffB); PG8_STAGE(PG8_SA(0, 1), cA + hstepA, voffA);
        if (wr == 1) PG8_BAR;
        PG8_WAIT_V(4); PG8_BAR;
        PG8_STAGE(PG8_SB(1, 0), cB + kstep, voffB); PG8_STAGE(PG8_SA(1, 0), cA + kstep, voffA); PG8_STAGE(PG8_SB(1, 1), cB + hstepB + kstep, voffB);
        PG8_WAIT_V(6); PG8_BAR;
    }
    for (;;) {
        const bool has_next = S.next(ui + 1, nxt);
        const char* nA = has_next ? (const char*)g.A + (size_t)nxt.pm * tstepA : cA; const char* nB = has_next ? (const char*)g.Bt + (size_t)nxt.pn * tstepB : cB;
        for (int t = 0; t < nt; t += 2) {
            const bool last = (t == nt - 2);
            if constexpr (Epi::HAS_WARM) { if (t == nt - 8) E.warm(cur, wid, lane, lds + 141312); }
            const char* a1 = cA + (size_t)(t + 1) * kstep;
            const char* a2 = last ? nA : cA + (size_t)(t + 2) * kstep; const char* b2 = last ? nB : cB + (size_t)(t + 2) * kstep;
            const char* a3 = a2 + kstep; const char* b3 = b2 + kstep;
            if (last && has_next) S.a_ready(nxt);
            if constexpr (SP2) {
            PG8_LDB(B0, 0, 0); PG8_LDB(B1, 0, 1); PG8_SCHED; PG8_LDA(At, 0, 0); PG8_STAGE(PG8_SA(1, 1), a1 + hstepA, voffA);
            PG8_WAIT_V(8); PG8_WAIT_L(0); PG8_BAR; PG8_MMA(0, 0, At, B0); PG8_MMA(0, 1, At, B1); PG8_BAR; PG8_SCHED;
            PG8_LDA(At, 0, 1); PG8_STAGE(PG8_SB(0, 0), b2, voffB); PG8_STAGE(PG8_SB(0, 1), b2 + hstepB, voffB); PG8_STAGE(PG8_SA(0, 0), a2, voffA);
            PG8_WAIT_V(8); PG8_WAIT_L(0); PG8_BAR; PG8_MMA(1, 0, At, B0); PG8_MMA(1, 1, At, B1); PG8_BAR; PG8_SCHED;
            PG8_LDB(B0, 1, 0); PG8_LDB(B1, 1, 1); PG8_SCHED; PG8_LDA(At, 1, 0); PG8_STAGE(PG8_SA(0, 1), a2 + hstepA, voffA);
            PG8_WAIT_V(8); PG8_WAIT_L(0); PG8_BAR; PG8_MMA(0, 0, At, B0); PG8_MMA(0, 1, At, B1); PG8_BAR; PG8_SCHED;
            PG8_LDA(At, 1, 1); PG8_STAGE(PG8_SB(1, 0), b3, voffB); PG8_STAGE(PG8_SB(1, 1), b3 + hstepB, voffB); PG8_STAGE(PG8_SA(1, 0), a3, voffA);
            PG8_WAIT_V(8); PG8_WAIT_L(0); PG8_BAR; PG8_MMA(1, 0, At, B0); PG8_MMA(1, 1, At, B1); PG8_BAR; PG8_SCHED;
            } else {
            PG8_LDB(B0, 0, 0); PG8_SCHED; PG8_LDA(At, 0, 0); PG8_STAGE(PG8_SA(1, 1), a1 + hstepA, voffA);
            PG8_WAIT_L(8); PG8_BAR; PG8_WAIT_L(0); PG8_MMA(0, 0, At, B0); PG8_BAR; PG8_SCHED;
            PG8_LDB(B1, 0, 1); PG8_STAGE(PG8_SB(0, 0), b2, voffB);
            PG8_BAR; PG8_WAIT_L(0); PG8_MMA(0, 1, At, B1); PG8_BAR;
            PG8_LDA(At, 0, 1); PG8_STAGE(PG8_SA(0, 0), a2, voffA);
            PG8_BAR; PG8_WAIT_L(0); PG8_MMA(1, 0, At, B0); PG8_BAR; PG8_SCHED;
            PG8_STAGE(PG8_SB(0, 1), b2 + hstepB, voffB);
            PG8_WAIT_V(6); PG8_BAR; PG8_MMA(1, 1, At, B1); PG8_BAR;
            PG8_LDB(B0, 1, 0); PG8_SCHED; PG8_LDA(At, 1, 0); PG8_STAGE(PG8_SA(0, 1), a2 + hstepA, voffA);
            PG8_WAIT_L(8); PG8_BAR; PG8_WAIT_L(0); PG8_MMA(0, 0, At, B0); PG8_BAR; PG8_SCHED;
            PG8_LDB(B1, 1, 1); PG8_STAGE(PG8_SB(1, 0), b3, voffB);
            PG8_BAR; PG8_WAIT_L(0); PG8_MMA(0, 1, At, B1); PG8_BAR;
            PG8_LDA(At, 1, 1); PG8_STAGE(PG8_SA(1, 0), a3, voffA);
            PG8_BAR; PG8_WAIT_L(0); PG8_MMA(1, 0, At, B0); PG8_BAR; PG8_SCHED;
            PG8_STAGE(PG8_SB(1, 1), b3 + hstepB, voffB);
            PG8_WAIT_V(6); PG8_BAR; PG8_MMA(1, 1, At, B1); PG8_BAR;
            }
        }
        if constexpr (ALIGN_EPI) { if (wr == 0) PG8_BAR; }
        if constexpr (!Epi::AFTER_DRAIN) { E(acc, cur, wr, wc, fr, fq); S.done(cur); }
        if (!has_next) break;
#pragma unroll
        for (int a = 0; a < 2; ++a)
#pragma unroll
            for (int b = 0; b < 2; ++b)
#pragma unroll
                for (int m = 0; m < 4; ++m)
#pragma unroll
                    for (int n = 0; n < 2; ++n) acc[a][b][m][n] = (f32x4){0.f, 0.f, 0.f, 0.f};
        cur = nxt; cA = nA; cB = nB; ++ui;
        if constexpr (Epi::HAS_PF) E.prefetch(cur, tid);
        if constexpr (ALIGN_EPI) { if (wr == 1) PG8_BAR; }
    }
    PG8_WAIT_V(0);
    if constexpr (!ALIGN_EPI) { if (wr == 0) PG8_BAR; }
    PG8_BAR;
    if constexpr (Epi::AFTER_DRAIN) { E.fused(acc, cur, wr, wc, fr, fq, lds, wid, lane); S.done(cur); }
#undef PG8_SA
#undef PG8_SB
#undef PG8_STAGE
#undef PG8_LDA
#undef PG8_LDB
#undef PG8_MMA
#undef PG8_WAIT_V
#undef PG8_WAIT_L
#undef PG8_BAR
#undef PG8_SCHED
}
}
#define LAS __attribute__((address_space(3)))
typedef unsigned short bf16;
typedef float f32x4 __attribute__((ext_vector_type(4)));
typedef float f32x16 __attribute__((ext_vector_type(16)));
typedef short bf16x8 __attribute__((ext_vector_type(8)));
typedef short s16x4 __attribute__((ext_vector_type(4)));
typedef unsigned u32x4 __attribute__((ext_vector_type(4)));
typedef unsigned u32x2 __attribute__((ext_vector_type(2)));
typedef float f32x2_t __attribute__((ext_vector_type(2)));
typedef __bf16 bf16x2_t __attribute__((ext_vector_type(2)));

constexpr int D = 1024, MP = 65536, MS = 2048, M = MP + MS, DFF = 4096;
constexpr int LDP = 6144, NPROJ = 6176, NPROJ_PAD = 6400;
constexpr float ALPHA = 1.6817928305074290f, LN_EPS = 1e-5f, RMS_EPS = 1e-5f, LOG2E = 1.4426950408889634f;
constexpr size_t O_KP = 69206016, O_VP = 102760448, O_HP = 136314880, O_CP = 153092096, O_KS = 153878528, O_VS = 158072832, O_HS = 162267136, O_CS = 179044352;
constexpr size_t MiB = 1u << 20;
constexpr size_t WS_WA = 1 * MiB, WS_WB = 14 * MiB, WS_WUP = 18 * MiB, WS_WDN = 26 * MiB, WS_XB = 34 * MiB, WS_DT = 166 * MiB, WS_BIG = 175 * MiB;
constexpr size_t WS_O = WS_BIG + 396 * MiB, WS_CK = WS_BIG + 528 * MiB, WS_CV = WS_BIG + 560 * MiB, WS_END = WS_BIG + 792 * MiB;
constexpr size_t WS_AUX = WS_END, WS_ST0 = WS_AUX, WS_ST1 = WS_AUX + 2304 * 1024, WS_CSA = WS_AUX + 4608 * 1024, WS_BWA = WS_CSA + 32 * 1024, WS_CSU = WS_CSA + 64 * 1024, WS_BWU = WS_CSA + 80 * 1024, WS_MR0 = WS_AUX + 4736 * 1024, WS_MR1 = WS_AUX + 5312 * 1024, WS_WDN1 = WS_AUX + 6 * MiB, WS_END2 = WS_AUX + 14 * MiB;
constexpr float FXS = 1048576.f, FXI = 1.f / 1048576.f;
typedef long long i64x2_t __attribute__((ext_vector_type(2)));
constexpr int LDS_BYTES = 147456;

__device__ __forceinline__ unsigned pk2(float lo, float hi) { f32x2_t v = {lo, hi}; bf16x2_t b = __builtin_convertvector(v, bf16x2_t); return __builtin_bit_cast(unsigned, b); }
__device__ __forceinline__ float bf2f(unsigned short u) { return __uint_as_float((unsigned)u << 16); }
__device__ __forceinline__ float bflo(unsigned u) { return __uint_as_float(u << 16); }
__device__ __forceinline__ float bfhi(unsigned u) { return __uint_as_float(u & 0xffff0000u); }
__device__ __forceinline__ float fexp2(float x) { return __builtin_amdgcn_exp2f(x); }
__device__ __forceinline__ float frcp(float x) { return __builtin_amdgcn_rcpf(x); }
__device__ __forceinline__ float silu_f(float v) { return v * frcp(1.0f + fexp2(-v * LOG2E)); }
__device__ __forceinline__ int crow(int r, int hi) { return (r & 3) + 8 * (r >> 2) + 4 * hi; }
__device__ __forceinline__ bf16x8 pack8(const f32x16& x, int s) {
    u32x4 p; p.x = pk2(x[8 * s], x[8 * s + 1]); p.y = pk2(x[8 * s + 2], x[8 * s + 3]); p.z = pk2(x[8 * s + 4], x[8 * s + 5]); p.w = pk2(x[8 * s + 6], x[8 * s + 7]);
    return __builtin_bit_cast(bf16x8, p);
}
#define MFMA32(a, b, c) __builtin_amdgcn_mfma_f32_32x32x16_bf16((a), (b), (c), 0, 0, 0)
__device__ __forceinline__ float wave_sum(float v) {
#pragma unroll
    for (int o = 1; o < 64; o <<= 1) v += __shfl_xor(v, o);
    return v;
}

namespace pg8 {
struct RowNorm {
    const float* st; const float* cs; const float* bw; float* mr_out;
    PG8_LAS float* T;
    float mu[2][4], rs[2][4]; f32x4 c[2][2], b[2][2];
    __device__ __forceinline__ void load(const Unit& u, int wr, int wc, int fr, int fq, const f32x4 pfa, const f32x4 pfb) {
        if (!st) return;
        const int tid = (wr * 4 + wc) * 64 + fq * 16 + fr;
        if (tid < 256) { const float mean = ((pfa[0] + pfa[2]) + (pfb[0] + pfb[2])) * (1.f / 1024.f), var = ((pfa[1] + pfa[3]) + (pfb[1] + pfb[3])) * (1.f / 1024.f) - mean * mean;
            const f32x2_t mrv = {mean, 1.0f / sqrtf(var + LN_EPS)};
            *(PG8_LAS f32x2_t*)(T + 2 * tid) = mrv;
            if (mr_out && u.pn == 0) *(f32x2_t*)(mr_out + 2 * (unsigned)(u.pm * BM + tid)) = mrv; }
        PG8_LAS float* CB = T + 1024;
        if (tid >= 256 && tid < 320) { const int t4 = 4 * (tid - 256); const f32x4 cc = *(const f32x4*)(cs + u.pn * BM + t4), bb = *(const f32x4*)(bw + u.pn * BM + t4);
            *(PG8_LAS f32x4*)(CB + t4) = cc; *(PG8_LAS f32x4*)(CB + 256 + t4) = bb; }
        asm volatile("s_waitcnt lgkmcnt(0)" ::: "memory"); __builtin_amdgcn_s_barrier(); asm volatile("" ::: "memory");
        const int cl = wc * 32 + 8 * fq;
#pragma unroll
        for (int bj = 0; bj < 2; ++bj)
#pragma unroll
            for (int n = 0; n < 2; ++n) { c[bj][n] = *(const PG8_LAS f32x4*)(CB + cl + bj * HALF + 4 * n); b[bj][n] = *(const PG8_LAS f32x4*)(CB + 256 + cl + bj * HALF + 4 * n); }
#pragma unroll
        for (int ai = 0; ai < 2; ++ai)
#pragma unroll
            for (int m = 0; m < 4; ++m) { const f32x2_t v = *(const PG8_LAS f32x2_t*)(T + 2 * (ai * HALF + wr * 64 + m * 16 + fr)); mu[ai][m] = v.x; rs[ai][m] = v.y; }
    }
    __device__ __forceinline__ f32x4 apply(const f32x4 a, int ai, int m, int bj, int n) const { return st ? (a - c[bj][n] * mu[ai][m]) * rs[ai][m] + b[bj][n] : a; }
};
#define PG8_PF_MEMBERS mutable f32x4 pfa, pfb; static constexpr bool HAS_PF = true, HAS_WARM = false; \
    __device__ __forceinline__ void prefetch(const Unit& u, int tid) const { if (st && tid < 256) { const float* sp = st + 8 * (unsigned)(u.pm * BM + tid); pfa = *(const f32x4*)sp; pfb = *(const f32x4*)(sp + 4); } }
struct EpiQKV {
    static constexpr bool PERM = true, AFTER_DRAIN = false;
    bf16_t* QKV; float* out; int li; const float* st; const float* cs; const float* bw; float* mr_out; PG8_LAS float* T; PG8_PF_MEMBERS
    __device__ __forceinline__ void operator()(const f32x4 (&acc)[2][2][4][2], const Unit& u, int wr, int wc, int fr, int fq) const {
        asm volatile("" : "+v"(fr));
        RowNorm rn; rn.st = st; rn.cs = cs; rn.bw = bw; rn.mr_out = mr_out; rn.T = T; rn.load(u, wr, wc, fr, fq, pfa, pfb);
        float* fdst = nullptr;
        if (u.pn >= 4) {
            const bool isv = u.pn >= 8;
            if (u.pm < 256) { const int b = u.pm >> 3, tt = u.pm & 7; if (tt >= 6) fdst = out + (isv ? O_VP : O_KP) + ((size_t)(li * 32 + b) * 512 + (size_t)(tt - 6) * 256) * 1024; }
            else fdst = out + (isv ? O_VS : O_KS) + ((size_t)li * 2048 + (size_t)(u.pm - 256) * 256) * 1024;
        }
        const int col0 = u.pn * BM + wc * 32 + 8 * fq, colk = (u.pn & 3) * BM + wc * 32 + 8 * fq;
#pragma unroll
        for (int ai = 0; ai < 2; ++ai)
#pragma unroll
            for (int m = 0; m < 4; ++m) { const int rl = ai * HALF + wr * 64 + m * 16 + fr; bf16_t* rowp = QKV + (unsigned)((u.pm * BM + rl) * 3072 + col0);
#pragma unroll
                for (int bj = 0; bj < 2; ++bj) { const f32x4 v0 = rn.apply(acc[ai][bj][m][0], ai, m, bj, 0), v1 = rn.apply(acc[ai][bj][m][1], ai, m, bj, 1);
                    u32x4 w; w.x = pk2(v0[0], v0[1]); w.y = pk2(v0[2], v0[3]); w.z = pk2(v1[0], v1[1]); w.w = pk2(v1[2], v1[3]);
                    *(u32x4*)(rowp + bj * HALF) = w;
                    if (fdst) { float* fp = fdst + (unsigned)(rl * 1024 + colk + bj * HALF); *(f32x4*)fp = v0; *(f32x4*)(fp + 4) = v1; } }
                asm volatile("" ::: "memory"); }
    }
};
struct EpiBf16Plain {
    static constexpr bool PERM = true, AFTER_DRAIN = false;
    bf16_t* O; int ldc; int relu2; const float* st; const float* cs; const float* bw; float* mr_out; PG8_LAS float* T; PG8_PF_MEMBERS
    __device__ __forceinline__ void operator()(const f32x4 (&acc)[2][2][4][2], const Unit& u, int wr, int wc, int fr, int fq) const {
        asm volatile("" : "+v"(fr));
        RowNorm rn; rn.st = st; rn.cs = cs; rn.bw = bw; rn.mr_out = mr_out; rn.T = T; rn.load(u, wr, wc, fr, fq, pfa, pfb);
        const int col0 = u.pn * BM + wc * 32 + 8 * fq;
#pragma unroll
        for (int ai = 0; ai < 2; ++ai)
#pragma unroll
            for (int m = 0; m < 4; ++m) { const int rl = ai * HALF + wr * 64 + m * 16 + fr; bf16_t* rowp = O + (unsigned)((u.pm * BM + rl) * ldc + col0);
#pragma unroll
                for (int bj = 0; bj < 2; ++bj) { f32x4 v0 = rn.apply(acc[ai][bj][m][0], ai, m, bj, 0), v1 = rn.apply(acc[ai][bj][m][1], ai, m, bj, 1);
                    if (relu2) { v0 = __builtin_elementwise_max(v0, (f32x4){0.f, 0.f, 0.f, 0.f}); v1 = __builtin_elementwise_max(v1, (f32x4){0.f, 0.f, 0.f, 0.f}); v0 = v0 * v0; v1 = v1 * v1; }
                    u32x4 w; w.x = pk2(v0[0], v0[1]); w.y = pk2(v0[2], v0[3]); w.z = pk2(v1[0], v1[1]); w.w = pk2(v1[2], v1[3]);
                    *(u32x4*)(rowp + bj * HALF) = w; } }
    }
};
struct EpiSsmIn {
    static constexpr bool PERM = true, AFTER_DRAIN = false;
    bf16_t* P; float* DT; const float* st; const float* cs; const float* bw; float* mr_out; PG8_LAS float* T; PG8_PF_MEMBERS
    __device__ __forceinline__ void operator()(const f32x4 (&acc)[2][2][4][2], const Unit& u, int wr, int wc, int fr, int fq) const {
        asm volatile("" : "+v"(fr));
        RowNorm rn; rn.st = st; rn.cs = cs; rn.bw = bw; rn.mr_out = mr_out; rn.T = T; rn.load(u, wr, wc, fr, fq, pfa, pfb);
        if (u.pn < 24) {
            const int col0 = u.pn * BM + wc * 32 + 8 * fq;
#pragma unroll
            for (int ai = 0; ai < 2; ++ai)
#pragma unroll
                for (int m = 0; m < 4; ++m) { const int rl = ai * HALF + wr * 64 + m * 16 + fr; bf16_t* rowp = P + (unsigned)((u.pm * BM + rl) * LDP + col0);
#pragma unroll
                    for (int bj = 0; bj < 2; ++bj) { const f32x4 v0 = rn.apply(acc[ai][bj][m][0], ai, m, bj, 0), v1 = rn.apply(acc[ai][bj][m][1], ai, m, bj, 1);
                        u32x4 w; w.x = pk2(v0[0], v0[1]); w.y = pk2(v0[2], v0[3]); w.z = pk2(v1[0], v1[1]); w.w = pk2(v1[2], v1[3]);
                        *(u32x4*)(rowp + bj * HALF) = w; }
                    asm volatile("" ::: "memory"); }
        } else if (wc == 0) {
#pragma unroll
            for (int ai = 0; ai < 2; ++ai)
#pragma unroll
                for (int m = 0; m < 4; ++m) { const int rl = ai * HALF + wr * 64 + m * 16 + fr; float* fp = DT + (unsigned)((u.pm * BM + rl) * 32 + 8 * fq);
                    *(f32x4*)fp = rn.apply(acc[ai][0][m][0], ai, m, 0, 0); *(f32x4*)(fp + 4) = rn.apply(acc[ai][0][m][1], ai, m, 0, 1); }
        }
    }
};
struct EpiResid {
    static constexpr bool PERM = true, AFTER_DRAIN = false, HAS_PF = false, HAS_WARM = false;
    __device__ __forceinline__ void warm(const Unit& u, int wid, int lane, PG8_LAS unsigned char* dummy) const {
#pragma unroll
        for (int i = 0; i < 2; ++i) { const int line = wid * 128 + i * 64 + lane, row = line >> 2, seg = line & 3;
            const char* gp = (const char*)XB + ((size_t)(unsigned)((u.pm * BM + row) * D + u.pn * BM)) * 2 + seg * 128;
            __builtin_amdgcn_global_load_lds((const unsigned*)gp, (PG8_LAS unsigned*)(dummy + wid * 256), 4, 0, 0); }
    }
    bf16_t* XB; const float* st_in; const float* gin; const float* bin; float* st_out; PG8_LAS float* P;
    static constexpr int DEPTH = 1;
    __device__ __forceinline__ void operator()(const f32x4 (&acc)[2][2][4][2], const Unit& u, int wr, int wc, int fr, int fq) const {
        asm volatile("" : "+v"(fr));
        const int col0 = u.pn * BM + wc * 32 + 8 * fq;
        const unsigned rowb0 = (unsigned)(u.pm * BM + wr * 64 + fr);
        PG8_LAS float* GB = P + 3072;
        { const int tid_ = (wr * 4 + wc) * 64 + fq * 16 + fr;
          if (st_in && tid_ < 64) { const f32x4 gg = *(const f32x4*)(gin + u.pn * BM + 4 * tid_), bb = *(const f32x4*)(bin + u.pn * BM + 4 * tid_);
              *(PG8_LAS f32x4*)(GB + 4 * tid_) = gg; *(PG8_LAS f32x4*)(GB + 256 + 4 * tid_) = bb; } }
        if (st_in) { asm volatile("s_waitcnt lgkmcnt(0)" ::: "memory"); __builtin_amdgcn_s_barrier(); asm volatile("" ::: "memory"); }
        const int cl = wc * 32 + 8 * fq;
#pragma unroll
        for (int ai = 0; ai < 2; ++ai) {
            u32x4 xv[4][2]; f32x2_t mr[4];
#pragma unroll
            for (int m = 0; m < 4; ++m) { const unsigned row_ = rowb0 + (unsigned)(ai * HALF + m * 16); const bf16_t* rp_ = XB + row_ * D + col0;
                xv[m][0] = *(const u32x4*)rp_; xv[m][1] = *(const u32x4*)(rp_ + HALF);
                if (st_in) mr[m] = *(const f32x2_t*)(st_in + 2 * row_); else mr[m] = (f32x2_t){0.f, 1.f}; }
            asm volatile("" ::: "memory");
#pragma unroll
            for (int m = 0; m < 4; ++m) {
                const unsigned row = rowb0 + (unsigned)(ai * HALF + m * 16);
                bf16_t* rowb = XB + row * D + col0;
                float mean = 0.f, rstd = 1.f;
                if (st_in) { mean = mr[m].x; rstd = mr[m].y; }
                float s1 = 0.f, s2 = 0.f;
#pragma unroll
                for (int bj = 0; bj < 2; ++bj) {
                    const u32x4 xw = xv[m][bj];
                    f32x4 x0 = (f32x4){bflo(xw.x), bfhi(xw.x), bflo(xw.y), bfhi(xw.y)}, x1 = (f32x4){bflo(xw.z), bfhi(xw.z), bflo(xw.w), bfhi(xw.w)};
                    if (st_in) { int c_ = cl + bj * HALF; asm volatile("" : "+v"(c_));
                        const f32x4 g0 = *(const PG8_LAS f32x4*)(GB + c_), g1 = *(const PG8_LAS f32x4*)(GB + c_ + 4), b0 = *(const PG8_LAS f32x4*)(GB + 256 + c_), b1 = *(const PG8_LAS f32x4*)(GB + 256 + c_ + 4);
                        x0 = (x0 - mean) * rstd * g0 + b0; x1 = (x1 - mean) * rstd * g1 + b1; }
                    const f32x4 v0 = x0 * ALPHA + acc[ai][bj][m][0], v1 = x1 * ALPHA + acc[ai][bj][m][1];
                    u32x4 w; w.x = pk2(v0[0], v0[1]); w.y = pk2(v0[2], v0[3]); w.z = pk2(v1[0], v1[1]); w.w = pk2(v1[2], v1[3]); *(u32x4*)(rowb + bj * HALF) = w;
                    s1 += ((v0[0] + v0[1]) + (v0[2] + v0[3])) + ((v1[0] + v1[1]) + (v1[2] + v1[3]));
                    s2 += ((v0[0] * v0[0] + v0[1] * v0[1]) + (v0[2] * v0[2] + v0[3] * v0[3])) + ((v1[0] * v1[0] + v1[1] * v1[1]) + (v1[2] * v1[2] + v1[3] * v1[3])); }
                s1 += __shfl_xor(s1, 16); s2 += __shfl_xor(s2, 16); s1 += __shfl_xor(s1, 32); s2 += __shfl_xor(s2, 32);
                if (fq == 0) *(PG8_LAS f32x2_t*)(P + ((ai * HALF + wr * 64 + m * 16 + fr) * 4 + wc) * 2) = (f32x2_t){s1, s2};
            }
            asm volatile("" ::: "memory");
        }
        asm volatile("s_waitcnt lgkmcnt(0)" ::: "memory"); __builtin_amdgcn_s_barrier(); asm volatile("" ::: "memory");
        const int tid = (wr * 4 + wc) * 64 + fq * 16 + fr;
        if (tid < 256) { const f32x4 qa = *(const PG8_LAS f32x4*)(P + tid * 8), qb = *(const PG8_LAS f32x4*)(P + tid * 8 + 4);
            *(f32x2_t*)(st_out + 8 * (unsigned)(u.pm * BM + tid) + 2 * u.pn) = (f32x2_t){(qa[0] + qa[2]) + (qb[0] + qb[2]), (qa[1] + qa[3]) + (qb[1] + qb[3])}; }
    }
};
}
#define XB_TMO      128
#define XB_XCNT(j)  (256  + 64 * (j))
#define XB_XSUB(j)  (1280 + 64 * (j))
#define XB_XGEN(j)  (2304 + 64 * (j))
#define XB_TOP      3328
#define XB_TOPGEN   3392
#define XCD_BAR_WORDS 3456
#define XB_SPIN_CAP (1u << 18)

__device__ __forceinline__ unsigned xb_ld(unsigned* p)              { return __hip_atomic_load(p, __ATOMIC_RELAXED, __HIP_MEMORY_SCOPE_AGENT); }
__device__ __forceinline__ unsigned xb_add(unsigned* p, unsigned v) { return __hip_atomic_fetch_add(p, v, __ATOMIC_RELAXED, __HIP_MEMORY_SCOPE_AGENT); }
__device__ __forceinline__ unsigned xb_xcc_id() { return (unsigned)__builtin_amdgcn_s_getreg((3 << 11) | 20) & 0xFu; }
#define XB_SPIN(cond, bar) do { unsigned _sp = 0; while (cond) { __builtin_amdgcn_s_sleep(1); \
    if ((++_sp & 255u) == 0u) { if (xb_ld(&(bar)[XB_TMO])) break; if (_sp > XB_SPIN_CAP) { atomicAdd(&(bar)[XB_TMO], 1u); break; } } } } while (0)

struct XcdBarrier {
    int w0;
    unsigned* bar; unsigned x;
    volatile LAS unsigned* st;
};

__device__ __forceinline__ XcdBarrier xcd_barrier_post(unsigned* bar, volatile LAS unsigned* st) {
    XcdBarrier b; b.bar = bar; b.x = xb_xcc_id(); b.st = st;
    if (threadIdx.x == 0) (void)xb_add(&bar[XB_XCNT(b.x)], 1u);
    return b;
}
__device__ __forceinline__ void xcd_barrier_complete(unsigned* bar, unsigned x, unsigned& nloc, unsigned& nx) {
    const unsigned G = gridDim.x * gridDim.y * gridDim.z;
    unsigned sum, cnt, mine, sp = 0u;
    for (;;) {
        sum = 0u; cnt = 0u; mine = 0u;
#pragma unroll
        for (unsigned j = 0; j < 16; ++j) { const unsigned c = xb_ld(&bar[XB_XCNT(j)]); sum += c; cnt += (c > 0u) ? 1u : 0u; mine = (j == x) ? c : mine; }
        if (sum == G) break;
        __builtin_amdgcn_s_sleep(1);
        if ((++sp & 255u) == 0u) { if (xb_ld(&bar[XB_TMO])) break; if (sp > XB_SPIN_CAP) { atomicAdd(&bar[XB_TMO], 1u); break; } }
    }
    nloc = mine > 0u ? mine : 1u; nx = cnt > 0u ? cnt : 1u;
}

__device__ __forceinline__ void xcd_barrier(const XcdBarrier& b) {
    asm volatile("s_waitcnt vmcnt(0)" ::: "memory");
    __syncthreads();
    if (b.w0 == 0 && lane_id_() == 0) {
        unsigned* bar = b.bar;
        __builtin_amdgcn_s_waitcnt(0);
        unsigned nloc = b.st[0], nx = b.st[1];
        if (nloc == 0u) { xcd_barrier_complete(bar, b.x, nloc, nx); b.st[0] = nloc; b.st[1] = nx; }
        const unsigned old = xb_add(&bar[XB_XSUB(b.x)], 1u);
        const unsigned gen = old / nloc;
        if (old + 1u == (gen + 1u) * nloc) {
            __builtin_amdgcn_fence(__ATOMIC_RELEASE, "agent");
            asm volatile("s_waitcnt vmcnt(0)" ::: "memory");
            const unsigned og = xb_add(&bar[XB_TOP], 1u);
            const unsigned tg = og / nx;
            if (og + 1u == (tg + 1u) * nx) xb_add(&bar[XB_TOPGEN], 1u);
            else XB_SPIN(xb_ld(&bar[XB_TOPGEN]) == tg, bar);
            __builtin_amdgcn_fence(__ATOMIC_ACQUIRE, "agent");
            xb_add(&bar[XB_XGEN(b.x)], 1u);
            asm volatile("s_waitcnt vmcnt(0)" ::: "memory");
        } else {
            XB_SPIN(xb_ld(&bar[XB_XGEN(b.x)]) == gen, bar);
            __builtin_amdgcn_fence(__ATOMIC_ACQUIRE, "agent");
            asm volatile("s_waitcnt vmcnt(0)" ::: "memory");
        }
    }
    __syncthreads();
}

struct Args { const float* in[25]; int ph_lo, ph_hi; };
#define AIN(k) (a.in[(k) + z])
struct Frame { unsigned char* lds; int tid, lane, wave, G, bid; };

__device__ __forceinline__ void transpose_item(const float* W, int K, int N, bf16* WT, float* scr, int item, int lane) {
    const int nblk = N / 32, kb = item / nblk, nb = item % nblk, k0 = 64 * kb, n0 = 32 * nb;
#pragma unroll 8
    for (int i = 0; i < 32; ++i) { const int kk = 2 * i + (lane >> 5); scr[kk * 33 + (lane & 31)] = W[(size_t)(k0 + kk) * N + n0 + (lane & 31)]; }
    asm volatile("s_waitcnt lgkmcnt(0)" ::: "memory");
    const int c = lane & 7;
#pragma unroll
    for (int j = 0; j < 4; ++j) { const int n = (lane >> 3) + 8 * j; const float* s = scr + (8 * c) * 33 + n;
        u32x4 o; o.x = pk2(s[0 * 33], s[1 * 33]); o.y = pk2(s[2 * 33], s[3 * 33]); o.z = pk2(s[4 * 33], s[5 * 33]); o.w = pk2(s[6 * 33], s[7 * 33]);
        *(u32x4*)(WT + (size_t)(n0 + n) * K + k0 + 8 * c) = o; }
    asm volatile("s_waitcnt lgkmcnt(0)" ::: "memory");
}
__device__ __forceinline__ void transpose_fold_item(const float* W, int K, int N, bf16* WT, const float* g, const float* b, float* cs, float* bw, float* scr, int nb, int lane) {
    const int n0 = 32 * nb; float csp = 0.f, bwp = 0.f;
    for (int k0 = 0; k0 < K; k0 += 64) {
#pragma unroll 8
        for (int i = 0; i < 32; ++i) { const int kk = 2 * i + (lane >> 5); const float w = W[(size_t)(k0 + kk) * N + n0 + (lane & 31)];
            const float wg = w * g[k0 + kk]; const float wr = bflo(pk2(wg, 0.f) & 0xffffu); scr[kk * 33 + (lane & 31)] = wr; csp += wr; bwp += w * b[k0 + kk]; }
        asm volatile("s_waitcnt lgkmcnt(0)" ::: "memory");
        const int c = lane & 7;
#pragma unroll
        for (int j = 0; j < 4; ++j) { const int n = (lane >> 3) + 8 * j; const float* s = scr + (8 * c) * 33 + n;
            u32x4 o; o.x = pk2(s[0 * 33], s[1 * 33]); o.y = pk2(s[2 * 33], s[3 * 33]); o.z = pk2(s[4 * 33], s[5 * 33]); o.w = pk2(s[6 * 33], s[7 * 33]);
            *(u32x4*)(WT + (size_t)(n0 + n) * K + k0 + 8 * c) = o; }
        asm volatile("s_waitcnt lgkmcnt(0)" ::: "memory");
    }
    csp += __shfl_xor(csp, 32); bwp += __shfl_xor(bwp, 32);
    if (lane < 32) { cs[n0 + lane] = csp; bw[n0 + lane] = bwp; }
}
__device__ __forceinline__ void cvt_stream(const float* src, bf16* dst, size_t n, size_t gtid, size_t gthreads) {
    for (size_t i = gtid * 8; i < n; i += gthreads * 8) { const f32x4 a = *(const f32x4*)(src + i), b = *(const f32x4*)(src + i + 4);
        u32x4 o; o.x = pk2(a[0], a[1]); o.y = pk2(a[2], a[3]); o.z = pk2(b[0], b[1]); o.w = pk2(b[2], b[3]); *(u32x4*)(dst + i) = o; }
}
__device__ __forceinline__ void convert_phase(const Frame& F, const Args& a, int z, int L) {
    unsigned char* ws = (unsigned char*)AIN(24); float* outp = (float*)AIN(23); const int li = L >> 1; const bool ssm = (L & 1);
    float* scr = (float*)(F.lds + F.wave * 16384);
    const int gw = F.bid * 8 + F.wave, NGW = F.G * 8;
    const float* Wa = ssm ? AIN(9) + (size_t)li * D * NPROJ : AIN(6) + (size_t)li * D * 3072; const int Na = ssm ? NPROJ : 3072;
    const float* Wb = ssm ? AIN(16) + (size_t)li * 2048 * D : AIN(8) + (size_t)li * D * D; const int Kb = ssm ? 2048 : D;
    const float* Wu = AIN(19) + (size_t)L * D * DFF; const float* Wd = AIN(20) + (size_t)L * DFF * D;
    const bool foldA = (L > 0);
    const float* gA = AIN(21) + (L - 1) * D; const float* bA = AIN(22) + (L - 1) * D;
    const float* gU = AIN(17) + L * D; const float* bU = AIN(18) + L * D;
    const int Ia = foldA ? Na / 32 : (D / 64) * (Na / 32), Ib = (Kb / 64) * (D / 32), Iu = DFF / 32, Id = (DFF / 64) * (D / 32);
    const int NIT = Ia + Ib + Iu + Id;
    for (int it = gw; it < NIT; it += NGW) {
        int r = it;
        if (r < Iu) { transpose_fold_item(Wu, D, DFF, (bf16*)(ws + WS_WUP), gU, bU, (float*)(ws + WS_CSU), (float*)(ws + WS_BWU), scr, r, F.lane); continue; } r -= Iu;
        if (r < Ia) { if (foldA) transpose_fold_item(Wa, D, Na, (bf16*)(ws + WS_WA), gA, bA, (float*)(ws + WS_CSA), (float*)(ws + WS_BWA), scr, r, F.lane);
                      else transpose_item(Wa, D, Na, (bf16*)(ws + WS_WA), scr, r, F.lane); continue; } r -= Ia;
        if (r < Ib) { transpose_item(Wb, Kb, D, (bf16*)(ws + WS_WB), scr, r, F.lane); continue; } r -= Ib;
        transpose_item(Wd, DFF, D, (bf16*)(ws + WS_WDN), scr, r, F.lane);
    }
    const size_t gtid = (size_t)F.bid * 512 + F.tid, gth = (size_t)F.G * 512;
    if (!ssm) {
        cvt_stream(AIN(2) + (size_t)li * 32 * 512 * 1024, (bf16*)(ws + WS_CK), (size_t)32 * 512 * 1024, gtid, gth);
        cvt_stream(AIN(3) + (size_t)li * 32 * 512 * 1024, (bf16*)(ws + WS_CV), (size_t)32 * 512 * 1024, gtid, gth);
    }
    if (L == 0) {
        const size_t n = (size_t)M * D, np = (size_t)MP * D;
        bf16* XB = (bf16*)(ws + WS_XB);
        for (size_t i = gtid * 8; i < n; i += gth * 8) { const float* src = i < np ? AIN(0) + i : AIN(1) + (i - np);
            const f32x4 x0 = *(const f32x4*)src, x1 = *(const f32x4*)(src + 4);
            u32x4 o; o.x = pk2(x0[0], x0[1]); o.y = pk2(x0[2], x0[3]); o.z = pk2(x1[0], x1[1]); o.w = pk2(x1[2], x1[3]); *(u32x4*)(XB + i) = o; }
    }
}
__device__ __forceinline__ void ln_phase(const Frame& F, float* X, const bf16* XB, const float* g, const float* b) {
    const int gw = F.bid * 8 + F.wave, NGW = F.G * 8;
    f32x4 gv[4], bv[4];
#pragma unroll
    for (int j = 0; j < 4; ++j) { gv[j] = *(const f32x4*)(g + 4 * F.lane + 256 * j); bv[j] = *(const f32x4*)(b + 4 * F.lane + 256 * j); }
    for (int m = gw; m < M; m += NGW) {
        f32x4* xr = (f32x4*)(X + (size_t)m * D) + F.lane;
        const u32x2* xb = (const u32x2*)(XB + (size_t)m * D) + F.lane;
        f32x4 v[4]; float s = 0.f;
#pragma unroll
        for (int j = 0; j < 4; ++j) { const u32x2 w = xb[64 * j]; v[j] = (f32x4){bflo(w.x), bfhi(w.x), bflo(w.y), bfhi(w.y)}; s += (v[j][0] + v[j][1]) + (v[j][2] + v[j][3]); }
        const float mean = wave_sum(s) * (1.f / D); float s2 = 0.f;
#pragma unroll
        for (int j = 0; j < 4; ++j) { v[j] = v[j] - mean; s2 += (v[j][0] * v[j][0] + v[j][1] * v[j][1]) + (v[j][2] * v[j][2] + v[j][3] * v[j][3]); }
        const float rstd = 1.f / sqrtf(wave_sum(s2) * (1.f / D) + LN_EPS);
#pragma unroll
        for (int j = 0; j < 4; ++j) xr[64 * j] = v[j] * rstd * gv[j] + bv[j];
    }
}

__device__ __forceinline__ void attn_phase(const Frame& F, const float* relb, const bf16* QKV, const bf16* CK, const bf16* CV, bf16* O) {
    float* tbl = (float*)F.lds;
    for (int i = F.tid; i < 16 * 513; i += 512) tbl[i] = relb[i] * LOG2E;
    __syncthreads();
    LAS unsigned char* const vtl = (LAS unsigned char*)F.lds + 32896 + F.wave * 9216;
    LAS unsigned char* const qtl = (LAS unsigned char*)F.lds + 106624 + F.wave * 4608;
    const int lane = F.lane, l31 = lane & 31, hh = lane >> 5;
    const int i16 = lane & 15, q4 = i16 >> 2, p4 = i16 & 3, dblk = (lane >> 4) & 1;
    const int gw = F.bid * 8 + F.wave, NGW = F.G * 8;
    constexpr int NITEM = (32 * 32 + 32) * 32;
    constexpr float C2 = 0.125f * LOG2E;
    const int xw = (F.bid >> 3) * 8 + F.wave, xn = (F.G >> 3) * 8, xcd = F.bid & 7;
    for (int jt = xw; jt < NITEM / 8; jt += xn) {
        int lq_ = lane; asm volatile("" : "+v"(lq_));
        LAS unsigned char* const wbase = vtl + (((lq_ >> 3) * 72 + 8 * (lq_ & 7)) * 2);
        LAS unsigned char* const fbase = vtl + (((lq_ & 31) * 72 + 8 * (lq_ >> 5)) * 2);
        LAS unsigned char* const qbase = qtl + (((lq_ & 31) * 72 + 8 * (lq_ >> 5)) * 2);
        LAS unsigned char* const tbase = vtl + (((4 * (lq_ >> 5) + ((lq_ & 15) >> 2)) * 72 + 16 * ((lq_ >> 4) & 1) + 4 * (lq_ & 3)) * 2);
        const bool smp = jt >= 4096; const int r0 = smp ? jt - 4096 : jt;
        const int r = smp ? r0 : (r0 & ~255) | ((r0 + 10 * (r0 >> 8)) & 255);
        const int qh = r & 1, c = smp ? 0 : (r >> 1) & 31, h = smp ? (r >> 1) & 15 : (r >> 6) & 15, b = xcd + 8 * (smp ? (r >> 5) : (r >> 10));
        const size_t qrow0 = smp ? (size_t)MP + b * 64 + 32 * qh : (size_t)b * 2048 + 64 * c + 32 * qh;
        { bf16x8 qr[4];
#pragma unroll
          for (int i = 0; i < 4; ++i) qr[i] = *(const bf16x8*)(QKV + (qrow0 + 8 * i + (lane >> 3)) * 3072 + h * 64 + 8 * (lane & 7));
#pragma unroll
          for (int i = 0; i < 4; ++i) *(LAS bf16x8*)(qtl + ((8 * i + (lane >> 3)) * 72 + 8 * (lane & 7)) * 2) = qr[i]; }
        asm volatile("" ::: "memory");
        f32x16 o0, o1;
#pragma unroll
        for (int i = 0; i < 16; ++i) { o0[i] = 0.f; o1[i] = 0.f; }
        float mrun = -1e30f, lsum = 0.f;
        const float* tb = tbl + h * 513;
        const int jb0 = smp ? 0 : (c >= 8 ? 0 : 8 - c);
        bf16x8 kr[8], vr[8];
        { const bf16 *K0, *V0; int p0;
          if (!smp) { K0 = QKV + ((size_t)b * 2048 + 64 * (c - 8 + jb0)) * 3072 + 1024 + h * 64; V0 = K0 + 1024; p0 = 3072; }
          else { K0 = CK + ((size_t)b * 512) * 1024 + h * 64; V0 = CV + ((size_t)b * 512) * 1024 + h * 64; p0 = 1024; }
          const unsigned vo_ = ((unsigned)(lane >> 3) * (unsigned)p0 + 8u * (unsigned)(lane & 7)) * 2u;
#pragma unroll
          for (int i = 0; i < 8; ++i) { const unsigned o_ = vo_ + (unsigned)i * 16u * (unsigned)p0; kr[i] = *(const bf16x8*)((const char*)K0 + o_); vr[i] = *(const bf16x8*)((const char*)V0 + o_); } }
        for (int jb = jb0; jb <= 8; ++jb) {
            const bf16 *Kp, *Vp; int pitch;
            if (!smp) { Kp = QKV + ((size_t)b * 2048 + 64 * (c - 8 + jb)) * 3072 + 1024 + h * 64; Vp = Kp + 1024; pitch = 3072; }
            else if (jb < 8) { Kp = CK + ((size_t)b * 512 + 64 * jb) * 1024 + h * 64; Vp = CV + ((size_t)b * 512 + 64 * jb) * 1024 + h * 64; pitch = 1024; }
            else { Kp = QKV + ((size_t)MP + b * 64) * 3072 + 1024 + h * 64; Vp = Kp + 1024; pitch = 3072; }
            bf16x8 kf[2][4];
            asm volatile("" ::: "memory");
#pragma unroll
            for (int i = 0; i < 8; ++i) *(LAS bf16x8*)(wbase + i * 1152) = kr[i];
            asm volatile("" ::: "memory");
#pragma unroll
            for (int rb = 0; rb < 2; ++rb)
#pragma unroll
                for (int ks = 0; ks < 4; ++ks) kf[rb][ks] = *(const LAS bf16x8*)(fbase + rb * 4608 + ks * 32);
            asm volatile("" ::: "memory");
#pragma unroll
            for (int i = 0; i < 8; ++i) *(LAS bf16x8*)(wbase + i * 1152) = vr[i];
            asm volatile("" ::: "memory");
            if (jb < 8) { const bf16 *Kn, *Vn; int pn_;
                if (!smp) { Kn = Kp + (size_t)64 * 3072; Vn = Vp + (size_t)64 * 3072; pn_ = 3072; }
                else if (jb < 7) { Kn = Kp + (size_t)64 * 1024; Vn = Vp + (size_t)64 * 1024; pn_ = 1024; }
                else { Kn = QKV + ((size_t)MP + b * 64) * 3072 + 1024 + h * 64; Vn = Kn + 1024; pn_ = 3072; }
                const unsigned vo_ = ((unsigned)(lane >> 3) * (unsigned)pn_ + 8u * (unsigned)(lane & 7)) * 2u;
#pragma unroll
                for (int i = 0; i < 8; ++i) { const unsigned o_ = vo_ + (unsigned)i * 16u * (unsigned)pn_; kr[i] = *(const bf16x8*)((const char*)Kn + o_); vr[i] = *(const bf16x8*)((const char*)Vn + o_); } }
            f32x16 s0, s1;
#pragma unroll
            for (int i = 0; i < 16; ++i) { s0[i] = 0.f; s1[i] = 0.f; }
#pragma unroll
            for (int ks = 0; ks < 4; ++ks) { const bf16x8 qf = *(const LAS bf16x8*)(qbase + ks * 32); s0 = MFMA32(kf[0][ks], qf, s0); s1 = MFMA32(kf[1][ks], qf, s1); }
            if (jb <= 3) {
                const float cbias = tb[512];
#pragma unroll
                for (int i = 0; i < 16; ++i) { s0[i] = s0[i] * C2 + cbias; s1[i] = s1[i] * C2 + cbias; }
            } else if (jb == 4) {
                const int dbase = 64 * (8 - jb) + 32 * qh + l31 + 256;
#pragma unroll
                for (int i = 0; i < 16; ++i) { const int k0 = crow(i, hh); int i0 = dbase - k0; i0 = i0 > 512 ? 512 : i0; s0[i] = s0[i] * C2 + tb[i0]; }
                asm volatile("" ::: "memory");
#pragma unroll
                for (int i = 0; i < 16; ++i) { const int k0 = crow(i, hh); int i1 = dbase - k0 - 32; i1 = i1 > 512 ? 512 : i1; s1[i] = s1[i] * C2 + tb[i1]; }
            } else {
                const float* pb = tb + (64 * (8 - jb) + 32 * qh + l31 + 256 - 4 * hh - 59);
#pragma unroll
                for (int i = 0; i < 16; ++i) { const int ci = (i & 3) + 8 * (i >> 2); s0[i] = s0[i] * C2 + pb[59 - ci]; }
                asm volatile("" ::: "memory");
#pragma unroll
                for (int i = 0; i < 16; ++i) { const int ci = (i & 3) + 8 * (i >> 2); s1[i] = s1[i] * C2 + pb[27 - ci]; }
            }
            float mx = s0[0];
#pragma unroll
            for (int i = 1; i < 16; ++i) mx = fmaxf(mx, s0[i]);
#pragma unroll
            for (int i = 0; i < 16; ++i) mx = fmaxf(mx, s1[i]);
            mx = fmaxf(mx, __shfl_xor(mx, 32));
            const float mnew = fmaxf(mrun, mx), alpha = fexp2(mrun - mnew);
            mrun = mnew;
            float ps = 0.f;
#pragma unroll
            for (int i = 0; i < 16; ++i) { s0[i] = fexp2(s0[i] - mnew); s1[i] = fexp2(s1[i] - mnew); ps += s0[i] + s1[i]; }
            lsum = lsum * alpha + ps;
#pragma unroll
            for (int i = 0; i < 16; ++i) { o0[i] *= alpha; o1[i] *= alpha; }
#pragma unroll
            for (int rb = 0; rb < 2; ++rb)
#pragma unroll
                for (int s2 = 0; s2 < 2; ++s2) {
                    const bf16x8 pf = pack8(rb ? s1 : s0, s2);
#pragma unroll
                    for (int db = 0; db < 2; ++db) {
                        const s16x4 lo = __builtin_amdgcn_ds_read_tr16_b64_v4i16((LAS s16x4*)(tbase + (32 * rb + 16 * s2) * 144 + db * 64));
                        const s16x4 hi = __builtin_amdgcn_ds_read_tr16_b64_v4i16((LAS s16x4*)(tbase + (32 * rb + 16 * s2 + 8) * 144 + db * 64));
                        const bf16x8 va = __builtin_shufflevector(lo, hi, 0, 1, 2, 3, 4, 5, 6, 7);
                        if (db == 0) o0 = MFMA32(va, pf, o0); else o1 = MFMA32(va, pf, o1);
                    }
                }
            asm volatile("" ::: "memory");
        }
        const float inv = 1.0f / (lsum + __shfl_xor(lsum, 32));
        bf16* orow = O + (qrow0 + l31) * D + h * 64 + 4 * hh;
#pragma unroll
        for (int i4 = 0; i4 < 4; ++i4) {
            u32x2 w0; w0.x = pk2(o0[4 * i4] * inv, o0[4 * i4 + 1] * inv); w0.y = pk2(o0[4 * i4 + 2] * inv, o0[4 * i4 + 3] * inv); *(u32x2*)(orow + 8 * i4) = w0;
            u32x2 w1; w1.x = pk2(o1[4 * i4] * inv, o1[4 * i4 + 1] * inv); w1.y = pk2(o1[4 * i4 + 2] * inv, o1[4 * i4 + 3] * inv); *(u32x2*)(orow + 32 + 8 * i4) = w1;
        }
    }
}
constexpr int SX_XT = 0, SX_XWT = 36864, SX_BT = 73728, SX_BS = 92160, SX_CS = 109568, SX_DT = 126976, SX_CUM = SX_DT + 1024, SX_WIN = SX_DT + 2048, SX_PART = SX_DT + 3072;
__device__ __forceinline__ void ssd_phase(const Frame& F, const Args& a, int z, int li, bf16* PROJ, const float* DT, bf16* dryXB) {
    float* outp = (float*)AIN(23);
    unsigned char* lds = F.lds;
    bf16* Xt = (bf16*)(lds + SX_XT); bf16* Xwt = (bf16*)(lds + SX_XWT); bf16* Bt = (bf16*)(lds + SX_BT); bf16* Bs = (bf16*)(lds + SX_BS); bf16* Cs = (bf16*)(lds + SX_CS);
    float* dts = (float*)(lds + SX_DT); float* cums = (float*)(lds + SX_CUM); float* wins = (float*)(lds + SX_WIN); float* part = (float*)(lds + SX_PART);
    const int tid = F.tid, lane = F.lane, wave = F.wave, l31 = lane & 31, hh = lane >> 5;
    const int r = wave >> 1, half = wave & 1;
    const float* conv_w = AIN(10) + (size_t)li * 4 * 4096; const float* conv_b = AIN(11) + (size_t)li * 4096;
    const float* dt_bias = AIN(12) + li * 32; const float* a_log = AIN(13) + li * 32; const float* d_skip = AIN(14) + li * 32; const float* norm_w = AIN(15) + (size_t)li * 2048;
    for (int item = F.bid; item < 512; item += F.G) {
        const bool smp = item >= 256; const int bg = item & 255, b = bg >> 3, g = bg & 7;
        const size_t row0 = smp ? (size_t)MP + b * 64 : (size_t)b * 2048; const int nchunks = smp ? 1 : 32;
        const int hglob = g * 4 + r;
        const float Dr = d_skip[hglob];
        f32x16 hT[4];
        const size_t hoff = (((size_t)(li * 32 + b) * 32 + hglob) * 64 + 32 * half + l31) * 128 + 4 * hh;
        if (smp) { const float* hs = AIN(4) + hoff;
#pragma unroll
            for (int nb = 0; nb < 4; ++nb)
#pragma unroll
                for (int i4 = 0; i4 < 4; ++i4) { const f32x4 v = *(const f32x4*)(hs + 32 * nb + 8 * i4); hT[nb][4 * i4] = v[0]; hT[nb][4 * i4 + 1] = v[1]; hT[nb][4 * i4 + 2] = v[2]; hT[nb][4 * i4 + 3] = v[3]; }
        } else {
#pragma unroll
            for (int nb = 0; nb < 4; ++nb)
#pragma unroll
                for (int i = 0; i < 16; ++i) hT[nb][i] = 0.f;
        }
        float dt_pf = (tid < 256) ? DT[(row0 + lane) * 32 + g * 4 + wave] : 0.f;
#pragma unroll 1
        for (int c = 0; c < nchunks; ++c) {
            const size_t rowc = row0 + 64 * c;
            int lane_ = F.lane; asm volatile("" : "+v"(lane_));
            const int lane = lane_, l31 = lane & 31, hh = lane >> 5, tid = wave * 64 + lane;
            const int role = lane < 32 ? 0 : (lane < 48 ? 1 : 2);
            const int chbase = role == 0 ? g * 256 + 8 * lane : (role == 1 ? 2048 + g * 128 + 8 * (lane - 32) : 3072 + g * 128 + 8 * (lane - 48));
            if (tid < 256) {
                const int hr = g * 4 + wave;
                const float raw = dt_pf + dt_bias[hr];
                if (c + 1 < nchunks) dt_pf = DT[(rowc + 64 + lane) * 32 + hr];
                const float dt = raw > 20.f ? raw : log1pf(__expf(raw));
                const float am = -__expf(a_log[hr]) * LOG2E;
                float v = dt * am;
#pragma unroll
                for (int o = 1; o < 64; o <<= 1) { const float n = __shfl_up(v, o); if (lane >= o) v += n; }
                const float last = __shfl(v, 63);
                dts[wave * 64 + lane] = dt; cums[wave * 64 + lane] = v; wins[wave * 64 + lane] = fexp2(last - v) * dt;
            }
            __syncthreads();
            {
                const bf16* src = PROJ + 2048 + chbase;
                u32x4 raw[11];
#pragma unroll
                for (int i = 0; i < 11; ++i) {
                    const int rr = 8 * wave - 3 + i;
                    if (rr >= 0 || c > 0) raw[i] = *(const u32x4*)(src + (size_t)((long)rowc + rr) * LDP);
                    else if (!smp) raw[i] = (u32x4){0u, 0u, 0u, 0u};
                    else { const float* sc = AIN(5) + ((size_t)(li * 32 + b) * 3 + (3 + rr)) * 4096 + chbase; const f32x4 s0 = *(const f32x4*)sc, s1 = *(const f32x4*)(sc + 4);
                        raw[i] = (u32x4){pk2(s0[0], s0[1]), pk2(s0[2], s0[3]), pk2(s1[0], s1[1]), pk2(s1[2], s1[3])}; }
                }
                if (c == nchunks - 1 && wave == 7) {
                    float* co = outp + (smp ? O_CS : O_CP) + ((size_t)(li * 32 + b) * 3) * 4096 + chbase;
#pragma unroll
                    for (int k = 0; k < 3; ++k) { const u32x4 rw = raw[8 + k];
                        *(f32x4*)(co + k * 4096) = (f32x4){bflo(rw.x), bfhi(rw.x), bflo(rw.y), bfhi(rw.y)}; *(f32x4*)(co + k * 4096 + 4) = (f32x4){bflo(rw.z), bfhi(rw.z), bflo(rw.w), bfhi(rw.w)}; }
                }
                float win8[8];
                { const float* wp = wins + (lane < 32 ? (lane >> 3) : 0) * 64 + 8 * wave;
                  const f32x4 wa = *(const f32x4*)wp, wb = *(const f32x4*)(wp + 4);
                  win8[0] = wa[0]; win8[1] = wa[1]; win8[2] = wa[2]; win8[3] = wa[3]; win8[4] = wb[0]; win8[5] = wb[1]; win8[6] = wb[2]; win8[7] = wb[3]; }
#pragma unroll
                for (int hb = 0; hb < 2; ++hb) {
                    f32x4 wv[4], bvv;
#pragma unroll
                    for (int k = 0; k < 4; ++k) wv[k] = *(const f32x4*)(conv_w + k * 4096 + chbase + 4 * hb);
                    bvv = *(const f32x4*)(conv_b + chbase + 4 * hb);
                    unsigned pc[4][4];
#pragma unroll
                    for (int e4 = 0; e4 < 4; ++e4) {
                        const int e = 4 * hb + e4;
                        float xv[11];
#pragma unroll
                        for (int i = 0; i < 11; ++i) { const unsigned wd = raw[i][e >> 1]; xv[i] = (e & 1) ? bfhi(wd) : bflo(wd); }
                        const float w0 = wv[0][e4], w1 = wv[1][e4], w2 = wv[2][e4], w3 = wv[3][e4], bb = bvv[e4];
                        float o[8];
#pragma unroll
                        for (int j = 0; j < 8; ++j) o[j] = silu_f(bb + w0 * xv[j] + w1 * xv[j + 1] + w2 * xv[j + 2] + w3 * xv[j + 3]);
#pragma unroll
                        for (int j2 = 0; j2 < 4; ++j2) pc[e4][j2] = pk2(o[2 * j2], o[2 * j2 + 1]);
                        if (role == 0) {
                            *(u32x4*)(Xt + (8 * lane + e) * 72 + 8 * (wave ^ (lane & 7))) = (u32x4){pc[e4][0], pc[e4][1], pc[e4][2], pc[e4][3]};
                            *(u32x4*)(Xwt + (8 * lane + e) * 72 + 8 * (wave ^ (lane & 7))) = (u32x4){pk2(o[0] * win8[0], o[1] * win8[1]), pk2(o[2] * win8[2], o[3] * win8[3]), pk2(o[4] * win8[4], o[5] * win8[5]), pk2(o[6] * win8[6], o[7] * win8[7])};
                        } else if (role == 1) {
                            *(u32x4*)(Bt + (8 * (lane - 32) + e) * 72 + 8 * (wave ^ (lane & 7))) = (u32x4){pc[e4][0], pc[e4][1], pc[e4][2], pc[e4][3]};
                        }
                    }
                    if (role != 0) {
                        bf16* dst = (role == 1 ? Bs + 8 * (lane - 32) : Cs + 8 * (lane - 48)) + (8 * wave) * 136 + 4 * hb;
#pragma unroll
                        for (int j2 = 0; j2 < 4; ++j2) {
                            u32x2 lo, hi;
                            lo.x = __builtin_amdgcn_perm(pc[1][j2], pc[0][j2], 0x05040100u); hi.x = __builtin_amdgcn_perm(pc[1][j2], pc[0][j2], 0x07060302u);
                            lo.y = __builtin_amdgcn_perm(pc[3][j2], pc[2][j2], 0x05040100u); hi.y = __builtin_amdgcn_perm(pc[3][j2], pc[2][j2], 0x07060302u);
                            *(u32x2*)(dst + (2 * j2) * 136) = lo; *(u32x2*)(dst + (2 * j2 + 1) * 136) = hi;
                        }
                    }
                }
            }
            __syncthreads();
            bf16* zr0 = PROJ + (rowc + l31) * LDP + g * 256 + 64 * r + 32 * half + 4 * hh; bf16* zr1 = zr0 + (size_t)32 * LDP;
            u32x2 zp0[4], zp1[4];
#pragma unroll
            for (int i4 = 0; i4 < 4; ++i4) { zp0[i4] = *(const u32x2*)(zr0 + 8 * i4); zp1[i4] = *(const u32x2*)(zr1 + 8 * i4); }
            f32x16 cb00, cb01, cb11;
#pragma unroll
            for (int i = 0; i < 16; ++i) { cb00[i] = 0.f; cb01[i] = 0.f; cb11[i] = 0.f; }
#pragma unroll
            for (int ns = 0; ns < 8; ++ns) {
                const bf16x8 a0 = *(const bf16x8*)(Bs + l31 * 136 + 16 * ns + 8 * hh), a1 = *(const bf16x8*)(Bs + (32 + l31) * 136 + 16 * ns + 8 * hh);
                const bf16x8 c0 = *(const bf16x8*)(Cs + l31 * 136 + 16 * ns + 8 * hh), c1 = *(const bf16x8*)(Cs + (32 + l31) * 136 + 16 * ns + 8 * hh);
                cb00 = MFMA32(a0, c0, cb00); cb01 = MFMA32(a0, c1, cb01); cb11 = MFMA32(a1, c1, cb11);
            }
            const float* cumr = cums + r * 64; const float* dtr = dts + r * 64;
            const float cum_t0 = cumr[l31], cum_t1 = cumr[32 + l31];
#pragma unroll
            for (int i4 = 0; i4 < 4; ++i4) {
                const f32x4 cs0 = *(const f32x4*)(cumr + 8 * i4 + 4 * hh), cs1 = *(const f32x4*)(cumr + 32 + 8 * i4 + 4 * hh);
                const f32x4 ds0 = *(const f32x4*)(dtr + 8 * i4 + 4 * hh), ds1 = *(const f32x4*)(dtr + 32 + 8 * i4 + 4 * hh);
#pragma unroll
                for (int j = 0; j < 4; ++j) { const int i = 4 * i4 + j, s = 8 * i4 + 4 * hh + j;
                    float v00 = cb00[i] * fexp2(fminf(cum_t0 - cs0[j], 0.f)) * ds0[j]; v00 = (s <= l31) ? v00 : 0.f; v00 += (s == l31) ? Dr : 0.f; cb00[i] = v00;
                    cb01[i] = cb01[i] * fexp2(fminf(cum_t1 - cs0[j], 0.f)) * ds0[j];
                    float v11 = cb11[i] * fexp2(fminf(cum_t1 - cs1[j], 0.f)) * ds1[j]; v11 = (s <= l31) ? v11 : 0.f; v11 += (s == l31) ? Dr : 0.f; cb11[i] = v11; }
            }
            f32x16 y0, y1;
#pragma unroll
            for (int i = 0; i < 16; ++i) { y0[i] = 0.f; y1[i] = 0.f; }
#pragma unroll
            for (int nb = 0; nb < 4; ++nb)
#pragma unroll
                for (int s2 = 0; s2 < 2; ++s2) {
                    const bf16x8 ha = pack8(hT[nb], s2);
                    const int n0 = 32 * nb + 16 * s2 + 4 * hh;
                    const s16x4 c0l = *(const s16x4*)(Cs + l31 * 136 + n0), c0h = *(const s16x4*)(Cs + l31 * 136 + n0 + 8);
                    const s16x4 c1l = *(const s16x4*)(Cs + (32 + l31) * 136 + n0), c1h = *(const s16x4*)(Cs + (32 + l31) * 136 + n0 + 8);
                    y0 = MFMA32(ha, __builtin_shufflevector(c0l, c0h, 0, 1, 2, 3, 4, 5, 6, 7), y0);
                    y1 = MFMA32(ha, __builtin_shufflevector(c1l, c1h, 0, 1, 2, 3, 4, 5, 6, 7), y1);
                }
            { const float e0 = fexp2(cum_t0), e1 = fexp2(cum_t1);
#pragma unroll
              for (int i = 0; i < 16; ++i) { y0[i] *= e0; y1[i] *= e1; } }
            { const bf16* xrow = Xt + (64 * r + 32 * half + l31) * 72;
#pragma unroll
              for (int s2 = 0; s2 < 2; ++s2) {
                  const int swx = 8 * ((4 * half + (l31 >> 3)) & 7);
                  const s16x4 x0l = *(const s16x4*)(xrow + ((16 * s2) ^ swx) + 4 * hh), x0h = *(const s16x4*)(xrow + ((16 * s2 + 8) ^ swx) + 4 * hh);
                  const s16x4 x1l = *(const s16x4*)(xrow + ((32 + 16 * s2) ^ swx) + 4 * hh), x1h = *(const s16x4*)(xrow + ((32 + 16 * s2 + 8) ^ swx) + 4 * hh);
                  const bf16x8 xa0 = __builtin_shufflevector(x0l, x0h, 0, 1, 2, 3, 4, 5, 6, 7), xa1 = __builtin_shufflevector(x1l, x1h, 0, 1, 2, 3, 4, 5, 6, 7);
                  y0 = MFMA32(xa0, pack8(cb00, s2), y0);
                  y1 = MFMA32(xa0, pack8(cb01, s2), y1);
                  y1 = MFMA32(xa1, pack8(cb11, s2), y1);
              } }
            {
                float ss0 = 0.f, ss1 = 0.f;
#pragma unroll
                for (int i4 = 0; i4 < 4; ++i4) {
                    const u32x2 z0 = zp0[i4], z1 = zp1[i4];
                    const float za[4] = {bflo(z0.x), bfhi(z0.x), bflo(z0.y), bfhi(z0.y)}, zb[4] = {bflo(z1.x), bfhi(z1.x), bflo(z1.y), bfhi(z1.y)};
#pragma unroll
                    for (int j = 0; j < 4; ++j) { const float v0 = y0[4 * i4 + j] * silu_f(za[j]), v1 = y1[4 * i4 + j] * silu_f(zb[j]); y0[4 * i4 + j] = v0; y1[4 * i4 + j] = v1; ss0 += v0 * v0; ss1 += v1 * v1; }
                }
                ss0 += __shfl_xor(ss0, 32); ss1 += __shfl_xor(ss1, 32);
                if (hh == 0) { part[l31 * 8 + wave] = ss0; part[(32 + l31) * 8 + wave] = ss1; }
                __syncthreads();
                const f32x4 pa = *(const f32x4*)(part + l31 * 8), pb = *(const f32x4*)(part + l31 * 8 + 4), pc = *(const f32x4*)(part + (32 + l31) * 8), pd = *(const f32x4*)(part + (32 + l31) * 8 + 4);
                const float t0 = ((pa[0] + pa[1]) + (pa[2] + pa[3])) + ((pb[0] + pb[1]) + (pb[2] + pb[3])), t1 = ((pc[0] + pc[1]) + (pc[2] + pc[3])) + ((pd[0] + pd[1]) + (pd[2] + pd[3]));
                const float r0 = 1.0f / sqrtf(t0 * (1.f / 256.f) + RMS_EPS), r1 = 1.0f / sqrtf(t1 * (1.f / 256.f) + RMS_EPS);
                const float* nwp = norm_w + g * 256 + 64 * r + 32 * half + 4 * hh;
#pragma unroll
                for (int i4 = 0; i4 < 4; ++i4) { const f32x4 nw = *(const f32x4*)(nwp + 8 * i4);
                    u32x2 w0; w0.x = pk2(y0[4 * i4] * r0 * nw[0], y0[4 * i4 + 1] * r0 * nw[1]); w0.y = pk2(y0[4 * i4 + 2] * r0 * nw[2], y0[4 * i4 + 3] * r0 * nw[3]); if (!dryXB) *(u32x2*)(zr0 + 8 * i4) = w0; else if (g < 4) *(u32x2*)(dryXB + (rowc + l31) * 1024 + g * 256 + 64 * r + 32 * half + 4 * hh + 8 * i4) = w0;
                    u32x2 w1; w1.x = pk2(y1[4 * i4] * r1 * nw[0], y1[4 * i4 + 1] * r1 * nw[1]); w1.y = pk2(y1[4 * i4 + 2] * r1 * nw[2], y1[4 * i4 + 3] * r1 * nw[3]); if (!dryXB) *(u32x2*)(zr1 + 8 * i4) = w1; else if (g < 4) *(u32x2*)(dryXB + (rowc + 32 + l31) * 1024 + g * 256 + 64 * r + 32 * half + 4 * hh + 8 * i4) = w1; }
            }
            { const float dec = fexp2(cumr[63]);
#pragma unroll
              for (int nb = 0; nb < 4; ++nb)
#pragma unroll
                  for (int i = 0; i < 16; ++i) hT[nb][i] *= dec;
              const bf16* xw = Xwt + (64 * r + 32 * half + l31) * 72; const int swx = 8 * ((4 * half + (l31 >> 3)) & 7), swn = 8 * (l31 >> 3);
#pragma unroll
              for (int ss = 0; ss < 4; ++ss) { const bf16x8 bx = *(const bf16x8*)(xw + ((16 * ss + 8 * hh) ^ swx));
#pragma unroll
                  for (int nb = 0; nb < 4; ++nb) { const bf16x8 af = *(const bf16x8*)(Bt + (32 * nb + l31) * 72 + ((16 * ss + 8 * hh) ^ swn ^ (32 * (nb & 1)))); hT[nb] = MFMA32(af, bx, hT[nb]); } }
            }
            __syncthreads();
        }
        { float* ho = outp + (smp ? O_HS : O_HP) + hoff;
#pragma unroll
          for (int nb = 0; nb < 4; ++nb)
#pragma unroll
              for (int i4 = 0; i4 < 4; ++i4) *(f32x4*)(ho + 32 * nb + 8 * i4) = (f32x4){hT[nb][4 * i4], hT[nb][4 * i4 + 1], hT[nb][4 * i4 + 2], hT[nb][4 * i4 + 3]};
          }
    }
}
__global__ void __launch_bounds__(512, 2) fwd_megakernel(Args a) {
    extern __shared__ __attribute__((aligned(16))) unsigned char lds[];
    cg::grid_group grid = cg::this_grid();
    const int wv0 = __builtin_amdgcn_readfirstlane((int)threadIdx.x >> 6);
    Frame F; F.lds = lds; F.tid = threadIdx.x; F.lane = F.tid & 63; F.wave = __builtin_amdgcn_readfirstlane(F.tid >> 6); F.G = gridDim.x; F.bid = blockIdx.x;
    PG8_LAS unsigned char* glds = (PG8_LAS unsigned char*)lds;
    {
        int z = 0; asm volatile("" : "+s"(z));
        unsigned* bw = (unsigned*)AIN(24);
        if (blockIdx.x == 0) for (int i = threadIdx.x; i < XCD_BAR_WORDS; i += 512) __hip_atomic_store(bw + i, 0u, __ATOMIC_RELAXED, __HIP_MEMORY_SCOPE_AGENT);
        volatile LAS unsigned* st = (volatile LAS unsigned*)(glds + (LDS_BYTES - 16));
        if (threadIdx.x < 2) st[threadIdx.x] = 0u;
        __syncthreads();
        grid.sync();
        (void)xcd_barrier_post(bw, st);
    }
#ifndef REP_IN
#define REP_IN 1
#endif
#ifndef REP_ATT
#define REP_ATT 1
#endif
#ifndef REP_UP
#define REP_UP 1
#endif
#ifndef REP_CONV
#define REP_CONV 1
#endif
#ifndef REP_SYNC
#define REP_SYNC 1
#endif
    for (int ph = a.ph_lo; ph < a.ph_hi; ++ph) {
      const int sub_ = ph & 7; if (sub_ == 4 || (sub_ == 7 && ph != 31)) continue;
      {
        { int t_ = wv0 * 64 + lane_id_(); asm volatile("" : "+v"(t_)); F.tid = t_; F.lane = t_ & 63; F.wave = wv0; }
        { int g_ = (int)gridDim.x, b_ = (int)blockIdx.x; asm volatile("" : "+s"(g_), "+s"(b_)); F.G = g_; F.bid = b_; }
        int z = 0; asm volatile("" : "+s"(z));
        unsigned char* ws = (unsigned char*)AIN(24);
        bf16* WA = (bf16*)(ws + WS_WA); bf16* WB = (bf16*)(ws + WS_WB); bf16* WUP = (bf16*)(ws + WS_WUP); bf16* WDN = (bf16*)(ws + WS_WDN);
        bf16* XB = (bf16*)(ws + WS_XB); float* DT = (float*)(ws + WS_DT); bf16* BIG = (bf16*)(ws + WS_BIG);
        bf16* OB = (bf16*)(ws + WS_O); bf16* CK = (bf16*)(ws + WS_CK); bf16* CV = (bf16*)(ws + WS_CV);
        float* X = (float*)AIN(23);
        float* ST0 = (float*)(ws + WS_ST0); float* ST1 = (float*)(ws + WS_ST1);
        const int L = ph >> 3, sub = ph & 7, li = L >> 1; const bool ssm = (L & 1);
        if (sub == 0) {
#ifndef NO_CONV
 convert_phase(F, a, z, L);
#endif
 }
        else if (sub == 1) {
#if !defined(ONLY_SUB) || ONLY_SUB == 1
            pg8::StaticOrder S;
            if (!ssm) { pg8::Gemm g{XB, WA, M, 3072, D, D}; S.init(M, 3072, F.G, F.bid); pg8::EpiQKV E{BIG, X, li, L > 0 ? ST0 : (const float*)nullptr, (const float*)(ws + WS_CSA), (const float*)(ws + WS_BWA), (float*)(ws + WS_MR0), (PG8_LAS float*)(glds + 131072 + 8192)};
                pg8::gemm_phase<pg8::EpiQKV, pg8::StaticOrder, true, true>(glds, g, S, E, F.wave); }
            else { pg8::Gemm g{XB, WA, M, NPROJ_PAD, D, D}; S.init(M, NPROJ_PAD, F.G, F.bid); pg8::EpiSsmIn E{BIG, DT, ST0, (const float*)(ws + WS_CSA), (const float*)(ws + WS_BWA), (float*)(ws + WS_MR0), (PG8_LAS float*)(glds + 131072 + 8192)};
                pg8::gemm_phase<pg8::EpiSsmIn, pg8::StaticOrder, true, true>(glds, g, S, E, F.wave); }
#endif
        } else if (sub == 2) {
#ifndef NO_ATTN
            if (!ssm) attn_phase(F, AIN(7) + (size_t)li * 16 * 513, BIG, CK, CV, OB);
#endif
#ifndef NO_SSD
#ifdef PROBE_SSD
            if (ssm) for (int pass = 0; pass < 2; ++pass) { ssd_phase(F, a, z, li, BIG, DT, pass == 0 ? XB : nullptr);
                if (pass == 0) { XcdBarrier xb_; xb_.w0 = F.wave; xb_.bar = (unsigned*)AIN(24); xb_.x = xb_xcc_id(); xb_.st = (volatile LAS unsigned*)(glds + (LDS_BYTES - 16)); xcd_barrier(xb_); } }
#else
            if (ssm) ssd_phase(F, a, z, li, BIG, DT, nullptr);
#endif
#endif
        } else if (sub == 3) {
#if !defined(ONLY_SUB) || ONLY_SUB == 3
            pg8::StaticOrder S; S.init(M, D, F.G, F.bid); pg8::EpiResid E{XB, L > 0 ? (const float*)(ws + WS_MR0) : (const float*)nullptr, AIN(21) + (L > 0 ? L - 1 : 0) * D, AIN(22) + (L > 0 ? L - 1 : 0) * D, ST1, (PG8_LAS float*)(glds + 131072)};
#ifdef PROBE_S3
            { pg8::Gemm g0 = ssm ? pg8::Gemm{BIG, WB, M, D, 2048, LDP} : pg8::Gemm{OB, WB, M, D, D, D};
              pg8::EpiBf16Plain E0{ssm ? BIG + 2048 : BIG, ssm ? LDP : D, 0, (const float*)nullptr, (const float*)nullptr, (const float*)nullptr, (float*)nullptr, (PG8_LAS float*)(glds + 131072 + 8192)};
              pg8::gemm_phase<pg8::EpiBf16Plain, pg8::StaticOrder, true, true>(glds, g0, S, E0, F.wave);
              XcdBarrier xb_; xb_.w0 = F.wave; xb_.bar = (unsigned*)AIN(24); xb_.x = xb_xcc_id(); xb_.st = (volatile LAS unsigned*)(glds + (LDS_BYTES - 16)); xcd_barrier(xb_); }
#endif
            if (!ssm) { pg8::Gemm g{OB, WB, M, D, D, D}; pg8::gemm_phase<pg8::EpiResid, pg8::StaticOrder, true, true>(glds, g, S, E, F.wave); }
            else { pg8::Gemm g{BIG, WB, M, D, 2048, LDP}; pg8::gemm_phase<pg8::EpiResid, pg8::StaticOrder, true, true>(glds, g, S, E, F.wave); }
#endif
        } else if (sub == 4) ln_phase(F, X, XB, AIN(17) + L * D, AIN(18) + L * D);
        else if (sub == 5) {
#if !defined(ONLY_SUB) || ONLY_SUB == 5
 pg8::Gemm g{XB, WUP, M, DFF, D, D}; pg8::StaticOrder S; S.init(M, DFF, F.G, F.bid); pg8::EpiBf16Plain E{BIG, DFF, 1, ST1, (const float*)(ws + WS_CSU), (const float*)(ws + WS_BWU), (float*)(ws + WS_MR1), (PG8_LAS float*)(glds + 131072 + 8192)};
            pg8::gemm_phase<pg8::EpiBf16Plain, pg8::StaticOrder, true, true>(glds, g, S, E, F.wave);
#endif
 }
        else if (sub == 6) {
#if !defined(ONLY_SUB) || ONLY_SUB == 6
 pg8::Gemm g{BIG, WDN, M, D, DFF, DFF}; pg8::StaticOrder S; S.init(M, D, F.G, F.bid);
#ifdef PROBE_DN
            { pg8::EpiBf16Plain E0{(bf16*)(ws + WS_CK), D, 0, (const float*)nullptr, (const float*)nullptr, (const float*)nullptr, (float*)nullptr, (PG8_LAS float*)(glds + 131072 + 8192)};
              pg8::gemm_phase<pg8::EpiBf16Plain, pg8::StaticOrder, true, true>(glds, g, S, E0, F.wave);
              XcdBarrier xb_; xb_.w0 = F.wave; xb_.bar = (unsigned*)AIN(24); xb_.x = xb_xcc_id(); xb_.st = (volatile LAS unsigned*)(glds + (LDS_BYTES - 16)); xcd_barrier(xb_); }
#endif
 pg8::EpiResid E{XB, (const float*)(ws + WS_MR1), AIN(17) + L * D, AIN(18) + L * D, ST0, (PG8_LAS float*)(glds + 131072)};
            pg8::gemm_phase<pg8::EpiResid, pg8::StaticOrder, true, true>(glds, g, S, E, F.wave);
#endif
 }
        else ln_phase(F, X, XB, AIN(21) + L * D, AIN(22) + L * D);
        if (ph + 1 < a.ph_hi) { XcdBarrier xb_; xb_.w0 = F.wave; xb_.bar = (unsigned*)AIN(24); xb_.x = xb_xcc_id(); xb_.st = (volatile LAS unsigned*)(glds + (LDS_BYTES - 16)); xcd_barrier(xb_); }
      }
    }
}

extern "C" void kernel_launch(void* const* d_in, const int* in_sizes, int n_in, void* d_out, int out_size, void* d_ws, size_t ws_size, hipStream_t stream) {
    static int grid = 0;
    if (grid == 0) {
        if (n_in != 23 || ws_size < WS_END2) { fprintf(stderr, "kernel_launch: need 23 inputs and %zu bytes of workspace, got %d and %zu\n", (size_t)WS_END2, n_in, ws_size); grid = -1; return; }
        int dev = 0, cus = 0, per_cu = 0;
        hipGetDevice(&dev); hipDeviceGetAttribute(&cus, hipDeviceAttributeMultiprocessorCount, dev);
        if (hipFuncSetAttribute((const void*)fwd_megakernel, hipFuncAttributeMaxDynamicSharedMemorySize, LDS_BYTES) != hipSuccess) { fprintf(stderr, "kernel_launch: hipFuncSetAttribute failed\n"); grid = -1; return; }
        if (hipOccupancyMaxActiveBlocksPerMultiprocessor(&per_cu, (const void*)fwd_megakernel, 512, LDS_BYTES) != hipSuccess || per_cu < 1) per_cu = 1;
        (void)hipGetLastError();
        grid = cus * per_cu;
        if (grid % 8 != 0) { fprintf(stderr, "kernel_launch: grid %d is not a multiple of 8\n", grid); grid = -1; return; }
    }
    if (grid < 0) return;
    Args a{};
    for (int i = 0; i < 23; ++i) a.in[i] = (const float*)d_in[i];
    a.in[23] = (const float*)d_out; a.in[24] = (const float*)d_ws; a.ph_lo = 0; a.ph_hi = 32;
    void* args[] = {&a};
    hipError_t e = hipLaunchCooperativeKernel((const void*)fwd_megakernel, dim3(grid), dim3(512), args, LDS_BYTES, stream);
    if (e != hipSuccess) fprintf(stderr, "cooperative launch failed: %s (grid %d)\n", hipGetErrorString(e), grid);
}
```

```cpp
#include <hip/hip_runtime.h>
#include <hip/hip_cooperative_groups.h>
#include <cstdio>
#include <cstdint>
namespace cg = cooperative_groups;
__device__ __forceinline__ int lane_id_() { return (int)__builtin_amdgcn_mbcnt_hi(~0u, __builtin_amdgcn_mbcnt_lo(~0u, 0u)); }
namespace pg8 {
#define PG8_LAS __attribute__((address_space(3)))
typedef unsigned short bf16_t;
typedef short bf16x8 __attribute__((ext_vector_type(8)));
typedef float f32x4 __attribute__((ext_vector_type(4)));
typedef unsigned u32x4 __attribute__((ext_vector_type(4)));
constexpr int BM = 256, BK = 64, HALF = 128, HTB = HALF * BK * 2  , STAGE_BYTES = 8 * HTB, NXCD = 8, WGM = 8;

__host__ __device__ __forceinline__ int lds_byte(int r, int c) { const int st = (r >> 4) * 2 + (c >> 5), rr = r & 15, cc = c & 31, ob = rr * 64 + cc * 2; return st * 1024 + (ob ^ (((ob >> 9) & 1) << 5)); }
__host__ __device__ __forceinline__ void stage_rc(int b, int& R, int& C) { const int st = b / 1024, sb = b % 1024, swz = sb ^ (((sb >> 9) & 1) << 5); R = (st >> 1) * 16 + swz / 64; C = (st & 1) * 32 + (swz % 64) / 2; }
__host__ __device__ __forceinline__ int perm32(int rho) { const int n = rho >> 4, i = rho & 15; return 8 * (i >> 2) + 4 * n + (i & 3); }

struct Unit { int pm, pn, kb; };
struct Gemm { const bf16_t* A; const bf16_t* Bt; int M, N, K, lda, ldb; };

struct StaticOrder {
    int nM, nN, nwg, G, c;
    __host__ __device__ void init(int M, int N, int G_, int c_) { nM = M / BM; nN = N / BM; nwg = nM * nN; G = G_; c = c_; }
    __host__ __device__ bool next(int i, Unit& u) const {
        const long L = (long)i * G + c; if (L >= nwg) return false;
        int wgid = (int)L; { const int q = nwg / NXCD, r = nwg % NXCD, xcd = wgid % NXCD, off = wgid / NXCD; wgid = (xcd < r ? xcd * (q + 1) : r * (q + 1) + (xcd - r) * q) + off; }
        const int nig = WGM * nN, gid = wgid / nig, fm = gid * WGM, gsz = (nM - fm) < WGM ? (nM - fm) : WGM;
        u.pm = fm + ((wgid % nig) % gsz); u.pn = (wgid % nig) / gsz; u.kb = 0; return true;
    }
    __device__ __forceinline__ void a_ready(const Unit&) const {}
    __device__ __forceinline__ void done(const Unit&) const {}
};

__device__ __forceinline__ unsigned cvt_pk_bf16(float lo, float hi) { unsigned r; asm volatile("v_cvt_pk_bf16_f32 %0, %1, %2" : "=v"(r) : "v"(lo), "v"(hi)); return r; }
typedef float f32x2 __attribute__((ext_vector_type(2)));
template <class Epi, class Sched, bool ALIGN_EPI = false, bool SP2 = false>
__device__ __forceinline__ void gemm_phase(PG8_LAS unsigned char* lds, const Gemm g, const Sched& S, const Epi& E, const int wave_id) {
    int tid_ = wave_id * 64 + lane_id_(); asm volatile("" : "+v"(tid_));
    const int tid = tid_, wid = __builtin_amdgcn_readfirstlane(tid >> 6), lane = tid & 63, wr = wid >> 2, wc = wid & 3, fr = lane & 15, fq = lane >> 4;
    const int K = g.K, nt = K / BK;
    unsigned voffA[2], voffB[2];
#pragma unroll
    for (int i = 0; i < 2; ++i) { int R, C; stage_rc(tid * 16 + i * 8192, R, C); const int Rb = Epi::PERM ? ((R & ~31) + perm32(R & 31)) : R;
        voffA[i] = (unsigned)(R * g.lda + C) * 2u; voffB[i] = (unsigned)(Rb * g.ldb + C) * 2u; }
    const size_t kstep = (size_t)(BK * 2);
    const size_t hstepA = (size_t)HALF * g.lda * 2, hstepB = (size_t)HALF * g.ldb * 2;
    const size_t tstepA = 2 * hstepA, tstepB = 2 * hstepB;
    const unsigned ldsw = (unsigned)wid * 1024u;
    const int aoff = lds_byte(wr * 64 + fr, fq * 8), boff = lds_byte(wc * 32 + fr, fq * 8);
#define PG8_SA(b, h) (((b) * 2 + (h)) * HTB)
#define PG8_SB(b, h) ((4 + (b) * 2 + (h)) * HTB)
#define PG8_STAGE(bufoff, gbase, voff) do { _Pragma("unroll") for (int _i = 0; _i < 2; ++_i) \
        __builtin_amdgcn_global_load_lds((const unsigned*)((const char*)(gbase) + (voff)[_i]), (PG8_LAS unsigned*)(lds + (bufoff) + ldsw + _i * 8192), 16, 0, 0); } while (0)
#define PG8_LDA(dst, b, h) do { _Pragma("unroll") for (int m = 0; m < 4; ++m) _Pragma("unroll") for (int k = 0; k < 2; ++k) dst[m][k] = *(const PG8_LAS bf16x8*)(lds + PG8_SA(b, h) + aoff + m * 2048 + k * 1024); } while (0)
#define PG8_LDB(dst, b, h) do { _Pragma("unroll") for (int n = 0; n < 2; ++n) _Pragma("unroll") for (int k = 0; k < 2; ++k) dst[n][k] = *(const PG8_LAS bf16x8*)(lds + PG8_SB(b, h) + boff + n * 2048 + k * 1024); } while (0)
#define PG8_MMA(ai, bj, At, Bt) do { __builtin_amdgcn_s_setprio(1); _Pragma("unroll") for (int m = 0; m < 4; ++m) _Pragma("unroll") for (int n = 0; n < 2; ++n) _Pragma("unroll") for (int k = 0; k < 2; ++k) \
        acc[ai][bj][m][n] = __builtin_amdgcn_mfma_f32_16x16x32_bf16(Bt[n][k], At[m][k], acc[ai][bj][m][n], 0, 0, 0); __builtin_amdgcn_s_setprio(0); } while (0)
#define PG8_WAIT_V(n) asm volatile("s_waitcnt vmcnt(" #n ")" ::: "memory")
#define PG8_WAIT_L(n) asm volatile("s_waitcnt lgkmcnt(" #n ")" ::: "memory")
#define PG8_BAR __builtin_amdgcn_s_barrier()
#define PG8_SCHED __builtin_amdgcn_sched_barrier(0)
    Unit cur, nxt; int ui = 0;
    if (!S.next(0, cur)) return;
    f32x4 acc[2][2][4][2];
#pragma unroll
    for (int a = 0; a < 2; ++a)
#pragma unroll
        for (int b = 0; b < 2; ++b)
#pragma unroll
            for (int m = 0; m < 4; ++m)
#pragma unroll
                for (int n = 0; n < 2; ++n) acc[a][b][m][n] = (f32x4){0.f, 0.f, 0.f, 0.f};
    bf16x8 At[4][2], B0[2][2], B1[2][2];
    const char* cA = (const char*)g.A + (size_t)cur.pm * tstepA + (size_t)cur.kb * K * 2; const char* cB = (const char*)g.Bt + (size_t)cur.pn * tstepB + (size_t)cur.kb * K * 2;
    S.a_ready(cur);
    if constexpr (Epi::HAS_PF) E.prefetch(cur, tid);
    if constexpr (SP2) {
        PG8_STAGE(PG8_SB(0, 0), cB, voffB); PG8_STAGE(PG8_SB(0, 1), cB + hstepB, voffB); PG8_STAGE(PG8_SA(0, 0), cA, voffA); PG8_STAGE(PG8_SA(0, 1), cA + hstepA, voffA);
        if (wr == 1) PG8_BAR;
        PG8_WAIT_V(2); PG8_BAR;
        PG8_STAGE(PG8_SB(1, 0), cB + kstep, voffB); PG8_STAGE(PG8_SA(1, 0), cA + kstep, voffA); PG8_STAGE(PG8_SB(1, 1), cB + hstepB + kstep, voffB);
        PG8_WAIT_V(6); PG8_BAR;
    } else {
        PG8_STAGE(PG8_SB(0, 0), cB, voffB); PG8_STAGE(PG8_SA(0, 0), cA, voffA); PG8_STAGE(PG8_SB(0, 1), cB + hstepB, voffB); PG8_STAGE(PG8_SA(0, 1), cA + hstepA, voffA);
        if (wr == 1) PG8_BAR;
        PG8_WAIT_V(4); PG8_BAR;
        PG8_STAGE(PG8_SB(1, 0), cB + kstep, voffB); PG8_STAGE(PG8_SA(1, 0), cA + kstep, voffA); PG8_STAGE(PG8_SB(1, 1), cB + hstepB + kstep, voffB);
        PG8_WAIT_V(6); PG8_BAR;
    }
    for (;;) {
        const bool has_next = S.next(ui + 1, nxt);
        const char* nA = has_next ? (const char*)g.A + (size_t)nxt.pm * tstepA + (size_t)nxt.kb * K * 2 : cA; const char* nB = has_next ? (const char*)g.Bt + (size_t)nxt.pn * tstepB + (size_t)nxt.kb * K * 2 : cB;
        for (int t = 0; t < nt; t += 2) {
            const bool last = (t == nt - 2);
            if constexpr (Epi::HAS_WARM) { if (t == nt - 8) E.warm(cur, wid, lane, lds + 141312); }
            const char* a1 = cA + (size_t)(t + 1) * kstep;
            const char* a2 = last ? nA : cA + (size_t)(t + 2) * kstep; const char* b2 = last ? nB : cB + (size_t)(t + 2) * kstep;
            const char* a3 = a2 + kstep; const char* b3 = b2 + kstep;
            if (last && has_next) S.a_ready(nxt);
            if constexpr (SP2) {
            PG8_LDB(B0, 0, 0); PG8_LDB(B1, 0, 1); PG8_SCHED; PG8_LDA(At, 0, 0); PG8_STAGE(PG8_SA(1, 1), a1 + hstepA, voffA);
            PG8_WAIT_V(8); PG8_WAIT_L(0); PG8_BAR; PG8_MMA(0, 0, At, B0); PG8_MMA(0, 1, At, B1); PG8_BAR; PG8_SCHED;
            PG8_LDA(At, 0, 1); PG8_STAGE(PG8_SB(0, 0), b2, voffB); PG8_STAGE(PG8_SB(0, 1), b2 + hstepB, voffB); PG8_STAGE(PG8_SA(0, 0), a2, voffA);
            PG8_WAIT_V(8); PG8_WAIT_L(0); PG8_BAR; PG8_MMA(1, 0, At, B0); PG8_MMA(1, 1, At, B1); PG8_BAR; PG8_SCHED;
            PG8_LDB(B0, 1, 0); PG8_LDB(B1, 1, 1); PG8_SCHED; PG8_LDA(At, 1, 0); PG8_STAGE(PG8_SA(0, 1), a2 + hstepA, voffA);
            PG8_WAIT_V(8); PG8_WAIT_L(0); PG8_BAR; PG8_MMA(0, 0, At, B0); PG8_MMA(0, 1, At, B1); PG8_BAR; PG8_SCHED;
            PG8_LDA(At, 1, 1); PG8_STAGE(PG8_SB(1, 0), b3, voffB); PG8_STAGE(PG8_SB(1, 1), b3 + hstepB, voffB); PG8_STAGE(PG8_SA(1, 0), a3, voffA);
            PG8_WAIT_V(8); PG8_WAIT_L(0); PG8_BAR; PG8_MMA(1, 0, At, B0); PG8_MMA(1, 1, At, B1); PG8_BAR; PG8_SCHED;
            } else {
            PG8_LDB(B0, 0, 0); PG8_SCHED; PG8_LDA(At, 0, 0); PG8_STAGE(PG8_SA(1, 1), a1 + hstepA, voffA);
            PG8_WAIT_L(8); PG8_BAR; PG8_WAIT_L(0); PG8_MMA(0, 0, At, B0); PG8_BAR; PG8_SCHED;
            PG8_LDB(B1, 0, 1); PG8_STAGE(PG8_SB(0, 0), b2, voffB);
            PG8_BAR; PG8_WAIT_L(0); PG8_MMA(0, 1, At, B1); PG8_BAR;
            PG8_LDA(At, 0, 1); PG8_STAGE(PG8_SA(0, 0), a2, voffA);
            PG8_BAR; PG8_WAIT_L(0); PG8_MMA(1, 0, At, B0); PG8_BAR; PG8_SCHED;
            PG8_STAGE(PG8_SB(0, 1), b2 + hstepB, voffB);
            PG8_WAIT_V(6); PG8_BAR; PG8_MMA(1, 1, At, B1); PG8_BAR;
            PG8_LDB(B0, 1, 0); PG8_SCHED; PG8_LDA(At, 1, 0); PG8_STAGE(PG8_SA(0, 1), a2 + hstepA, voffA);
            PG8_WAIT_L(8); PG8_BAR; PG8_WAIT_L(0); PG8_MMA(0, 0, At, B0); PG8_BAR; PG8_SCHED;
            PG8_LDB(B1, 1, 1); PG8_STAGE(PG8_SB(1, 0), b3, voffB);
            PG8_BAR; PG8_WAIT_L(0); PG8_MMA(0, 1, At, B1); PG8_BAR;
            PG8_LDA(At, 1, 1); PG8_STAGE(PG8_SA(1, 0), a3, voffA);
            PG8_BAR; PG8_WAIT_L(0); PG8_MMA(1, 0, At, B0); PG8_BAR; PG8_SCHED;
            PG8_STAGE(PG8_SB(1, 1), b3 + hstepB, voffB);
            PG8_WAIT_V(6); PG8_BAR; PG8_MMA(1, 1, At, B1); PG8_BAR;
            }
        }
        if constexpr (ALIGN_EPI) { if (wr == 0) PG8_BAR; }
        if constexpr (!Epi::AFTER_DRAIN) { E(acc, cur, wr, wc, fr, fq); S.done(cur); }
        if (!has_next) break;
#pragma unroll
        for (int a = 0; a < 2; ++a)
#pragma unroll
            for (int b = 0; b < 2; ++b)
#pragma unroll
                for (int m = 0; m < 4; ++m)
#pragma unroll
                    for (int n = 0; n < 2; ++n) acc[a][b][m][n] = (f32x4){0.f, 0.f, 0.f, 0.f};
        cur = nxt; cA = nA; cB = nB; ++ui;
        if constexpr (Epi::HAS_PF) E.prefetch(cur, tid);
        if constexpr (ALIGN_EPI) { if (wr == 1) PG8_BAR; }
    }
    PG8_WAIT_V(0);
    if constexpr (!ALIGN_EPI) { if (wr == 0) PG8_BAR; }
    PG8_BAR;
    if constexpr (Epi::AFTER_DRAIN) { E.fused(acc, cur, wr, wc, fr, fq, lds, wid, lane); S.done(cur); }
#undef PG8_SA
#undef PG8_SB
#undef PG8_STAGE
#undef PG8_LDA
#undef PG8_LDB
#undef PG8_MMA
#undef PG8_WAIT_V
#undef PG8_WAIT_L
#undef PG8_BAR
#undef PG8_SCHED
}
}
#define LAS __attribute__((address_space(3)))
typedef unsigned short bf16;
typedef float f32x4 __attribute__((ext_vector_type(4)));
typedef float f32x16 __attribute__((ext_vector_type(16)));
typedef short bf16x8 __attribute__((ext_vector_type(8)));
typedef short s16x4 __attribute__((ext_vector_type(4)));
typedef unsigned u32x4 __attribute__((ext_vector_type(4)));
typedef unsigned u32x2 __attribute__((ext_vector_type(2)));
typedef float f32x2_t __attribute__((ext_vector_type(2)));
typedef __bf16 bf16x2_t __attribute__((ext_vector_type(2)));

constexpr int D = 1024, MP = 65536, MS = 2048, M = MP + MS, DFF = 4096;
constexpr int LDP = 6144, NPROJ = 6176, NPROJ_PAD = 6400;
constexpr float ALPHA = 1.6817928305074290f, LN_EPS = 1e-5f, RMS_EPS = 1e-5f, LOG2E = 1.4426950408889634f;
constexpr size_t O_KP = 69206016, O_VP = 102760448, O_HP = 136314880, O_CP = 153092096, O_KS = 153878528, O_VS = 158072832, O_HS = 162267136, O_CS = 179044352;
constexpr size_t MiB = 1u << 20;
constexpr size_t WS_WA = 1 * MiB, WS_WB = 14 * MiB, WS_WUP = 18 * MiB, WS_WDN = 26 * MiB, WS_XB = 34 * MiB, WS_DT = 166 * MiB, WS_BIG = 175 * MiB;
constexpr size_t WS_O = WS_BIG + 396 * MiB, WS_CK = WS_BIG + 528 * MiB, WS_CV = WS_BIG + 560 * MiB, WS_END = WS_BIG + 792 * MiB;
constexpr size_t WS_AUX = WS_END, WS_ST0 = WS_AUX, WS_ST1 = WS_AUX + 2304 * 1024, WS_CSA = WS_AUX + 4608 * 1024, WS_BWA = WS_CSA + 32 * 1024, WS_CSU = WS_CSA + 64 * 1024, WS_BWU = WS_CSA + 80 * 1024, WS_MR0 = WS_AUX + 4736 * 1024, WS_MR1 = WS_AUX + 5312 * 1024, WS_WDN1 = WS_AUX + 6 * MiB, WS_END2 = WS_AUX + 14 * MiB;
constexpr float FXS = 1048576.f, FXI = 1.f / 1048576.f;
typedef long long i64x2_t __attribute__((ext_vector_type(2)));
constexpr int LDS_BYTES = 147456;

__device__ __forceinline__ unsigned pk2(float lo, float hi) { f32x2_t v = {lo, hi}; bf16x2_t b = __builtin_convertvector(v, bf16x2_t); return __builtin_bit_cast(unsigned, b); }
__device__ __forceinline__ float bf2f(unsigned short u) { return __uint_as_float((unsigned)u << 16); }
__device__ __forceinline__ float bflo(unsigned u) { return __uint_as_float(u << 16); }
__device__ __forceinline__ float bfhi(unsigned u) { return __uint_as_float(u & 0xffff0000u); }
__device__ __forceinline__ float fexp2(float x) { return __builtin_amdgcn_exp2f(x); }
__device__ __forceinline__ float frcp(float x) { return __builtin_amdgcn_rcpf(x); }
__device__ __forceinline__ float silu_f(float v) { return v * frcp(1.0f + fexp2(-v * LOG2E)); }
__device__ __forceinline__ int crow(int r, int hi) { return (r & 3) + 8 * (r >> 2) + 4 * hi; }
__device__ __forceinline__ bf16x8 pack8(const f32x16& x, int s) {
    u32x4 p; p.x = pk2(x[8 * s], x[8 * s + 1]); p.y = pk2(x[8 * s + 2], x[8 * s + 3]); p.z = pk2(x[8 * s + 4], x[8 * s + 5]); p.w = pk2(x[8 * s + 6], x[8 * s + 7]);
    return __builtin_bit_cast(bf16x8, p);
}
#define MFMA32(a, b, c) __builtin_amdgcn_mfma_f32_32x32x16_bf16((a), (b), (c), 0, 0, 0)
__device__ __forceinline__ float wave_sum(float v) {
#pragma unroll
    for (int o = 1; o < 64; o <<= 1) v += __shfl_xor(v, o);
    return v;
}

namespace pg8 {
struct RowNorm {
    const float* st; const float* cs; const float* bw; float* mr_out;
    PG8_LAS float* T;
    float mu[2][4], rs[2][4]; f32x4 c[2][2], b[2][2];
    __device__ __forceinline__ void load(const Unit& u, int wr, int wc, int fr, int fq, const f32x4 pfa, const f32x4 pfb) {
        if (!st) return;
        const int tid = (wr * 4 + wc) * 64 + fq * 16 + fr;
        if (tid < 256) { const float mean = ((pfa[0] + pfa[2]) + (pfb[0] + pfb[2])) * (1.f / 1024.f), var = ((pfa[1] + pfa[3]) + (pfb[1] + pfb[3])) * (1.f / 1024.f) - mean * mean;
            const f32x2_t mrv = {mean, 1.0f / sqrtf(var + LN_EPS)};
            *(PG8_LAS f32x2_t*)(T + 2 * tid) = mrv;
            if (mr_out && u.pn == 0) *(f32x2_t*)(mr_out + 2 * (unsigned)(u.pm * BM + tid)) = mrv; }
        PG8_LAS float* CB = T + 1024;
        if (tid >= 256 && tid < 320) { const int t4 = 4 * (tid - 256); const f32x4 cc = *(const f32x4*)(cs + u.pn * BM + t4), bb = *(const f32x4*)(bw + u.pn * BM + t4);
            *(PG8_LAS f32x4*)(CB + t4) = cc; *(PG8_LAS f32x4*)(CB + 256 + t4) = bb; }
        asm volatile("s_waitcnt lgkmcnt(0)" ::: "memory"); __builtin_amdgcn_s_barrier(); asm volatile("" ::: "memory");
        const int cl = wc * 32 + 8 * fq;
#pragma unroll
        for (int bj = 0; bj < 2; ++bj)
#pragma unroll
            for (int n = 0; n < 2; ++n) { c[bj][n] = *(const PG8_LAS f32x4*)(CB + cl + bj * HALF + 4 * n); b[bj][n] = *(const PG8_LAS f32x4*)(CB + 256 + cl + bj * HALF + 4 * n); }
#pragma unroll
        for (int ai = 0; ai < 2; ++ai)
#pragma unroll
            for (int m = 0; m < 4; ++m) { const f32x2_t v = *(const PG8_LAS f32x2_t*)(T + 2 * (ai * HALF + wr * 64 + m * 16 + fr)); mu[ai][m] = v.x; rs[ai][m] = v.y; }
    }
    __device__ __forceinline__ f32x4 apply(const f32x4 a, int ai, int m, int bj, int n) const { return st ? (a - c[bj][n] * mu[ai][m]) * rs[ai][m] + b[bj][n] : a; }
};
#define PG8_PF_MEMBERS mutable f32x4 pfa, pfb; static constexpr bool HAS_PF = true, HAS_WARM = false; \
    __device__ __forceinline__ void prefetch(const Unit& u, int tid) const { if (st && tid < 256) { const float* sp = st + 8 * (unsigned)(u.pm * BM + tid); pfa = *(const f32x4*)sp; pfb = *(const f32x4*)(sp + 4); } }
struct EpiQKV {
    static constexpr bool PERM = true, AFTER_DRAIN = false;
    bf16_t* QKV; float* out; int li; const float* st; const float* cs; const float* bw; float* mr_out; PG8_LAS float* T; PG8_PF_MEMBERS
    __device__ __forceinline__ void operator()(const f32x4 (&acc)[2][2][4][2], const Unit& u, int wr, int wc, int fr, int fq) const {
        asm volatile("" : "+v"(fr));
        RowNorm rn; rn.st = st; rn.cs = cs; rn.bw = bw; rn.mr_out = mr_out; rn.T = T; rn.load(u, wr, wc, fr, fq, pfa, pfb);
        float* fdst = nullptr;
        if (u.pn >= 4) {
            const bool isv = u.pn >= 8;
            if (u.pm < 256) { const int b = u.pm >> 3, tt = u.pm & 7; if (tt >= 6) fdst = out + (isv ? O_VP : O_KP) + ((size_t)(li * 32 + b) * 512 + (size_t)(tt - 6) * 256) * 1024; }
            else fdst = out + (isv ? O_VS : O_KS) + ((size_t)li * 2048 + (size_t)(u.pm - 256) * 256) * 1024;
        }
        const int col0 = u.pn * BM + wc * 32 + 8 * fq, colk = (u.pn & 3) * BM + wc * 32 + 8 * fq;
#pragma unroll
        for (int ai = 0; ai < 2; ++ai)
#pragma unroll
            for (int m = 0; m < 4; ++m) { const int rl = ai * HALF + wr * 64 + m * 16 + fr; bf16_t* rowp = QKV + (unsigned)((u.pm * BM + rl) * 3072 + col0);
#pragma unroll
                for (int bj = 0; bj < 2; ++bj) { const f32x4 v0 = rn.apply(acc[ai][bj][m][0], ai, m, bj, 0), v1 = rn.apply(acc[ai][bj][m][1], ai, m, bj, 1);
                    u32x4 w; w.x = pk2(v0[0], v0[1]); w.y = pk2(v0[2], v0[3]); w.z = pk2(v1[0], v1[1]); w.w = pk2(v1[2], v1[3]);
                    *(u32x4*)(rowp + bj * HALF) = w;
                    if (fdst) { float* fp = fdst + (unsigned)(rl * 1024 + colk + bj * HALF); *(f32x4*)fp = v0; *(f32x4*)(fp + 4) = v1; } }
                asm volatile("" ::: "memory"); }
    }
};
struct EpiBf16Plain {
    static constexpr bool PERM = true, AFTER_DRAIN = false;
    bf16_t* O; int ldc; int relu2; const float* st; const float* cs; const float* bw; float* mr_out; PG8_LAS float* T; PG8_PF_MEMBERS
    __device__ __forceinline__ void operator()(const f32x4 (&acc)[2][2][4][2], const Unit& u, int wr, int wc, int fr, int fq) const {
        asm volatile("" : "+v"(fr));
        RowNorm rn; rn.st = st; rn.cs = cs; rn.bw = bw; rn.mr_out = mr_out; rn.T = T; rn.load(u, wr, wc, fr, fq, pfa, pfb);
        const int col0 = u.pn * BM + wc * 32 + 8 * fq;
#pragma unroll
        for (int ai = 0; ai < 2; ++ai)
#pragma unroll
            for (int m = 0; m < 4; ++m) { const int rl = ai * HALF + wr * 64 + m * 16 + fr; bf16_t* rowp = O + (unsigned)((u.pm * BM + rl) * ldc + col0);
#pragma unroll
                for (int bj = 0; bj < 2; ++bj) { f32x4 v0 = rn.apply(acc[ai][bj][m][0], ai, m, bj, 0), v1 = rn.apply(acc[ai][bj][m][1], ai, m, bj, 1);
                    if (relu2) { v0 = __builtin_elementwise_max(v0, (f32x4){0.f, 0.f, 0.f, 0.f}); v1 = __builtin_elementwise_max(v1, (f32x4){0.f, 0.f, 0.f, 0.f}); v0 = v0 * v0; v1 = v1 * v1; }
                    u32x4 w; w.x = pk2(v0[0], v0[1]); w.y = pk2(v0[2], v0[3]); w.z = pk2(v1[0], v1[1]); w.w = pk2(v1[2], v1[3]);
                    *(u32x4*)(rowp + bj * HALF) = w; } }
    }
};
struct EpiSsmIn {
    static constexpr bool PERM = true, AFTER_DRAIN = false;
    bf16_t* P; float* DT; const float* st; const float* cs; const float* bw; float* mr_out; PG8_LAS float* T; PG8_PF_MEMBERS
    __device__ __forceinline__ void operator()(const f32x4 (&acc)[2][2][4][2], const Unit& u, int wr, int wc, int fr, int fq) const {
        asm volatile("" : "+v"(fr));
        RowNorm rn; rn.st = st; rn.cs = cs; rn.bw = bw; rn.mr_out = mr_out; rn.T = T; rn.load(u, wr, wc, fr, fq, pfa, pfb);
        if (u.pn < 24) {
            const int col0 = u.pn * BM + wc * 32 + 8 * fq;
#pragma unroll
            for (int ai = 0; ai < 2; ++ai)
#pragma unroll
                for (int m = 0; m < 4; ++m) { const int rl = ai * HALF + wr * 64 + m * 16 + fr; bf16_t* rowp = P + (unsigned)((u.pm * BM + rl) * LDP + col0);
#pragma unroll
                    for (int bj = 0; bj < 2; ++bj) { const f32x4 v0 = rn.apply(acc[ai][bj][m][0], ai, m, bj, 0), v1 = rn.apply(acc[ai][bj][m][1], ai, m, bj, 1);
                        u32x4 w; w.x = pk2(v0[0], v0[1]); w.y = pk2(v0[2], v0[3]); w.z = pk2(v1[0], v1[1]); w.w = pk2(v1[2], v1[3]);
                        *(u32x4*)(rowp + bj * HALF) = w; }
                    asm volatile("" ::: "memory"); }
        } else if (wc == 0) {
#pragma unroll
            for (int ai = 0; ai < 2; ++ai)
#pragma unroll
                for (int m = 0; m < 4; ++m) { const int rl = ai * HALF + wr * 64 + m * 16 + fr; float* fp = DT + (unsigned)((u.pm * BM + rl) * 32 + 8 * fq);
                    *(f32x4*)fp = rn.apply(acc[ai][0][m][0], ai, m, 0, 0); *(f32x4*)(fp + 4) = rn.apply(acc[ai][0][m][1], ai, m, 0, 1); }
        }
    }
};
struct SplitOrder { int G, c;
    __device__ __forceinline__ bool next(int i, Unit& u) const { const int L = i * G + c; if (L >= 256) return false; const int t = L >> 3; u.pm = 256 + (t >> 2); u.pn = t & 3; u.kb = L & 7; return true; }
    __device__ __forceinline__ void a_ready(const Unit&) const {}
    __device__ __forceinline__ void done(const Unit&) const {}
};
struct EpiPartial {
    static constexpr bool PERM = false, AFTER_DRAIN = false, HAS_PF = false, HAS_WARM = false;
    float* SP;
    __device__ __forceinline__ void operator()(const f32x4 (&acc)[2][2][4][2], const Unit& u, int wr, int wc, int fr, int fq) const {
        asm volatile("" : "+v"(fr));
        float* base = SP + (size_t)((((u.pm - 256) * 4 + u.pn) * 8 + u.kb)) * 65536 + (unsigned)((wr * 64 + fr) * 256 + wc * 32 + 4 * fq);
#pragma unroll
        for (int ai = 0; ai < 2; ++ai)
#pragma unroll
            for (int m = 0; m < 4; ++m) {
#pragma unroll
                for (int bj = 0; bj < 2; ++bj)
#pragma unroll
                    for (int n = 0; n < 2; ++n) *(f32x4*)(base + (unsigned)((ai * HALF + m * 16) * 256 + bj * HALF + n * 16)) = acc[ai][bj][m][n];
                asm volatile("" ::: "memory"); }
    }
};
struct EpiResid {
    static constexpr bool PERM = true, AFTER_DRAIN = false, HAS_PF = false, HAS_WARM = false;
    __device__ __forceinline__ void warm(const Unit& u, int wid, int lane, PG8_LAS unsigned char* dummy) const {
#pragma unroll
        for (int i = 0; i < 2; ++i) { const int line = wid * 128 + i * 64 + lane, row = line >> 2, seg = line & 3;
            const char* gp = (const char*)XB + ((size_t)(unsigned)((u.pm * BM + row) * D + u.pn * BM)) * 2 + seg * 128;
            __builtin_amdgcn_global_load_lds((const unsigned*)gp, (PG8_LAS unsigned*)(dummy + wid * 256), 4, 0, 0); }
    }
    bf16_t* XB; const float* st_in; const float* gin; const float* bin; float* st_out; PG8_LAS float* P;
    static constexpr int DEPTH = 1;
    __device__ __forceinline__ void operator()(const f32x4 (&acc)[2][2][4][2], const Unit& u, int wr, int wc, int fr, int fq) const {
        asm volatile("" : "+v"(fr));
        const int col0 = u.pn * BM + wc * 32 + 8 * fq;
        const unsigned rowb0 = (unsigned)(u.pm * BM + wr * 64 + fr);
        PG8_LAS float* GB = P + 3072;
        { const int tid_ = (wr * 4 + wc) * 64 + fq * 16 + fr;
          if (st_in && tid_ < 64) { const f32x4 gg = *(const f32x4*)(gin + u.pn * BM + 4 * tid_), bb = *(const f32x4*)(bin + u.pn * BM + 4 * tid_);
              *(PG8_LAS f32x4*)(GB + 4 * tid_) = gg; *(PG8_LAS f32x4*)(GB + 256 + 4 * tid_) = bb; } }
        if (st_in) { asm volatile("s_waitcnt lgkmcnt(0)" ::: "memory"); __builtin_amdgcn_s_barrier(); asm volatile("" ::: "memory"); }
        const int cl = wc * 32 + 8 * fq;
#pragma unroll
        for (int ai = 0; ai < 2; ++ai) {
            u32x4 xv[4][2]; f32x2_t mr[4];
#pragma unroll
            for (int m = 0; m < 4; ++m) { const unsigned row_ = rowb0 + (unsigned)(ai * HALF + m * 16); const bf16_t* rp_ = XB + row_ * D + col0;
                xv[m][0] = *(const u32x4*)rp_; xv[m][1] = *(const u32x4*)(rp_ + HALF);
                if (st_in) mr[m] = *(const f32x2_t*)(st_in + 2 * row_); else mr[m] = (f32x2_t){0.f, 1.f}; }
            asm volatile("" ::: "memory");
#pragma unroll
            for (int m = 0; m < 4; ++m) {
                const unsigned row = rowb0 + (unsigned)(ai * HALF + m * 16);
                bf16_t* rowb = XB + row * D + col0;
                float mean = 0.f, rstd = 1.f;
                if (st_in) { mean = mr[m].x; rstd = mr[m].y; }
                float s1 = 0.f, s2 = 0.f;
#pragma unroll
                for (int bj = 0; bj < 2; ++bj) {
                    const u32x4 xw = xv[m][bj];
                    f32x4 x0 = (f32x4){bflo(xw.x), bfhi(xw.x), bflo(xw.y), bfhi(xw.y)}, x1 = (f32x4){bflo(xw.z), bfhi(xw.z), bflo(xw.w), bfhi(xw.w)};
                    if (st_in) { int c_ = cl + bj * HALF; asm volatile("" : "+v"(c_));
                        const f32x4 g0 = *(const PG8_LAS f32x4*)(GB + c_), g1 = *(const PG8_LAS f32x4*)(GB + c_ + 4), b0 = *(const PG8_LAS f32x4*)(GB + 256 + c_), b1 = *(const PG8_LAS f32x4*)(GB + 256 + c_ + 4);
                        x0 = (x0 - mean) * rstd * g0 + b0; x1 = (x1 - mean) * rstd * g1 + b1; }
                    const f32x4 v0 = x0 * ALPHA + acc[ai][bj][m][0], v1 = x1 * ALPHA + acc[ai][bj][m][1];
                    u32x4 w; w.x = pk2(v0[0], v0[1]); w.y = pk2(v0[2], v0[3]); w.z = pk2(v1[0], v1[1]); w.w = pk2(v1[2], v1[3]); *(u32x4*)(rowb + bj * HALF) = w;
                    s1 += ((v0[0] + v0[1]) + (v0[2] + v0[3])) + ((v1[0] + v1[1]) + (v1[2] + v1[3]));
                    s2 += ((v0[0] * v0[0] + v0[1] * v0[1]) + (v0[2] * v0[2] + v0[3] * v0[3])) + ((v1[0] * v1[0] + v1[1] * v1[1]) + (v1[2] * v1[2] + v1[3] * v1[3])); }
                s1 += __shfl_xor(s1, 16); s2 += __shfl_xor(s2, 16); s1 += __shfl_xor(s1, 32); s2 += __shfl_xor(s2, 32);
                if (fq == 0) *(PG8_LAS f32x2_t*)(P + ((ai * HALF + wr * 64 + m * 16 + fr) * 4 + wc) * 2) = (f32x2_t){s1, s2};
            }
            asm volatile("" ::: "memory");
        }
        asm volatile("s_waitcnt lgkmcnt(0)" ::: "memory"); __builtin_amdgcn_s_barrier(); asm volatile("" ::: "memory");
        const int tid = (wr * 4 + wc) * 64 + fq * 16 + fr;
        if (tid < 256) { const f32x4 qa = *(const PG8_LAS f32x4*)(P + tid * 8), qb = *(const PG8_LAS f32x4*)(P + tid * 8 + 4);
            *(f32x2_t*)(st_out + 8 * (unsigned)(u.pm * BM + tid) + 2 * u.pn) = (f32x2_t){(qa[0] + qa[2]) + (qb[0] + qb[2]), (qa[1] + qa[3]) + (qb[1] + qb[3])}; }
    }
};
}
#define XB_TMO      128
#define XB_XCNT(j)  (256  + 64 * (j))
#define XB_XSUB(j)  (1280 + 64 * (j))
#define XB_XGEN(j)  (2304 + 64 * (j))
#define XB_TOP      3328
#define XB_TOPGEN   3392
#define XCD_BAR_WORDS 3456
#define XB_SPIN_CAP (1u << 18)

__device__ __forceinline__ unsigned xb_ld(unsigned* p)              { return __hip_atomic_load(p, __ATOMIC_RELAXED, __HIP_MEMORY_SCOPE_AGENT); }
__device__ __forceinline__ unsigned xb_add(unsigned* p, unsigned v) { return __hip_atomic_fetch_add(p, v, __ATOMIC_RELAXED, __HIP_MEMORY_SCOPE_AGENT); }
__device__ __forceinline__ unsigned xb_xcc_id() { return (unsigned)__builtin_amdgcn_s_getreg((3 << 11) | 20) & 0xFu; }
#define XB_SPIN(cond, bar) do { unsigned _sp = 0; while (cond) { __builtin_amdgcn_s_sleep(1); \
    if ((++_sp & 255u) == 0u) { if (xb_ld(&(bar)[XB_TMO])) break; if (_sp > XB_SPIN_CAP) { atomicAdd(&(bar)[XB_TMO], 1u); break; } } } } while (0)

struct XcdBarrier {
    int w0;
    unsigned* bar; unsigned x;
    volatile LAS unsigned* st;
};

__device__ __forceinline__ XcdBarrier xcd_barrier_post(unsigned* bar, volatile LAS unsigned* st) {
    XcdBarrier b; b.bar = bar; b.x = xb_xcc_id(); b.st = st;
    if (threadIdx.x == 0) (void)xb_add(&bar[XB_XCNT(b.x)], 1u);
    return b;
}
__device__ __forceinline__ void xcd_barrier_complete(unsigned* bar, unsigned x, unsigned& nloc, unsigned& nx) {
    const unsigned G = gridDim.x * gridDim.y * gridDim.z;
    unsigned sum, cnt, mine, sp = 0u;
    for (;;) {
        sum = 0u; cnt = 0u; mine = 0u;
#pragma unroll
        for (unsigned j = 0; j < 16; ++j) { const unsigned c = xb_ld(&bar[XB_XCNT(j)]); sum += c; cnt += (c > 0u) ? 1u : 0u; mine = (j == x) ? c : mine; }
        if (sum == G) break;
        __builtin_amdgcn_s_sleep(1);
        if ((++sp & 255u) == 0u) { if (xb_ld(&bar[XB_TMO])) break; if (sp > XB_SPIN_CAP) { atomicAdd(&bar[XB_TMO], 1u); break; } }
    }
    nloc = mine > 0u ? mine : 1u; nx = cnt > 0u ? cnt : 1u;
}

__device__ __forceinline__ void xcd_barrier(const XcdBarrier& b) {
    asm volatile("s_waitcnt vmcnt(0)" ::: "memory");
    __syncthreads();
    if (b.w0 == 0 && lane_id_() == 0) {
        unsigned* bar = b.bar;
        __builtin_amdgcn_s_waitcnt(0);
        unsigned nloc = b.st[0], nx = b.st[1];
        if (nloc == 0u) { xcd_barrier_complete(bar, b.x, nloc, nx); b.st[0] = nloc; b.st[1] = nx; }
        const unsigned old = xb_add(&bar[XB_XSUB(b.x)], 1u);
        const unsigned gen = old / nloc;
        if (old + 1u == (gen + 1u) * nloc) {
            __builtin_amdgcn_fence(__ATOMIC_RELEASE, "agent");
            asm volatile("s_waitcnt vmcnt(0)" ::: "memory");
            const unsigned og = xb_add(&bar[XB_TOP], 1u);
            const unsigned tg = og / nx;
            if (og + 1u == (tg + 1u) * nx) xb_add(&bar[XB_TOPGEN], 1u);
            else XB_SPIN(xb_ld(&bar[XB_TOPGEN]) == tg, bar);
            __builtin_amdgcn_fence(__ATOMIC_ACQUIRE, "agent");
            xb_add(&bar[XB_XGEN(b.x)], 1u);
            asm volatile("s_waitcnt vmcnt(0)" ::: "memory");
        } else {
            XB_SPIN(xb_ld(&bar[XB_XGEN(b.x)]) == gen, bar);
            __builtin_amdgcn_fence(__ATOMIC_ACQUIRE, "agent");
            asm volatile("s_waitcnt vmcnt(0)" ::: "memory");
        }
    }
    __syncthreads();
}

struct Args { const float* in[25]; int ph_lo, ph_hi; };
#define AIN(k) (a.in[(k) + z])
struct Frame { unsigned char* lds; int tid, lane, wave, G, bid; };

__device__ __forceinline__ void transpose_item(const float* W, int K, int N, bf16* WT, float* scr, int item, int lane) {
    const int nblk = N / 32, kb = item / nblk, nb = item % nblk, k0 = 64 * kb, n0 = 32 * nb;
    {
        float tv[32]; const float* wp = W + (size_t)(k0 + (lane >> 5)) * N + n0 + (lane & 31);
#pragma unroll
        for (int i = 0; i < 32; ++i) tv[i] = wp[(size_t)(2 * i) * N];
        asm volatile("" ::: "memory");
#pragma unroll
        for (int i = 0; i < 32; ++i) scr[(2 * i + (lane >> 5)) * 33 + (lane & 31)] = tv[i];
    }
    asm volatile("s_waitcnt lgkmcnt(0)" ::: "memory");
    const int c = lane & 7;
#pragma unroll
    for (int j = 0; j < 4; ++j) { const int n = (lane >> 3) + 8 * j; const float* s = scr + (8 * c) * 33 + n;
        u32x4 o; o.x = pk2(s[0 * 33], s[1 * 33]); o.y = pk2(s[2 * 33], s[3 * 33]); o.z = pk2(s[4 * 33], s[5 * 33]); o.w = pk2(s[6 * 33], s[7 * 33]);
        *(u32x4*)(WT + (size_t)(n0 + n) * K + k0 + 8 * c) = o; }
    asm volatile("s_waitcnt lgkmcnt(0)" ::: "memory");
}
__device__ __forceinline__ void transpose_fold_item(const float* W, int K, int N, bf16* WT, const float* g, const float* b, float* cs, float* bw, float* scr, int nb, int lane) {
    const int n0 = 32 * nb; float csp = 0.f, bwp = 0.f;
    for (int k0 = 0; k0 < K; k0 += 64) {
        {
            float tv[32], tg[32], tb[32]; const float* wp = W + (size_t)(k0 + (lane >> 5)) * N + n0 + (lane & 31);
#pragma unroll
            for (int i = 0; i < 32; ++i) { tv[i] = wp[(size_t)(2 * i) * N]; tg[i] = g[k0 + 2 * i + (lane >> 5)]; tb[i] = b[k0 + 2 * i + (lane >> 5)]; }
            asm volatile("" ::: "memory");
#pragma unroll
            for (int i = 0; i < 32; ++i) { const float wg = tv[i] * tg[i]; const float wr = bflo(pk2(wg, 0.f) & 0xffffu); scr[(2 * i + (lane >> 5)) * 33 + (lane & 31)] = wr; csp += wr; bwp += tv[i] * tb[i]; }
        }
        asm volatile("s_waitcnt lgkmcnt(0)" ::: "memory");
        const int c = lane & 7;
#pragma unroll
        for (int j = 0; j < 4; ++j) { const int n = (lane >> 3) + 8 * j; const float* s = scr + (8 * c) * 33 + n;
            u32x4 o; o.x = pk2(s[0 * 33], s[1 * 33]); o.y = pk2(s[2 * 33], s[3 * 33]); o.z = pk2(s[4 * 33], s[5 * 33]); o.w = pk2(s[6 * 33], s[7 * 33]);
            *(u32x4*)(WT + (size_t)(n0 + n) * K + k0 + 8 * c) = o; }
        asm volatile("s_waitcnt lgkmcnt(0)" ::: "memory");
    }
    csp += __shfl_xor(csp, 32); bwp += __shfl_xor(bwp, 32);
    if (lane < 32) { cs[n0 + lane] = csp; bw[n0 + lane] = bwp; }
}
__device__ __forceinline__ void cvt_stream(const float* src, bf16* dst, size_t n, size_t gtid, size_t gthreads) {
    const size_t step = gthreads * 8; size_t i = gtid * 8;
    for (; i + 3 * step < n; i += 4 * step) {
        f32x4 a[4], b[4];
#pragma unroll
        for (int j = 0; j < 4; ++j) { a[j] = *(const f32x4*)(src + i + j * step); b[j] = *(const f32x4*)(src + i + j * step + 4); }
        asm volatile("" ::: "memory");
#pragma unroll
        for (int j = 0; j < 4; ++j) { u32x4 o; o.x = pk2(a[j][0], a[j][1]); o.y = pk2(a[j][2], a[j][3]); o.z = pk2(b[j][0], b[j][1]); o.w = pk2(b[j][2], b[j][3]); *(u32x4*)(dst + i + j * step) = o; }
    }
    for (; i < n; i += step) { const f32x4 a = *(const f32x4*)(src + i), b = *(const f32x4*)(src + i + 4);
        u32x4 o; o.x = pk2(a[0], a[1]); o.y = pk2(a[2], a[3]); o.z = pk2(b[0], b[1]); o.w = pk2(b[2], b[3]); *(u32x4*)(dst + i) = o; }
}
__device__ __forceinline__ void convert_phase(const Frame& F, const Args& a, int z, int L) {
    unsigned char* ws = (unsigned char*)AIN(24); float* outp = (float*)AIN(23); const int li = L >> 1; const bool ssm = (L & 1);
    float* scr = (float*)(F.lds + F.wave * 16384);
    const int gw = F.bid * 8 + F.wave, NGW = F.G * 8;
    const float* Wa = ssm ? AIN(9) + (size_t)li * D * NPROJ : AIN(6) + (size_t)li * D * 3072; const int Na = ssm ? NPROJ : 3072;
    const float* Wb = ssm ? AIN(16) + (size_t)li * 2048 * D : AIN(8) + (size_t)li * D * D; const int Kb = ssm ? 2048 : D;
    const float* Wu = AIN(19) + (size_t)L * D * DFF; const float* Wd = AIN(20) + (size_t)L * DFF * D;
    const bool foldA = (L > 0);
    const float* gA = AIN(21) + (L - 1) * D; const float* bA = AIN(22) + (L - 1) * D;
    const float* gU = AIN(17) + L * D; const float* bU = AIN(18) + L * D;
    const int Ia = foldA ? Na / 32 : (D / 64) * (Na / 32), Ib = (Kb / 64) * (D / 32), Iu = DFF / 32, Id = (DFF / 64) * (D / 32);
    const int NIT = Ia + Ib + Iu + Id;
    for (int it = gw; it < NIT; it += NGW) {
        int r = it;
        if (r < Iu) { transpose_fold_item(Wu, D, DFF, (bf16*)(ws + WS_WUP), gU, bU, (float*)(ws + WS_CSU), (float*)(ws + WS_BWU), scr, r, F.lane); continue; } r -= Iu;
        if (r < Ia) { if (foldA) transpose_fold_item(Wa, D, Na, (bf16*)(ws + WS_WA), gA, bA, (float*)(ws + WS_CSA), (float*)(ws + WS_BWA), scr, r, F.lane);
                      else transpose_item(Wa, D, Na, (bf16*)(ws + WS_WA), scr, r, F.lane); continue; } r -= Ia;
        if (r < Ib) { transpose_item(Wb, Kb, D, (bf16*)(ws + WS_WB), scr, r, F.lane); continue; } r -= Ib;
        transpose_item(Wd, DFF, D, (bf16*)(ws + WS_WDN), scr, r, F.lane);
    }
    const size_t gtid = (size_t)F.bid * 512 + F.tid, gth = (size_t)F.G * 512;
    if (!ssm) {
        cvt_stream(AIN(2) + (size_t)li * 32 * 512 * 1024, (bf16*)(ws + WS_CK), (size_t)32 * 512 * 1024, gtid, gth);
        cvt_stream(AIN(3) + (size_t)li * 32 * 512 * 1024, (bf16*)(ws + WS_CV), (size_t)32 * 512 * 1024, gtid, gth);
    }
    if (L == 0) {
        const size_t n = (size_t)M * D, np = (size_t)MP * D;
        bf16* XB = (bf16*)(ws + WS_XB);
        cvt_stream(AIN(0), XB, np, gtid, gth); cvt_stream(AIN(1), XB + np, n - np, gtid, gth);
    }
}
__device__ __forceinline__ void ln_phase(const Frame& F, float* X, const bf16* XB, const float* g, const float* b) {
    const int gw = F.bid * 8 + F.wave, NGW = F.G * 8;
    f32x4 gv[4], bv[4];
#pragma unroll
    for (int j = 0; j < 4; ++j) { gv[j] = *(const f32x4*)(g + 4 * F.lane + 256 * j); bv[j] = *(const f32x4*)(b + 4 * F.lane + 256 * j); }
    auto ln_row = [&](const int m, const u32x2 (&w)[4]) __attribute__((always_inline)) {
        f32x4* xr = (f32x4*)(X + (size_t)m * D) + F.lane;
        f32x4 v[4]; float s = 0.f;
#pragma unroll
        for (int j = 0; j < 4; ++j) { v[j] = (f32x4){bflo(w[j].x), bfhi(w[j].x), bflo(w[j].y), bfhi(w[j].y)}; s += (v[j][0] + v[j][1]) + (v[j][2] + v[j][3]); }
        const float mean = wave_sum(s) * (1.f / D); float s2 = 0.f;
#pragma unroll
        for (int j = 0; j < 4; ++j) { v[j] = v[j] - mean; s2 += (v[j][0] * v[j][0] + v[j][1] * v[j][1]) + (v[j][2] * v[j][2] + v[j][3] * v[j][3]); }
        const float rstd = 1.f / sqrtf(wave_sum(s2) * (1.f / D) + LN_EPS);
#pragma unroll
        for (int j = 0; j < 4; ++j) xr[64 * j] = v[j] * rstd * gv[j] + bv[j];
    };
    int m = gw;
    for (; m + NGW < M; m += 2 * NGW) {
        u32x2 w0[4], w1[4]; const u32x2* xb0 = (const u32x2*)(XB + (size_t)m * D) + F.lane; const u32x2* xb1 = (const u32x2*)(XB + (size_t)(m + NGW) * D) + F.lane;
#pragma unroll
        for (int j = 0; j < 4; ++j) { w0[j] = xb0[64 * j]; w1[j] = xb1[64 * j]; }
        asm volatile("" ::: "memory");
        ln_row(m, w0); ln_row(m + NGW, w1);
    }
    for (; m < M; m += NGW) { u32x2 w0[4]; const u32x2* xb0 = (const u32x2*)(XB + (size_t)m * D) + F.lane;
#pragma unroll
        for (int j = 0; j < 4; ++j) w0[j] = xb0[64 * j];
        ln_row(m, w0); }
}

__device__ __forceinline__ void attn_phase(const Frame& F, const float* relb, const bf16* QKV, const bf16* CK, const bf16* CV, bf16* O) {
    float* tbl = (float*)F.lds;
    for (int i = F.tid; i < 16 * 513; i += 512) tbl[i] = relb[i] * LOG2E;
    __syncthreads();
    LAS unsigned char* const vtl = (LAS unsigned char*)F.lds + 32896 + F.wave * 9216;
    LAS unsigned char* const qtl = (LAS unsigned char*)F.lds + 106624 + F.wave * 4608;
    const int lane = F.lane, l31 = lane & 31, hh = lane >> 5;
    const int i16 = lane & 15, q4 = i16 >> 2, p4 = i16 & 3, dblk = (lane >> 4) & 1;
    const int gw = F.bid * 8 + F.wave, NGW = F.G * 8;
    constexpr int NITEM = (32 * 32 + 32) * 32;
    constexpr float C2 = 0.125f * LOG2E;
    const int xw = (F.bid >> 3) * 8 + F.wave, xn = (F.G >> 3) * 8, xcd = F.bid & 7;
    for (int jt = xw; jt < NITEM / 8; jt += xn) {
        int lq_ = lane; asm volatile("" : "+v"(lq_));
        LAS unsigned char* const wbase = vtl + (((lq_ >> 3) * 72 + 8 * (lq_ & 7)) * 2);
        LAS unsigned char* const fbase = vtl + (((lq_ & 31) * 72 + 8 * (lq_ >> 5)) * 2);
        LAS unsigned char* const qbase = qtl + (((lq_ & 31) * 72 + 8 * (lq_ >> 5)) * 2);
        LAS unsigned char* const tbase = vtl + (((4 * (lq_ >> 5) + ((lq_ & 15) >> 2)) * 72 + 16 * ((lq_ >> 4) & 1) + 4 * (lq_ & 3)) * 2);
        const bool smp = jt >= 4096; const int r0 = smp ? jt - 4096 : jt;
        const int r = smp ? r0 : (r0 & ~255) | ((r0 + 10 * (r0 >> 8)) & 255);
        const int qh = r & 1, c = smp ? 0 : (r >> 1) & 31, h = smp ? (r >> 1) & 15 : (r >> 6) & 15, b = xcd + 8 * (smp ? (r >> 5) : (r >> 10));
        const size_t qrow0 = smp ? (size_t)MP + b * 64 + 32 * qh : (size_t)b * 2048 + 64 * c + 32 * qh;
        { bf16x8 qr[4];
#pragma unroll
          for (int i = 0; i < 4; ++i) qr[i] = *(const bf16x8*)(QKV + (qrow0 + 8 * i + (lane >> 3)) * 3072 + h * 64 + 8 * (lane & 7));
#pragma unroll
          for (int i = 0; i < 4; ++i) *(LAS bf16x8*)(qtl + ((8 * i + (lane >> 3)) * 72 + 8 * (lane & 7)) * 2) = qr[i]; }
        asm volatile("" ::: "memory");
        f32x16 o0, o1;
#pragma unroll
        for (int i = 0; i < 16; ++i) { o0[i] = 0.f; o1[i] = 0.f; }
        float mrun = -1e30f, lsum = 0.f;
        const float* tb = tbl + h * 513;
        const int jb0 = smp ? 0 : (c >= 8 ? 0 : 8 - c);
        bf16x8 kr[8], vr[8];
        { const bf16 *K0, *V0; int p0;
          if (!smp) { K0 = QKV + ((size_t)b * 2048 + 64 * (c - 8 + jb0)) * 3072 + 1024 + h * 64; V0 = K0 + 1024; p0 = 3072; }
          else { K0 = CK + ((size_t)b * 512) * 1024 + h * 64; V0 = CV + ((size_t)b * 512) * 1024 + h * 64; p0 = 1024; }
          const unsigned vo_ = ((unsigned)(lane >> 3) * (unsigned)p0 + 8u * (unsigned)(lane & 7)) * 2u;
#pragma unroll
          for (int i = 0; i < 8; ++i) { const unsigned o_ = vo_ + (unsigned)i * 16u * (unsigned)p0; kr[i] = *(const bf16x8*)((const char*)K0 + o_); vr[i] = *(const bf16x8*)((const char*)V0 + o_); } }
        for (int jb = jb0; jb <= 8; ++jb) {
            const bf16 *Kp, *Vp; int pitch;
            if (!smp) { Kp = QKV + ((size_t)b * 2048 + 64 * (c - 8 + jb)) * 3072 + 1024 + h * 64; Vp = Kp + 1024; pitch = 3072; }
            else if (jb < 8) { Kp = CK + ((size_t)b * 512 + 64 * jb) * 1024 + h * 64; Vp = CV + ((size_t)b * 512 + 64 * jb) * 1024 + h * 64; pitch = 1024; }
            else { Kp = QKV + ((size_t)MP + b * 64) * 3072 + 1024 + h * 64; Vp = Kp + 1024; pitch = 3072; }
            bf16x8 kf[2][4];
            asm volatile("" ::: "memory");
#pragma unroll
            for (int i = 0; i < 8; ++i) *(LAS bf16x8*)(wbase + i * 1152) = kr[i];
            asm volatile("" ::: "memory");
#pragma unroll
            for (int rb = 0; rb < 2; ++rb)
#pragma unroll
                for (int ks = 0; ks < 4; ++ks) kf[rb][ks] = *(const LAS bf16x8*)(fbase + rb * 4608 + ks * 32);
            asm volatile("" ::: "memory");
#pragma unroll
            for (int i = 0; i < 8; ++i) *(LAS bf16x8*)(wbase + i * 1152) = vr[i];
            asm volatile("" ::: "memory");
            if (jb < 8) { const bf16 *Kn, *Vn; int pn_;
                if (!smp) { Kn = Kp + (size_t)64 * 3072; Vn = Vp + (size_t)64 * 3072; pn_ = 3072; }
                else if (jb < 7) { Kn = Kp + (size_t)64 * 1024; Vn = Vp + (size_t)64 * 1024; pn_ = 1024; }
                else { Kn = QKV + ((size_t)MP + b * 64) * 3072 + 1024 + h * 64; Vn = Kn + 1024; pn_ = 3072; }
                const unsigned vo_ = ((unsigned)(lane >> 3) * (unsigned)pn_ + 8u * (unsigned)(lane & 7)) * 2u;
#pragma unroll
                for (int i = 0; i < 8; ++i) { const unsigned o_ = vo_ + (unsigned)i * 16u * (unsigned)pn_; kr[i] = *(const bf16x8*)((const char*)Kn + o_); vr[i] = *(const bf16x8*)((const char*)Vn + o_); } }
            f32x16 s0, s1;
#pragma unroll
            for (int i = 0; i < 16; ++i) { s0[i] = 0.f; s1[i] = 0.f; }
#pragma unroll
            for (int ks = 0; ks < 4; ++ks) { const bf16x8 qf = *(const LAS bf16x8*)(qbase + ks * 32); s0 = MFMA32(kf[0][ks], qf, s0); s1 = MFMA32(kf[1][ks], qf, s1); }
            if (jb <= 3) {
                const float cbias = tb[512];
#pragma unroll
                for (int i = 0; i < 16; ++i) { s0[i] = s0[i] * C2 + cbias; s1[i] = s1[i] * C2 + cbias; }
            } else if (jb == 4) {
                const int dbase = 64 * (8 - jb) + 32 * qh + l31 + 256;
#pragma unroll
                for (int i = 0; i < 16; ++i) { const int k0 = crow(i, hh); int i0 = dbase - k0; i0 = i0 > 512 ? 512 : i0; s0[i] = s0[i] * C2 + tb[i0]; }
                asm volatile("" ::: "memory");
#pragma unroll
                for (int i = 0; i < 16; ++i) { const int k0 = crow(i, hh); int i1 = dbase - k0 - 32; i1 = i1 > 512 ? 512 : i1; s1[i] = s1[i] * C2 + tb[i1]; }
            } else {
                const float* pb = tb + (64 * (8 - jb) + 32 * qh + l31 + 256 - 4 * hh - 59);
#pragma unroll
                for (int i = 0; i < 16; ++i) { const int ci = (i & 3) + 8 * (i >> 2); s0[i] = s0[i] * C2 + pb[59 - ci]; }
                asm volatile("" ::: "memory");
#pragma unroll
                for (int i = 0; i < 16; ++i) { const int ci = (i & 3) + 8 * (i >> 2); s1[i] = s1[i] * C2 + pb[27 - ci]; }
            }
            float mx = s0[0];
#pragma unroll
            for (int i = 1; i < 16; ++i) mx = fmaxf(mx, s0[i]);
#pragma unroll
            for (int i = 0; i < 16; ++i) mx = fmaxf(mx, s1[i]);
            mx = fmaxf(mx, __shfl_xor(mx, 32));
            const float mnew = fmaxf(mrun, mx), alpha = fexp2(mrun - mnew);
            mrun = mnew;
            float ps = 0.f;
#pragma unroll
            for (int i = 0; i < 16; ++i) { s0[i] = fexp2(s0[i] - mnew); s1[i] = fexp2(s1[i] - mnew); ps += s0[i] + s1[i]; }
            lsum = lsum * alpha + ps;
#pragma unroll
            for (int i = 0; i < 16; ++i) { o0[i] *= alpha; o1[i] *= alpha; }
#pragma unroll
            for (int rb = 0; rb < 2; ++rb)
#pragma unroll
                for (int s2 = 0; s2 < 2; ++s2) {
                    const bf16x8 pf = pack8(rb ? s1 : s0, s2);
#pragma unroll
                    for (int db = 0; db < 2; ++db) {
                        const s16x4 lo = __builtin_amdgcn_ds_read_tr16_b64_v4i16((LAS s16x4*)(tbase + (32 * rb + 16 * s2) * 144 + db * 64));
                        const s16x4 hi = __builtin_amdgcn_ds_read_tr16_b64_v4i16((LAS s16x4*)(tbase + (32 * rb + 16 * s2 + 8) * 144 + db * 64));
                        const bf16x8 va = __builtin_shufflevector(lo, hi, 0, 1, 2, 3, 4, 5, 6, 7);
                        if (db == 0) o0 = MFMA32(va, pf, o0); else o1 = MFMA32(va, pf, o1);
                    }
                }
            asm volatile("" ::: "memory");
        }
        const float inv = 1.0f / (lsum + __shfl_xor(lsum, 32));
        bf16* orow = O + (qrow0 + l31) * D + h * 64 + 4 * hh;
#pragma unroll
        for (int i4 = 0; i4 < 4; ++i4) {
            u32x2 w0; w0.x = pk2(o0[4 * i4] * inv, o0[4 * i4 + 1] * inv); w0.y = pk2(o0[4 * i4 + 2] * inv, o0[4 * i4 + 3] * inv); *(u32x2*)(orow + 8 * i4) = w0;
            u32x2 w1; w1.x = pk2(o1[4 * i4] * inv, o1[4 * i4 + 1] * inv); w1.y = pk2(o1[4 * i4 + 2] * inv, o1[4 * i4 + 3] * inv); *(u32x2*)(orow + 32 + 8 * i4) = w1;
        }
    }
}
constexpr int SX_XT = 0, SX_XWT = 36864, SX_BT = 73728, SX_BS = 92160, SX_CS = 109568, SX_DT = 126976, SX_CUM = SX_DT + 1024, SX_WIN = SX_DT + 2048, SX_PART = SX_DT + 3072;
__device__ __forceinline__ void ssd_phase(const Frame& F, const Args& a, int z, int li, bf16* PROJ, const float* DT, bf16* dryXB) {
    float* outp = (float*)AIN(23);
    unsigned char* lds = F.lds;
    bf16* Xt = (bf16*)(lds + SX_XT); bf16* Xwt = (bf16*)(lds + SX_XWT); bf16* Bt = (bf16*)(lds + SX_BT); bf16* Bs = (bf16*)(lds + SX_BS); bf16* Cs = (bf16*)(lds + SX_CS);
    float* dts = (float*)(lds + SX_DT); float* cums = (float*)(lds + SX_CUM); float* wins = (float*)(lds + SX_WIN); float* part = (float*)(lds + SX_PART);
    const int tid = F.tid, lane = F.lane, wave = F.wave, l31 = lane & 31, hh = lane >> 5;
    const int r = wave >> 1, half = wave & 1;
    const float* conv_w = AIN(10) + (size_t)li * 4 * 4096; const float* conv_b = AIN(11) + (size_t)li * 4096;
    const float* dt_bias = AIN(12) + li * 32; const float* a_log = AIN(13) + li * 32; const float* d_skip = AIN(14) + li * 32; const float* norm_w = AIN(15) + (size_t)li * 2048;
    for (int item = F.bid; item < 512; item += F.G) {
        const bool smp = item >= 256; const int bg = item & 255, b = bg >> 3, g = bg & 7;
        const size_t row0 = smp ? (size_t)MP + b * 64 : (size_t)b * 2048; const int nchunks = smp ? 1 : 32;
        const int hglob = g * 4 + r;
        const float Dr = d_skip[hglob];
        f32x16 hT[4];
        const size_t hoff = (((size_t)(li * 32 + b) * 32 + hglob) * 64 + 32 * half + l31) * 128 + 4 * hh;
        if (smp) { const float* hs = AIN(4) + hoff;
#pragma unroll
            for (int nb = 0; nb < 4; ++nb)
#pragma unroll
                for (int i4 = 0; i4 < 4; ++i4) { const f32x4 v = *(const f32x4*)(hs + 32 * nb + 8 * i4); hT[nb][4 * i4] = v[0]; hT[nb][4 * i4 + 1] = v[1]; hT[nb][4 * i4 + 2] = v[2]; hT[nb][4 * i4 + 3] = v[3]; }
        } else {
#pragma unroll
            for (int nb = 0; nb < 4; ++nb)
#pragma unroll
                for (int i = 0; i < 16; ++i) hT[nb][i] = 0.f;
        }
        float dt_pf = (tid < 256) ? DT[(row0 + lane) * 32 + g * 4 + wave] : 0.f;
#pragma unroll 1
        for (int c = 0; c < nchunks; ++c) {
            const size_t rowc = row0 + 64 * c;
            int lane_ = F.lane; asm volatile("" : "+v"(lane_));
            const int lane = lane_, l31 = lane & 31, hh = lane >> 5, tid = wave * 64 + lane;
            const int role = lane < 32 ? 0 : (lane < 48 ? 1 : 2);
            const int chbase = role == 0 ? g * 256 + 8 * lane : (role == 1 ? 2048 + g * 128 + 8 * (lane - 32) : 3072 + g * 128 + 8 * (lane - 48));
            if (tid < 256) {
                const int hr = g * 4 + wave;
                const float raw = dt_pf + dt_bias[hr];
                if (c + 1 < nchunks) dt_pf = DT[(rowc + 64 + lane) * 32 + hr];
                const float dt = raw > 20.f ? raw : log1pf(__expf(raw));
                const float am = -__expf(a_log[hr]) * LOG2E;
                float v = dt * am;
#pragma unroll
                for (int o = 1; o < 64; o <<= 1) { const float n = __shfl_up(v, o); if (lane >= o) v += n; }
                const float last = __shfl(v, 63);
                dts[wave * 64 + lane] = dt; cums[wave * 64 + lane] = v; wins[wave * 64 + lane] = fexp2(last - v) * dt;
            }
            __syncthreads();
            {
                const bf16* src = PROJ + 2048 + chbase;
                u32x4 raw[11];
#pragma unroll
                for (int i = 0; i < 11; ++i) {
                    const int rr = 8 * wave - 3 + i;
                    if (rr >= 0 || c > 0) raw[i] = *(const u32x4*)(src + (size_t)((long)rowc + rr) * LDP);
                    else if (!smp) raw[i] = (u32x4){0u, 0u, 0u, 0u};
                    else { const float* sc = AIN(5) + ((size_t)(li * 32 + b) * 3 + (3 + rr)) * 4096 + chbase; const f32x4 s0 = *(const f32x4*)sc, s1 = *(const f32x4*)(sc + 4);
                        raw[i] = (u32x4){pk2(s0[0], s0[1]), pk2(s0[2], s0[3]), pk2(s1[0], s1[1]), pk2(s1[2], s1[3])}; }
                }
                if (c == nchunks - 1 && wave == 7) {
                    float* co = outp + (smp ? O_CS : O_CP) + ((size_t)(li * 32 + b) * 3) * 4096 + chbase;
#pragma unroll
                    for (int k = 0; k < 3; ++k) { const u32x4 rw = raw[8 + k];
                        *(f32x4*)(co + k * 4096) = (f32x4){bflo(rw.x), bfhi(rw.x), bflo(rw.y), bfhi(rw.y)}; *(f32x4*)(co + k * 4096 + 4) = (f32x4){bflo(rw.z), bfhi(rw.z), bflo(rw.w), bfhi(rw.w)}; }
                }
                float win8[8];
                { const float* wp = wins + (lane < 32 ? (lane >> 3) : 0) * 64 + 8 * wave;
                  const f32x4 wa = *(const f32x4*)wp, wb = *(const f32x4*)(wp + 4);
                  win8[0] = wa[0]; win8[1] = wa[1]; win8[2] = wa[2]; win8[3] = wa[3]; win8[4] = wb[0]; win8[5] = wb[1]; win8[6] = wb[2]; win8[7] = wb[3]; }
#pragma unroll
                for (int hb = 0; hb < 2; ++hb) {
                    f32x4 wv[4], bvv;
#pragma unroll
                    for (int k = 0; k < 4; ++k) wv[k] = *(const f32x4*)(conv_w + k * 4096 + chbase + 4 * hb);
                    bvv = *(const f32x4*)(conv_b + chbase + 4 * hb);
                    unsigned pc[4][4];
#pragma unroll
                    for (int e4 = 0; e4 < 4; ++e4) {
                        const int e = 4 * hb + e4;
                        float xv[11];
#pragma unroll
                        for (int i = 0; i < 11; ++i) { const unsigned wd = raw[i][e >> 1]; xv[i] = (e & 1) ? bfhi(wd) : bflo(wd); }
                        const float w0 = wv[0][e4], w1 = wv[1][e4], w2 = wv[2][e4], w3 = wv[3][e4], bb = bvv[e4];
                        float o[8];
#pragma unroll
                        for (int j = 0; j < 8; ++j) o[j] = silu_f(bb + w0 * xv[j] + w1 * xv[j + 1] + w2 * xv[j + 2] + w3 * xv[j + 3]);
#pragma unroll
                        for (int j2 = 0; j2 < 4; ++j2) pc[e4][j2] = pk2(o[2 * j2], o[2 * j2 + 1]);
                        if (role == 0) {
                            *(u32x4*)(Xt + (8 * lane + e) * 72 + 8 * (wave ^ (lane & 7))) = (u32x4){pc[e4][0], pc[e4][1], pc[e4][2], pc[e4][3]};
                            *(u32x4*)(Xwt + (8 * lane + e) * 72 + 8 * (wave ^ (lane & 7))) = (u32x4){pk2(o[0] * win8[0], o[1] * win8[1]), pk2(o[2] * win8[2], o[3] * win8[3]), pk2(o[4] * win8[4], o[5] * win8[5]), pk2(o[6] * win8[6], o[7] * win8[7])};
                        } else if (role == 1) {
                            *(u32x4*)(Bt + (8 * (lane - 32) + e) * 72 + 8 * (wave ^ (lane & 7))) = (u32x4){pc[e4][0], pc[e4][1], pc[e4][2], pc[e4][3]};
                        }
                    }
                    if (role != 0) {
                        bf16* dst = (role == 1 ? Bs + 8 * (lane - 32) : Cs + 8 * (lane - 48)) + (8 * wave) * 136 + 4 * hb;
#pragma unroll
                        for (int j2 = 0; j2 < 4; ++j2) {
                            u32x2 lo, hi;
                            lo.x = __builtin_amdgcn_perm(pc[1][j2], pc[0][j2], 0x05040100u); hi.x = __builtin_amdgcn_perm(pc[1][j2], pc[0][j2], 0x07060302u);
                            lo.y = __builtin_amdgcn_perm(pc[3][j2], pc[2][j2], 0x05040100u); hi.y = __builtin_amdgcn_perm(pc[3][j2], pc[2][j2], 0x07060302u);
                            *(u32x2*)(dst + (2 * j2) * 136) = lo; *(u32x2*)(dst + (2 * j2 + 1) * 136) = hi;
                        }
                    }
                }
            }
            __syncthreads();
            bf16* zr0 = PROJ + (rowc + l31) * LDP + g * 256 + 64 * r + 32 * half + 4 * hh; bf16* zr1 = zr0 + (size_t)32 * LDP;
            u32x2 zp0[4], zp1[4];
#pragma unroll
            for (int i4 = 0; i4 < 4; ++i4) { zp0[i4] = *(const u32x2*)(zr0 + 8 * i4); zp1[i4] = *(const u32x2*)(zr1 + 8 * i4); }
            f32x16 cb00, cb01, cb11;
#pragma unroll
            for (int i = 0; i < 16; ++i) { cb00[i] = 0.f; cb01[i] = 0.f; cb11[i] = 0.f; }
#pragma unroll
            for (int ns = 0; ns < 8; ++ns) {
                const bf16x8 a0 = *(const bf16x8*)(Bs + l31 * 136 + 16 * ns + 8 * hh), a1 = *(const bf16x8*)(Bs + (32 + l31) * 136 + 16 * ns + 8 * hh);
                const bf16x8 c0 = *(const bf16x8*)(Cs + l31 * 136 + 16 * ns + 8 * hh), c1 = *(const bf16x8*)(Cs + (32 + l31) * 136 + 16 * ns + 8 * hh);
                cb00 = MFMA32(a0, c0, cb00); cb01 = MFMA32(a0, c1, cb01); cb11 = MFMA32(a1, c1, cb11);
            }
            const float* cumr = cums + r * 64; const float* dtr = dts + r * 64;
            const float cum_t0 = cumr[l31], cum_t1 = cumr[32 + l31];
#pragma unroll
            for (int i4 = 0; i4 < 4; ++i4) {
                const f32x4 cs0 = *(const f32x4*)(cumr + 8 * i4 + 4 * hh), cs1 = *(const f32x4*)(cumr + 32 + 8 * i4 + 4 * hh);
                const f32x4 ds0 = *(const f32x4*)(dtr + 8 * i4 + 4 * hh), ds1 = *(const f32x4*)(dtr + 32 + 8 * i4 + 4 * hh);
#pragma unroll
                for (int j = 0; j < 4; ++j) { const int i = 4 * i4 + j, s = 8 * i4 + 4 * hh + j;
                    float v00 = cb00[i] * fexp2(fminf(cum_t0 - cs0[j], 0.f)) * ds0[j]; v00 = (s <= l31) ? v00 : 0.f; v00 += (s == l31) ? Dr : 0.f; cb00[i] = v00;
                    cb01[i] = cb01[i] * fexp2(fminf(cum_t1 - cs0[j], 0.f)) * ds0[j];
                    float v11 = cb11[i] * fexp2(fminf(cum_t1 - cs1[j], 0.f)) * ds1[j]; v11 = (s <= l31) ? v11 : 0.f; v11 += (s == l31) ? Dr : 0.f; cb11[i] = v11; }
            }
            f32x16 y0, y1;
#pragma unroll
            for (int i = 0; i < 16; ++i) { y0[i] = 0.f; y1[i] = 0.f; }
#pragma unroll
            for (int nb = 0; nb < 4; ++nb)
#pragma unroll
                for (int s2 = 0; s2 < 2; ++s2) {
                    const bf16x8 ha = pack8(hT[nb], s2);
                    const int n0 = 32 * nb + 16 * s2 + 4 * hh;
                    const s16x4 c0l = *(const s16x4*)(Cs + l31 * 136 + n0), c0h = *(const s16x4*)(Cs + l31 * 136 + n0 + 8);
                    const s16x4 c1l = *(const s16x4*)(Cs + (32 + l31) * 136 + n0), c1h = *(const s16x4*)(Cs + (32 + l31) * 136 + n0 + 8);
                    y0 = MFMA32(ha, __builtin_shufflevector(c0l, c0h, 0, 1, 2, 3, 4, 5, 6, 7), y0);
                    y1 = MFMA32(ha, __builtin_shufflevector(c1l, c1h, 0, 1, 2, 3, 4, 5, 6, 7), y1);
                }
            { const float e0 = fexp2(cum_t0), e1 = fexp2(cum_t1);
#pragma unroll
              for (int i = 0; i < 16; ++i) { y0[i] *= e0; y1[i] *= e1; } }
            { const bf16* xrow = Xt + (64 * r + 32 * half + l31) * 72;
#pragma unroll
              for (int s2 = 0; s2 < 2; ++s2) {
                  const int swx = 8 * ((4 * half + (l31 >> 3)) & 7);
                  const s16x4 x0l = *(const s16x4*)(xrow + ((16 * s2) ^ swx) + 4 * hh), x0h = *(const s16x4*)(xrow + ((16 * s2 + 8) ^ swx) + 4 * hh);
                  const s16x4 x1l = *(const s16x4*)(xrow + ((32 + 16 * s2) ^ swx) + 4 * hh), x1h = *(const s16x4*)(xrow + ((32 + 16 * s2 + 8) ^ swx) + 4 * hh);
                  const bf16x8 xa0 = __builtin_shufflevector(x0l, x0h, 0, 1, 2, 3, 4, 5, 6, 7), xa1 = __builtin_shufflevector(x1l, x1h, 0, 1, 2, 3, 4, 5, 6, 7);
                  y0 = MFMA32(xa0, pack8(cb00, s2), y0);
                  y1 = MFMA32(xa0, pack8(cb01, s2), y1);
                  y1 = MFMA32(xa1, pack8(cb11, s2), y1);
              } }
            {
                float ss0 = 0.f, ss1 = 0.f;
#pragma unroll
                for (int i4 = 0; i4 < 4; ++i4) {
                    const u32x2 z0 = zp0[i4], z1 = zp1[i4];
                    const float za[4] = {bflo(z0.x), bfhi(z0.x), bflo(z0.y), bfhi(z0.y)}, zb[4] = {bflo(z1.x), bfhi(z1.x), bflo(z1.y), bfhi(z1.y)};
#pragma unroll
                    for (int j = 0; j < 4; ++j) { const float v0 = y0[4 * i4 + j] * silu_f(za[j]), v1 = y1[4 * i4 + j] * silu_f(zb[j]); y0[4 * i4 + j] = v0; y1[4 * i4 + j] = v1; ss0 += v0 * v0; ss1 += v1 * v1; }
                }
                ss0 += __shfl_xor(ss0, 32); ss1 += __shfl_xor(ss1, 32);
                if (hh == 0) { part[l31 * 8 + wave] = ss0; part[(32 + l31) * 8 + wave] = ss1; }
                __syncthreads();
                const f32x4 pa = *(const f32x4*)(part + l31 * 8), pb = *(const f32x4*)(part + l31 * 8 + 4), pc = *(const f32x4*)(part + (32 + l31) * 8), pd = *(const f32x4*)(part + (32 + l31) * 8 + 4);
                const float t0 = ((pa[0] + pa[1]) + (pa[2] + pa[3])) + ((pb[0] + pb[1]) + (pb[2] + pb[3])), t1 = ((pc[0] + pc[1]) + (pc[2] + pc[3])) + ((pd[0] + pd[1]) + (pd[2] + pd[3]));
                const float r0 = 1.0f / sqrtf(t0 * (1.f / 256.f) + RMS_EPS), r1 = 1.0f / sqrtf(t1 * (1.f / 256.f) + RMS_EPS);
                const float* nwp = norm_w + g * 256 + 64 * r + 32 * half + 4 * hh;
#pragma unroll
                for (int i4 = 0; i4 < 4; ++i4) { const f32x4 nw = *(const f32x4*)(nwp + 8 * i4);
                    u32x2 w0; w0.x = pk2(y0[4 * i4] * r0 * nw[0], y0[4 * i4 + 1] * r0 * nw[1]); w0.y = pk2(y0[4 * i4 + 2] * r0 * nw[2], y0[4 * i4 + 3] * r0 * nw[3]); if (!dryXB) *(u32x2*)(zr0 + 8 * i4) = w0; else if (g < 4) *(u32x2*)(dryXB + (rowc + l31) * 1024 + g * 256 + 64 * r + 32 * half + 4 * hh + 8 * i4) = w0;
                    u32x2 w1; w1.x = pk2(y1[4 * i4] * r1 * nw[0], y1[4 * i4 + 1] * r1 * nw[1]); w1.y = pk2(y1[4 * i4 + 2] * r1 * nw[2], y1[4 * i4 + 3] * r1 * nw[3]); if (!dryXB) *(u32x2*)(zr1 + 8 * i4) = w1; else if (g < 4) *(u32x2*)(dryXB + (rowc + 32 + l31) * 1024 + g * 256 + 64 * r + 32 * half + 4 * hh + 8 * i4) = w1; }
            }
            { const float dec = fexp2(cumr[63]);
#pragma unroll
              for (int nb = 0; nb < 4; ++nb)
#pragma unroll
                  for (int i = 0; i < 16; ++i) hT[nb][i] *= dec;
              const bf16* xw = Xwt + (64 * r + 32 * half + l31) * 72; const int swx = 8 * ((4 * half + (l31 >> 3)) & 7), swn = 8 * (l31 >> 3);
#pragma unroll
              for (int ss = 0; ss < 4; ++ss) { const bf16x8 bx = *(const bf16x8*)(xw + ((16 * ss + 8 * hh) ^ swx));
#pragma unroll
                  for (int nb = 0; nb < 4; ++nb) { const bf16x8 af = *(const bf16x8*)(Bt + (32 * nb + l31) * 72 + ((16 * ss + 8 * hh) ^ swn ^ (32 * (nb & 1)))); hT[nb] = MFMA32(af, bx, hT[nb]); } }
            }
            __syncthreads();
        }
        { float* ho = outp + (smp ? O_HS : O_HP) + hoff;
#pragma unroll
          for (int nb = 0; nb < 4; ++nb)
#pragma unroll
              for (int i4 = 0; i4 < 4; ++i4) *(f32x4*)(ho + 32 * nb + 8 * i4) = (f32x4){hT[nb][4 * i4], hT[nb][4 * i4 + 1], hT[nb][4 * i4 + 2], hT[nb][4 * i4 + 3]};
          }
    }
}
__device__ __forceinline__ void sample_reduce_phase(const Frame& F, const float* SP, bf16* XB, const float* MR, const float* g, const float* b, float* ST) {
    const int gw = F.bid * 8 + F.wave, NGW = F.G * 8, lane = F.lane;
    for (int seg = gw; seg < MS * 4; seg += NGW) {
        const int rowl = seg >> 2, pn = seg & 3, t = (rowl >> 8) * 4 + pn, rl = rowl & 255; const unsigned row = (unsigned)(MP + rowl);
        const float* sp = SP + (size_t)(t * 8) * 65536 + (unsigned)(rl * 256 + 4 * lane);
        f32x4 p[8];
#pragma unroll
        for (int ks = 0; ks < 8; ++ks) p[ks] = *(const f32x4*)(sp + (size_t)ks * 65536);
        bf16* xp = XB + row * D + pn * 256 + 4 * lane;
        const u32x2 xw = *(const u32x2*)xp; const f32x2_t mr = *(const f32x2_t*)(MR + 2 * row);
        const f32x4 gg = *(const f32x4*)(g + pn * 256 + 4 * lane), bb = *(const f32x4*)(b + pn * 256 + 4 * lane);
        asm volatile("" ::: "memory");
        f32x4 acc = p[0];
#pragma unroll
        for (int ks = 1; ks < 8; ++ks) acc = acc + p[ks];
        f32x4 x = (f32x4){bflo(xw.x), bfhi(xw.x), bflo(xw.y), bfhi(xw.y)};
        x = (x - mr.x) * mr.y * gg + bb;
        const f32x4 v = x * ALPHA + acc;
        u32x2 w; w.x = pk2(v[0], v[1]); w.y = pk2(v[2], v[3]); *(u32x2*)xp = w;
        const float s1 = wave_sum((v[0] + v[1]) + (v[2] + v[3])), s2 = wave_sum((v[0] * v[0] + v[1] * v[1]) + (v[2] * v[2] + v[3] * v[3]));
        if (lane == 0) *(f32x2_t*)(ST + 8 * row + 2 * pn) = (f32x2_t){s1, s2};
    }
}

__global__ void __launch_bounds__(512, 2) fwd_megakernel(Args a) {
    extern __shared__ __attribute__((aligned(16))) unsigned char lds[];
    cg::grid_group grid = cg::this_grid();
    const int wv0 = __builtin_amdgcn_readfirstlane((int)threadIdx.x >> 6);
    Frame F; F.lds = lds; F.tid = threadIdx.x; F.lane = F.tid & 63; F.wave = __builtin_amdgcn_readfirstlane(F.tid >> 6); F.G = gridDim.x; F.bid = blockIdx.x;
    PG8_LAS unsigned char* glds = (PG8_LAS unsigned char*)lds;
    {
        int z = 0; asm volatile("" : "+s"(z));
        unsigned* bw = (unsigned*)AIN(24);
        if (blockIdx.x == 0) for (int i = threadIdx.x; i < XCD_BAR_WORDS; i += 512) __hip_atomic_store(bw + i, 0u, __ATOMIC_RELAXED, __HIP_MEMORY_SCOPE_AGENT);
        volatile LAS unsigned* st = (volatile LAS unsigned*)(glds + (LDS_BYTES - 16));
        if (threadIdx.x < 2) st[threadIdx.x] = 0u;
        __syncthreads();
        grid.sync();
        (void)xcd_barrier_post(bw, st);
    }
#ifndef REP_IN
#define REP_IN 1
#endif
#ifndef REP_ATT
#define REP_ATT 1
#endif
#ifndef REP_UP
#define REP_UP 1
#endif
#ifndef REP_CONV
#define REP_CONV 1
#endif
#ifndef REP_SYNC
#define REP_SYNC 1
#endif
    for (int ph = a.ph_lo; ph < a.ph_hi; ++ph) {
      const int sub_ = ph & 7; if (sub_ == 4) continue;
      {
        { int t_ = wv0 * 64 + lane_id_(); asm volatile("" : "+v"(t_)); F.tid = t_; F.lane = t_ & 63; F.wave = wv0; }
        { int g_ = (int)gridDim.x, b_ = (int)blockIdx.x; asm volatile("" : "+s"(g_), "+s"(b_)); F.G = g_; F.bid = b_; }
        int z = 0; asm volatile("" : "+s"(z));
        unsigned char* ws = (unsigned char*)AIN(24);
        bf16* WA = (bf16*)(ws + WS_WA); bf16* WB = (bf16*)(ws + WS_WB); bf16* WUP = (bf16*)(ws + WS_WUP); bf16* WDN = (bf16*)(ws + WS_WDN);
        bf16* XB = (bf16*)(ws + WS_XB); float* DT = (float*)(ws + WS_DT); bf16* BIG = (bf16*)(ws + WS_BIG);
        bf16* OB = (bf16*)(ws + WS_O); bf16* CK = (bf16*)(ws + WS_CK); bf16* CV = (bf16*)(ws + WS_CV);
        float* X = (float*)AIN(23);
        float* ST0 = (float*)(ws + WS_ST0); float* ST1 = (float*)(ws + WS_ST1);
        const int L = ph >> 3, sub = ph & 7, li = L >> 1; const bool ssm = (L & 1);
        if (sub == 0) {
#ifndef NO_CONV
 convert_phase(F, a, z, L);
#endif
 }
        else if (sub == 1) {
#if !defined(ONLY_SUB) || ONLY_SUB == 1
            pg8::StaticOrder S;
            if (!ssm) { pg8::Gemm g{XB, WA, M, 3072, D, D, D}; S.init(M, 3072, F.G, F.bid); pg8::EpiQKV E{BIG, X, li, L > 0 ? ST0 : (const float*)nullptr, (const float*)(ws + WS_CSA), (const float*)(ws + WS_BWA), (float*)(ws + WS_MR0), (PG8_LAS float*)(glds + 131072 + 8192)};
                pg8::gemm_phase<pg8::EpiQKV, pg8::StaticOrder, true, true>(glds, g, S, E, F.wave); }
            else { pg8::Gemm g{XB, WA, M, NPROJ_PAD, D, D, D}; S.init(M, NPROJ_PAD, F.G, F.bid); pg8::EpiSsmIn E{BIG, DT, ST0, (const float*)(ws + WS_CSA), (const float*)(ws + WS_BWA), (float*)(ws + WS_MR0), (PG8_LAS float*)(glds + 131072 + 8192)};
                pg8::gemm_phase<pg8::EpiSsmIn, pg8::StaticOrder, true, true>(glds, g, S, E, F.wave); }
#endif
        } else if (sub == 2) {
#ifndef NO_ATTN
            if (!ssm) attn_phase(F, AIN(7) + (size_t)li * 16 * 513, BIG, CK, CV, OB);
#endif
#ifndef NO_SSD
#ifdef PROBE_SSD
            if (ssm) for (int pass = 0; pass < 2; ++pass) { ssd_phase(F, a, z, li, BIG, DT, pass == 0 ? XB : nullptr);
                if (pass == 0) { XcdBarrier xb_; xb_.w0 = F.wave; xb_.bar = (unsigned*)AIN(24); xb_.x = xb_xcc_id(); xb_.st = (volatile LAS unsigned*)(glds + (LDS_BYTES - 16)); xcd_barrier(xb_); } }
#else
            if (ssm) ssd_phase(F, a, z, li, BIG, DT, nullptr);
#endif
#endif
        } else if (sub == 3) {
#if !defined(ONLY_SUB) || ONLY_SUB == 3
            pg8::StaticOrder S; S.init(M, D, F.G, F.bid); pg8::EpiResid E{XB, L > 0 ? (const float*)(ws + WS_MR0) : (const float*)nullptr, AIN(21) + (L > 0 ? L - 1 : 0) * D, AIN(22) + (L > 0 ? L - 1 : 0) * D, ST1, (PG8_LAS float*)(glds + 131072)};
#ifdef PROBE_S3
            { pg8::Gemm g0 = ssm ? pg8::Gemm{BIG, WB, M, D, 2048, LDP, 2048} : pg8::Gemm{OB, WB, M, D, D, D, D};
              pg8::EpiBf16Plain E0{ssm ? BIG + 2048 : BIG, ssm ? LDP : D, 0, (const float*)nullptr, (const float*)nullptr, (const float*)nullptr, (float*)nullptr, (PG8_LAS float*)(glds + 131072 + 8192)};
              pg8::gemm_phase<pg8::EpiBf16Plain, pg8::StaticOrder, true, true>(glds, g0, S, E0, F.wave);
              XcdBarrier xb_; xb_.w0 = F.wave; xb_.bar = (unsigned*)AIN(24); xb_.x = xb_xcc_id(); xb_.st = (volatile LAS unsigned*)(glds + (LDS_BYTES - 16)); xcd_barrier(xb_); }
#endif
            if (!ssm) { pg8::Gemm g{OB, WB, M, D, D, D, D}; pg8::gemm_phase<pg8::EpiResid, pg8::StaticOrder, true, true>(glds, g, S, E, F.wave); }
            else { pg8::Gemm g{BIG, WB, M, D, 2048, LDP, 2048}; pg8::gemm_phase<pg8::EpiResid, pg8::StaticOrder, true, true>(glds, g, S, E, F.wave); }
#endif
        } else if (sub == 4) ln_phase(F, X, XB, AIN(17) + L * D, AIN(18) + L * D);
        else if (sub == 5) {
#if !defined(ONLY_SUB) || ONLY_SUB == 5
 pg8::Gemm g{XB, WUP, M, DFF, D, D, D}; pg8::StaticOrder S; S.init(M, DFF, F.G, F.bid); pg8::EpiBf16Plain E{BIG, DFF, 1, ST1, (const float*)(ws + WS_CSU), (const float*)(ws + WS_BWU), (float*)(ws + WS_MR1), (PG8_LAS float*)(glds + 131072 + 8192)};
            pg8::gemm_phase<pg8::EpiBf16Plain, pg8::StaticOrder, true, true>(glds, g, S, E, F.wave);
#endif
 }
        else if (sub == 6) {
#if !defined(ONLY_SUB) || ONLY_SUB == 6
 pg8::Gemm g{BIG, WDN, M, D, DFF, DFF, DFF}; pg8::StaticOrder S; S.init(MP, D, F.G, F.bid);
#ifdef PROBE_DN
            { pg8::EpiBf16Plain E0{(bf16*)(ws + WS_CK), D, 0, (const float*)nullptr, (const float*)nullptr, (const float*)nullptr, (float*)nullptr, (PG8_LAS float*)(glds + 131072 + 8192)};
              pg8::gemm_phase<pg8::EpiBf16Plain, pg8::StaticOrder, true, true>(glds, g, S, E0, F.wave);
              XcdBarrier xb_; xb_.w0 = F.wave; xb_.bar = (unsigned*)AIN(24); xb_.x = xb_xcc_id(); xb_.st = (volatile LAS unsigned*)(glds + (LDS_BYTES - 16)); xcd_barrier(xb_); }
#endif
 pg8::EpiResid E{XB, (const float*)(ws + WS_MR1), AIN(17) + L * D, AIN(18) + L * D, ST0, (PG8_LAS float*)(glds + 131072)};
            pg8::gemm_phase<pg8::EpiResid, pg8::StaticOrder, true, true>(glds, g, S, E, F.wave);
            { pg8::Gemm g2{BIG, WDN, M, D, DFF / 8, DFF, DFF}; pg8::SplitOrder S2{F.G, F.bid}; pg8::EpiPartial E2{(float*)(ws + WS_CK)};
              pg8::gemm_phase<pg8::EpiPartial, pg8::SplitOrder, true, true>(glds, g2, S2, E2, F.wave); }
#endif
 }
        else { sample_reduce_phase(F, (const float*)(ws + WS_CK), XB, (const float*)(ws + WS_MR1), AIN(17) + L * D, AIN(18) + L * D, ST0);
            if (ph == 31) { { XcdBarrier xb_; xb_.w0 = F.wave; xb_.bar = (unsigned*)AIN(24); xb_.x = xb_xcc_id(); xb_.st = (volatile LAS unsigned*)(glds + (LDS_BYTES - 16)); xcd_barrier(xb_); }
                ln_phase(F, X, XB, AIN(21) + L * D, AIN(22) + L * D); } }
        if (ph + 1 < a.ph_hi) { XcdBarrier xb_; xb_.w0 = F.wave; xb_.bar = (unsigned*)AIN(24); xb_.x = xb_xcc_id(); xb_.st = (volatile LAS unsigned*)(glds + (LDS_BYTES - 16)); xcd_barrier(xb_); }
      }
    }
}

extern "C" void kernel_launch(void* const* d_in, const int* in_sizes, int n_in, void* d_out, int out_size, void* d_ws, size_t ws_size, hipStream_t stream) {
    static int grid = 0;
    if (grid == 0) {
        if (n_in != 23 || ws_size < WS_END2) { fprintf(stderr, "kernel_launch: need 23 inputs and %zu bytes of workspace, got %d and %zu\n", (size_t)WS_END2, n_in, ws_size); grid = -1; return; }
        int dev = 0, cus = 0, per_cu = 0;
        hipGetDevice(&dev); hipDeviceGetAttribute(&cus, hipDeviceAttributeMultiprocessorCount, dev);
        if (hipFuncSetAttribute((const void*)fwd_megakernel, hipFuncAttributeMaxDynamicSharedMemorySize, LDS_BYTES) != hipSuccess) { fprintf(stderr, "kernel_launch: hipFuncSetAttribute failed\n"); grid = -1; return; }
        if (hipOccupancyMaxActiveBlocksPerMultiprocessor(&per_cu, (const void*)fwd_megakernel, 512, LDS_BYTES) != hipSuccess || per_cu < 1) per_cu = 1;
        (void)hipGetLastError();
        grid = cus * per_cu;
        if (grid % 8 != 0) { fprintf(stderr, "kernel_launch: grid %d is not a multiple of 8\n", grid); grid = -1; return; }
    }
    if (grid < 0) return;
    Args a{};
    for (int i = 0; i < 23; ++i) a.in[i] = (const float*)d_in[i];
    a.in[23] = (const float*)d_out; a.in[24] = (const float*)d_ws; a.ph_lo = 0; a.ph_hi = 32;
    void* args[] = {&a};
    hipError_t e = hipLaunchCooperativeKernel((const void*)fwd_megakernel, dim3(grid), dim3(512), args, LDS_BYTES, stream);
    if (e != hipSuccess) fprintf(stderr, "cooperative launch failed: %s (grid %d)\n", hipGetErrorString(e), grid);
}
```

```cpp
#include <hip/hip_runtime.h>
#include <hip/hip_cooperative_groups.h>
#include <cstdio>
#include <cstdint>
namespace cg = cooperative_groups;
__device__ __forceinline__ int lane_id_() { return (int)__builtin_amdgcn_mbcnt_hi(~0u, __builtin_amdgcn_mbcnt_lo(~0u, 0u)); }
namespace pg8 {
#define PG8_LAS __attribute__((address_space(3)))
typedef unsigned short bf16_t;
typedef short bf16x8 __attribute__((ext_vector_type(8)));
typedef float f32x4 __attribute__((ext_vector_type(4)));
typedef unsigned u32x4 __attribute__((ext_vector_type(4)));
constexpr int BM = 256, BK = 64, HALF = 128, HTB = HALF * BK * 2  , STAGE_BYTES = 8 * HTB, NXCD = 8, WGM = 8;

__host__ __device__ __forceinline__ int lds_byte(int r, int c) { const int st = (r >> 4) * 2 + (c >> 5), rr = r & 15, cc = c & 31, ob = rr * 64 + cc * 2; return st * 1024 + (ob ^ (((ob >> 9) & 1) << 5)); }
__host__ __device__ __forceinline__ void stage_rc(int b, int& R, int& C) { const int st = b / 1024, sb = b % 1024, swz = sb ^ (((sb >> 9) & 1) << 5); R = (st >> 1) * 16 + swz / 64; C = (st & 1) * 32 + (swz % 64) / 2; }
__host__ __device__ __forceinline__ int perm32(int rho) { const int n = rho >> 4, i = rho & 15; return 8 * (i >> 2) + 4 * n + (i & 3); }

struct Unit { int pm, pn, kb; };
struct Gemm { const bf16_t* A; const bf16_t* Bt; int M, N, K, lda, ldb; };

struct StaticOrder {
    int nM, nN, nwg, G, c;
    __host__ __device__ void init(int M, int N, int G_, int c_) { nM = M / BM; nN = N / BM; nwg = nM * nN; G = G_; c = c_; }
    __host__ __device__ bool next(int i, Unit& u) const {
        const long L = (long)i * G + c; if (L >= nwg) return false;
        int wgid = (int)L; { const int q = nwg / NXCD, r = nwg % NXCD, xcd = wgid % NXCD, off = wgid / NXCD; wgid = (xcd < r ? xcd * (q + 1) : r * (q + 1) + (xcd - r) * q) + off; }
        const int nig = WGM * nN, gid = wgid / nig, fm = gid * WGM, gsz = (nM - fm) < WGM ? (nM - fm) : WGM;
        u.pm = fm + ((wgid % nig) % gsz); u.pn = (wgid % nig) / gsz; u.kb = 0; return true;
    }
    __device__ __forceinline__ void a_ready(const Unit&) const {}
    __device__ __forceinline__ void done(const Unit&) const {}
};

__device__ __forceinline__ unsigned cvt_pk_bf16(float lo, float hi) { unsigned r; asm volatile("v_cvt_pk_bf16_f32 %0, %1, %2" : "=v"(r) : "v"(lo), "v"(hi)); return r; }
typedef float f32x2 __attribute__((ext_vector_type(2)));
template <class Epi, class Sched, bool ALIGN_EPI = false, bool SP2 = false>
__device__ __forceinline__ void gemm_phase(PG8_LAS unsigned char* lds, const Gemm g, const Sched& S, const Epi& E, const int wave_id) {
    int tid_ = wave_id * 64 + lane_id_(); asm volatile("" : "+v"(tid_));
    const int tid = tid_, wid = __builtin_amdgcn_readfirstlane(tid >> 6), lane = tid & 63, wr = wid >> 2, wc = wid & 3, fr = lane & 15, fq = lane >> 4;
    const int K = g.K, nt = K / BK;
    unsigned voffA[2], voffB[2];
#pragma unroll
    for (int i = 0; i < 2; ++i) { int R, C; stage_rc(tid * 16 + i * 8192, R, C); const int Rb = Epi::PERM ? ((R & ~31) + perm32(R & 31)) : R;
        voffA[i] = (unsigned)(R * g.lda + C) * 2u; voffB[i] = (unsigned)(Rb * g.ldb + C) * 2u; }
    const size_t kstep = (size_t)(BK * 2);
    const size_t hstepA = (size_t)HALF * g.lda * 2, hstepB = (size_t)HALF * g.ldb * 2;
    const size_t tstepA = 2 * hstepA, tstepB = 2 * hstepB;
    const unsigned ldsw = (unsigned)wid * 1024u;
    const int aoff = lds_byte(wr * 64 + fr, fq * 8), boff = lds_byte(wc * 32 + fr, fq * 8);
#define PG8_SA(b, h) (((b) * 2 + (h)) * HTB)
#define PG8_SB(b, h) ((4 + (b) * 2 + (h)) * HTB)
#define PG8_STAGE(bufoff, gbase, voff) do { _Pragma("unroll") for (int _i = 0; _i < 2; ++_i) \
        __builtin_amdgcn_global_load_lds((const unsigned*)((const char*)(gbase) + (voff)[_i]), (PG8_LAS unsigned*)(lds + (bufoff) + ldsw + _i * 8192), 16, 0, 0); } while (0)
#define PG8_LDA(dst, b, h) do { _Pragma("unroll") for (int m = 0; m < 4; ++m) _Pragma("unroll") for (int k = 0; k < 2; ++k) dst[m][k] = *(const PG8_LAS bf16x8*)(lds + PG8_SA(b, h) + aoff + m * 2048 + k * 1024); } while (0)
#define PG8_LDB(dst, b, h) do { _Pragma("unroll") for (int n = 0; n < 2; ++n) _Pragma("unroll") for (int k = 0; k < 2; ++k) dst[n][k] = *(const PG8_LAS bf16x8*)(lds + PG8_SB(b, h) + boff + n * 2048 + k * 1024); } while (0)
#define PG8_MMA(ai, bj, At, Bt) do { __builtin_amdgcn_s_setprio(1); _Pragma("unroll") for (int m = 0; m < 4; ++m) _Pragma("unroll") for (int n = 0; n < 2; ++n) _Pragma("unroll") for (int k = 0; k < 2; ++k) \
        acc[ai][bj][m][n] = __builtin_amdgcn_mfma_f32_16x16x32_bf16(Bt[n][k], At[m][k], acc[ai][bj][m][n], 0, 0, 0); __builtin_amdgcn_s_setprio(0); } while (0)
#define PG8_WAIT_V(n) asm volatile("s_waitcnt vmcnt(" #n ")" ::: "memory")
#define PG8_WAIT_L(n) asm volatile("s_waitcnt lgkmcnt(" #n ")" ::: "memory")
#define PG8_BAR __builtin_amdgcn_s_barrier()
#define PG8_SCHED __builtin_amdgcn_sched_barrier(0)
    Unit cur, nxt; int ui = 0;
    if (!S.next(0, cur)) return;
    f32x4 acc[2][2][4][2];
#pragma unroll
    for (int a = 0; a < 2; ++a)
#pragma unroll
        for (int b = 0; b < 2; ++b)
#pragma unroll
            for (int m = 0; m < 4; ++m)
#pragma unroll
                for (int n = 0; n < 2; ++n) acc[a][b][m][n] = (f32x4){0.f, 0.f, 0.f, 0.f};
    bf16x8 At[4][2], B0[2][2], B1[2][2];
    const char* cA = (const char*)g.A + (size_t)cur.pm * tstepA + (size_t)cur.kb * K * 2; const char* cB = (const char*)g.Bt + (size_t)cur.pn * tstepB + (size_t)cur.kb * K * 2;
    S.a_ready(cur);
    if constexpr (Epi::HAS_PF) E.prefetch(cur, tid);
    if constexpr (SP2) {
        PG8_STAGE(PG8_SB(0, 0), cB, voffB); PG8_STAGE(PG8_SB(0, 1), cB + hstepB, voffB); PG8_STAGE(PG8_SA(0, 0), cA, voffA); PG8_STAGE(PG8_SA(0, 1), cA + hstepA, voffA);
        if (wr == 1) PG8_BAR;
        PG8_WAIT_V(2); PG8_BAR;
        PG8_STAGE(PG8_SB(1, 0), cB + kstep, voffB); PG8_STAGE(PG8_SA(1, 0), cA + kstep, voffA); PG8_STAGE(PG8_SB(1, 1), cB + hstepB + kstep, voffB);
        PG8_WAIT_V(6); PG8_BAR;
    } else {
        PG8_STAGE(PG8_SB(0, 0), cB, voffB); PG8_STAGE(PG8_SA(0, 0), cA, voffA); PG8_STAGE(PG8_SB(0, 1), cB + hstepB, voffB); PG8_STAGE(PG8_SA(0, 1), cA + hstepA, voffA);
        if (wr == 1) PG8_BAR;
        PG8_WAIT_V(4); PG8_BAR;
        PG8_STAGE(PG8_SB(1, 0), cB + kstep, voffB); PG8_STAGE(PG8_SA(1, 0), cA + kstep, voffA); PG8_STAGE(PG8_SB(1, 1), cB + hstepB + kstep, voffB);
        PG8_WAIT_V(6); PG8_BAR;
    }
    for (;;) {
        const bool has_next = S.next(ui + 1, nxt);
        const char* nA = has_next ? (const char*)g.A + (size_t)nxt.pm * tstepA + (size_t)nxt.kb * K * 2 : cA; const char* nB = has_next ? (const char*)g.Bt + (size_t)nxt.pn * tstepB + (size_t)nxt.kb * K * 2 : cB;
        for (int t = 0; t < nt; t += 2) {
            const bool last = (t == nt - 2);
            if constexpr (Epi::HAS_WARM) { if (t == nt - 8) E.warm(cur, wid, lane, lds + 141312); }
            const char* a1 = cA + (size_t)(t + 1) * kstep;
            const char* a2 = last ? nA : cA + (size_t)(t + 2) * kstep; const char* b2 = last ? nB : cB + (size_t)(t + 2) * kstep;
            const char* a3 = a2 + kstep; const char* b3 = b2 + kstep;
            if (last && has_next) S.a_ready(nxt);
            if constexpr (SP2) {
            PG8_LDB(B0, 0, 0); PG8_LDB(B1, 0, 1); PG8_SCHED; PG8_LDA(At, 0, 0); PG8_STAGE(PG8_SA(1, 1), a1 + hstepA, voffA);
            PG8_WAIT_V(8); PG8_WAIT_L(0); PG8_BAR; PG8_MMA(0, 0, At, B0); PG8_MMA(0, 1, At, B1); PG8_BAR; PG8_SCHED;
            PG8_LDA(At, 0, 1); PG8_STAGE(PG8_SB(0, 0), b2, voffB); PG8_STAGE(PG8_SB(0, 1), b2 + hstepB, voffB); PG8_STAGE(PG8_SA(0, 0), a2, voffA);
            PG8_WAIT_V(8); PG8_WAIT_L(0); PG8_BAR; PG8_MMA(1, 0, At, B0); PG8_MMA(1, 1, At, B1); PG8_BAR; PG8_SCHED;
            PG8_LDB(B0, 1, 0); PG8_LDB(B1, 1, 1); PG8_SCHED; PG8_LDA(At, 1, 0); PG8_STAGE(PG8_SA(0, 1), a2 + hstepA, voffA);
            PG8_WAIT_V(8); PG8_WAIT_L(0); PG8_BAR; PG8_MMA(0, 0, At, B0); PG8_MMA(0, 1, At, B1); PG8_BAR; PG8_SCHED;
            PG8_LDA(At, 1, 1); PG8_STAGE(PG8_SB(1, 0), b3, voffB); PG8_STAGE(PG8_SB(1, 1), b3 + hstepB, voffB); PG8_STAGE(PG8_SA(1, 0), a3, voffA);
            PG8_WAIT_V(8); PG8_WAIT_L(0); PG8_BAR; PG8_MMA(1, 0, At, B0); PG8_MMA(1, 1, At, B1); PG8_BAR; PG8_SCHED;
            } else {
            PG8_LDB(B0, 0, 0); PG8_SCHED; PG8_LDA(At, 0, 0); PG8_STAGE(PG8_SA(1, 1), a1 + hstepA, voffA);
            PG8_WAIT_L(8); PG8_BAR; PG8_WAIT_L(0); PG8_MMA(0, 0, At, B0); PG8_BAR; PG8_SCHED;
            PG8_LDB(B1, 0, 1); PG8_STAGE(PG8_SB(0, 0), b2, voffB);
            PG8_BAR; PG8_WAIT_L(0); PG8_MMA(0, 1, At, B1); PG8_BAR;
            PG8_LDA(At, 0, 1); PG8_STAGE(PG8_SA(0, 0), a2, voffA);
            PG8_BAR; PG8_WAIT_L(0); PG8_MMA(1, 0, At, B0); PG8_BAR; PG8_SCHED;
            PG8_STAGE(PG8_SB(0, 1), b2 + hstepB, voffB);
            PG8_WAIT_V(6); PG8_BAR; PG8_MMA(1, 1, At, B1); PG8_BAR;
            PG8_LDB(B0, 1, 0); PG8_SCHED; PG8_LDA(At, 1, 0); PG8_STAGE(PG8_SA(0, 1), a2 + hstepA, voffA);
            PG8_WAIT_L(8); PG8_BAR; PG8_WAIT_L(0); PG8_MMA(0, 0, At, B0); PG8_BAR; PG8_SCHED;
            PG8_LDB(B1, 1, 1); PG8_STAGE(PG8_SB(1, 0), b3, voffB);
            PG8_BAR; PG8_WAIT_L(0); PG8_MMA(0, 1, At, B1); PG8_BAR;
            PG8_LDA(At, 1, 1); PG8_STAGE(PG8_SA(1, 0), a3, voffA);
            PG8_BAR; PG8_WAIT_L(0); PG8_MMA(1, 0, At, B0); PG8_BAR; PG8_SCHED;
            PG8_STAGE(PG8_SB(1, 1), b3 + hstepB, voffB);
            PG8_WAIT_V(6); PG8_BAR; PG8_MMA(1, 1, At, B1); PG8_BAR;
            }
        }
        if constexpr (ALIGN_EPI) { if (wr == 0) PG8_BAR; }
        if constexpr (!Epi::AFTER_DRAIN) { E(acc, cur, wr, wc, fr, fq); S.done(cur); }
        if (!has_next) break;
#pragma unroll
        for (int a = 0; a < 2; ++a)
#pragma unroll
            for (int b = 0; b < 2; ++b)
#pragma unroll
                for (int m = 0; m < 4; ++m)
#pragma unroll
                    for (int n = 0; n < 2; ++n) acc[a][b][m][n] = (f32x4){0.f, 0.f, 0.f, 0.f};
        cur = nxt; cA = nA; cB = nB; ++ui;
        if constexpr (Epi::HAS_PF) E.prefetch(cur, tid);
        if constexpr (ALIGN_EPI) { if (wr == 1) PG8_BAR; }
    }
    PG8_WAIT_V(0);
    if constexpr (!ALIGN_EPI) { if (wr == 0) PG8_BAR; }
    PG8_BAR;
    if constexpr (Epi::AFTER_DRAIN) { E.fused(acc, cur, wr, wc, fr, fq, lds, wid, lane); S.done(cur); }
#undef PG8_SA
#undef PG8_SB
#undef PG8_STAGE
#undef PG8_LDA
#undef PG8_LDB
#undef PG8_MMA
#undef PG8_WAIT_V
#undef PG8_WAIT_L
#undef PG8_BAR
#undef PG8_SCHED
}
}
#define LAS __attribute__((address_space(3)))
typedef unsigned short bf16;
typedef float f32x4 __attribute__((ext_vector_type(4)));
typedef float f32x16 __attribute__((ext_vector_type(16)));
typedef short bf16x8 __attribute__((ext_vector_type(8)));
typedef short s16x4 __attribute__((ext_vector_type(4)));
typedef unsigned u32x4 __attribute__((ext_vector_type(4)));
typedef unsigned u32x2 __attribute__((ext_vector_type(2)));
typedef float f32x2_t __attribute__((ext_vector_type(2)));
typedef __bf16 bf16x2_t __attribute__((ext_vector_type(2)));

constexpr int D = 1024, MP = 65536, MS = 2048, M = MP + MS, DFF = 4096;
constexpr int LDP = 6144, NPROJ = 6176, NPROJ_PAD = 6400;
constexpr float ALPHA = 1.6817928305074290f, LN_EPS = 1e-5f, RMS_EPS = 1e-5f, LOG2E = 1.4426950408889634f;
constexpr size_t O_KP = 69206016, O_VP = 102760448, O_HP = 136314880, O_CP = 153092096, O_KS = 153878528, O_VS = 158072832, O_HS = 162267136, O_CS = 179044352;
constexpr size_t MiB = 1u << 20;
constexpr size_t WS_WA = 1 * MiB, WS_WB = 14 * MiB, WS_WUP = 18 * MiB, WS_WDN = 26 * MiB, WS_XB = 34 * MiB, WS_DT = 166 * MiB, WS_BIG = 175 * MiB;
constexpr size_t WS_O = WS_BIG + 396 * MiB, WS_CK = WS_BIG + 528 * MiB, WS_CV = WS_BIG + 560 * MiB, WS_END = WS_BIG + 792 * MiB;
constexpr size_t WS_AUX = WS_END, WS_ST0 = WS_AUX, WS_ST1 = WS_AUX + 2304 * 1024, WS_CSA = WS_AUX + 4608 * 1024, WS_BWA = WS_CSA + 32 * 1024, WS_CSU = WS_CSA + 64 * 1024, WS_BWU = WS_CSA + 80 * 1024, WS_MR0 = WS_AUX + 4736 * 1024, WS_MR1 = WS_AUX + 5312 * 1024, WS_WDN1 = WS_AUX + 6 * MiB, WS_END2 = WS_AUX + 14 * MiB;
constexpr float FXS = 1048576.f, FXI = 1.f / 1048576.f;
typedef long long i64x2_t __attribute__((ext_vector_type(2)));
constexpr int LDS_BYTES = 147456;

__device__ __forceinline__ unsigned pk2(float lo, float hi) { f32x2_t v = {lo, hi}; bf16x2_t b = __builtin_convertvector(v, bf16x2_t); return __builtin_bit_cast(unsigned, b); }
__device__ __forceinline__ float bf2f(unsigned short u) { return __uint_as_float((unsigned)u << 16); }
__device__ __forceinline__ float bflo(unsigned u) { return __uint_as_float(u << 16); }
__device__ __forceinline__ float bfhi(unsigned u) { return __uint_as_float(u & 0xffff0000u); }
__device__ __forceinline__ float fexp2(float x) { return __builtin_amdgcn_exp2f(x); }
__device__ __forceinline__ float frcp(float x) { return __builtin_amdgcn_rcpf(x); }
__device__ __forceinline__ float silu_f(float v) { return v * frcp(1.0f + fexp2(-v * LOG2E)); }
__device__ __forceinline__ int crow(int r, int hi) { return (r & 3) + 8 * (r >> 2) + 4 * hi; }
__device__ __forceinline__ bf16x8 pack8(const f32x16& x, int s) {
    u32x4 p; p.x = pk2(x[8 * s], x[8 * s + 1]); p.y = pk2(x[8 * s + 2], x[8 * s + 3]); p.z = pk2(x[8 * s + 4], x[8 * s + 5]); p.w = pk2(x[8 * s + 6], x[8 * s + 7]);
    return __builtin_bit_cast(bf16x8, p);
}
#define MFMA32(a, b, c) __builtin_amdgcn_mfma_f32_32x32x16_bf16((a), (b), (c), 0, 0, 0)
__device__ __forceinline__ float wave_sum(float v) {
#pragma unroll
    for (int o = 1; o < 64; o <<= 1) v += __shfl_xor(v, o);
    return v;
}

namespace pg8 {
struct RowNorm {
    const float* st; const float* cs; const float* bw; float* mr_out;
    PG8_LAS float* T;
    float mu[2][4], rs[2][4]; f32x4 c[2][2], b[2][2];
    __device__ __forceinline__ void load(const Unit& u, int wr, int wc, int fr, int fq, const f32x4 pfa, const f32x4 pfb) {
        if (!st) return;
        const int tid = (wr * 4 + wc) * 64 + fq * 16 + fr;
        if (tid < 256) { const float mean = ((pfa[0] + pfa[2]) + (pfb[0] + pfb[2])) * (1.f / 1024.f), var = ((pfa[1] + pfa[3]) + (pfb[1] + pfb[3])) * (1.f / 1024.f) - mean * mean;
            const f32x2_t mrv = {mean, 1.0f / sqrtf(var + LN_EPS)};
            *(PG8_LAS f32x2_t*)(T + 2 * tid) = mrv;
            if (mr_out && u.pn == 0) *(f32x2_t*)(mr_out + 2 * (unsigned)(u.pm * BM + tid)) = mrv; }
        PG8_LAS float* CB = T + 1024;
        if (tid >= 256 && tid < 320) { const int t4 = 4 * (tid - 256); const f32x4 cc = *(const f32x4*)(cs + u.pn * BM + t4), bb = *(const f32x4*)(bw + u.pn * BM + t4);
            *(PG8_LAS f32x4*)(CB + t4) = cc; *(PG8_LAS f32x4*)(CB + 256 + t4) = bb; }
        asm volatile("s_waitcnt lgkmcnt(0)" ::: "memory"); __builtin_amdgcn_s_barrier(); asm volatile("" ::: "memory");
        const int cl = wc * 32 + 8 * fq;
#pragma unroll
        for (int bj = 0; bj < 2; ++bj)
#pragma unroll
            for (int n = 0; n < 2; ++n) { c[bj][n] = *(const PG8_LAS f32x4*)(CB + cl + bj * HALF + 4 * n); b[bj][n] = *(const PG8_LAS f32x4*)(CB + 256 + cl + bj * HALF + 4 * n); }
#pragma unroll
        for (int ai = 0; ai < 2; ++ai)
#pragma unroll
            for (int m = 0; m < 4; ++m) { const f32x2_t v = *(const PG8_LAS f32x2_t*)(T + 2 * (ai * HALF + wr * 64 + m * 16 + fr)); mu[ai][m] = v.x; rs[ai][m] = v.y; }
    }
    __device__ __forceinline__ f32x4 apply(const f32x4 a, int ai, int m, int bj, int n) const { return st ? (a - c[bj][n] * mu[ai][m]) * rs[ai][m] + b[bj][n] : a; }
};
#define PG8_PF_MEMBERS mutable f32x4 pfa, pfb; static constexpr bool HAS_PF = true, HAS_WARM = false; \
    __device__ __forceinline__ void prefetch(const Unit& u, int tid) const { if (st && tid < 256) { const float* sp = st + 8 * (unsigned)(u.pm * BM + tid); pfa = *(const f32x4*)sp; pfb = *(const f32x4*)(sp + 4); } }
struct EpiQKV {
    static constexpr bool PERM = true, AFTER_DRAIN = false;
    bf16_t* QKV; float* out; int li; const float* st; const float* cs; const float* bw; float* mr_out; PG8_LAS float* T; PG8_PF_MEMBERS
    __device__ __forceinline__ void operator()(const f32x4 (&acc)[2][2][4][2], const Unit& u, int wr, int wc, int fr, int fq) const {
        asm volatile("" : "+v"(fr));
        RowNorm rn; rn.st = st; rn.cs = cs; rn.bw = bw; rn.mr_out = mr_out; rn.T = T; rn.load(u, wr, wc, fr, fq, pfa, pfb);
        float* fdst = nullptr;
        if (u.pn >= 4) {
            const bool isv = u.pn >= 8;
            if (u.pm < 256) { const int b = u.pm >> 3, tt = u.pm & 7; if (tt >= 6) fdst = out + (isv ? O_VP : O_KP) + ((size_t)(li * 32 + b) * 512 + (size_t)(tt - 6) * 256) * 1024; }
            else fdst = out + (isv ? O_VS : O_KS) + ((size_t)li * 2048 + (size_t)(u.pm - 256) * 256) * 1024;
        }
        const int col0 = u.pn * BM + wc * 32 + 8 * fq, colk = (u.pn & 3) * BM + wc * 32 + 8 * fq;
#pragma unroll
        for (int ai = 0; ai < 2; ++ai)
#pragma unroll
            for (int m = 0; m < 4; ++m) { const int rl = ai * HALF + wr * 64 + m * 16 + fr; bf16_t* rowp = QKV + (unsigned)((u.pm * BM + rl) * 3072 + col0);
#pragma unroll
                for (int bj = 0; bj < 2; ++bj) { const f32x4 v0 = rn.apply(acc[ai][bj][m][0], ai, m, bj, 0), v1 = rn.apply(acc[ai][bj][m][1], ai, m, bj, 1);
                    u32x4 w; w.x = pk2(v0[0], v0[1]); w.y = pk2(v0[2], v0[3]); w.z = pk2(v1[0], v1[1]); w.w = pk2(v1[2], v1[3]);
                    *(u32x4*)(rowp + bj * HALF) = w;
                    if (fdst) { float* fp = fdst + (unsigned)(rl * 1024 + colk + bj * HALF); *(f32x4*)fp = v0; *(f32x4*)(fp + 4) = v1; } }
                asm volatile("" ::: "memory"); }
    }
};
struct EpiBf16Plain {
    static constexpr bool PERM = true, AFTER_DRAIN = false;
    bf16_t* O; int ldc; int relu2; const float* st; const float* cs; const float* bw; float* mr_out; PG8_LAS float* T; PG8_PF_MEMBERS
    __device__ __forceinline__ void operator()(const f32x4 (&acc)[2][2][4][2], const Unit& u, int wr, int wc, int fr, int fq) const {
        asm volatile("" : "+v"(fr));
        RowNorm rn; rn.st = st; rn.cs = cs; rn.bw = bw; rn.mr_out = mr_out; rn.T = T; rn.load(u, wr, wc, fr, fq, pfa, pfb);
        const int col0 = u.pn * BM + wc * 32 + 8 * fq;
#pragma unroll
        for (int ai = 0; ai < 2; ++ai)
#pragma unroll
            for (int m = 0; m < 4; ++m) { const int rl = ai * HALF + wr * 64 + m * 16 + fr; bf16_t* rowp = O + (unsigned)((u.pm * BM + rl) * ldc + col0);
#pragma unroll
                for (int bj = 0; bj < 2; ++bj) { f32x4 v0 = rn.apply(acc[ai][bj][m][0], ai, m, bj, 0), v1 = rn.apply(acc[ai][bj][m][1], ai, m, bj, 1);
                    if (relu2) { v0 = __builtin_elementwise_max(v0, (f32x4){0.f, 0.f, 0.f, 0.f}); v1 = __builtin_elementwise_max(v1, (f32x4){0.f, 0.f, 0.f, 0.f}); v0 = v0 * v0; v1 = v1 * v1; }
                    u32x4 w; w.x = pk2(v0[0], v0[1]); w.y = pk2(v0[2], v0[3]); w.z = pk2(v1[0], v1[1]); w.w = pk2(v1[2], v1[3]);
                    *(u32x4*)(rowp + bj * HALF) = w; } }
    }
};
struct EpiSsmIn {
    static constexpr bool PERM = true, AFTER_DRAIN = false;
    bf16_t* P; float* DT; const float* st; const float* cs; const float* bw; float* mr_out; PG8_LAS float* T; PG8_PF_MEMBERS
    __device__ __forceinline__ void operator()(const f32x4 (&acc)[2][2][4][2], const Unit& u, int wr, int wc, int fr, int fq) const {
        asm volatile("" : "+v"(fr));
        RowNorm rn; rn.st = st; rn.cs = cs; rn.bw = bw; rn.mr_out = mr_out; rn.T = T; rn.load(u, wr, wc, fr, fq, pfa, pfb);
        if (u.pn < 24) {
            const int col0 = u.pn * BM + wc * 32 + 8 * fq;
#pragma unroll
            for (int ai = 0; ai < 2; ++ai)
#pragma unroll
                for (int m = 0; m < 4; ++m) { const int rl = ai * HALF + wr * 64 + m * 16 + fr; bf16_t* rowp = P + (unsigned)((u.pm * BM + rl) * LDP + col0);
#pragma unroll
                    for (int bj = 0; bj < 2; ++bj) { const f32x4 v0 = rn.apply(acc[ai][bj][m][0], ai, m, bj, 0), v1 = rn.apply(acc[ai][bj][m][1], ai, m, bj, 1);
                        u32x4 w; w.x = pk2(v0[0], v0[1]); w.y = pk2(v0[2], v0[3]); w.z = pk2(v1[0], v1[1]); w.w = pk2(v1[2], v1[3]);
                        *(u32x4*)(rowp + bj * HALF) = w; }
                    asm volatile("" ::: "memory"); }
        } else if (wc == 0) {
#pragma unroll
            for (int ai = 0; ai < 2; ++ai)
#pragma unroll
                for (int m = 0; m < 4; ++m) { const int rl = ai * HALF + wr * 64 + m * 16 + fr; float* fp = DT + (unsigned)((u.pm * BM + rl) * 32 + 8 * fq);
                    *(f32x4*)fp = rn.apply(acc[ai][0][m][0], ai, m, 0, 0); *(f32x4*)(fp + 4) = rn.apply(acc[ai][0][m][1], ai, m, 0, 1); }
        }
    }
};
struct SplitOrder { int G, c;
    __device__ __forceinline__ bool next(int i, Unit& u) const { const int L = i * G + c; if (L >= 256) return false; const int t = L >> 3; u.pm = 256 + (t >> 2); u.pn = t & 3; u.kb = L & 7; return true; }
    __device__ __forceinline__ void a_ready(const Unit&) const {}
    __device__ __forceinline__ void done(const Unit&) const {}
};
struct EpiPartial {
    static constexpr bool PERM = false, AFTER_DRAIN = false, HAS_PF = false, HAS_WARM = false;
    float* SP;
    __device__ __forceinline__ void operator()(const f32x4 (&acc)[2][2][4][2], const Unit& u, int wr, int wc, int fr, int fq) const {
        asm volatile("" : "+v"(fr));
        float* base = SP + (size_t)((((u.pm - 256) * 4 + u.pn) * 8 + u.kb)) * 65536 + (unsigned)((wr * 64 + fr) * 256 + wc * 32 + 4 * fq);
#pragma unroll
        for (int ai = 0; ai < 2; ++ai)
#pragma unroll
            for (int m = 0; m < 4; ++m) {
#pragma unroll
                for (int bj = 0; bj < 2; ++bj)
#pragma unroll
                    for (int n = 0; n < 2; ++n) *(f32x4*)(base + (unsigned)((ai * HALF + m * 16) * 256 + bj * HALF + n * 16)) = acc[ai][bj][m][n];
                asm volatile("" ::: "memory"); }
    }
};
struct EpiResid {
    static constexpr bool PERM = true, AFTER_DRAIN = false, HAS_PF = false, HAS_WARM = false;
    __device__ __forceinline__ void warm(const Unit& u, int wid, int lane, PG8_LAS unsigned char* dummy) const {
#pragma unroll
        for (int i = 0; i < 2; ++i) { const int line = wid * 128 + i * 64 + lane, row = line >> 2, seg = line & 3;
            const char* gp = (const char*)XB + ((size_t)(unsigned)((u.pm * BM + row) * D + u.pn * BM)) * 2 + seg * 128;
            __builtin_amdgcn_global_load_lds((const unsigned*)gp, (PG8_LAS unsigned*)(dummy + wid * 256), 4, 0, 0); }
    }
    bf16_t* XB; const float* st_in; const float* gin; const float* bin; float* st_out; PG8_LAS float* P;
    static constexpr int DEPTH = 1;
    __device__ __forceinline__ void operator()(const f32x4 (&acc)[2][2][4][2], const Unit& u, int wr, int wc, int fr, int fq) const {
        asm volatile("" : "+v"(fr));
        const int col0 = u.pn * BM + wc * 32 + 8 * fq;
        const unsigned rowb0 = (unsigned)(u.pm * BM + wr * 64 + fr);
        PG8_LAS float* GB = P + 3072;
        { const int tid_ = (wr * 4 + wc) * 64 + fq * 16 + fr;
          if (st_in && tid_ < 64) { const f32x4 gg = *(const f32x4*)(gin + u.pn * BM + 4 * tid_), bb = *(const f32x4*)(bin + u.pn * BM + 4 * tid_);
              *(PG8_LAS f32x4*)(GB + 4 * tid_) = gg; *(PG8_LAS f32x4*)(GB + 256 + 4 * tid_) = bb; } }
        if (st_in) { asm volatile("s_waitcnt lgkmcnt(0)" ::: "memory"); __builtin_amdgcn_s_barrier(); asm volatile("" ::: "memory"); }
        const int cl = wc * 32 + 8 * fq;
#pragma unroll
        for (int ai = 0; ai < 2; ++ai) {
            u32x4 xv[4][2]; f32x2_t mr[4];
#pragma unroll
            for (int m = 0; m < 4; ++m) { const unsigned row_ = rowb0 + (unsigned)(ai * HALF + m * 16); const bf16_t* rp_ = XB + row_ * D + col0;
                xv[m][0] = *(const u32x4*)rp_; xv[m][1] = *(const u32x4*)(rp_ + HALF);
                if (st_in) mr[m] = *(const f32x2_t*)(st_in + 2 * row_); else mr[m] = (f32x2_t){0.f, 1.f}; }
            asm volatile("" ::: "memory");
#pragma unroll
            for (int m = 0; m < 4; ++m) {
                const unsigned row = rowb0 + (unsigned)(ai * HALF + m * 16);
                bf16_t* rowb = XB + row * D + col0;
                float mean = 0.f, rstd = 1.f;
                if (st_in) { mean = mr[m].x; rstd = mr[m].y; }
                float s1 = 0.f, s2 = 0.f;
#pragma unroll
                for (int bj = 0; bj < 2; ++bj) {
                    const u32x4 xw = xv[m][bj];
                    f32x4 x0 = (f32x4){bflo(xw.x), bfhi(xw.x), bflo(xw.y), bfhi(xw.y)}, x1 = (f32x4){bflo(xw.z), bfhi(xw.z), bflo(xw.w), bfhi(xw.w)};
                    if (st_in) { int c_ = cl + bj * HALF; asm volatile("" : "+v"(c_));
                        const f32x4 g0 = *(const PG8_LAS f32x4*)(GB + c_), g1 = *(const PG8_LAS f32x4*)(GB + c_ + 4), b0 = *(const PG8_LAS f32x4*)(GB + 256 + c_), b1 = *(const PG8_LAS f32x4*)(GB + 256 + c_ + 4);
                        x0 = (x0 - mean) * rstd * g0 + b0; x1 = (x1 - mean) * rstd * g1 + b1; }
                    const f32x4 v0 = x0 * ALPHA + acc[ai][bj][m][0], v1 = x1 * ALPHA + acc[ai][bj][m][1];
                    u32x4 w; w.x = pk2(v0[0], v0[1]); w.y = pk2(v0[2], v0[3]); w.z = pk2(v1[0], v1[1]); w.w = pk2(v1[2], v1[3]); *(u32x4*)(rowb + bj * HALF) = w;
                    s1 += ((v0[0] + v0[1]) + (v0[2] + v0[3])) + ((v1[0] + v1[1]) + (v1[2] + v1[3]));
                    s2 += ((v0[0] * v0[0] + v0[1] * v0[1]) + (v0[2] * v0[2] + v0[3] * v0[3])) + ((v1[0] * v1[0] + v1[1] * v1[1]) + (v1[2] * v1[2] + v1[3] * v1[3])); }
                s1 += __shfl_xor(s1, 16); s2 += __shfl_xor(s2, 16); s1 += __shfl_xor(s1, 32); s2 += __shfl_xor(s2, 32);
                if (fq == 0) *(PG8_LAS f32x2_t*)(P + ((ai * HALF + wr * 64 + m * 16 + fr) * 4 + wc) * 2) = (f32x2_t){s1, s2};
            }
            asm volatile("" ::: "memory");
        }
        asm volatile("s_waitcnt lgkmcnt(0)" ::: "memory"); __builtin_amdgcn_s_barrier(); asm volatile("" ::: "memory");
        const int tid = (wr * 4 + wc) * 64 + fq * 16 + fr;
        if (tid < 256) { const f32x4 qa = *(const PG8_LAS f32x4*)(P + tid * 8), qb = *(const PG8_LAS f32x4*)(P + tid * 8 + 4);
            *(f32x2_t*)(st_out + 8 * (unsigned)(u.pm * BM + tid) + 2 * u.pn) = (f32x2_t){(qa[0] + qa[2]) + (qb[0] + qb[2]), (qa[1] + qa[3]) + (qb[1] + qb[3])}; }
    }
};
}
#define XB_TMO      128
#define XB_XCNT(j)  (256  + 64 * (j))
#define XB_XSUB(j)  (1280 + 64 * (j))
#define XB_XGEN(j)  (2304 + 64 * (j))
#define XB_TOP      3328
#define XB_TOPGEN   3392
#define XCD_BAR_WORDS 3456
#define XB_SPIN_CAP (1u << 18)

__device__ __forceinline__ unsigned xb_ld(unsigned* p)              { return __hip_atomic_load(p, __ATOMIC_RELAXED, __HIP_MEMORY_SCOPE_AGENT); }
__device__ __forceinline__ unsigned xb_add(unsigned* p, unsigned v) { return __hip_atomic_fetch_add(p, v, __ATOMIC_RELAXED, __HIP_MEMORY_SCOPE_AGENT); }
__device__ __forceinline__ unsigned xb_xcc_id() { return (unsigned)__builtin_amdgcn_s_getreg((3 << 11) | 20) & 0xFu; }
#define XB_SPIN(cond, bar) do { unsigned _sp = 0; while (cond) { __builtin_amdgcn_s_sleep(1); \
    if ((++_sp & 255u) == 0u) { if (xb_ld(&(bar)[XB_TMO])) break; if (_sp > XB_SPIN_CAP) { atomicAdd(&(bar)[XB_TMO], 1u); break; } } } } while (0)

struct XcdBarrier {
    int w0;
    unsigned* bar; unsigned x;
    volatile LAS unsigned* st;
};

__device__ __forceinline__ XcdBarrier xcd_barrier_post(unsigned* bar, volatile LAS unsigned* st) {
    XcdBarrier b; b.bar = bar; b.x = xb_xcc_id(); b.st = st;
    if (threadIdx.x == 0) (void)xb_add(&bar[XB_XCNT(b.x)], 1u);
    return b;
}
__device__ __forceinline__ void xcd_barrier_complete(unsigned* bar, unsigned x, unsigned& nloc, unsigned& nx) {
    const unsigned G = gridDim.x * gridDim.y * gridDim.z;
    unsigned sum, cnt, mine, sp = 0u;
    for (;;) {
        sum = 0u; cnt = 0u; mine = 0u;
#pragma unroll
        for (unsigned j = 0; j < 16; ++j) { const unsigned c = xb_ld(&bar[XB_XCNT(j)]); sum += c; cnt += (c > 0u) ? 1u : 0u; mine = (j == x) ? c : mine; }
        if (sum == G) break;
        __builtin_amdgcn_s_sleep(1);
        if ((++sp & 255u) == 0u) { if (xb_ld(&bar[XB_TMO])) break; if (sp > XB_SPIN_CAP) { atomicAdd(&bar[XB_TMO], 1u); break; } }
    }
    nloc = mine > 0u ? mine : 1u; nx = cnt > 0u ? cnt : 1u;
}

__device__ __forceinline__ void xcd_barrier(const XcdBarrier& b) {
    asm volatile("s_waitcnt vmcnt(0)" ::: "memory");
    __syncthreads();
    if (b.w0 == 0 && lane_id_() == 0) {
        unsigned* bar = b.bar;
        __builtin_amdgcn_s_waitcnt(0);
        unsigned nloc = b.st[0], nx = b.st[1];
        if (nloc == 0u) { xcd_barrier_complete(bar, b.x, nloc, nx); b.st[0] = nloc; b.st[1] = nx; }
        const unsigned old = xb_add(&bar[XB_XSUB(b.x)], 1u);
        const unsigned gen = old / nloc;
        if (old + 1u == (gen + 1u) * nloc) {
            __builtin_amdgcn_fence(__ATOMIC_RELEASE, "agent");
            asm volatile("s_waitcnt vmcnt(0)" ::: "memory");
            const unsigned og = xb_add(&bar[XB_TOP], 1u);
            const unsigned tg = og / nx;
            if (og + 1u == (tg + 1u) * nx) xb_add(&bar[XB_TOPGEN], 1u);
            else XB_SPIN(xb_ld(&bar[XB_TOPGEN]) == tg, bar);
            __builtin_amdgcn_fence(__ATOMIC_ACQUIRE, "agent");
            xb_add(&bar[XB_XGEN(b.x)], 1u);
            asm volatile("s_waitcnt vmcnt(0)" ::: "memory");
        } else {
            XB_SPIN(xb_ld(&bar[XB_XGEN(b.x)]) == gen, bar);
            __builtin_amdgcn_fence(__ATOMIC_ACQUIRE, "agent");
            asm volatile("s_waitcnt vmcnt(0)" ::: "memory");
        }
    }
    __syncthreads();
}

struct Args { const float* in[25]; int ph_lo, ph_hi; };
#define AIN(k) (a.in[(k) + z])
struct Frame { unsigned char* lds; int tid, lane, wave, G, bid; };

__device__ __forceinline__ void transpose_item(const float* W, int K, int N, bf16* WT, float* scr, int item, int lane) {
    const int nblk = N / 32, kb = item / nblk, nb = item % nblk, k0 = 64 * kb, n0 = 32 * nb;
    {
        float tv[32]; const float* wp = W + (size_t)(k0 + (lane >> 5)) * N + n0 + (lane & 31);
#pragma unroll
        for (int i = 0; i < 32; ++i) tv[i] = wp[(size_t)(2 * i) * N];
        asm volatile("" ::: "memory");
#pragma unroll
        for (int i = 0; i < 32; ++i) scr[(2 * i + (lane >> 5)) * 33 + (lane & 31)] = tv[i];
    }
    asm volatile("s_waitcnt lgkmcnt(0)" ::: "memory");
    const int c = lane & 7;
#pragma unroll
    for (int j = 0; j < 4; ++j) { const int n = (lane >> 3) + 8 * j; const float* s = scr + (8 * c) * 33 + n;
        u32x4 o; o.x = pk2(s[0 * 33], s[1 * 33]); o.y = pk2(s[2 * 33], s[3 * 33]); o.z = pk2(s[4 * 33], s[5 * 33]); o.w = pk2(s[6 * 33], s[7 * 33]);
        *(u32x4*)(WT + (size_t)(n0 + n) * K + k0 + 8 * c) = o; }
    asm volatile("s_waitcnt lgkmcnt(0)" ::: "memory");
}
__device__ __forceinline__ void transpose_fold_item(const float* W, int K, int N, bf16* WT, const float* g, const float* b, float* cs, float* bw, float* scr, int nb, int lane) {
    const int n0 = 32 * nb; float csp = 0.f, bwp = 0.f;
    for (int k0 = 0; k0 < K; k0 += 64) {
        {
            float tv[32], tg[32], tb[32]; const float* wp = W + (size_t)(k0 + (lane >> 5)) * N + n0 + (lane & 31);
#pragma unroll
            for (int i = 0; i < 32; ++i) { tv[i] = wp[(size_t)(2 * i) * N]; tg[i] = g[k0 + 2 * i + (lane >> 5)]; tb[i] = b[k0 + 2 * i + (lane >> 5)]; }
            asm volatile("" ::: "memory");
#pragma unroll
            for (int i = 0; i < 32; ++i) { const float wg = tv[i] * tg[i]; const float wr = bflo(pk2(wg, 0.f) & 0xffffu); scr[(2 * i + (lane >> 5)) * 33 + (lane & 31)] = wr; csp += wr; bwp += tv[i] * tb[i]; }
        }
        asm volatile("s_waitcnt lgkmcnt(0)" ::: "memory");
        const int c = lane & 7;
#pragma unroll
        for (int j = 0; j < 4; ++j) { const int n = (lane >> 3) + 8 * j; const float* s = scr + (8 * c) * 33 + n;
            u32x4 o; o.x = pk2(s[0 * 33], s[1 * 33]); o.y = pk2(s[2 * 33], s[3 * 33]); o.z = pk2(s[4 * 33], s[5 * 33]); o.w = pk2(s[6 * 33], s[7 * 33]);
            *(u32x4*)(WT + (size_t)(n0 + n) * K + k0 + 8 * c) = o; }
        asm volatile("s_waitcnt lgkmcnt(0)" ::: "memory");
    }
    csp += __shfl_xor(csp, 32); bwp += __shfl_xor(bwp, 32);
    if (lane < 32) { cs[n0 + lane] = csp; bw[n0 + lane] = bwp; }
}
__device__ __forceinline__ void cvt_stream(const float* src, bf16* dst, size_t n, size_t gtid, size_t gthreads) {
    const size_t step = gthreads * 8; size_t i = gtid * 8;
    for (; i + 3 * step < n; i += 4 * step) {
        f32x4 a[4], b[4];
#pragma unroll
        for (int j = 0; j < 4; ++j) { a[j] = *(const f32x4*)(src + i + j * step); b[j] = *(const f32x4*)(src + i + j * step + 4); }
        asm volatile("" ::: "memory");
#pragma unroll
        for (int j = 0; j < 4; ++j) { u32x4 o; o.x = pk2(a[j][0], a[j][1]); o.y = pk2(a[j][2], a[j][3]); o.z = pk2(b[j][0], b[j][1]); o.w = pk2(b[j][2], b[j][3]); *(u32x4*)(dst + i + j * step) = o; }
    }
    for (; i < n; i += step) { const f32x4 a = *(const f32x4*)(src + i), b = *(const f32x4*)(src + i + 4);
        u32x4 o; o.x = pk2(a[0], a[1]); o.y = pk2(a[2], a[3]); o.z = pk2(b[0], b[1]); o.w = pk2(b[2], b[3]); *(u32x4*)(dst + i) = o; }
}
__device__ __forceinline__ void convert_phase(const Frame& F, const Args& a, int z, int L) {
    unsigned char* ws = (unsigned char*)AIN(24); float* outp = (float*)AIN(23); const int li = L >> 1; const bool ssm = (L & 1);
    float* scr = (float*)(F.lds + F.wave * 16384);
    const int gw = F.bid * 8 + F.wave, NGW = F.G * 8;
    const float* Wa = ssm ? AIN(9) + (size_t)li * D * NPROJ : AIN(6) + (size_t)li * D * 3072; const int Na = ssm ? NPROJ : 3072;
    const float* Wb = ssm ? AIN(16) + (size_t)li * 2048 * D : AIN(8) + (size_t)li * D * D; const int Kb = ssm ? 2048 : D;
    const float* Wu = AIN(19) + (size_t)L * D * DFF; const float* Wd = AIN(20) + (size_t)L * DFF * D;
    const bool foldA = (L > 0);
    const float* gA = AIN(21) + (L - 1) * D; const float* bA = AIN(22) + (L - 1) * D;
    const float* gU = AIN(17) + L * D; const float* bU = AIN(18) + L * D;
    const int Ia = foldA ? Na / 32 : (D / 64) * (Na / 32), Ib = (Kb / 64) * (D / 32), Iu = DFF / 32, Id = (DFF / 64) * (D / 32);
    const int NIT = Ia + Ib + Iu + Id;
    for (int it = gw; it < NIT; it += NGW) {
        int r = it;
        if (r < Iu) { transpose_fold_item(Wu, D, DFF, (bf16*)(ws + WS_WUP), gU, bU, (float*)(ws + WS_CSU), (float*)(ws + WS_BWU), scr, r, F.lane); continue; } r -= Iu;
        if (r < Ia) { if (foldA) transpose_fold_item(Wa, D, Na, (bf16*)(ws + WS_WA), gA, bA, (float*)(ws + WS_CSA), (float*)(ws + WS_BWA), scr, r, F.lane);
                      else transpose_item(Wa, D, Na, (bf16*)(ws + WS_WA), scr, r, F.lane); continue; } r -= Ia;
        if (r < Ib) { transpose_item(Wb, Kb, D, (bf16*)(ws + WS_WB), scr, r, F.lane); continue; } r -= Ib;
        transpose_item(Wd, DFF, D, (bf16*)(ws + WS_WDN), scr, r, F.lane);
    }
    const size_t gtid = (size_t)F.bid * 512 + F.tid, gth = (size_t)F.G * 512;
    if (!ssm) {
        cvt_stream(AIN(2) + (size_t)li * 32 * 512 * 1024, (bf16*)(ws + WS_CK), (size_t)32 * 512 * 1024, gtid, gth);
        cvt_stream(AIN(3) + (size_t)li * 32 * 512 * 1024, (bf16*)(ws + WS_CV), (size_t)32 * 512 * 1024, gtid, gth);
    }
    if (L == 0) {
        const size_t n = (size_t)M * D, np = (size_t)MP * D;
        bf16* XB = (bf16*)(ws + WS_XB);
        cvt_stream(AIN(0), XB, np, gtid, gth); cvt_stream(AIN(1), XB + np, n - np, gtid, gth);
    }
}
__device__ __forceinline__ void ln_phase(const Frame& F, float* X, const bf16* XB, const float* g, const float* b) {
    const int gw = F.bid * 8 + F.wave, NGW = F.G * 8;
    f32x4 gv[4], bv[4];
#pragma unroll
    for (int j = 0; j < 4; ++j) { gv[j] = *(const f32x4*)(g + 4 * F.lane + 256 * j); bv[j] = *(const f32x4*)(b + 4 * F.lane + 256 * j); }
    auto ln_row = [&](const int m, const u32x2 (&w)[4]) __attribute__((always_inline)) {
        f32x4* xr = (f32x4*)(X + (size_t)m * D) + F.lane;
        f32x4 v[4]; float s = 0.f;
#pragma unroll
        for (int j = 0; j < 4; ++j) { v[j] = (f32x4){bflo(w[j].x), bfhi(w[j].x), bflo(w[j].y), bfhi(w[j].y)}; s += (v[j][0] + v[j][1]) + (v[j][2] + v[j][3]); }
        const float mean = wave_sum(s) * (1.f / D); float s2 = 0.f;
#pragma unroll
        for (int j = 0; j < 4; ++j) { v[j] = v[j] - mean; s2 += (v[j][0] * v[j][0] + v[j][1] * v[j][1]) + (v[j][2] * v[j][2] + v[j][3] * v[j][3]); }
        const float rstd = 1.f / sqrtf(wave_sum(s2) * (1.f / D) + LN_EPS);
#pragma unroll
        for (int j = 0; j < 4; ++j) xr[64 * j] = v[j] * rstd * gv[j] + bv[j];
    };
    int m = gw;
    for (; m + NGW < M; m += 2 * NGW) {
        u32x2 w0[4], w1[4]; const u32x2* xb0 = (const u32x2*)(XB + (size_t)m * D) + F.lane; const u32x2* xb1 = (const u32x2*)(XB + (size_t)(m + NGW) * D) + F.lane;
#pragma unroll
        for (int j = 0; j < 4; ++j) { w0[j] = xb0[64 * j]; w1[j] = xb1[64 * j]; }
        asm volatile("" ::: "memory");
        ln_row(m, w0); ln_row(m + NGW, w1);
    }
    for (; m < M; m += NGW) { u32x2 w0[4]; const u32x2* xb0 = (const u32x2*)(XB + (size_t)m * D) + F.lane;
#pragma unroll
        for (int j = 0; j < 4; ++j) w0[j] = xb0[64 * j];
        ln_row(m, w0); }
}

__device__ __forceinline__ void attn_phase(const Frame& F, const float* relb, const bf16* QKV, const bf16* CK, const bf16* CV, bf16* O) {
    float* tbl = (float*)F.lds;
    { float tv[17];
#pragma unroll
      for (int j = 0; j < 17; ++j) { const int i = F.tid + 512 * j; tv[j] = relb[i < 16 * 513 ? i : 0]; }
      asm volatile("" ::: "memory");
#pragma unroll
      for (int j = 0; j < 17; ++j) { const int i = F.tid + 512 * j; if (i < 16 * 513) tbl[i] = tv[j] * LOG2E; } }
    __syncthreads();
    LAS unsigned char* const vtl = (LAS unsigned char*)F.lds + 32896 + F.wave * 9216;
    LAS unsigned char* const qtl = (LAS unsigned char*)F.lds + 106624 + F.wave * 4608;
    const int lane = F.lane, l31 = lane & 31, hh = lane >> 5;
    const int i16 = lane & 15, q4 = i16 >> 2, p4 = i16 & 3, dblk = (lane >> 4) & 1;
    const int gw = F.bid * 8 + F.wave, NGW = F.G * 8;
    constexpr int NITEM = (32 * 32 + 32) * 32;
    constexpr float C2 = 0.125f * LOG2E;
    const int xw = (F.bid >> 3) * 8 + F.wave, xn = (F.G >> 3) * 8, xcd = F.bid & 7;
    for (int jt = xw; jt < NITEM / 8; jt += xn) {
        int lq_ = lane; asm volatile("" : "+v"(lq_));
        LAS unsigned char* const wbase = vtl + (((lq_ >> 3) * 72 + 8 * (lq_ & 7)) * 2);
        LAS unsigned char* const fbase = vtl + (((lq_ & 31) * 72 + 8 * (lq_ >> 5)) * 2);
        LAS unsigned char* const qbase = qtl + (((lq_ & 31) * 72 + 8 * (lq_ >> 5)) * 2);
        LAS unsigned char* const tbase = vtl + (((4 * (lq_ >> 5) + ((lq_ & 15) >> 2)) * 72 + 16 * ((lq_ >> 4) & 1) + 4 * (lq_ & 3)) * 2);
        const bool smp = jt >= 4096; const int r0 = smp ? jt - 4096 : jt;
        const int r = smp ? r0 : (r0 & ~255) | ((r0 + 10 * (r0 >> 8)) & 255);
        const int qh = r & 1, c = smp ? 0 : (r >> 1) & 31, h = smp ? (r >> 1) & 15 : (r >> 6) & 15, b = xcd + 8 * (smp ? (r >> 5) : (r >> 10));
        const size_t qrow0 = smp ? (size_t)MP + b * 64 + 32 * qh : (size_t)b * 2048 + 64 * c + 32 * qh;
        { bf16x8 qr[4];
#pragma unroll
          for (int i = 0; i < 4; ++i) qr[i] = *(const bf16x8*)(QKV + (qrow0 + 8 * i + (lane >> 3)) * 3072 + h * 64 + 8 * (lane & 7));
#pragma unroll
          for (int i = 0; i < 4; ++i) *(LAS bf16x8*)(qtl + ((8 * i + (lane >> 3)) * 72 + 8 * (lane & 7)) * 2) = qr[i]; }
        asm volatile("" ::: "memory");
        f32x16 o0, o1;
#pragma unroll
        for (int i = 0; i < 16; ++i) { o0[i] = 0.f; o1[i] = 0.f; }
        float mrun = -1e30f, lsum = 0.f;
        const float* tb = tbl + h * 513;
        const int jb0 = smp ? 0 : (c >= 8 ? 0 : 8 - c);
        bf16x8 kr[8], vr[8];
        { const bf16 *K0, *V0; int p0;
          if (!smp) { K0 = QKV + ((size_t)b * 2048 + 64 * (c - 8 + jb0)) * 3072 + 1024 + h * 64; V0 = K0 + 1024; p0 = 3072; }
          else { K0 = CK + ((size_t)b * 512) * 1024 + h * 64; V0 = CV + ((size_t)b * 512) * 1024 + h * 64; p0 = 1024; }
          const unsigned vo_ = ((unsigned)(lane >> 3) * (unsigned)p0 + 8u * (unsigned)(lane & 7)) * 2u;
#pragma unroll
          for (int i = 0; i < 8; ++i) { const unsigned o_ = vo_ + (unsigned)i * 16u * (unsigned)p0; kr[i] = *(const bf16x8*)((const char*)K0 + o_); vr[i] = *(const bf16x8*)((const char*)V0 + o_); } }
        for (int jb = jb0; jb <= 8; ++jb) {
            const bf16 *Kp, *Vp; int pitch;
            if (!smp) { Kp = QKV + ((size_t)b * 2048 + 64 * (c - 8 + jb)) * 3072 + 1024 + h * 64; Vp = Kp + 1024; pitch = 3072; }
            else if (jb < 8) { Kp = CK + ((size_t)b * 512 + 64 * jb) * 1024 + h * 64; Vp = CV + ((size_t)b * 512 + 64 * jb) * 1024 + h * 64; pitch = 1024; }
            else { Kp = QKV + ((size_t)MP + b * 64) * 3072 + 1024 + h * 64; Vp = Kp + 1024; pitch = 3072; }
            bf16x8 kf[2][4];
            asm volatile("" ::: "memory");
#pragma unroll
            for (int i = 0; i < 8; ++i) *(LAS bf16x8*)(wbase + i * 1152) = kr[i];
            asm volatile("" ::: "memory");
#pragma unroll
            for (int rb = 0; rb < 2; ++rb)
#pragma unroll
                for (int ks = 0; ks < 4; ++ks) kf[rb][ks] = *(const LAS bf16x8*)(fbase + rb * 4608 + ks * 32);
            asm volatile("" ::: "memory");
#pragma unroll
            for (int i = 0; i < 8; ++i) *(LAS bf16x8*)(wbase + i * 1152) = vr[i];
            asm volatile("" ::: "memory");
            if (jb < 8) { const bf16 *Kn, *Vn; int pn_;
                if (!smp) { Kn = Kp + (size_t)64 * 3072; Vn = Vp + (size_t)64 * 3072; pn_ = 3072; }
                else if (jb < 7) { Kn = Kp + (size_t)64 * 1024; Vn = Vp + (size_t)64 * 1024; pn_ = 1024; }
                else { Kn = QKV + ((size_t)MP + b * 64) * 3072 + 1024 + h * 64; Vn = Kn + 1024; pn_ = 3072; }
                const unsigned vo_ = ((unsigned)(lane >> 3) * (unsigned)pn_ + 8u * (unsigned)(lane & 7)) * 2u;
#pragma unroll
                for (int i = 0; i < 8; ++i) { const unsigned o_ = vo_ + (unsigned)i * 16u * (unsigned)pn_; kr[i] = *(const bf16x8*)((const char*)Kn + o_); vr[i] = *(const bf16x8*)((const char*)Vn + o_); } }
            f32x16 s0, s1;
#pragma unroll
            for (int i = 0; i < 16; ++i) { s0[i] = 0.f; s1[i] = 0.f; }
#pragma unroll
            for (int ks = 0; ks < 4; ++ks) { const bf16x8 qf = *(const LAS bf16x8*)(qbase + ks * 32); s0 = MFMA32(kf[0][ks], qf, s0); s1 = MFMA32(kf[1][ks], qf, s1); }
            if (jb <= 3) {
                const float cbias = tb[512];
#pragma unroll
                for (int i = 0; i < 16; ++i) { s0[i] = s0[i] * C2 + cbias; s1[i] = s1[i] * C2 + cbias; }
            } else if (jb == 4) {
                const int dbase = 64 * (8 - jb) + 32 * qh + l31 + 256;
#pragma unroll
                for (int i = 0; i < 16; ++i) { const int k0 = crow(i, hh); int i0 = dbase - k0; i0 = i0 > 512 ? 512 : i0; s0[i] = s0[i] * C2 + tb[i0]; }
                asm volatile("" ::: "memory");
#pragma unroll
                for (int i = 0; i < 16; ++i) { const int k0 = crow(i, hh); int i1 = dbase - k0 - 32; i1 = i1 > 512 ? 512 : i1; s1[i] = s1[i] * C2 + tb[i1]; }
            } else {
                const float* pb = tb + (64 * (8 - jb) + 32 * qh + l31 + 256 - 4 * hh - 59);
#pragma unroll
                for (int i = 0; i < 16; ++i) { const int ci = (i & 3) + 8 * (i >> 2); s0[i] = s0[i] * C2 + pb[59 - ci]; }
                asm volatile("" ::: "memory");
#pragma unroll
                for (int i = 0; i < 16; ++i) { const int ci = (i & 3) + 8 * (i >> 2); s1[i] = s1[i] * C2 + pb[27 - ci]; }
            }
            float mx = s0[0];
#pragma unroll
            for (int i = 1; i < 16; ++i) mx = fmaxf(mx, s0[i]);
#pragma unroll
            for (int i = 0; i < 16; ++i) mx = fmaxf(mx, s1[i]);
            mx = fmaxf(mx, __shfl_xor(mx, 32));
            const float mnew = fmaxf(mrun, mx), alpha = fexp2(mrun - mnew);
            mrun = mnew;
            float ps = 0.f;
#pragma unroll
            for (int i = 0; i < 16; ++i) { s0[i] = fexp2(s0[i] - mnew); s1[i] = fexp2(s1[i] - mnew); ps += s0[i] + s1[i]; }
            lsum = lsum * alpha + ps;
#pragma unroll
            for (int i = 0; i < 16; ++i) { o0[i] *= alpha; o1[i] *= alpha; }
#pragma unroll
            for (int rb = 0; rb < 2; ++rb)
#pragma unroll
                for (int s2 = 0; s2 < 2; ++s2) {
                    const bf16x8 pf = pack8(rb ? s1 : s0, s2);
#pragma unroll
                    for (int db = 0; db < 2; ++db) {
                        const s16x4 lo = __builtin_amdgcn_ds_read_tr16_b64_v4i16((LAS s16x4*)(tbase + (32 * rb + 16 * s2) * 144 + db * 64));
                        const s16x4 hi = __builtin_amdgcn_ds_read_tr16_b64_v4i16((LAS s16x4*)(tbase + (32 * rb + 16 * s2 + 8) * 144 + db * 64));
                        const bf16x8 va = __builtin_shufflevector(lo, hi, 0, 1, 2, 3, 4, 5, 6, 7);
                        if (db == 0) o0 = MFMA32(va, pf, o0); else o1 = MFMA32(va, pf, o1);
                    }
                }
            asm volatile("" ::: "memory");
        }
        const float inv = 1.0f / (lsum + __shfl_xor(lsum, 32));
        bf16* orow = O + (qrow0 + l31) * D + h * 64 + 4 * hh;
#pragma unroll
        for (int i4 = 0; i4 < 4; ++i4) {
            u32x2 w0; w0.x = pk2(o0[4 * i4] * inv, o0[4 * i4 + 1] * inv); w0.y = pk2(o0[4 * i4 + 2] * inv, o0[4 * i4 + 3] * inv); *(u32x2*)(orow + 8 * i4) = w0;
            u32x2 w1; w1.x = pk2(o1[4 * i4] * inv, o1[4 * i4 + 1] * inv); w1.y = pk2(o1[4 * i4 + 2] * inv, o1[4 * i4 + 3] * inv); *(u32x2*)(orow + 32 + 8 * i4) = w1;
        }
    }
}
constexpr int SX_XT = 0, SX_XWT = 36864, SX_BT = 73728, SX_BS = 92160, SX_CS = 109568, SX_DT = 126976, SX_CUM = SX_DT + 1024, SX_WIN = SX_DT + 2048, SX_PART = SX_DT + 3072;
__device__ __forceinline__ void ssd_phase(const Frame& F, const Args& a, int z, int li, bf16* PROJ, const float* DT, bf16* dryXB) {
    float* outp = (float*)AIN(23);
    unsigned char* lds = F.lds;
    bf16* Xt = (bf16*)(lds + SX_XT); bf16* Xwt = (bf16*)(lds + SX_XWT); bf16* Bt = (bf16*)(lds + SX_BT); bf16* Bs = (bf16*)(lds + SX_BS); bf16* Cs = (bf16*)(lds + SX_CS);
    float* dts = (float*)(lds + SX_DT); float* cums = (float*)(lds + SX_CUM); float* wins = (float*)(lds + SX_WIN); float* part = (float*)(lds + SX_PART);
    const int tid = F.tid, lane = F.lane, wave = F.wave, l31 = lane & 31, hh = lane >> 5;
    const int r = wave >> 1, half = wave & 1;
    const float* conv_w = AIN(10) + (size_t)li * 4 * 4096; const float* conv_b = AIN(11) + (size_t)li * 4096;
    const float* dt_bias = AIN(12) + li * 32; const float* a_log = AIN(13) + li * 32; const float* d_skip = AIN(14) + li * 32; const float* norm_w = AIN(15) + (size_t)li * 2048;
    for (int item = F.bid; item < 512; item += F.G) {
        const bool smp = item >= 256; const int bg = item & 255, b = bg >> 3, g = bg & 7;
        const size_t row0 = smp ? (size_t)MP + b * 64 : (size_t)b * 2048; const int nchunks = smp ? 1 : 32;
        const int hglob = g * 4 + r;
        const float Dr = d_skip[hglob];
        f32x16 hT[4];
        const size_t hoff = (((size_t)(li * 32 + b) * 32 + hglob) * 64 + 32 * half + l31) * 128 + 4 * hh;
        if (smp) { const float* hs = AIN(4) + hoff;
            f32x4 hv[16];
#pragma unroll
            for (int q = 0; q < 16; ++q) hv[q] = *(const f32x4*)(hs + 32 * (q >> 2) + 8 * (q & 3));
            asm volatile("" ::: "memory");
#pragma unroll
            for (int nb = 0; nb < 4; ++nb)
#pragma unroll
                for (int i4 = 0; i4 < 4; ++i4) { const f32x4 v = hv[4 * nb + i4]; hT[nb][4 * i4] = v[0]; hT[nb][4 * i4 + 1] = v[1]; hT[nb][4 * i4 + 2] = v[2]; hT[nb][4 * i4 + 3] = v[3]; }
        } else {
#pragma unroll
            for (int nb = 0; nb < 4; ++nb)
#pragma unroll
                for (int i = 0; i < 16; ++i) hT[nb][i] = 0.f;
        }
        float dt_pf = (tid < 256) ? DT[(row0 + lane) * 32 + g * 4 + wave] : 0.f;
        const float dtb_i = dt_bias[g * 4 + (wave & 3)], am_i = -__expf(a_log[g * 4 + (wave & 3)]) * LOG2E;
#pragma unroll 1
        for (int c = 0; c < nchunks; ++c) {
            const size_t rowc = row0 + 64 * c;
            int lane_ = F.lane; asm volatile("" : "+v"(lane_));
            const int lane = lane_, l31 = lane & 31, hh = lane >> 5, tid = wave * 64 + lane;
            const int role = lane < 32 ? 0 : (lane < 48 ? 1 : 2);
            const int chbase = role == 0 ? g * 256 + 8 * lane : (role == 1 ? 2048 + g * 128 + 8 * (lane - 32) : 3072 + g * 128 + 8 * (lane - 48));
            if (tid < 256) {
                const int hr = g * 4 + wave;
                const float raw = dt_pf + dtb_i;
                const float dt = raw > 20.f ? raw : log1pf(__expf(raw));
                const float am = am_i;
                float v = dt * am;
#pragma unroll
                for (int o = 1; o < 64; o <<= 1) { const float n = __shfl_up(v, o); if (lane >= o) v += n; }
                const float last = __shfl(v, 63);
                dts[wave * 64 + lane] = dt; cums[wave * 64 + lane] = v; wins[wave * 64 + lane] = fexp2(last - v) * dt;
            }
            __syncthreads();
            {
                const bf16* src = PROJ + 2048 + chbase;
                u32x4 raw[11];
#pragma unroll
                for (int i = 0; i < 11; ++i) {
                    const int rr = 8 * wave - 3 + i;
                    if (rr >= 0 || c > 0) raw[i] = *(const u32x4*)(src + (size_t)((long)rowc + rr) * LDP);
                    else if (!smp) raw[i] = (u32x4){0u, 0u, 0u, 0u};
                    else { const float* sc = AIN(5) + ((size_t)(li * 32 + b) * 3 + (3 + rr)) * 4096 + chbase; const f32x4 s0 = *(const f32x4*)sc, s1 = *(const f32x4*)(sc + 4);
                        raw[i] = (u32x4){pk2(s0[0], s0[1]), pk2(s0[2], s0[3]), pk2(s1[0], s1[1]), pk2(s1[2], s1[3])}; }
                }
                if (c == nchunks - 1 && wave == 7) {
                    float* co = outp + (smp ? O_CS : O_CP) + ((size_t)(li * 32 + b) * 3) * 4096 + chbase;
#pragma unroll
                    for (int k = 0; k < 3; ++k) { const u32x4 rw = raw[8 + k];
                        *(f32x4*)(co + k * 4096) = (f32x4){bflo(rw.x), bfhi(rw.x), bflo(rw.y), bfhi(rw.y)}; *(f32x4*)(co + k * 4096 + 4) = (f32x4){bflo(rw.z), bfhi(rw.z), bflo(rw.w), bfhi(rw.w)}; }
                }
                float win8[8];
                { const float* wp = wins + (lane < 32 ? (lane >> 3) : 0) * 64 + 8 * wave;
                  const f32x4 wa = *(const f32x4*)wp, wb = *(const f32x4*)(wp + 4);
                  win8[0] = wa[0]; win8[1] = wa[1]; win8[2] = wa[2]; win8[3] = wa[3]; win8[4] = wb[0]; win8[5] = wb[1]; win8[6] = wb[2]; win8[7] = wb[3]; }
#pragma unroll
                for (int hb = 0; hb < 2; ++hb) {
                    f32x4 wv[4], bvv;
#pragma unroll
                    for (int k = 0; k < 4; ++k) wv[k] = *(const f32x4*)(conv_w + k * 4096 + chbase + 4 * hb);
                    bvv = *(const f32x4*)(conv_b + chbase + 4 * hb);
                    unsigned pc[4][4];
#pragma unroll
                    for (int e4 = 0; e4 < 4; ++e4) {
                        const int e = 4 * hb + e4;
                        float xv[11];
#pragma unroll
                        for (int i = 0; i < 11; ++i) { const unsigned wd = raw[i][e >> 1]; xv[i] = (e & 1) ? bfhi(wd) : bflo(wd); }
                        const float w0 = wv[0][e4], w1 = wv[1][e4], w2 = wv[2][e4], w3 = wv[3][e4], bb = bvv[e4];
                        float o[8];
#pragma unroll
                        for (int j = 0; j < 8; ++j) o[j] = silu_f(bb + w0 * xv[j] + w1 * xv[j + 1] + w2 * xv[j + 2] + w3 * xv[j + 3]);
#pragma unroll
                        for (int j2 = 0; j2 < 4; ++j2) pc[e4][j2] = pk2(o[2 * j2], o[2 * j2 + 1]);
                        if (role == 0) {
                            *(u32x4*)(Xt + (8 * lane + e) * 72 + 8 * (wave ^ (lane & 7))) = (u32x4){pc[e4][0], pc[e4][1], pc[e4][2], pc[e4][3]};
                            *(u32x4*)(Xwt + (8 * lane + e) * 72 + 8 * (wave ^ (lane & 7))) = (u32x4){pk2(o[0] * win8[0], o[1] * win8[1]), pk2(o[2] * win8[2], o[3] * win8[3]), pk2(o[4] * win8[4], o[5] * win8[5]), pk2(o[6] * win8[6], o[7] * win8[7])};
                        } else if (role == 1) {
                            *(u32x4*)(Bt + (8 * (lane - 32) + e) * 72 + 8 * (wave ^ (lane & 7))) = (u32x4){pc[e4][0], pc[e4][1], pc[e4][2], pc[e4][3]};
                        }
                    }
                    if (role != 0) {
                        bf16* dst = (role == 1 ? Bs + 8 * (lane - 32) : Cs + 8 * (lane - 48)) + (8 * wave) * 136 + 4 * hb;
#pragma unroll
                        for (int j2 = 0; j2 < 4; ++j2) {
                            u32x2 lo, hi;
                            lo.x = __builtin_amdgcn_perm(pc[1][j2], pc[0][j2], 0x05040100u); hi.x = __builtin_amdgcn_perm(pc[1][j2], pc[0][j2], 0x07060302u);
                            lo.y = __builtin_amdgcn_perm(pc[3][j2], pc[2][j2], 0x05040100u); hi.y = __builtin_amdgcn_perm(pc[3][j2], pc[2][j2], 0x07060302u);
                            *(u32x2*)(dst + (2 * j2) * 136) = lo; *(u32x2*)(dst + (2 * j2 + 1) * 136) = hi;
                        }
                    }
                }
            }
            __syncthreads();
            bf16* zr0 = PROJ + (rowc + l31) * LDP + g * 256 + 64 * r + 32 * half + 4 * hh; bf16* zr1 = zr0 + (size_t)32 * LDP;
            if (tid < 256 && c + 1 < nchunks) dt_pf = DT[(rowc + 64 + lane) * 32 + g * 4 + wave];
            u32x2 zp0[4], zp1[4];
#pragma unroll
            for (int i4 = 0; i4 < 4; ++i4) { zp0[i4] = *(const u32x2*)(zr0 + 8 * i4); zp1[i4] = *(const u32x2*)(zr1 + 8 * i4); }
            f32x16 cb00, cb01, cb11;
#pragma unroll
            for (int i = 0; i < 16; ++i) { cb00[i] = 0.f; cb01[i] = 0.f; cb11[i] = 0.f; }
#pragma unroll
            for (int ns = 0; ns < 8; ++ns) {
                const bf16x8 a0 = *(const bf16x8*)(Bs + l31 * 136 + 16 * ns + 8 * hh), a1 = *(const bf16x8*)(Bs + (32 + l31) * 136 + 16 * ns + 8 * hh);
                const bf16x8 c0 = *(const bf16x8*)(Cs + l31 * 136 + 16 * ns + 8 * hh), c1 = *(const bf16x8*)(Cs + (32 + l31) * 136 + 16 * ns + 8 * hh);
                cb00 = MFMA32(a0, c0, cb00); cb01 = MFMA32(a0, c1, cb01); cb11 = MFMA32(a1, c1, cb11);
            }
            const float* cumr = cums + r * 64; const float* dtr = dts + r * 64;
            const float cum_t0 = cumr[l31], cum_t1 = cumr[32 + l31];
#pragma unroll
            for (int i4 = 0; i4 < 4; ++i4) {
                const f32x4 cs0 = *(const f32x4*)(cumr + 8 * i4 + 4 * hh), cs1 = *(const f32x4*)(cumr + 32 + 8 * i4 + 4 * hh);
                const f32x4 ds0 = *(const f32x4*)(dtr + 8 * i4 + 4 * hh), ds1 = *(const f32x4*)(dtr + 32 + 8 * i4 + 4 * hh);
#pragma unroll
                for (int j = 0; j < 4; ++j) { const int i = 4 * i4 + j, s = 8 * i4 + 4 * hh + j;
                    float v00 = cb00[i] * fexp2(fminf(cum_t0 - cs0[j], 0.f)) * ds0[j]; v00 = (s <= l31) ? v00 : 0.f; v00 += (s == l31) ? Dr : 0.f; cb00[i] = v00;
                    cb01[i] = cb01[i] * fexp2(fminf(cum_t1 - cs0[j], 0.f)) * ds0[j];
                    float v11 = cb11[i] * fexp2(fminf(cum_t1 - cs1[j], 0.f)) * ds1[j]; v11 = (s <= l31) ? v11 : 0.f; v11 += (s == l31) ? Dr : 0.f; cb11[i] = v11; }
            }
            f32x16 y0, y1;
#pragma unroll
            for (int i = 0; i < 16; ++i) { y0[i] = 0.f; y1[i] = 0.f; }
#pragma unroll
            for (int nb = 0; nb < 4; ++nb)
#pragma unroll
                for (int s2 = 0; s2 < 2; ++s2) {
                    const bf16x8 ha = pack8(hT[nb], s2);
                    const int n0 = 32 * nb + 16 * s2 + 4 * hh;
                    const s16x4 c0l = *(const s16x4*)(Cs + l31 * 136 + n0), c0h = *(const s16x4*)(Cs + l31 * 136 + n0 + 8);
                    const s16x4 c1l = *(const s16x4*)(Cs + (32 + l31) * 136 + n0), c1h = *(const s16x4*)(Cs + (32 + l31) * 136 + n0 + 8);
                    y0 = MFMA32(ha, __builtin_shufflevector(c0l, c0h, 0, 1, 2, 3, 4, 5, 6, 7), y0);
                    y1 = MFMA32(ha, __builtin_shufflevector(c1l, c1h, 0, 1, 2, 3, 4, 5, 6, 7), y1);
                }
            { const float e0 = fexp2(cum_t0), e1 = fexp2(cum_t1);
#pragma unroll
              for (int i = 0; i < 16; ++i) { y0[i] *= e0; y1[i] *= e1; } }
            { const bf16* xrow = Xt + (64 * r + 32 * half + l31) * 72;
#pragma unroll
              for (int s2 = 0; s2 < 2; ++s2) {
                  const int swx = 8 * ((4 * half + (l31 >> 3)) & 7);
                  const s16x4 x0l = *(const s16x4*)(xrow + ((16 * s2) ^ swx) + 4 * hh), x0h = *(const s16x4*)(xrow + ((16 * s2 + 8) ^ swx) + 4 * hh);
                  const s16x4 x1l = *(const s16x4*)(xrow + ((32 + 16 * s2) ^ swx) + 4 * hh), x1h = *(const s16x4*)(xrow + ((32 + 16 * s2 + 8) ^ swx) + 4 * hh);
                  const bf16x8 xa0 = __builtin_shufflevector(x0l, x0h, 0, 1, 2, 3, 4, 5, 6, 7), xa1 = __builtin_shufflevector(x1l, x1h, 0, 1, 2, 3, 4, 5, 6, 7);
                  y0 = MFMA32(xa0, pack8(cb00, s2), y0);
                  y1 = MFMA32(xa0, pack8(cb01, s2), y1);
                  y1 = MFMA32(xa1, pack8(cb11, s2), y1);
              } }
            {
                float ss0 = 0.f, ss1 = 0.f;
#pragma unroll
                for (int i4 = 0; i4 < 4; ++i4) {
                    const u32x2 z0 = zp0[i4], z1 = zp1[i4];
                    const float za[4] = {bflo(z0.x), bfhi(z0.x), bflo(z0.y), bfhi(z0.y)}, zb[4] = {bflo(z1.x), bfhi(z1.x), bflo(z1.y), bfhi(z1.y)};
#pragma unroll
                    for (int j = 0; j < 4; ++j) { const float v0 = y0[4 * i4 + j] * silu_f(za[j]), v1 = y1[4 * i4 + j] * silu_f(zb[j]); y0[4 * i4 + j] = v0; y1[4 * i4 + j] = v1; ss0 += v0 * v0; ss1 += v1 * v1; }
                }
                ss0 += __shfl_xor(ss0, 32); ss1 += __shfl_xor(ss1, 32);
                f32x4 nwv[4];
                { const float* nwp0 = norm_w + g * 256 + 64 * r + 32 * half + 4 * hh;
#pragma unroll
                  for (int i4 = 0; i4 < 4; ++i4) nwv[i4] = *(const f32x4*)(nwp0 + 8 * i4); }
                if (hh == 0) { part[l31 * 8 + wave] = ss0; part[(32 + l31) * 8 + wave] = ss1; }
                __syncthreads();
                const f32x4 pa = *(const f32x4*)(part + l31 * 8), pb = *(const f32x4*)(part + l31 * 8 + 4), pc = *(const f32x4*)(part + (32 + l31) * 8), pd = *(const f32x4*)(part + (32 + l31) * 8 + 4);
                const float t0 = ((pa[0] + pa[1]) + (pa[2] + pa[3])) + ((pb[0] + pb[1]) + (pb[2] + pb[3])), t1 = ((pc[0] + pc[1]) + (pc[2] + pc[3])) + ((pd[0] + pd[1]) + (pd[2] + pd[3]));
                const float r0 = 1.0f / sqrtf(t0 * (1.f / 256.f) + RMS_EPS), r1 = 1.0f / sqrtf(t1 * (1.f / 256.f) + RMS_EPS);
                const float* nwp = norm_w + g * 256 + 64 * r + 32 * half + 4 * hh;
#pragma unroll
                for (int i4 = 0; i4 < 4; ++i4) { const f32x4 nw = nwv[i4];
                    u32x2 w0; w0.x = pk2(y0[4 * i4] * r0 * nw[0], y0[4 * i4 + 1] * r0 * nw[1]); w0.y = pk2(y0[4 * i4 + 2] * r0 * nw[2], y0[4 * i4 + 3] * r0 * nw[3]); if (!dryXB) *(u32x2*)(zr0 + 8 * i4) = w0; else if (g < 4) *(u32x2*)(dryXB + (rowc + l31) * 1024 + g * 256 + 64 * r + 32 * half + 4 * hh + 8 * i4) = w0;
                    u32x2 w1; w1.x = pk2(y1[4 * i4] * r1 * nw[0], y1[4 * i4 + 1] * r1 * nw[1]); w1.y = pk2(y1[4 * i4 + 2] * r1 * nw[2], y1[4 * i4 + 3] * r1 * nw[3]); if (!dryXB) *(u32x2*)(zr1 + 8 * i4) = w1; else if (g < 4) *(u32x2*)(dryXB + (rowc + 32 + l31) * 1024 + g * 256 + 64 * r + 32 * half + 4 * hh + 8 * i4) = w1; }
            }
            { const float dec = fexp2(cumr[63]);
#pragma unroll
              for (int nb = 0; nb < 4; ++nb)
#pragma unroll
                  for (int i = 0; i < 16; ++i) hT[nb][i] *= dec;
              const bf16* xw = Xwt + (64 * r + 32 * half + l31) * 72; const int swx = 8 * ((4 * half + (l31 >> 3)) & 7), swn = 8 * (l31 >> 3);
#pragma unroll
              for (int ss = 0; ss < 4; ++ss) { const bf16x8 bx = *(const bf16x8*)(xw + ((16 * ss + 8 * hh) ^ swx));
#pragma unroll
                  for (int nb = 0; nb < 4; ++nb) { const bf16x8 af = *(const bf16x8*)(Bt + (32 * nb + l31) * 72 + ((16 * ss + 8 * hh) ^ swn ^ (32 * (nb & 1)))); hT[nb] = MFMA32(af, bx, hT[nb]); } }
            }
            __syncthreads();
        }
        { float* ho = outp + (smp ? O_HS : O_HP) + hoff;
#pragma unroll
          for (int nb = 0; nb < 4; ++nb)
#pragma unroll
              for (int i4 = 0; i4 < 4; ++i4) *(f32x4*)(ho + 32 * nb + 8 * i4) = (f32x4){hT[nb][4 * i4], hT[nb][4 * i4 + 1], hT[nb][4 * i4 + 2], hT[nb][4 * i4 + 3]};
          }
    }
}
__device__ __forceinline__ void sample_reduce_phase(const Frame& F, const float* SP, bf16* XB, const float* MR, const float* g, const float* b, float* ST) {
    const int gw = F.bid * 8 + F.wave, NGW = F.G * 8, lane = F.lane;
    for (int seg = gw; seg < MS * 4; seg += NGW) {
        const int rowl = seg >> 2, pn = seg & 3, t = (rowl >> 8) * 4 + pn, rl = rowl & 255; const unsigned row = (unsigned)(MP + rowl);
        const float* sp = SP + (size_t)(t * 8) * 65536 + (unsigned)(rl * 256 + 4 * lane);
        f32x4 p[8];
#pragma unroll
        for (int ks = 0; ks < 8; ++ks) p[ks] = *(const f32x4*)(sp + (size_t)ks * 65536);
        bf16* xp = XB + row * D + pn * 256 + 4 * lane;
        const u32x2 xw = *(const u32x2*)xp; const f32x2_t mr = *(const f32x2_t*)(MR + 2 * row);
        const f32x4 gg = *(const f32x4*)(g + pn * 256 + 4 * lane), bb = *(const f32x4*)(b + pn * 256 + 4 * lane);
        asm volatile("" ::: "memory");
        f32x4 acc = p[0];
#pragma unroll
        for (int ks = 1; ks < 8; ++ks) acc = acc + p[ks];
        f32x4 x = (f32x4){bflo(xw.x), bfhi(xw.x), bflo(xw.y), bfhi(xw.y)};
        x = (x - mr.x) * mr.y * gg + bb;
        const f32x4 v = x * ALPHA + acc;
        u32x2 w; w.x = pk2(v[0], v[1]); w.y = pk2(v[2], v[3]); *(u32x2*)xp = w;
        const float s1 = wave_sum((v[0] + v[1]) + (v[2] + v[3])), s2 = wave_sum((v[0] * v[0] + v[1] * v[1]) + (v[2] * v[2] + v[3] * v[3]));
        if (lane == 0) *(f32x2_t*)(ST + 8 * row + 2 * pn) = (f32x2_t){s1, s2};
    }
}

__global__ void __launch_bounds__(512, 2) fwd_megakernel(Args a) {
    extern __shared__ __attribute__((aligned(16))) unsigned char lds[];
    cg::grid_group grid = cg::this_grid();
    const int wv0 = __builtin_amdgcn_readfirstlane((int)threadIdx.x >> 6);
    Frame F; F.lds = lds; F.tid = threadIdx.x; F.lane = F.tid & 63; F.wave = __builtin_amdgcn_readfirstlane(F.tid >> 6); F.G = gridDim.x; F.bid = blockIdx.x;
    PG8_LAS unsigned char* glds = (PG8_LAS unsigned char*)lds;
    {
        int z = 0; asm volatile("" : "+s"(z));
        unsigned* bw = (unsigned*)AIN(24);
        if (blockIdx.x == 0) for (int i = threadIdx.x; i < XCD_BAR_WORDS; i += 512) __hip_atomic_store(bw + i, 0u, __ATOMIC_RELAXED, __HIP_MEMORY_SCOPE_AGENT);
        volatile LAS unsigned* st = (volatile LAS unsigned*)(glds + (LDS_BYTES - 16));
        if (threadIdx.x < 2) st[threadIdx.x] = 0u;
        __syncthreads();
        grid.sync();
        (void)xcd_barrier_post(bw, st);
    }
#ifndef REP_IN
#define REP_IN 1
#endif
#ifndef REP_ATT
#define REP_ATT 1
#endif
#ifndef REP_UP
#define REP_UP 1
#endif
#ifndef REP_CONV
#define REP_CONV 1
#endif
#ifndef REP_SYNC
#define REP_SYNC 1
#endif
    for (int ph = a.ph_lo; ph < a.ph_hi; ++ph) {
      const int sub_ = ph & 7; if (sub_ == 4) continue;
      {
        { int t_ = wv0 * 64 + lane_id_(); asm volatile("" : "+v"(t_)); F.tid = t_; F.lane = t_ & 63; F.wave = wv0; }
        { int g_ = (int)gridDim.x, b_ = (int)blockIdx.x; asm volatile("" : "+s"(g_), "+s"(b_)); F.G = g_; F.bid = b_; }
        int z = 0; asm volatile("" : "+s"(z));
        unsigned char* ws = (unsigned char*)AIN(24);
        bf16* WA = (bf16*)(ws + WS_WA); bf16* WB = (bf16*)(ws + WS_WB); bf16* WUP = (bf16*)(ws + WS_WUP); bf16* WDN = (bf16*)(ws + WS_WDN);
        bf16* XB = (bf16*)(ws + WS_XB); float* DT = (float*)(ws + WS_DT); bf16* BIG = (bf16*)(ws + WS_BIG);
        bf16* OB = (bf16*)(ws + WS_O); bf16* CK = (bf16*)(ws + WS_CK); bf16* CV = (bf16*)(ws + WS_CV);
        float* X = (float*)AIN(23);
        float* ST0 = (float*)(ws + WS_ST0); float* ST1 = (float*)(ws + WS_ST1);
        const int L = ph >> 3, sub = ph & 7, li = L >> 1; const bool ssm = (L & 1);
        if (sub == 0) {
#ifndef NO_CONV
 convert_phase(F, a, z, L);
#endif
 }
        else if (sub == 1) {
#if !defined(ONLY_SUB) || ONLY_SUB == 1
            pg8::StaticOrder S;
            if (!ssm) { pg8::Gemm g{XB, WA, M, 3072, D, D, D}; S.init(M, 3072, F.G, F.bid); pg8::EpiQKV E{BIG, X, li, L > 0 ? ST0 : (const float*)nullptr, (const float*)(ws + WS_CSA), (const float*)(ws + WS_BWA), (float*)(ws + WS_MR0), (PG8_LAS float*)(glds + 131072 + 8192)};
                pg8::gemm_phase<pg8::EpiQKV, pg8::StaticOrder, true, true>(glds, g, S, E, F.wave); }
            else { pg8::Gemm g{XB, WA, M, NPROJ_PAD, D, D, D}; S.init(M, NPROJ_PAD, F.G, F.bid); pg8::EpiSsmIn E{BIG, DT, ST0, (const float*)(ws + WS_CSA), (const float*)(ws + WS_BWA), (float*)(ws + WS_MR0), (PG8_LAS float*)(glds + 131072 + 8192)};
                pg8::gemm_phase<pg8::EpiSsmIn, pg8::StaticOrder, true, true>(glds, g, S, E, F.wave); }
#endif
        } else if (sub == 2) {
#ifndef NO_ATTN
            if (!ssm) attn_phase(F, AIN(7) + (size_t)li * 16 * 513, BIG, CK, CV, OB);
#endif
#ifndef NO_SSD
#ifdef PROBE_SSD
            if (ssm) for (int pass = 0; pass < 2; ++pass) { ssd_phase(F, a, z, li, BIG, DT, pass == 0 ? XB : nullptr);
                if (pass == 0) { XcdBarrier xb_; xb_.w0 = F.wave; xb_.bar = (unsigned*)AIN(24); xb_.x = xb_xcc_id(); xb_.st = (volatile LAS unsigned*)(glds + (LDS_BYTES - 16)); xcd_barrier(xb_); } }
#else
            if (ssm) ssd_phase(F, a, z, li, BIG, DT, nullptr);
#endif
#endif
        } else if (sub == 3) {
#if !defined(ONLY_SUB) || ONLY_SUB == 3
            pg8::StaticOrder S; S.init(M, D, F.G, F.bid); pg8::EpiResid E{XB, L > 0 ? (const float*)(ws + WS_MR0) : (const float*)nullptr, AIN(21) + (L > 0 ? L - 1 : 0) * D, AIN(22) + (L > 0 ? L - 1 : 0) * D, ST1, (PG8_LAS float*)(glds + 131072)};
#ifdef PROBE_S3
            { pg8::Gemm g0 = ssm ? pg8::Gemm{BIG, WB, M, D, 2048, LDP, 2048} : pg8::Gemm{OB, WB, M, D, D, D, D};
              pg8::EpiBf16Plain E0{ssm ? BIG + 2048 : BIG, ssm ? LDP : D, 0, (const float*)nullptr, (const float*)nullptr, (const float*)nullptr, (float*)nullptr, (PG8_LAS float*)(glds + 131072 + 8192)};
              pg8::gemm_phase<pg8::EpiBf16Plain, pg8::StaticOrder, true, true>(glds, g0, S, E0, F.wave);
              XcdBarrier xb_; xb_.w0 = F.wave; xb_.bar = (unsigned*)AIN(24); xb_.x = xb_xcc_id(); xb_.st = (volatile LAS unsigned*)(glds + (LDS_BYTES - 16)); xcd_barrier(xb_); }
#endif
            if (!ssm) { pg8::Gemm g{OB, WB, M, D, D, D, D}; pg8::gemm_phase<pg8::EpiResid, pg8::StaticOrder, true, true>(glds, g, S, E, F.wave); }
            else { pg8::Gemm g{BIG, WB, M, D, 2048, LDP, 2048}; pg8::gemm_phase<pg8::EpiResid, pg8::StaticOrder, true, true>(glds, g, S, E, F.wave); }
#endif
        } else if (sub == 4) ln_phase(F, X, XB, AIN(17) + L * D, AIN(18) + L * D);
        else if (sub == 5) {
#if !defined(ONLY_SUB) || ONLY_SUB == 5
 pg8::Gemm g{XB, WUP, M, DFF, D, D, D}; pg8::StaticOrder S; S.init(M, DFF, F.G, F.bid); pg8::EpiBf16Plain E{BIG, DFF, 1, ST1, (const float*)(ws + WS_CSU), (const float*)(ws + WS_BWU), (float*)(ws + WS_MR1), (PG8_LAS float*)(glds + 131072 + 8192)};
            pg8::gemm_phase<pg8::EpiBf16Plain, pg8::StaticOrder, true, true>(glds, g, S, E, F.wave);
#endif
 }
        else if (sub == 6) {
#if !defined(ONLY_SUB) || ONLY_SUB == 6
 pg8::Gemm g{BIG, WDN, M, D, DFF, DFF, DFF}; pg8::StaticOrder S; S.init(MP, D, F.G, F.bid);
#ifdef PROBE_DN
            { pg8::EpiBf16Plain E0{(bf16*)(ws + WS_CK), D, 0, (const float*)nullptr, (const float*)nullptr, (const float*)nullptr, (float*)nullptr, (PG8_LAS float*)(glds + 131072 + 8192)};
              pg8::gemm_phase<pg8::EpiBf16Plain, pg8::StaticOrder, true, true>(glds, g, S, E0, F.wave);
              XcdBarrier xb_; xb_.w0 = F.wave; xb_.bar = (unsigned*)AIN(24); xb_.x = xb_xcc_id(); xb_.st = (volatile LAS unsigned*)(glds + (LDS_BYTES - 16)); xcd_barrier(xb_); }
#endif
 pg8::EpiResid E{XB, (const float*)(ws + WS_MR1), AIN(17) + L * D, AIN(18) + L * D, ST0, (PG8_LAS float*)(glds + 131072)};
            pg8::gemm_phase<pg8::EpiResid, pg8::StaticOrder, true, true>(glds, g, S, E, F.wave);
            { pg8::Gemm g2{BIG, WDN, M, D, DFF / 8, DFF, DFF}; pg8::SplitOrder S2{F.G, F.bid}; pg8::EpiPartial E2{(float*)(ws + WS_CK)};
              pg8::gemm_phase<pg8::EpiPartial, pg8::SplitOrder, true, true>(glds, g2, S2, E2, F.wave); }
#endif
 }
        else { sample_reduce_phase(F, (const float*)(ws + WS_CK), XB, (const float*)(ws + WS_MR1), AIN(17) + L * D, AIN(18) + L * D, ST0);
            if (ph == 31) { { XcdBarrier xb_; xb_.w0 = F.wave; xb_.bar = (unsigned*)AIN(24); xb_.x = xb_xcc_id(); xb_.st = (volatile LAS unsigned*)(glds + (LDS_BYTES - 16)); xcd_barrier(xb_); }
                ln_phase(F, X, XB, AIN(21) + L * D, AIN(22) + L * D); } }
        if (ph + 1 < a.ph_hi) { XcdBarrier xb_; xb_.w0 = F.wave; xb_.bar = (unsigned*)AIN(24); xb_.x = xb_xcc_id(); xb_.st = (volatile LAS unsigned*)(glds + (LDS_BYTES - 16)); xcd_barrier(xb_); }
      }
    }
}

extern "C" void kernel_launch(void* const* d_in, const int* in_sizes, int n_in, void* d_out, int out_size, void* d_ws, size_t ws_size, hipStream_t stream) {
    static int grid = 0;
    if (grid == 0) {
        if (n_in != 23 || ws_size < WS_END2) { fprintf(stderr, "kernel_launch: need 23 inputs and %zu bytes of workspace, got %d and %zu\n", (size_t)WS_END2, n_in, ws_size); grid = -1; return; }
        int dev = 0, cus = 0, per_cu = 0;
        hipGetDevice(&dev); hipDeviceGetAttribute(&cus, hipDeviceAttributeMultiprocessorCount, dev);
        if (hipFuncSetAttribute((const void*)fwd_megakernel, hipFuncAttributeMaxDynamicSharedMemorySize, LDS_BYTES) != hipSuccess) { fprintf(stderr, "kernel_launch: hipFuncSetAttribute failed\n"); grid = -1; return; }
        if (hipOccupancyMaxActiveBlocksPerMultiprocessor(&per_cu, (const void*)fwd_megakernel, 512, LDS_BYTES) != hipSuccess || per_cu < 1) per_cu = 1;
        (void)hipGetLastError();
        grid = cus * per_cu;
        if (grid % 8 != 0) { fprintf(stderr, "kernel_launch: grid %d is not a multiple of 8\n", grid); grid = -1; return; }
    }
    if (grid < 0) return;
    Args a{};
    for (int i = 0; i < 23; ++i) a.in[i] = (const float*)d_in[i];
    a.in[23] = (const float*)d_out; a.in[24] = (const float*)d_ws; a.ph_lo = 0; a.ph_hi = 32;
    void* args[] = {&a};
    hipError_t e = hipLaunchCooperativeKernel((const void*)fwd_megakernel, dim3(grid), dim3(512), args, LDS_BYTES, stream);
    if (e != hipSuccess) fprintf(stderr, "cooperative launch failed: %s (grid %d)\n", hipGetErrorString(e), grid);
}
```
